# Optimizing an MI355X kernel written in HIP

```python
import math
import jax
import jax.numpy as jnp
from jax import lax
import numpy as np

D_MODEL = 2048
BATCH = 4
SEQ = 2048
DEPTH = 2

CHUNK = 64
D_MIX = D_MODEL
N_MIXERS = 4
GROUP_W = D_MIX // N_MIXERS
NORM_EPS = 1e-6

GLA_HEADS = 4
GLA_DV = GROUP_W // GLA_HEADS
GLA_DK = GLA_DV // 2
GLA_GATE_RANK = 16
GLA_GATE_NORMALIZER = 16.0

RWKV_HEAD = 64
RWKV_HEADS = GROUP_W // RWKV_HEAD
RWKV_W_RANK = 64
RWKV_A_RANK = 64
RWKV_V_RANK = 32
RWKV_LN_EPS = 64e-5
RWKV_DECAY_OFFSET = 0.5

SSD_HEADDIM = 64
SSD_HEADS = GROUP_W // SSD_HEADDIM
SSD_GROUPS = 2
SSD_STATE = 128
SSD_CONV = 4
SSD_XBC = GROUP_W + 2 * SSD_GROUPS * SSD_STATE

MLSTM_HEADS = 4
MLSTM_HEAD = GROUP_W // MLSTM_HEADS
MLSTM_CONV = 4

kernel_name = 'hybrid_gla_rwkv7_ssd_mlstm_heads'


def rwkv_shift_width(layer):
    return 3 * GROUP_W + RWKV_W_RANK + RWKV_A_RANK + (RWKV_V_RANK if layer > 0 else 0)


def in_layout(layer):
    return (('gla_q', GLA_HEADS * GLA_DK), ('gla_k', GLA_HEADS * GLA_DK), ('gla_v', GROUP_W),
            ('gla_gk', GLA_GATE_RANK), ('gla_z', GROUP_W),
            ('rwkv_shift', rwkv_shift_width(layer)), ('rwkv_z', GROUP_W),
            ('ssd_xbc', SSD_XBC), ('ssd_dt', SSD_HEADS), ('ssd_z', GROUP_W),
            ('mlstm_qk', 2 * GROUP_W), ('mlstm_v', GROUP_W), ('mlstm_i', MLSTM_HEADS),
            ('mlstm_f', MLSTM_HEADS), ('mlstm_o', GROUP_W), ('mlstm_z', GROUP_W))


def split_cols(proj, layout):
    idx = np.cumsum([w for _, w in layout])[:-1].tolist()
    parts = jnp.split(proj, idx, axis=-1)
    return {name: part for (name, _), part in zip(layout, parts)}


def rms_norm(x, g, eps=NORM_EPS):
    xf = x.astype(jnp.float32)
    y = xf * lax.rsqrt(jnp.mean(xf * xf, axis=-1, keepdims=True) + eps)
    return (y * g.astype(jnp.float32)).astype(x.dtype)


def head_rms_norm(y, g, eps=NORM_EPS):
    y = y * lax.rsqrt(jnp.mean(y * y, axis=-1, keepdims=True) + eps)
    return y * g.astype(jnp.float32).reshape(y.shape[-2:])


def head_layer_norm(y, g, eps):
    mu = jnp.mean(y, axis=-1, keepdims=True)
    yc = y - mu
    y = yc * lax.rsqrt(jnp.mean(yc * yc, axis=-1, keepdims=True) + eps)
    return y * g.astype(jnp.float32).reshape(y.shape[-2:])


def causal_depthwise_conv(x, w, b):
    k = w.shape[0]
    y = lax.conv_general_dilated(x, w[:, None, :].astype(x.dtype), window_strides=(1,),
                                 padding=[(k - 1, 0)], dimension_numbers=('NWC', 'WIO', 'NWC'),
                                 feature_group_count=x.shape[-1])
    return y + b.astype(x.dtype)


def token_shift(x):
    return jnp.pad(x, ((0, 0), (1, 0), (0, 0)))[:, :-1]


def causal_mask():
    return jnp.tril(jnp.ones((CHUNK, CHUNK), dtype=bool))


def chunk_state_scan(decay, inc):
    def step(state, xs):
        d, u = xs
        return d * state + u, state
    _, prev = lax.scan(step, jnp.zeros_like(inc[0]), (decay, inc))
    return prev


def gla_mixer(q, k, v, gk_low, z, gk_w2, gk_b, norm_g):
    f32 = jnp.float32
    B, S, _ = q.shape
    nc = S // CHUNK
    q = q.astype(f32).reshape(B, nc, CHUNK, GLA_HEADS, GLA_DK) * GLA_DK ** -0.5
    k = k.astype(f32).reshape(B, nc, CHUNK, GLA_HEADS, GLA_DK)
    v = v.astype(f32).reshape(B, nc, CHUNK, GLA_HEADS, GLA_DV)
    gk = gk_low.astype(f32) @ gk_w2.astype(f32) + gk_b.astype(f32)
    log_a = jax.nn.log_sigmoid(gk).reshape(B, nc, CHUNK, GLA_HEADS, GLA_DK) / GLA_GATE_NORMALIZER
    cum = jnp.cumsum(log_a, axis=2)
    last = cum[:, :, -1:]
    qg = q * jnp.exp(cum)
    kg = k * jnp.exp(-cum)
    kd = k * jnp.exp(last - cum)
    att = jnp.where(causal_mask(), jnp.einsum('bnlhd,bnshd->bnhls', qg, kg), 0.0)
    o = jnp.einsum('bnhls,bnshv->bnlhv', att, v)
    inc = jnp.einsum('bnshd,bnshv->nbhdv', kd, v)
    decay = jnp.exp(last[:, :, 0]).transpose(1, 0, 2, 3)[..., None]
    s_prev = chunk_state_scan(decay, inc)
    o = o + jnp.einsum('bnlhd,nbhdv->bnlhv', qg, s_prev)
    o = head_rms_norm(o.reshape(B, S, GLA_HEADS, GLA_DV), norm_g)
    return o.reshape(B, S, GROUP_W) * jax.nn.silu(z.astype(f32))


def rwkv7_mixer(feats, z, v_first, mu, w0, w2, a0, a2, k_k, k_a, r_k, ln_g, ln_b, v0, v2):
    f32 = jnp.float32
    B, S, _ = feats.shape
    f = feats.astype(f32)
    f = f + mu.astype(f32) * (token_shift(f) - f)
    widths = [GROUP_W, GROUP_W, GROUP_W, RWKV_W_RANK, RWKV_A_RANK] + ([] if v0 is None else [RWKV_V_RANK])
    parts = jnp.split(f, np.cumsum(widths)[:-1].tolist(), axis=-1)
    r, k, v, wl, al = parts[:5]
    w_log = -jax.nn.softplus(-(w0 + jnp.tanh(wl) @ w2)) - RWKV_DECAY_OFFSET
    decay = jnp.exp(-jnp.exp(w_log))
    a = jax.nn.sigmoid(a0 + al @ a2)
    if v0 is None:
        v_first = v
    else:
        v = v + (v_first - v) * jax.nn.sigmoid(v0 + parts[5] @ v2)
    hs = lambda t: t.reshape(B, S, RWKV_HEADS, RWKV_HEAD)
    kk = hs(k * k_k)
    kk = kk / jnp.maximum(jnp.sqrt(jnp.sum(kk * kk, axis=-1, keepdims=True)), 1e-12)
    k = k * (1.0 + (a - 1.0) * k_a)
    r, k, v, decay, a = hs(r), hs(k), hs(v), hs(decay), hs(a)
    b_vec = kk * a

    def step(state, xs):
        r_t, k_t, v_t, w_t, kk_t, b_t = xs
        sa = jnp.einsum('bhij,bhj->bhi', state, -kk_t)
        state = (state * w_t[:, :, None, :] + sa[..., None] * b_t[:, :, None, :]
                 + v_t[..., None] * k_t[:, :, None, :])
        return state, jnp.einsum('bhij,bhj->bhi', state, r_t)

    xs = tuple(t.transpose(1, 0, 2, 3) for t in (r, k, v, decay, kk, b_vec))
    init = jnp.zeros((B, RWKV_HEADS, RWKV_HEAD, RWKV_HEAD), f32)
    _, y = lax.scan(step, init, xs)
    y = y.transpose(1, 0, 2, 3)
    y = head_layer_norm(y, ln_g, RWKV_LN_EPS) + ln_b.astype(f32).reshape(RWKV_HEADS, RWKV_HEAD)
    bonus = jnp.sum(r * k * r_k.astype(f32), axis=-1, keepdims=True) * v
    y = (y + bonus).reshape(B, S, GROUP_W) * jax.nn.silu(z.astype(f32))
    return y, v_first


def ssd_mixer(xbc, dt_raw, z, conv_w, conv_b, dt_bias, a_log, d_skip, norm_g):
    f32 = jnp.float32
    B, S, _ = xbc.shape
    nc = S // CHUNK
    E = SSD_HEADS // SSD_GROUPS
    xbc = jax.nn.silu(causal_depthwise_conv(xbc.astype(f32), conv_w.astype(f32), conv_b.astype(f32)))
    x, bm, cm = jnp.split(xbc, [GROUP_W, GROUP_W + SSD_GROUPS * SSD_STATE], axis=-1)
    dt = jax.nn.softplus(dt_raw.astype(f32) + dt_bias.astype(f32))
    a = -jnp.exp(a_log.astype(f32))
    x = x.reshape(B, S, SSD_HEADS, SSD_HEADDIM)
    xdt = (x * dt[..., None]).reshape(B, nc, CHUNK, SSD_GROUPS, E, SSD_HEADDIM)
    bm = bm.reshape(B, nc, CHUNK, SSD_GROUPS, SSD_STATE)
    cm = cm.reshape(B, nc, CHUNK, SSD_GROUPS, SSD_STATE)
    cum = jnp.cumsum((dt * a).reshape(B, nc, CHUNK, SSD_GROUPS, E), axis=2)
    cum_t = cum.transpose(0, 1, 3, 4, 2)
    seg = cum_t[..., :, None] - cum_t[..., None, :]
    L = jnp.exp(jnp.where(causal_mask(), seg, -jnp.inf))
    cb = jnp.einsum('bnlgs,bnmgs->bnglm', cm, bm)
    y = jnp.einsum('bnglm,bngelm,bnmgep->bnlgep', cb, L, xdt)
    last = cum[:, :, -1:]
    inc = jnp.einsum('bnmgs,bnmge,bnmgep->nbgeps', bm, jnp.exp(last - cum), xdt)
    decay = jnp.exp(last[:, :, 0]).transpose(1, 0, 2, 3)[..., None, None]
    s_prev = chunk_state_scan(decay, inc)
    y = y + jnp.einsum('bnlgs,nbgeps,bnlge->bnlgep', cm, s_prev, jnp.exp(cum))
    y = y.reshape(B, S, SSD_HEADS, SSD_HEADDIM) + d_skip.astype(f32)[:, None] * x
    y = y.reshape(B, S, GROUP_W) * jax.nn.silu(z.astype(f32))
    return rms_norm(y, norm_g)


def mlstm_mixer(qk, v, i_pre, f_pre, o_pre, z, conv_w, conv_b, ig_b, fg_b, norm_g):
    f32 = jnp.float32
    B, S, _ = qk.shape
    nc = S // CHUNK
    H, Dh = MLSTM_HEADS, MLSTM_HEAD
    qk = jax.nn.silu(causal_depthwise_conv(qk.astype(f32), conv_w.astype(f32), conv_b.astype(f32)))
    q, k = jnp.split(qk, 2, axis=-1)
    q = q.reshape(B, nc, CHUNK, H, Dh)
    k = k.reshape(B, nc, CHUNK, H, Dh) * Dh ** -0.5
    v = v.astype(f32).reshape(B, nc, CHUNK, H, Dh)
    log_i = (i_pre.astype(f32) + ig_b.astype(f32)).reshape(B, nc, CHUNK, H)
    log_f = jax.nn.log_sigmoid(f_pre.astype(f32) + fg_b.astype(f32)).reshape(B, nc, CHUNK, H)
    cum = jnp.cumsum(log_f, axis=2)
    last = cum[:, :, -1]
    g = last[:, :, None] - cum + log_i
    g_max = jnp.max(g, axis=2)
    w_end = jnp.exp(g - g_max[:, :, None])
    c_loc = jnp.einsum('bnsh,bnshd,bnshe->nbhde', w_end, k, v)
    n_loc = jnp.einsum('bnsh,bnshd->nbhd', w_end, k)

    def step(carry, xs):
        c, n, m = carry
        lf, gm, cl, nl = xs
        m_new = jnp.maximum(lf + m, gm)
        a_old = jnp.exp(lf + m - m_new)
        a_new = jnp.exp(gm - m_new)
        c_new = a_old[..., None, None] * c + a_new[..., None, None] * cl
        n_new = a_old[..., None] * n + a_new[..., None] * nl
        return (c_new, n_new, m_new), (c, n, m)

    init = (jnp.zeros((B, H, Dh, Dh), f32), jnp.zeros((B, H, Dh), f32), jnp.zeros((B, H), f32))
    _, (c_prev, n_prev, m_prev) = lax.scan(
        step, init, (last.transpose(1, 0, 2), g_max.transpose(1, 0, 2), c_loc, n_loc))
    cum_t = cum.transpose(0, 1, 3, 2)
    log_d = cum_t[..., :, None] - cum_t[..., None, :] + log_i.transpose(0, 1, 3, 2)[..., None, :]
    log_d = jnp.where(causal_mask(), log_d, -jnp.inf)
    m_inter = cum_t + m_prev.transpose(1, 0, 2)[..., None]
    m_l = jnp.maximum(m_inter, jnp.max(log_d, axis=-1))
    wqk = jnp.einsum('bnlhd,bnshd->bnhls', q, k) * jnp.exp(log_d - m_l[..., None])
    w_inter = jnp.exp(m_inter - m_l)
    num = (jnp.einsum('bnhls,bnshe->bnlhe', wqk, v)
           + w_inter.transpose(0, 1, 3, 2)[..., None] * jnp.einsum('bnlhd,nbhde->bnlhe', q, c_prev))
    den = jnp.sum(wqk, axis=-1) + w_inter * jnp.einsum('bnlhd,nbhd->bnhl', q, n_prev)
    den = jnp.maximum(jnp.abs(den), jnp.exp(-m_l))
    h = num / den.transpose(0, 1, 3, 2)[..., None]
    h = h.reshape(B, S, H, Dh) * jax.nn.sigmoid(o_pre.astype(f32)).reshape(B, S, H, Dh)
    h = head_layer_norm(h, norm_g, NORM_EPS)
    return h.reshape(B, S, GROUP_W) * jax.nn.silu(z.astype(f32))


def hybrid_layer(x, v_first, layer, p):
    h = rms_norm(x, p['norm_g'])
    c = split_cols(h @ p['w_in'], in_layout(layer))
    y_gla = gla_mixer(c['gla_q'], c['gla_k'], c['gla_v'], c['gla_gk'], c['gla_z'],
                      p['gla_gk_w2'], p['gla_gk_b'], p['gla_norm_g'])
    y_rwkv, v_first = rwkv7_mixer(c['rwkv_shift'], c['rwkv_z'], v_first, p['rwkv_mu'],
                                  p['rwkv_w0'], p['rwkv_w2'], p['rwkv_a0'], p['rwkv_a2'],
                                  p['rwkv_k_k'], p['rwkv_k_a'], p['rwkv_r_k'],
                                  p['rwkv_ln_g'], p['rwkv_ln_b'], p['rwkv_v0'], p['rwkv_v2'])
    y_ssd = ssd_mixer(c['ssd_xbc'], c['ssd_dt'], c['ssd_z'], p['ssd_conv_w'], p['ssd_conv_b'],
                      p['ssd_dt_bias'], p['ssd_a_log'], p['ssd_d'], p['ssd_norm_g'])
    y_mlstm = mlstm_mixer(c['mlstm_qk'], c['mlstm_v'], c['mlstm_i'], c['mlstm_f'], c['mlstm_o'],
                          c['mlstm_z'], p['mlstm_conv_w'], p['mlstm_conv_b'], p['mlstm_ig_b'],
                          p['mlstm_fg_b'], p['mlstm_norm_g'])
    y = jnp.concatenate([y_gla, y_rwkv, y_ssd, y_mlstm], axis=-1).astype(x.dtype)
    return x + y @ p['w_out'], v_first


def setup_inputs(seed: int = 0) -> dict:
    key = jax.random.key(seed)
    keys = iter(jax.random.split(key, 128))
    normal = lambda shape, scale: scale * jax.random.normal(next(keys), shape, jnp.float32)
    gain = lambda n: 1.0 + normal((n,), 0.02)
    inputs = {'x': normal((BATCH, SEQ, D_MODEL), 1.0)}
    for l in range(DEPTH):
        n_in = sum(w for _, w in in_layout(l))
        p = {}
        p['norm_g'] = gain(D_MODEL)
        p['w_in'] = normal((D_MODEL, n_in), D_MODEL ** -0.5)
        p['w_out'] = normal((D_MIX, D_MODEL), 0.5 * D_MIX ** -0.5)
        p['gla_gk_w2'] = normal((GLA_GATE_RANK, GLA_HEADS * GLA_DK), GLA_GATE_RANK ** -0.5)
        p['gla_gk_b'] = normal((GLA_HEADS * GLA_DK,), 0.1)
        p['gla_norm_g'] = gain(GROUP_W)
        p['rwkv_mu'] = jax.random.uniform(next(keys), (rwkv_shift_width(l),), jnp.float32)
        p['rwkv_w0'] = normal((GROUP_W,), 0.5)
        p['rwkv_w2'] = normal((RWKV_W_RANK, GROUP_W), 0.1)
        p['rwkv_a0'] = normal((GROUP_W,), 0.1)
        p['rwkv_a2'] = normal((RWKV_A_RANK, GROUP_W), 0.1)
        if l > 0:
            p['rwkv_v0'] = normal((GROUP_W,), 0.1)
            p['rwkv_v2'] = normal((RWKV_V_RANK, GROUP_W), 0.1)
        p['rwkv_k_k'] = 0.85 + normal((GROUP_W,), 0.02)
        p['rwkv_k_a'] = 1.0 + normal((GROUP_W,), 0.02)
        p['rwkv_r_k'] = normal((RWKV_HEADS, RWKV_HEAD), 0.1)
        p['rwkv_ln_g'] = gain(GROUP_W)
        p['rwkv_ln_b'] = normal((GROUP_W,), 0.02)
        p['ssd_conv_w'] = normal((SSD_CONV, SSD_XBC), SSD_CONV ** -0.5)
        p['ssd_conv_b'] = normal((SSD_XBC,), 0.02)
        dt0 = jnp.exp(jax.random.uniform(next(keys), (SSD_HEADS,), jnp.float32,
                                         math.log(1e-3), math.log(1e-1)))
        p['ssd_dt_bias'] = dt0 + jnp.log(-jnp.expm1(-dt0))
        p['ssd_a_log'] = jnp.log(jax.random.uniform(next(keys), (SSD_HEADS,), jnp.float32, 1.0, 16.0))
        p['ssd_d'] = 1.0 + normal((SSD_HEADS,), 0.1)
        p['ssd_norm_g'] = gain(GROUP_W)
        p['mlstm_conv_w'] = normal((MLSTM_CONV, 2 * GROUP_W), MLSTM_CONV ** -0.5)
        p['mlstm_conv_b'] = normal((2 * GROUP_W,), 0.02)
        p['mlstm_ig_b'] = normal((MLSTM_HEADS,), 0.1)
        p['mlstm_fg_b'] = jnp.linspace(3.0, 6.0, MLSTM_HEADS, dtype=jnp.float32) + normal((MLSTM_HEADS,), 0.1)
        p['mlstm_norm_g'] = gain(GROUP_W)
        for name, val in p.items():
            inputs[name + '_' + str(l)] = val
    inputs['final_norm_g'] = gain(D_MODEL)
    return inputs


def reference(x,
              norm_g_0, w_in_0, w_out_0, gla_gk_w2_0, gla_gk_b_0, gla_norm_g_0,
              rwkv_mu_0, rwkv_w0_0, rwkv_w2_0, rwkv_a0_0, rwkv_a2_0,
              rwkv_k_k_0, rwkv_k_a_0, rwkv_r_k_0, rwkv_ln_g_0, rwkv_ln_b_0,
              ssd_conv_w_0, ssd_conv_b_0, ssd_dt_bias_0, ssd_a_log_0, ssd_d_0, ssd_norm_g_0,
              mlstm_conv_w_0, mlstm_conv_b_0, mlstm_ig_b_0, mlstm_fg_b_0, mlstm_norm_g_0,
              norm_g_1, w_in_1, w_out_1, gla_gk_w2_1, gla_gk_b_1, gla_norm_g_1,
              rwkv_mu_1, rwkv_w0_1, rwkv_w2_1, rwkv_a0_1, rwkv_a2_1, rwkv_v0_1, rwkv_v2_1,
              rwkv_k_k_1, rwkv_k_a_1, rwkv_r_k_1, rwkv_ln_g_1, rwkv_ln_b_1,
              ssd_conv_w_1, ssd_conv_b_1, ssd_dt_bias_1, ssd_a_log_1, ssd_d_1, ssd_norm_g_1,
              mlstm_conv_w_1, mlstm_conv_b_1, mlstm_ig_b_1, mlstm_fg_b_1, mlstm_norm_g_1,
              final_norm_g):
    layers = [
        dict(norm_g=norm_g_0, w_in=w_in_0, w_out=w_out_0, gla_gk_w2=gla_gk_w2_0, gla_gk_b=gla_gk_b_0,
             gla_norm_g=gla_norm_g_0, rwkv_mu=rwkv_mu_0, rwkv_w0=rwkv_w0_0, rwkv_w2=rwkv_w2_0,
             rwkv_a0=rwkv_a0_0, rwkv_a2=rwkv_a2_0, rwkv_v0=None, rwkv_v2=None,
             rwkv_k_k=rwkv_k_k_0, rwkv_k_a=rwkv_k_a_0, rwkv_r_k=rwkv_r_k_0, rwkv_ln_g=rwkv_ln_g_0,
             rwkv_ln_b=rwkv_ln_b_0, ssd_conv_w=ssd_conv_w_0, ssd_conv_b=ssd_conv_b_0,
             ssd_dt_bias=ssd_dt_bias_0, ssd_a_log=ssd_a_log_0, ssd_d=ssd_d_0, ssd_norm_g=ssd_norm_g_0,
             mlstm_conv_w=mlstm_conv_w_0, mlstm_conv_b=mlstm_conv_b_0, mlstm_ig_b=mlstm_ig_b_0,
             mlstm_fg_b=mlstm_fg_b_0, mlstm_norm_g=mlstm_norm_g_0),
        dict(norm_g=norm_g_1, w_in=w_in_1, w_out=w_out_1, gla_gk_w2=gla_gk_w2_1, gla_gk_b=gla_gk_b_1,
             gla_norm_g=gla_norm_g_1, rwkv_mu=rwkv_mu_1, rwkv_w0=rwkv_w0_1, rwkv_w2=rwkv_w2_1,
             rwkv_a0=rwkv_a0_1, rwkv_a2=rwkv_a2_1, rwkv_v0=rwkv_v0_1, rwkv_v2=rwkv_v2_1,
             rwkv_k_k=rwkv_k_k_1, rwkv_k_a=rwkv_k_a_1, rwkv_r_k=rwkv_r_k_1, rwkv_ln_g=rwkv_ln_g_1,
             rwkv_ln_b=rwkv_ln_b_1, ssd_conv_w=ssd_conv_w_1, ssd_conv_b=ssd_conv_b_1,
             ssd_dt_bias=ssd_dt_bias_1, ssd_a_log=ssd_a_log_1, ssd_d=ssd_d_1, ssd_norm_g=ssd_norm_g_1,
             mlstm_conv_w=mlstm_conv_w_1, mlstm_conv_b=mlstm_conv_b_1, mlstm_ig_b=mlstm_ig_b_1,
             mlstm_fg_b=mlstm_fg_b_1, mlstm_norm_g=mlstm_norm_g_1),
    ]
    v_first = None
    for layer in range(DEPTH):
        x, v_first = hybrid_layer(x, v_first, layer, layers[layer])
    return rms_norm(x, final_norm_g)
```

```cpp
#include <hip/hip_runtime.h>
#include <hip/hip_cooperative_groups.h>
#include <cstdio>
namespace cg = cooperative_groups;

namespace pg8 {
#define PG8_LAS __attribute__((address_space(3)))
typedef unsigned short bf16_t;
typedef short bf16x8 __attribute__((ext_vector_type(8)));
typedef float f32x4 __attribute__((ext_vector_type(4)));
typedef unsigned u32x4 __attribute__((ext_vector_type(4)));
constexpr int BM = 256, BK = 64, HALF = 128, HTB = HALF * BK * 2  , STAGE_BYTES = 8 * HTB, NXCD = 8, WGM = 8;

__host__ __device__ __forceinline__ int lds_byte(int r, int c) { const int st = (r >> 4) * 2 + (c >> 5), rr = r & 15, cc = c & 31, ob = rr * 64 + cc * 2; return st * 1024 + (ob ^ (((ob >> 9) & 1) << 5)); }
__host__ __device__ __forceinline__ void stage_rc(int b, int& R, int& C) { const int st = b / 1024, sb = b % 1024, swz = sb ^ (((sb >> 9) & 1) << 5); R = (st >> 1) * 16 + swz / 64; C = (st & 1) * 32 + (swz % 64) / 2; }
__host__ __device__ __forceinline__ int perm32(int rho) { const int n = rho >> 4, i = rho & 15; return 8 * (i >> 2) + 4 * n + (i & 3); }

struct Unit { int pm, pn; };
struct Gemm { const bf16_t* A; const bf16_t* Bt; int M, N, K; };

struct StaticOrder {
    int nM, nN, nwg, G, c;
    __host__ __device__ void init(int M, int N, int G_, int c_) { nM = M / BM; nN = N / BM; nwg = nM * nN; G = G_; c = c_; }
    __host__ __device__ bool next(int i, Unit& u) const {
        const long L = (long)i * G + c; if (L >= nwg) return false;
        int wgid = (int)L; { const int q = nwg / NXCD, r = nwg % NXCD, xcd = wgid % NXCD, off = wgid / NXCD; wgid = (xcd < r ? xcd * (q + 1) : r * (q + 1) + (xcd - r) * q) + off; }
        const int nig = WGM * nN, gid = wgid / nig, fm = gid * WGM, gsz = (nM - fm) < WGM ? (nM - fm) : WGM;
        u.pm = fm + ((wgid % nig) % gsz); u.pn = (wgid % nig) / gsz; return true;
    }
    __device__ __forceinline__ void a_ready(const Unit&) const {}
    __device__ __forceinline__ void done(const Unit&) const {}
};
__device__ __forceinline__ unsigned cvt_pk_bf16(float lo, float hi) { unsigned r; asm volatile("v_cvt_pk_bf16_f32 %0, %1, %2" : "=v"(r) : "v"(lo), "v"(hi)); return r; }
template <class Epi, class Sched, bool STAMP = false>
__device__ __forceinline__ void gemm_phase(PG8_LAS unsigned char* lds, const Gemm g, const Sched& S, const Epi& E, unsigned long long* stamps) {
    const int tid = threadIdx.x, wid = __builtin_amdgcn_readfirstlane(tid >> 6), lane = tid & 63, wr = wid >> 2, wc = wid & 3, fr = lane & 15, fq = lane >> 4;
    const int K = g.K, nt = K / BK;
    int ts_lo = 0, ts_hi = 0, nts = 0; const unsigned long long rt_entry = STAMP ? (unsigned long long)wall_clock64() : 0ull;
#define PG8_STAMP() do { if (STAMP && wid == 0 && nts < 64) { const unsigned long long _c = (unsigned long long)clock64(); \
        ts_lo = (lane == nts) ? (int)(unsigned)_c : ts_lo; ts_hi = (lane == nts) ? (int)(unsigned)(_c >> 32) : ts_hi; ++nts; } } while (0)
    PG8_STAMP();
    unsigned voffA[2], voffB[2];
#pragma unroll
    for (int i = 0; i < 2; ++i) { int R, C; stage_rc(tid * 16 + i * 8192, R, C); const int Rb = Epi::PERM ? ((R & ~31) + perm32(R & 31)) : R;
        voffA[i] = (unsigned)(R * K + C) * 2u; voffB[i] = (unsigned)(Rb * K + C) * 2u; }
    const size_t kstep = (size_t)(BK * 2);
    const size_t hstep = (size_t)HALF * K * 2;
    const size_t tstep = 2 * hstep;
    const unsigned ldsw = (unsigned)wid * 1024u;
    const int aoff = lds_byte(wr * 64 + fr, fq * 8), boff = lds_byte(wc * 32 + fr, fq * 8);
#define PG8_SA(b, h) (((b) * 2 + (h)) * HTB)
#define PG8_SB(b, h) ((4 + (b) * 2 + (h)) * HTB)
#define PG8_STAGE(bufoff, gbase, voff) do { _Pragma("unroll") for (int _i = 0; _i < 2; ++_i) \
        __builtin_amdgcn_global_load_lds((const unsigned*)((const char*)(gbase) + (voff)[_i]), (PG8_LAS unsigned*)(lds + (bufoff) + ldsw + _i * 8192), 16, 0, 0); } while (0)
#define PG8_LDA(dst, b, h) do { _Pragma("unroll") for (int m = 0; m < 4; ++m) _Pragma("unroll") for (int k = 0; k < 2; ++k) dst[m][k] = *(const PG8_LAS bf16x8*)(lds + PG8_SA(b, h) + aoff + m * 2048 + k * 1024); } while (0)
#define PG8_LDB(dst, b, h) do { _Pragma("unroll") for (int n = 0; n < 2; ++n) _Pragma("unroll") for (int k = 0; k < 2; ++k) dst[n][k] = *(const PG8_LAS bf16x8*)(lds + PG8_SB(b, h) + boff + n * 2048 + k * 1024); } while (0)
#define PG8_MMA(ai, bj, At, Bt) do { __builtin_amdgcn_s_setprio(1); _Pragma("unroll") for (int m = 0; m < 4; ++m) _Pragma("unroll") for (int n = 0; n < 2; ++n) _Pragma("unroll") for (int k = 0; k < 2; ++k) \
        acc[ai][bj][m][n] = __builtin_amdgcn_mfma_f32_16x16x32_bf16(Bt[n][k], At[m][k], acc[ai][bj][m][n], 0, 0, 0); __builtin_amdgcn_s_setprio(0); } while (0)
#define PG8_WAIT_V(n) asm volatile("s_waitcnt vmcnt(" #n ")" ::: "memory")
#define PG8_WAIT_L(n) asm volatile("s_waitcnt lgkmcnt(" #n ")" ::: "memory")
#define PG8_BAR __builtin_amdgcn_s_barrier()
#define PG8_SCHED __builtin_amdgcn_sched_barrier(0)
    Unit cur, nxt; int ui = 0;
    if (!S.next(0, cur)) return;
    f32x4 acc[2][2][4][2];
#pragma unroll
    for (int a = 0; a < 2; ++a)
#pragma unroll
        for (int b = 0; b < 2; ++b)
#pragma unroll
            for (int m = 0; m < 4; ++m)
#pragma unroll
                for (int n = 0; n < 2; ++n) acc[a][b][m][n] = (f32x4){0.f, 0.f, 0.f, 0.f};
    bf16x8 At[4][2], B0[2][2], B1[2][2];
    const char* cA = (const char*)g.A + (size_t)cur.pm * tstep; const char* cB = (const char*)g.Bt + (size_t)cur.pn * tstep;
    S.a_ready(cur);
    PG8_STAGE(PG8_SB(0, 0), cB, voffB); PG8_STAGE(PG8_SA(0, 0), cA, voffA); PG8_STAGE(PG8_SB(0, 1), cB + hstep, voffB); PG8_STAGE(PG8_SA(0, 1), cA + hstep, voffA);
    if (wr == 1) PG8_BAR;
    PG8_WAIT_V(4); PG8_BAR;
    PG8_STAGE(PG8_SB(1, 0), cB + kstep, voffB); PG8_STAGE(PG8_SA(1, 0), cA + kstep, voffA); PG8_STAGE(PG8_SB(1, 1), cB + hstep + kstep, voffB);
    PG8_WAIT_V(6); PG8_BAR;
    PG8_STAMP();
    for (;;) {
        const bool has_next = S.next(ui + 1, nxt);
        const char* nA = has_next ? (const char*)g.A + (size_t)nxt.pm * tstep : cA; const char* nB = has_next ? (const char*)g.Bt + (size_t)nxt.pn * tstep : cB;
        for (int t = 0; t < nt; t += 2) {
            const bool last = (t == nt - 2);
            const char* a1 = cA + (size_t)(t + 1) * kstep;
            const char* a2 = last ? nA : cA + (size_t)(t + 2) * kstep; const char* b2 = last ? nB : cB + (size_t)(t + 2) * kstep;
            const char* a3 = a2 + kstep; const char* b3 = b2 + kstep;
            if (last && has_next) S.a_ready(nxt);
            PG8_LDB(B0, 0, 0); PG8_SCHED; PG8_LDA(At, 0, 0); PG8_STAGE(PG8_SA(1, 1), a1 + hstep, voffA);
            PG8_WAIT_L(8); PG8_BAR; PG8_WAIT_L(0); PG8_MMA(0, 0, At, B0); PG8_BAR; PG8_SCHED;
            PG8_LDB(B1, 0, 1); PG8_STAGE(PG8_SB(0, 0), b2, voffB);
            PG8_BAR; PG8_WAIT_L(0); PG8_MMA(0, 1, At, B1); PG8_BAR;
            PG8_LDA(At, 0, 1); PG8_STAGE(PG8_SA(0, 0), a2, voffA);
            PG8_BAR; PG8_WAIT_L(0); PG8_MMA(1, 0, At, B0); PG8_BAR; PG8_SCHED;
            PG8_STAGE(PG8_SB(0, 1), b2 + hstep, voffB);
            PG8_WAIT_V(6); PG8_BAR; PG8_MMA(1, 1, At, B1); PG8_BAR;
            PG8_LDB(B0, 1, 0); PG8_SCHED; PG8_LDA(At, 1, 0); PG8_STAGE(PG8_SA(0, 1), a2 + hstep, voffA);
            PG8_WAIT_L(8); PG8_BAR; PG8_WAIT_L(0); PG8_MMA(0, 0, At, B0); PG8_BAR; PG8_SCHED;
            PG8_LDB(B1, 1, 1); PG8_STAGE(PG8_SB(1, 0), b3, voffB);
            PG8_BAR; PG8_WAIT_L(0); PG8_MMA(0, 1, At, B1); PG8_BAR;
            PG8_LDA(At, 1, 1); PG8_STAGE(PG8_SA(1, 0), a3, voffA);
            PG8_BAR; PG8_WAIT_L(0); PG8_MMA(1, 0, At, B0); PG8_BAR; PG8_SCHED;
            PG8_STAGE(PG8_SB(1, 1), b3 + hstep, voffB);
            PG8_WAIT_V(6); PG8_BAR; PG8_MMA(1, 1, At, B1); PG8_BAR;
        }
        PG8_STAMP();
        if constexpr (!Epi::AFTER_DRAIN) { E(acc, cur, wr, wc, fr, fq); S.done(cur); }
        PG8_STAMP();
        if (!has_next) break;
#pragma unroll
        for (int a = 0; a < 2; ++a)
#pragma unroll
            for (int b = 0; b < 2; ++b)
#pragma unroll
                for (int m = 0; m < 4; ++m)
#pragma unroll
                    for (int n = 0; n < 2; ++n) acc[a][b][m][n] = (f32x4){0.f, 0.f, 0.f, 0.f};
        cur = nxt; cA = nA; cB = nB; ++ui;
    }
    PG8_WAIT_V(0);
    if (wr == 0) PG8_BAR;
    PG8_BAR;
    if constexpr (Epi::AFTER_DRAIN) { E.fused(acc, cur, wr, wc, fr, fq, lds, wid, lane); S.done(cur); }
    PG8_STAMP();
    if (STAMP && wid == 0) { stamps[lane] = lane < nts ? (((unsigned long long)(unsigned)ts_hi << 32) | (unsigned)ts_lo) : 0ull;
        if (lane == 62) stamps[62] = rt_entry; if (lane == 63) stamps[63] = (unsigned long long)wall_clock64(); }
#undef PG8_STAMP
#undef PG8_SA
#undef PG8_SB
#undef PG8_STAGE
#undef PG8_LDA
#undef PG8_LDB
#undef PG8_MMA
#undef PG8_WAIT_V
#undef PG8_WAIT_L
#undef PG8_BAR
#undef PG8_SCHED
}
}

typedef unsigned short bf16_t;
typedef float f32x4 __attribute__((ext_vector_type(4)));
#define LAS __attribute__((address_space(3)))
typedef LAS float* ldsf;

constexpr int M_TOK = 8192, DM = 2048, SEQL = 2048, LDP = 7936, XSSN = 32;
constexpr int LDS_BYTES = 160 * 1024;
constexpr int N_PHASES = 12;

enum { I_NORM_G = 0, I_W_IN, I_W_OUT, I_GK_W2, I_GK_B, I_GLA_NG, I_RW_MU, I_RW_W0, I_RW_W2, I_RW_A0, I_RW_A2, I_RW_KK, I_RW_KA, I_RW_RK, I_RW_LNG, I_RW_LNB,
       I_SSD_CW, I_SSD_CB, I_SSD_DTB, I_SSD_ALOG, I_SSD_D, I_SSD_NG, I_ML_CW, I_ML_CB, I_ML_IGB, I_ML_FGB, I_ML_NG };

struct Params {
    const float* in[58];
    float* out;
    bf16_t* Wi; bf16_t* Wo0; bf16_t* Wo1; bf16_t* actA; bf16_t* proj; bf16_t* xb1;
    float* rwA; float* rwB; float* rwV; float* xss0; float* xss1; float* xss2;
};
typedef const __attribute__((address_space(4))) Params* CP;
__device__ __forceinline__ const float* LP(CP P, int l, int idx) { return P->in[(l ? 28 : 1) + idx + ((l && idx >= I_RW_KK) ? 2 : 0)]; }

struct Cols { int rw, rwz, sx, sdt, sz, mqk, mv, mi, mf, mo, mz, nin; };
__device__ __forceinline__ Cols cols(int l) {
    const int RW = l ? 1696 : 1664; Cols c;
    c.rw = 1552; c.rwz = 1552 + RW; c.sx = c.rwz + 512; c.sdt = c.sx + 1024; c.sz = c.sdt + 8; c.mqk = c.sz + 512; c.mv = c.mqk + 1024;
    c.mi = c.mv + 512; c.mf = c.mi + 4; c.mo = c.mf + 4; c.mz = c.mo + 512; c.nin = c.mz + 512; return c;
}
constexpr int C_GQ = 0, C_GK = 256, C_GV = 512, C_GGK = 1024, C_GZ = 1040;

__device__ __forceinline__ float bf2f(bf16_t u) { return __uint_as_float(((unsigned)u) << 16); }
__device__ __forceinline__ bf16_t f2bf(float f) { unsigned u = __float_as_uint(f); u += 0x7FFFu + ((u >> 16) & 1u); return (bf16_t)(u >> 16); }
__device__ __forceinline__ unsigned pack2(float lo, float hi) { return (unsigned)f2bf(lo) | ((unsigned)f2bf(hi) << 16); }
__device__ __forceinline__ void unpack8(const uint4 u, float* f) {
    f[0] = __uint_as_float(u.x << 16); f[1] = __uint_as_float(u.x & 0xffff0000u); f[2] = __uint_as_float(u.y << 16); f[3] = __uint_as_float(u.y & 0xffff0000u);
    f[4] = __uint_as_float(u.z << 16); f[5] = __uint_as_float(u.z & 0xffff0000u); f[6] = __uint_as_float(u.w << 16); f[7] = __uint_as_float(u.w & 0xffff0000u);
}
__device__ __forceinline__ void load8(const bf16_t* p, float* f) { unpack8(*(const uint4*)p, f); }
__device__ __forceinline__ void store8(bf16_t* p, const float* f) { uint4 u; u.x = pack2(f[0], f[1]); u.y = pack2(f[2], f[3]); u.z = pack2(f[4], f[5]); u.w = pack2(f[6], f[7]); *(uint4*)p = u; }
__device__ __forceinline__ float softplusf(float x) { return fmaxf(x, 0.f) + log1pf(expf(-fabsf(x))); }
__device__ __forceinline__ float logsigmoidf(float x) { return fminf(x, 0.f) - log1pf(expf(-fabsf(x))); }
__device__ __forceinline__ float sigmoidf_(float x) { return 1.f / (1.f + expf(-x)); }
__device__ __forceinline__ float siluf(float x) { return x / (1.f + expf(-x)); }
__device__ __forceinline__ float wave_sum(float v) { for (int o = 32; o; o >>= 1) v += __shfl_xor(v, o); return v; }
__device__ __forceinline__ float wave_max(float v) { for (int o = 32; o; o >>= 1) v = fmaxf(v, __shfl_xor(v, o)); return v; }
template <int CTRL> __device__ __forceinline__ float dppf(float v) { return __int_as_float(__builtin_amdgcn_update_dpp(0, __float_as_int(v), CTRL, 0xF, 0xF, true)); }
__device__ __forceinline__ float reduce8(float v) { v += dppf<0xB1>(v); v += dppf<0x4E>(v); v += dppf<0x141>(v); return v; }

template <class FA, class FB> __device__ __forceinline__ f32x4 mm16(int K, FA fa, FB fb, f32x4 acc) {
    const int lane = threadIdx.x & 63, i = lane & 15, kq = lane >> 4;
#pragma unroll 4
    for (int k0 = 0; k0 < K; k0 += 4) { const float a = fa(i, k0 + kq), b = fb(k0 + kq, i); acc = __builtin_amdgcn_mfma_f32_16x16x4f32(a, b, acc, 0, 0, 0); }
    return acc;
}
__device__ __forceinline__ void tri_tile(int idx, int& tl, int& ts) {
    tl = (idx >= 6) ? 3 : (idx >= 3) ? 2 : (idx >= 1) ? 1 : 0; ts = idx - (tl * (tl + 1)) / 2;
}

struct EpiProj {
    static constexpr bool PERM = true, AFTER_DRAIN = false;
    bf16_t* O; const float* xss;
    __device__ __forceinline__ void operator()(const f32x4 (&acc)[2][2][4][2], const pg8::Unit& u, int wr, int wc, int fr, int fq) const {
        const int row0 = u.pm * 256 + wr * 64 + fr, col0 = u.pn * 256 + wc * 32 + 8 * fq;
#pragma unroll
        for (int ai = 0; ai < 2; ++ai)
#pragma unroll
            for (int m = 0; m < 4; ++m) {
                const int row = row0 + ai * 128 + m * 16;
                const float4* sp = (const float4*)(xss + (size_t)row * XSSN); float s = 0.f;
#pragma unroll
                for (int q = 0; q < XSSN / 4; ++q) { const float4 v = sp[q]; s += (v.x + v.y) + (v.z + v.w); }
                const float rstd = rsqrtf(s * (1.f / DM) + 1e-6f);
                bf16_t* rowp = O + (size_t)row * LDP + col0;
#pragma unroll
                for (int bj = 0; bj < 2; ++bj) {
                    const f32x4 v0 = acc[ai][bj][m][0] * rstd, v1 = acc[ai][bj][m][1] * rstd;
                    uint4 o; o.x = pg8::cvt_pk_bf16(v0[0], v0[1]); o.y = pg8::cvt_pk_bf16(v0[2], v0[3]); o.z = pg8::cvt_pk_bf16(v1[0], v1[1]); o.w = pg8::cvt_pk_bf16(v1[2], v1[3]);
                    *(uint4*)(rowp + bj * 128) = o;
                }
            }
    }
};
struct EpiOut {
    static constexpr bool PERM = false, AFTER_DRAIN = false;
    const float* xin; float* xout; bf16_t* xb; float* xss;
    __device__ __forceinline__ void operator()(const f32x4 (&acc)[2][2][4][2], const pg8::Unit& u, int wr, int wc, int fr, int fq) const {
        const int row0 = u.pm * 256 + wr * 64 + fr, col0 = u.pn * 256 + wc * 32 + 4 * fq;
#pragma unroll
        for (int ai = 0; ai < 2; ++ai)
#pragma unroll
            for (int m = 0; m < 4; ++m) {
                const int row = row0 + ai * 128 + m * 16; float ss = 0.f;
#pragma unroll
                for (int bj = 0; bj < 2; ++bj)
#pragma unroll
                    for (int n = 0; n < 2; ++n) {
                        const size_t off = (size_t)row * DM + col0 + bj * 128 + n * 16;
                        const f32x4 v = acc[ai][bj][m][n] + *(const f32x4*)(xin + off);
                        *(f32x4*)(xout + off) = v; ss += v[0] * v[0] + v[1] * v[1] + v[2] * v[2] + v[3] * v[3];
                        if (xb) { uint2 o; o.x = pg8::cvt_pk_bf16(v[0], v[1]); o.y = pg8::cvt_pk_bf16(v[2], v[3]); *(uint2*)(xb + off) = o; }
                    }
                ss += __shfl_xor(ss, 16); ss += __shfl_xor(ss, 32);
                if (fq == 0) xss[(size_t)row * XSSN + u.pn * 4 + wc] = ss;
            }
    }
};

__device__ __forceinline__ void transpose_convert(const float* __restrict__ src, int K, int N, int Npad, bf16_t* __restrict__ dst, const float* __restrict__ rowscale, ldsf lds) {
    const int tid = threadIdx.x, nkt = K / 64, ntiles = nkt * (Npad / 64);
    for (int tile = blockIdx.x; tile < ntiles; tile += gridDim.x) {
        const int k0 = (tile % nkt) * 64, n0 = (tile / nkt) * 64;
#pragma unroll
        for (int i = 0; i < 8; ++i) {
            const int e = tid + i * 512, kk = e >> 6, nn = e & 63;
            float v = 0.f;
            if (n0 + nn < N) { v = src[(size_t)(k0 + kk) * N + n0 + nn]; if (rowscale) v *= rowscale[k0 + kk]; }
            lds[kk * 65 + nn] = v;
        }
        __syncthreads();
#pragma unroll
        for (int i = 0; i < 4; ++i) {
            const int e = tid + i * 512, nn = e >> 5, k2 = (e & 31) * 2;
            *(unsigned*)(dst + (size_t)(n0 + nn) * K + k0 + k2) = pack2(lds[k2 * 65 + nn], lds[(k2 + 1) * 65 + nn]);
        }
        __syncthreads();
    }
}
__device__ __forceinline__ void x_convert(CP P) {
    const int wave = threadIdx.x >> 6, lane = threadIdx.x & 63;
    for (int row = blockIdx.x * 8 + wave; row < M_TOK; row += gridDim.x * 8) {
        const float4* xr = (const float4*)(P->in[0] + (size_t)row * DM); float ss = 0.f;
#pragma unroll
        for (int i = 0; i < 8; ++i) {
            const float4 v = xr[lane + i * 64]; ss += v.x * v.x + v.y * v.y + v.z * v.z + v.w * v.w;
            uint2 o; o.x = pack2(v.x, v.y); o.y = pack2(v.z, v.w); *(uint2*)(P->actA + (size_t)row * DM + (lane + i * 64) * 4) = o;
        }
        ss = wave_sum(ss);
        if (lane < XSSN) P->xss0[(size_t)row * XSSN + lane] = (lane == 0) ? ss : 0.f;
    }
}

__device__ __forceinline__ void rwkv_prep(CP P, int l, ldsf lds) {
    const Cols C = cols(l); const int tid = threadIdx.x, wave = tid >> 6, lane = tid & 63, li = lane & 15, kq = lane >> 4;
    const float* mu = LP(P, l, I_RW_MU); const float* w0 = LP(P, l, I_RW_W0); const float* w2 = LP(P, l, I_RW_W2);
    const float* a0 = LP(P, l, I_RW_A0); const float* a2 = LP(P, l, I_RW_A2); const float* v0 = P->in[39]; const float* v2 = P->in[40];
    ldsf sWl = lds, sAl = lds + 32 * 65, sVl = lds + 2 * 32 * 65;
    const int NL = l ? 160 : 128;
    for (int tile = blockIdx.x; tile < M_TOK / 32; tile += gridDim.x) {
        const int t0 = tile * 32;
        for (int e = tid; e < 32 * NL; e += 512) {
            const int tt = e / NL, j = e % NL, col = 1536 + j, t = t0 + tt;
            const float cur = bf2f(P->proj[(size_t)t * LDP + C.rw + col]);
            const float prev = (t % SEQL == 0) ? 0.f : bf2f(P->proj[(size_t)(t - 1) * LDP + C.rw + col]);
            const float f = cur + mu[col] * (prev - cur);
            if (j < 64) sWl[tt * 65 + j] = tanhf(f); else if (j < 128) sAl[tt * 65 + j - 64] = f; else sVl[tt * 33 + j - 128] = f;
        }
        __syncthreads();
        for (int tl = wave; tl < 64; tl += 8) {
            const int tt16 = tl & 1, cc = (tl >> 1) * 16;
            const f32x4 z4 = {0.f, 0.f, 0.f, 0.f};
            const f32x4 aW = mm16(64, [&](int i, int k) { return sWl[(tt16 * 16 + i) * 65 + k]; }, [&](int k, int c) { return w2[k * 512 + cc + c]; }, z4);
            const f32x4 aA = mm16(64, [&](int i, int k) { return sAl[(tt16 * 16 + i) * 65 + k]; }, [&](int k, int c) { return a2[k * 512 + cc + c]; }, z4);
            f32x4 aV = z4;
            if (l) aV = mm16(32, [&](int i, int k) { return sVl[(tt16 * 16 + i) * 33 + k]; }, [&](int k, int c) { return v2[k * 512 + cc + c]; }, z4);
            const int c = cc + li;
#pragma unroll
            for (int j = 0; j < 4; ++j) {
                const int t = t0 + tt16 * 16 + kq * 4 + j; const size_t o = (size_t)t * 512 + c;
                const float wl = w0[c] + aW[j]; const float wlog = -softplusf(-wl) - 0.5f;
                P->rwA[o] = expf(-expf(wlog));
                P->rwB[o] = sigmoidf_(a0[c] + aA[j]);
                const float cur = bf2f(P->proj[(size_t)t * LDP + C.rw + 1024 + c]);
                const float prev = (t % SEQL == 0) ? 0.f : bf2f(P->proj[(size_t)(t - 1) * LDP + C.rw + 1024 + c]);
                float v = cur + mu[1024 + c] * (prev - cur);
                if (l) { const float g = sigmoidf_(v0[c] + aV[j]); const float vf = P->rwV[o]; v = v + (vf - v) * g; }
                P->rwV[o] = v;
            }
        }
        __syncthreads();
    }
}

__device__ __forceinline__ void rwkv_scan_item(CP P, int l, int it, ldsf lds) {
    const Cols C = cols(l); const int tid = threadIdx.x;
    const int b = it >> 4, h = (it >> 1) & 7, rh = it & 1;
    ldsf sR = lds, sK = lds + 4096, sW = lds + 2 * 4096, sNK = lds + 3 * 4096, sB = lds + 4 * 4096, sV = lds + 5 * 4096, sY = lds + 5 * 4096 + 2048;
    const float* mu = LP(P, l, I_RW_MU); const float* k_k = LP(P, l, I_RW_KK); const float* k_a = LP(P, l, I_RW_KA);
    const int tt = tid >> 3, cg8 = (tid & 7) * 8, ch0 = h * 64 + cg8;
    const int ri = tid >> 3, js = (tid & 7) * 8;
    float S[8];
#pragma unroll
    for (int c = 0; c < 8; ++c) S[c] = 0.f;
    for (int n = 0; n < 32; ++n) {
        const int t0 = b * SEQL + n * 64;
        {
            const int t = t0 + tt;
            const bf16_t* pr = P->proj + (size_t)t * LDP + C.rw + ch0;
            float rc[8], kc[8], rp[8], kp[8];
            load8(pr, rc); load8(pr + 512, kc);
            if (n > 0 || tt > 0) { load8(pr - LDP, rp); load8(pr - LDP + 512, kp); }
            else {
#pragma unroll
                for (int e = 0; e < 8; ++e) { rp[e] = 0.f; kp[e] = 0.f; }
            }
            const float* ap = P->rwB + (size_t)t * 512 + ch0; const float* dp = P->rwA + (size_t)t * 512 + ch0;
            alignas(16) float av[8]; alignas(16) float dv[8]; float kkr[8], kl[8];
            *(float4*)av = *(const float4*)ap; *(float4*)(av + 4) = *(const float4*)(ap + 4);
            *(float4*)dv = *(const float4*)dp; *(float4*)(dv + 4) = *(const float4*)(dp + 4);
            float ss = 0.f;
#pragma unroll
            for (int e = 0; e < 8; ++e) {
                const float r = rc[e] + mu[ch0 + e] * (rp[e] - rc[e]);
                kl[e] = kc[e] + mu[512 + ch0 + e] * (kp[e] - kc[e]);
                kkr[e] = kl[e] * k_k[ch0 + e]; ss += kkr[e] * kkr[e];
                sR[tt * 64 + cg8 + e] = r;
            }
            ss += __shfl_xor(ss, 1); ss += __shfl_xor(ss, 2); ss += __shfl_xor(ss, 4);
            const float inv = 1.f / fmaxf(sqrtf(ss), 1e-12f);
#pragma unroll
            for (int e = 0; e < 8; ++e) {
                const float kk = kkr[e] * inv;
                sK[tt * 64 + cg8 + e] = kl[e] * (1.f + (av[e] - 1.f) * k_a[ch0 + e]);
                sW[tt * 64 + cg8 + e] = dv[e];
                sNK[tt * 64 + cg8 + e] = -kk;
                sB[tt * 64 + cg8 + e] = kk * av[e];
            }
            const int c4 = (tid & 7) * 4;
            const float4 v4 = *(const float4*)(P->rwV + (size_t)t * 512 + h * 64 + rh * 32 + c4);
            sV[tt * 32 + c4 + 0] = v4.x; sV[tt * 32 + c4 + 1] = v4.y; sV[tt * 32 + c4 + 2] = v4.z; sV[tt * 32 + c4 + 3] = v4.w;
        }
        __syncthreads();
        if (tid < 256) {
#pragma unroll 2
            for (int t = 0; t < 64; ++t) {
                alignas(16) float nk[8]; alignas(16) float w[8]; alignas(16) float bb[8]; alignas(16) float kk[8]; alignas(16) float rr[8];
                *(f32x4*)nk = *(const LAS f32x4*)(sNK + t * 64 + js); *(f32x4*)(nk + 4) = *(const LAS f32x4*)(sNK + t * 64 + js + 4);
                *(f32x4*)w = *(const LAS f32x4*)(sW + t * 64 + js); *(f32x4*)(w + 4) = *(const LAS f32x4*)(sW + t * 64 + js + 4);
                *(f32x4*)bb = *(const LAS f32x4*)(sB + t * 64 + js); *(f32x4*)(bb + 4) = *(const LAS f32x4*)(sB + t * 64 + js + 4);
                *(f32x4*)kk = *(const LAS f32x4*)(sK + t * 64 + js); *(f32x4*)(kk + 4) = *(const LAS f32x4*)(sK + t * 64 + js + 4);
                *(f32x4*)rr = *(const LAS f32x4*)(sR + t * 64 + js); *(f32x4*)(rr + 4) = *(const LAS f32x4*)(sR + t * 64 + js + 4);
                const float vi = sV[t * 32 + ri];
                float sa0 = S[0] * nk[0], sa1 = S[1] * nk[1];
#pragma unroll
                for (int c = 2; c < 8; c += 2) { sa0 += S[c] * nk[c]; sa1 += S[c + 1] * nk[c + 1]; }
                const float sa = reduce8(sa0 + sa1);
                float y0 = 0.f, y1 = 0.f;
#pragma unroll
                for (int c = 0; c < 8; c += 2) {
                    S[c] = S[c] * w[c] + (sa * bb[c] + vi * kk[c]); S[c + 1] = S[c + 1] * w[c + 1] + (sa * bb[c + 1] + vi * kk[c + 1]);
                    y0 += S[c] * rr[c]; y1 += S[c + 1] * rr[c + 1];
                }
                const float y = reduce8(y0 + y1);
                if ((tid & 7) == 0) sY[t * 32 + ri] = y;
            }
        }
        __syncthreads();
        {
            const int c4 = (tid & 7) * 4; const LAS float* yp = sY + tt * 32 + c4;
            uint2 o; o.x = pack2(yp[0], yp[1]); o.y = pack2(yp[2], yp[3]);
            *(uint2*)(P->proj + (size_t)(t0 + tt) * LDP + C.rw + 1024 + h * 64 + rh * 32 + c4) = o;
        }
    }
    __syncthreads();
}

__device__ __forceinline__ void mlstm_item(CP P, int l, int it, ldsf lds) {
    const Cols C = cols(l); const int tid = threadIdx.x, wave = tid >> 6, lane = tid & 63, li = lane & 15, kq = lane >> 4;
    const int b = it >> 4, h = (it >> 2) & 3, es = it & 3;
    ldsf sQ = lds, sK = sQ + 64 * 129, sV = sK + 64 * 129, sAtt = sV + 64 * 33, sC = sAtt + 64 * 65, sN = sC + 128 * 33;
    ldsf sCum = sN + 128, sLi = sCum + 64, sWend = sLi + 64, sMl = sWend + 64, sWint = sMl + 64, sDen = sWint + 64, sQn = sDen + 64, sScal = sQn + 64;
    const float* cw = LP(P, l, I_ML_CW); const float* cb = LP(P, l, I_ML_CB);
    const float igb = LP(P, l, I_ML_IGB)[h], fgb = LP(P, l, I_ML_FGB)[h];
    for (int e = tid; e < 64 * 65; e += 512) sAtt[e] = 0.f;
    for (int e = tid; e < 128 * 33 + 128; e += 512) sC[e] = 0.f;
    float m_prev = 0.f;
    __syncthreads();
    for (int n = 0; n < 32; ++n) {
        const int t0 = b * SEQL + n * 64;
        for (int e = tid; e < 64 * 256; e += 512) {
            const int s = e >> 8, c = e & 255, isk = c >> 7, d = c & 127, col = isk * 512 + h * 128 + d;
            float acc = cb[col];
#pragma unroll
            for (int j = 0; j < 4; ++j) { const int ts = n * 64 + s - 3 + j; if (ts >= 0) acc += cw[j * 1024 + col] * bf2f(P->proj[(size_t)(b * SEQL + ts) * LDP + C.mqk + col]); }
            const float v = siluf(acc);
            if (isk) sK[s * 129 + d] = v * 0.08838834764831845f; else sQ[s * 129 + d] = v;
        }
        for (int e = tid; e < 64 * 32; e += 512) { const int s = e >> 5, ee = e & 31; sV[s * 33 + ee] = bf2f(P->proj[(size_t)(t0 + s) * LDP + C.mv + h * 128 + es * 32 + ee]); }
        if (wave == 0) {
            const int s = lane;
            const float lgi = bf2f(P->proj[(size_t)(t0 + s) * LDP + C.mi + h]) + igb;
            const float lf = logsigmoidf(bf2f(P->proj[(size_t)(t0 + s) * LDP + C.mf + h]) + fgb);
            float cum = lf;
#pragma unroll
            for (int o = 1; o < 64; o <<= 1) { const float u = __shfl_up(cum, o); if (lane >= o) cum += u; }
            const float last = __shfl(cum, 63);
            const float g = last - cum + lgi; const float gmax = wave_max(g);
            float pm = lgi - cum;
#pragma unroll
            for (int o = 1; o < 64; o <<= 1) { const float u = __shfl_up(pm, o); if (lane >= o) pm = fmaxf(pm, u); }
            const float minter = cum + m_prev; const float ml = fmaxf(minter, cum + pm);
            sCum[s] = cum; sLi[s] = lgi; sWend[s] = expf(g - gmax); sMl[s] = ml; sWint[s] = expf(minter - ml);
            if (lane == 0) { sScal[0] = last; sScal[1] = gmax; }
        }
        __syncthreads();
        for (int idx = wave; idx < 10; idx += 8) {
            int tl, ts; tri_tile(idx, tl, ts);
            const f32x4 z4 = {0.f, 0.f, 0.f, 0.f};
            const f32x4 a = mm16(128, [&](int i, int k) { return sQ[(tl * 16 + i) * 129 + k]; }, [&](int k, int c) { return sK[(ts * 16 + c) * 129 + k]; }, z4);
#pragma unroll
            for (int j = 0; j < 4; ++j) {
                const int lr = tl * 16 + kq * 4 + j, sc = ts * 16 + li;
                sAtt[lr * 65 + sc] = (sc <= lr) ? a[j] * expf(sCum[lr] - sCum[sc] + sLi[sc] - sMl[lr]) : 0.f;
            }
        }
        if (wave == 7) { float q = 0.f; for (int d = 0; d < 128; ++d) q += sQ[lane * 129 + d] * sN[d]; sQn[lane] = q; }
        __syncthreads();
        if (wave == 0) {
            float dl = 0.f; for (int s = 0; s < 64; ++s) dl += sAtt[lane * 65 + s];
            const float den = dl + sWint[lane] * sQn[lane];
            sDen[lane] = fmaxf(fabsf(den), expf(-sMl[lane]));
        }
        __syncthreads();
        {
            const int tl = wave >> 1, te = wave & 1;
            const f32x4 z4 = {0.f, 0.f, 0.f, 0.f};
            const f32x4 a1 = mm16(64, [&](int i, int k) { return sAtt[(tl * 16 + i) * 65 + k]; }, [&](int k, int c) { return sV[k * 33 + te * 16 + c]; }, z4);
            const f32x4 a2 = mm16(128, [&](int i, int k) { return sQ[(tl * 16 + i) * 129 + k]; }, [&](int k, int c) { return sC[k * 33 + te * 16 + c]; }, z4);
#pragma unroll
            for (int j = 0; j < 4; ++j) {
                const int lr = tl * 16 + kq * 4 + j, e = te * 16 + li;
                const float hv = (a1[j] + sWint[lr] * a2[j]) / sDen[lr];
                P->proj[(size_t)(t0 + lr) * LDP + C.mv + h * 128 + es * 32 + e] = f2bf(hv);
            }
        }
        __syncthreads();
        {
            const float last = sScal[0], gmax = sScal[1];
            const float m_new = fmaxf(last + m_prev, gmax), a_old = expf(last + m_prev - m_new), a_new = expf(gmax - m_new);
            for (int tile = wave; tile < 16; tile += 8) {
                const int td = tile >> 1, te = tile & 1;
                const f32x4 z4 = {0.f, 0.f, 0.f, 0.f};
                const f32x4 a = mm16(64, [&](int i, int k) { return sK[k * 129 + td * 16 + i] * sWend[k]; }, [&](int k, int c) { return sV[k * 33 + te * 16 + c]; }, z4);
#pragma unroll
                for (int j = 0; j < 4; ++j) { const int d = td * 16 + kq * 4 + j, e = te * 16 + li; sC[d * 33 + e] = a_old * sC[d * 33 + e] + a_new * a[j]; }
            }
            if (tid < 128) { float s = 0.f; for (int k = 0; k < 64; ++k) s += sWend[k] * sK[k * 129 + tid]; sN[tid] = a_old * sN[tid] + a_new * s; }
            m_prev = m_new;
        }
        __syncthreads();
    }
}

__device__ __forceinline__ void ssd_item(CP P, int l, int it, ldsf lds) {
    const Cols C = cols(l); const int tid = threadIdx.x, wave = tid >> 6, lane = tid & 63, li = lane & 15, kq = lane >> 4;
    const int b = it >> 4, hh = (it >> 1) & 7, ps = it & 1, g = hh >> 2;
    ldsf sXr = lds, sX = sXr + 67 * 32, sB = sX + 64 * 33, sCm = sB + 64 * 129, sAtt = sCm + 64 * 129, sS = sAtt + 64 * 65;
    ldsf sCum = sS + 32 * 129, sDt = sCum + 64, sE = sDt + 64, sEc = sE + 64, sScal = sEc + 64;
    const float* cw = LP(P, l, I_SSD_CW); const float* cb = LP(P, l, I_SSD_CB);
    const float Aneg = -expf(LP(P, l, I_SSD_ALOG)[hh]), dtb = LP(P, l, I_SSD_DTB)[hh], dsk = LP(P, l, I_SSD_D)[hh];
    for (int e = tid; e < 64 * 65; e += 512) sAtt[e] = 0.f;
    for (int e = tid; e < 32 * 129; e += 512) sS[e] = 0.f;
    float hv = 0.f;
    __syncthreads();
    for (int n = 0; n < 32; ++n) {
        const int t0 = b * SEQL + n * 64;
        if (tid < 96) sXr[tid] = hv;
        for (int e = tid; e < 64 * 32; e += 512) { const int s = e >> 5, p = e & 31; sXr[(s + 3) * 32 + p] = bf2f(P->proj[(size_t)(t0 + s) * LDP + C.sx + hh * 64 + ps * 32 + p]); }
        for (int e = tid; e < 64 * 256; e += 512) {
            const int s = e >> 8, c = e & 255, isc = c >> 7, nn = c & 127, col = 512 + isc * 256 + g * 128 + nn;
            float acc = cb[col];
#pragma unroll
            for (int j = 0; j < 4; ++j) { const int ts = n * 64 + s - 3 + j; if (ts >= 0) acc += cw[j * 1024 + col] * bf2f(P->proj[(size_t)(b * SEQL + ts) * LDP + C.sx + col]); }
            const float v = siluf(acc);
            if (isc) sCm[s * 129 + nn] = v; else sB[s * 129 + nn] = v;
        }
        if (wave == 0) {
            const float dt = softplusf(bf2f(P->proj[(size_t)(t0 + lane) * LDP + C.sdt + hh]) + dtb);
            float cum = dt * Aneg;
#pragma unroll
            for (int o = 1; o < 64; o <<= 1) { const float u = __shfl_up(cum, o); if (lane >= o) cum += u; }
            const float last = __shfl(cum, 63);
            sDt[lane] = dt; sCum[lane] = cum; sE[lane] = expf(last - cum); sEc[lane] = expf(cum);
            if (lane == 0) sScal[0] = expf(last);
        }
        __syncthreads();
        for (int e = tid; e < 64 * 32; e += 512) {
            const int s = e >> 5, p = e & 31, col = hh * 64 + ps * 32 + p;
            float acc = cb[col];
#pragma unroll
            for (int j = 0; j < 4; ++j) acc += cw[j * 1024 + col] * sXr[(s + j) * 32 + p];
            sX[s * 33 + p] = siluf(acc);
        }
        for (int idx = wave; idx < 10; idx += 8) {
            int tl, ts; tri_tile(idx, tl, ts);
            const f32x4 z4 = {0.f, 0.f, 0.f, 0.f};
            const f32x4 a = mm16(128, [&](int i, int k) { return sCm[(tl * 16 + i) * 129 + k]; }, [&](int k, int c) { return sB[(ts * 16 + c) * 129 + k]; }, z4);
#pragma unroll
            for (int j = 0; j < 4; ++j) {
                const int lr = tl * 16 + kq * 4 + j, sc = ts * 16 + li;
                sAtt[lr * 65 + sc] = (sc <= lr) ? a[j] * expf(sCum[lr] - sCum[sc]) : 0.f;
            }
        }
        __syncthreads();
        {
            const int tl = wave >> 1, tp = wave & 1;
            const f32x4 z4 = {0.f, 0.f, 0.f, 0.f};
            const f32x4 a1 = mm16(64, [&](int i, int k) { return sAtt[(tl * 16 + i) * 65 + k]; }, [&](int k, int c) { return sX[k * 33 + tp * 16 + c] * sDt[k]; }, z4);
            const f32x4 a2 = mm16(128, [&](int i, int k) { return sCm[(tl * 16 + i) * 129 + k]; }, [&](int k, int c) { return sS[(tp * 16 + c) * 129 + k]; }, z4);
#pragma unroll
            for (int j = 0; j < 4; ++j) {
                const int lr = tl * 16 + kq * 4 + j, p = tp * 16 + li;
                const float y = a1[j] + sEc[lr] * a2[j] + dsk * sX[lr * 33 + p];
                P->proj[(size_t)(t0 + lr) * LDP + C.sx + hh * 64 + ps * 32 + p] = f2bf(y);
            }
        }
        __syncthreads();
        {
            const float elast = sScal[0];
            for (int tile = wave; tile < 16; tile += 8) {
                const int tp = tile & 1, tn = tile >> 1;
                const f32x4 z4 = {0.f, 0.f, 0.f, 0.f};
                const f32x4 a = mm16(64, [&](int i, int k) { return sX[k * 33 + tp * 16 + i] * (sDt[k] * sE[k]); }, [&](int k, int c) { return sB[k * 129 + tn * 16 + c]; }, z4);
#pragma unroll
                for (int j = 0; j < 4; ++j) { const int p = tp * 16 + kq * 4 + j, nn = tn * 16 + li; sS[p * 129 + nn] = elast * sS[p * 129 + nn] + a[j]; }
            }
            if (tid < 96) hv = sXr[64 * 32 + tid];
        }
        __syncthreads();
    }
}

__device__ __forceinline__ void gla_item(CP P, int l, int it, ldsf lds) {
    const int tid = threadIdx.x, wave = tid >> 6, lane = tid & 63, li = lane & 15, kq = lane >> 4;
    const int b = it >> 4, h = (it >> 2) & 3, vs = it & 3;
    ldsf sQ = lds, sK = sQ + 64 * 65, sCum = sK + 64 * 65, sV = sCum + 64 * 65, sAtt = sV + 64 * 33, sS = sAtt + 64 * 65, sGl = sS + 64 * 33, sW2 = sGl + 64 * 17, sGb = sW2 + 16 * 64, sSeg = sGb + 64, sDec = sSeg + 8 * 64;
    const float* gw2 = LP(P, l, I_GK_W2); const float* gb = LP(P, l, I_GK_B);
    for (int e = tid; e < 16 * 64; e += 512) sW2[e] = gw2[(e >> 6) * 256 + h * 64 + (e & 63)];
    if (tid < 64) sGb[tid] = gb[h * 64 + tid];
    for (int e = tid; e < 64 * 65; e += 512) sAtt[e] = 0.f;
    for (int e = tid; e < 64 * 33; e += 512) sS[e] = 0.f;
    __syncthreads();
    for (int n = 0; n < 32; ++n) {
        const int t0 = b * SEQL + n * 64;
        for (int e = tid; e < 4096; e += 512) {
            const int s = e >> 6, d = e & 63; const bf16_t* pr = P->proj + (size_t)(t0 + s) * LDP + h * 64 + d;
            sQ[s * 65 + d] = bf2f(pr[C_GQ]) * 0.125f; sK[s * 65 + d] = bf2f(pr[C_GK]);
        }
        for (int e = tid; e < 64 * 32; e += 512) { const int s = e >> 5, v = e & 31; sV[s * 33 + v] = bf2f(P->proj[(size_t)(t0 + s) * LDP + C_GV + h * 128 + vs * 32 + v]); }
        for (int e = tid; e < 64 * 16; e += 512) { const int s = e >> 4, r = e & 15; sGl[s * 17 + r] = bf2f(P->proj[(size_t)(t0 + s) * LDP + C_GGK + r]); }
        __syncthreads();
        for (int e = tid; e < 4096; e += 512) {
            const int s = e >> 6, d = e & 63; float gk = sGb[d];
#pragma unroll
            for (int r = 0; r < 16; ++r) gk += sGl[s * 17 + r] * sW2[r * 64 + d];
            sCum[s * 65 + d] = logsigmoidf(gk) * 0.0625f;
        }
        __syncthreads();
        const int d = tid & 63, seg = tid >> 6;
        {
            float run = 0.f;
#pragma unroll
            for (int r = 0; r < 8; ++r) { run += sCum[(seg * 8 + r) * 65 + d]; sCum[(seg * 8 + r) * 65 + d] = run; }
            sSeg[seg * 64 + d] = run;
        }
        __syncthreads();
        {
            float off = 0.f;
            for (int s2 = 0; s2 < seg; ++s2) off += sSeg[s2 * 64 + d];
#pragma unroll
            for (int r = 0; r < 8; ++r) {
                const int s = seg * 8 + r; const float c = sCum[s * 65 + d] + off;
                sQ[s * 65 + d] *= expf(c); sK[s * 65 + d] *= expf(-c);
                if (s == 63) sDec[d] = expf(c);
            }
        }
        __syncthreads();
        for (int idx = wave; idx < 10; idx += 8) {
            int tl, ts; tri_tile(idx, tl, ts);
            const f32x4 z4 = {0.f, 0.f, 0.f, 0.f};
            const f32x4 a = mm16(64, [&](int i, int k) { return sQ[(tl * 16 + i) * 65 + k]; }, [&](int k, int c) { return sK[(ts * 16 + c) * 65 + k]; }, z4);
#pragma unroll
            for (int j = 0; j < 4; ++j) { const int lr = tl * 16 + kq * 4 + j, sc = ts * 16 + li; sAtt[lr * 65 + sc] = (sc <= lr) ? a[j] : 0.f; }
        }
        __syncthreads();
        {
            const int tl = wave >> 1, tv = wave & 1;
            const f32x4 z4 = {0.f, 0.f, 0.f, 0.f};
            f32x4 a = mm16(64, [&](int i, int k) { return sAtt[(tl * 16 + i) * 65 + k]; }, [&](int k, int c) { return sV[k * 33 + tv * 16 + c]; }, z4);
            a = mm16(64, [&](int i, int k) { return sQ[(tl * 16 + i) * 65 + k]; }, [&](int k, int c) { return sS[k * 33 + tv * 16 + c]; }, a);
#pragma unroll
            for (int j = 0; j < 4; ++j) { const int lr = tl * 16 + kq * 4 + j, v = tv * 16 + li; P->proj[(size_t)(t0 + lr) * LDP + C_GV + h * 128 + vs * 32 + v] = f2bf(a[j]); }
        }
        __syncthreads();
        {
            const int td = wave >> 1, tv = wave & 1;
            const f32x4 z4 = {0.f, 0.f, 0.f, 0.f};
            const f32x4 a = mm16(64, [&](int i, int k) { return sK[k * 65 + td * 16 + i]; }, [&](int k, int c) { return sV[k * 33 + tv * 16 + c]; }, z4);
#pragma unroll
            for (int j = 0; j < 4; ++j) { const int dd = td * 16 + kq * 4 + j, v = tv * 16 + li; sS[dd * 33 + v] = sDec[dd] * (sS[dd * 33 + v] + a[j]); }
        }
        __syncthreads();
    }
}

__device__ __forceinline__ void scan_phase(CP P, int l, ldsf lds) {
    for (int it = blockIdx.x; it < 256; it += gridDim.x) {
        if (it < 64) rwkv_scan_item(P, l, it, lds);
        else if (it < 128) mlstm_item(P, l, it - 64, lds);
        else if (it < 192) ssd_item(P, l, it - 128, lds);
        else gla_item(P, l, it - 192, lds);
        __syncthreads();
    }
}

__device__ __forceinline__ void finalize_phase(CP P, int l) {
    const Cols C = cols(l); const int wave = threadIdx.x >> 6, lane = threadIdx.x & 63, c8 = lane * 8;
    const float* gla_g = LP(P, l, I_GLA_NG); const float* mu = LP(P, l, I_RW_MU); const float* k_a = LP(P, l, I_RW_KA); const float* r_k = LP(P, l, I_RW_RK);
    const float* ln_g = LP(P, l, I_RW_LNG); const float* ln_b = LP(P, l, I_RW_LNB); const float* ssd_g = LP(P, l, I_SSD_NG); const float* ml_g = LP(P, l, I_ML_NG);
    for (int t = blockIdx.x * 8 + wave; t < M_TOK; t += gridDim.x * 8) {
        const bf16_t* pr = P->proj + (size_t)t * LDP; bf16_t* yo = P->actA + (size_t)t * DM;
        float a[8], z[8], y[8];
        {
            load8(pr + C_GV + c8, a); load8(pr + C_GZ + c8, z);
            float ss = 0.f;
#pragma unroll
            for (int e = 0; e < 8; ++e) ss += a[e] * a[e];
            ss += __shfl_xor(ss, 1); ss += __shfl_xor(ss, 2); ss += __shfl_xor(ss, 4); ss += __shfl_xor(ss, 8);
            const float rstd = rsqrtf(ss * (1.f / 128.f) + 1e-6f);
#pragma unroll
            for (int e = 0; e < 8; ++e) y[e] = a[e] * rstd * gla_g[c8 + e] * siluf(z[e]);
            store8(yo + c8, y);
        }
        {
            load8(pr + C.rw + 1024 + c8, a); load8(pr + C.rwz + c8, z);
            float s = 0.f;
#pragma unroll
            for (int e = 0; e < 8; ++e) s += a[e];
            s += __shfl_xor(s, 1); s += __shfl_xor(s, 2); s += __shfl_xor(s, 4);
            const float mean = s * (1.f / 64.f); float vs = 0.f;
#pragma unroll
            for (int e = 0; e < 8; ++e) { a[e] -= mean; vs += a[e] * a[e]; }
            vs += __shfl_xor(vs, 1); vs += __shfl_xor(vs, 2); vs += __shfl_xor(vs, 4);
            const float rstd = rsqrtf(vs * (1.f / 64.f) + 64e-5f);
            float rc[8], kc[8], rp[8], kp[8];
            load8(pr + C.rw + c8, rc); load8(pr + C.rw + 512 + c8, kc);
            if (t % SEQL != 0) { load8(pr - LDP + C.rw + c8, rp); load8(pr - LDP + C.rw + 512 + c8, kp); }
            else {
#pragma unroll
                for (int e = 0; e < 8; ++e) { rp[e] = 0.f; kp[e] = 0.f; }
            }
            alignas(16) float av[8]; alignas(16) float vv[8];
            *(float4*)av = *(const float4*)(P->rwB + (size_t)t * 512 + c8); *(float4*)(av + 4) = *(const float4*)(P->rwB + (size_t)t * 512 + c8 + 4);
            *(float4*)vv = *(const float4*)(P->rwV + (size_t)t * 512 + c8); *(float4*)(vv + 4) = *(const float4*)(P->rwV + (size_t)t * 512 + c8 + 4);
            float bs = 0.f;
#pragma unroll
            for (int e = 0; e < 8; ++e) {
                const float r = rc[e] + mu[c8 + e] * (rp[e] - rc[e]);
                const float kl = kc[e] + mu[512 + c8 + e] * (kp[e] - kc[e]);
                const float k2 = kl * (1.f + (av[e] - 1.f) * k_a[c8 + e]);
                bs += r * k2 * r_k[c8 + e];
            }
            bs += __shfl_xor(bs, 1); bs += __shfl_xor(bs, 2); bs += __shfl_xor(bs, 4);
#pragma unroll
            for (int e = 0; e < 8; ++e) y[e] = (a[e] * rstd * ln_g[c8 + e] + ln_b[c8 + e] + bs * vv[e]) * siluf(z[e]);
            store8(yo + 512 + c8, y);
        }
        {
            load8(pr + C.sx + c8, a); load8(pr + C.sz + c8, z);
            float ss = 0.f;
#pragma unroll
            for (int e = 0; e < 8; ++e) { a[e] *= siluf(z[e]); ss += a[e] * a[e]; }
            ss = wave_sum(ss);
            const float rstd = rsqrtf(ss * (1.f / 512.f) + 1e-6f);
#pragma unroll
            for (int e = 0; e < 8; ++e) y[e] = a[e] * rstd * ssd_g[c8 + e];
            store8(yo + 1024 + c8, y);
        }
        {
            float o[8];
            load8(pr + C.mv + c8, a); load8(pr + C.mo + c8, o); load8(pr + C.mz + c8, z);
            float s = 0.f;
#pragma unroll
            for (int e = 0; e < 8; ++e) { a[e] *= sigmoidf_(o[e]); s += a[e]; }
            s += __shfl_xor(s, 1); s += __shfl_xor(s, 2); s += __shfl_xor(s, 4); s += __shfl_xor(s, 8);
            const float mean = s * (1.f / 128.f); float vs = 0.f;
#pragma unroll
            for (int e = 0; e < 8; ++e) { a[e] -= mean; vs += a[e] * a[e]; }
            vs += __shfl_xor(vs, 1); vs += __shfl_xor(vs, 2); vs += __shfl_xor(vs, 4); vs += __shfl_xor(vs, 8);
            const float rstd = rsqrtf(vs * (1.f / 128.f) + 1e-6f);
#pragma unroll
            for (int e = 0; e < 8; ++e) y[e] = a[e] * rstd * ml_g[c8 + e] * siluf(z[e]);
            store8(yo + 1536 + c8, y);
        }
    }
}

__device__ __forceinline__ void final_norm(CP P) {
    const int wave = threadIdx.x >> 6, lane = threadIdx.x & 63; const float* g = P->in[57];
    for (int row = blockIdx.x * 8 + wave; row < M_TOK; row += gridDim.x * 8) {
        float s = (lane < XSSN) ? P->xss2[(size_t)row * XSSN + lane] : 0.f; s = wave_sum(s);
        const float rstd = rsqrtf(s * (1.f / DM) + 1e-6f);
        float4* xr = (float4*)(P->out + (size_t)row * DM); const float4* gr = (const float4*)g;
#pragma unroll
        for (int i = 0; i < 8; ++i) { float4 v = xr[lane + i * 64]; const float4 gg = gr[lane + i * 64]; v.x *= rstd * gg.x; v.y *= rstd * gg.y; v.z *= rstd * gg.z; v.w *= rstd * gg.w; xr[lane + i * 64] = v; }
    }
}

__device__ __forceinline__ void gemm_inproj(CP P, const bf16_t* A, const float* xss, PG8_LAS unsigned char* lds) {
    pg8::Gemm g; g.A = A; g.Bt = P->Wi; g.M = M_TOK; g.N = LDP; g.K = DM;
    pg8::StaticOrder S; S.init(g.M, g.N, (int)gridDim.x, (int)blockIdx.x);
    EpiProj E; E.O = P->proj; E.xss = xss;
    pg8::gemm_phase<EpiProj, pg8::StaticOrder, false>(lds, g, S, E, nullptr);
}
__device__ __forceinline__ void gemm_outproj(CP P, const bf16_t* Wo, const float* xin, bf16_t* xb, float* xss, PG8_LAS unsigned char* lds) {
    pg8::Gemm g; g.A = P->actA; g.Bt = Wo; g.M = M_TOK; g.N = DM; g.K = DM;
    pg8::StaticOrder S; S.init(g.M, g.N, (int)gridDim.x, (int)blockIdx.x);
    EpiOut E; E.xin = xin; E.xout = P->out; E.xb = xb; E.xss = xss;
    pg8::gemm_phase<EpiOut, pg8::StaticOrder, false>(lds, g, S, E, nullptr);
}

#ifndef PH_MASK
#define PH_MASK 0xFFF
#endif
#define RUN_PHASE(k, body) do { if ((PH_MASK >> (k)) & 1) { if (ph_lo <= (k) && (k) < ph_hi) { CP P = Pc; asm volatile("" : "+s"(P)); body; if (coop && (k) + 1 < ph_hi) grid.sync(); } } } while (0)
__global__ void __launch_bounds__(512, 2) mega(Params Pk, int ph_lo, int ph_hi, int coop) {
    extern __shared__ __attribute__((aligned(16))) unsigned char shm[];
    PG8_LAS unsigned char* ldsb = (PG8_LAS unsigned char*)shm; ldsf lds = (ldsf)shm;
    cg::grid_group grid = cg::this_grid();
    const CP Pc = (CP)__builtin_amdgcn_kernarg_segment_ptr();
    RUN_PHASE(0, { transpose_convert(P->in[2], DM, 7840, LDP, P->Wi, P->in[1], lds); transpose_convert(P->in[3], DM, DM, DM, P->Wo0, nullptr, lds);
                   transpose_convert(P->in[30], DM, DM, DM, P->Wo1, nullptr, lds); x_convert(P); });
    RUN_PHASE(1, gemm_inproj(P, P->actA, P->xss0, ldsb));
    RUN_PHASE(2, { rwkv_prep(P, 0, lds); transpose_convert(P->in[29], DM, 7872, LDP, P->Wi, P->in[28], lds); });
    RUN_PHASE(3, scan_phase(P, 0, lds));
    RUN_PHASE(4, finalize_phase(P, 0));
    RUN_PHASE(5, gemm_outproj(P, P->Wo0, P->in[0], P->xb1, P->xss1, ldsb));
    RUN_PHASE(6, gemm_inproj(P, P->xb1, P->xss1, ldsb));
    RUN_PHASE(7, rwkv_prep(P, 1, lds));
    RUN_PHASE(8, scan_phase(P, 1, lds));
    RUN_PHASE(9, finalize_phase(P, 1));
    RUN_PHASE(10, gemm_outproj(P, P->Wo1, P->out, nullptr, P->xss2, ldsb));
    RUN_PHASE(11, final_norm(P));
}

#ifndef MK_COOP
#define MK_COOP 1
#endif
extern "C" void kernel_launch(void* const* d_in, const int* in_sizes, int n_in, void* d_out, int out_size, void* d_ws, size_t ws_size, hipStream_t stream) {
    Params p{};
    for (int i = 0; i < 58; ++i) p.in[i] = (const float*)d_in[i];
    p.out = (float*)d_out;
    char* w = (char*)d_ws; size_t off = 0;
    auto take = [&](size_t bytes) { char* r = w + off; off += (bytes + 255) & ~(size_t)255; return r; };
    p.Wi = (bf16_t*)take((size_t)LDP * DM * 2);
    p.Wo0 = (bf16_t*)take((size_t)DM * DM * 2);
    p.Wo1 = (bf16_t*)take((size_t)DM * DM * 2);
    p.actA = (bf16_t*)take((size_t)M_TOK * DM * 2);
    p.proj = (bf16_t*)take((size_t)M_TOK * LDP * 2);
    p.rwA = (float*)take((size_t)M_TOK * 512 * 4);
    p.rwB = (float*)take((size_t)M_TOK * 512 * 4);
    p.xb1 = (bf16_t*)p.rwA;
    p.rwV = (float*)take((size_t)M_TOK * 512 * 4);
    p.xss0 = (float*)take((size_t)M_TOK * XSSN * 4);
    p.xss1 = (float*)take((size_t)M_TOK * XSSN * 4);
    p.xss2 = (float*)take((size_t)M_TOK * XSSN * 4);
    if (off > ws_size) { fprintf(stderr, "workspace too small: need %zu have %zu\n", off, ws_size); return; }
    static int grid_blocks = 0;
    if (!grid_blocks) {
        hipFuncSetAttribute((const void*)mega, hipFuncAttributeMaxDynamicSharedMemorySize, LDS_BYTES);
        int dev = 0, cus = 0, per_cu = 0;
        hipGetDevice(&dev);
        hipDeviceGetAttribute(&cus, hipDeviceAttributeMultiprocessorCount, dev);
        hipOccupancyMaxActiveBlocksPerMultiprocessor(&per_cu, mega, 512, LDS_BYTES);
        if (per_cu > 1) per_cu = 1;
        grid_blocks = cus * per_cu;
        if (grid_blocks <= 0) grid_blocks = 256;
    }
#if MK_COOP
    int lo = 0, hi = N_PHASES, coop = 1;
    void* args[] = {&p, &lo, &hi, &coop};
    hipError_t e = hipLaunchCooperativeKernel((const void*)mega, dim3(grid_blocks), dim3(512), args, LDS_BYTES, stream);
    if (e != hipSuccess) fprintf(stderr, "cooperative launch failed: %s (grid %d)\n", hipGetErrorString(e), grid_blocks);
#else
    for (int ph = 0; ph < N_PHASES; ++ph) hipLaunchKernelGGL(mega, dim3(grid_blocks), dim3(512), LDS_BYTES, stream, p, ph, ph + 1, 0);
#endif
}
```

```cpp
#include <hip/hip_runtime.h>
#include <hip/hip_cooperative_groups.h>
#include <cstdio>
namespace cg = cooperative_groups;

namespace pg8 {
#define PG8_LAS __attribute__((address_space(3)))
typedef unsigned short bf16_t;
typedef short bf16x8 __attribute__((ext_vector_type(8)));
typedef float f32x4 __attribute__((ext_vector_type(4)));
typedef unsigned u32x4 __attribute__((ext_vector_type(4)));
constexpr int BM = 256, BK = 64, HALF = 128, HTB = HALF * BK * 2  , STAGE_BYTES = 8 * HTB, NXCD = 8, WGM = 8;

__host__ __device__ __forceinline__ int lds_byte(int r, int c) { const int st = (r >> 4) * 2 + (c >> 5), rr = r & 15, cc = c & 31, ob = rr * 64 + cc * 2; return st * 1024 + (ob ^ (((ob >> 9) & 1) << 5)); }
__host__ __device__ __forceinline__ void stage_rc(int b, int& R, int& C) { const int st = b / 1024, sb = b % 1024, swz = sb ^ (((sb >> 9) & 1) << 5); R = (st >> 1) * 16 + swz / 64; C = (st & 1) * 32 + (swz % 64) / 2; }
__host__ __device__ __forceinline__ int perm32(int rho) { const int n = rho >> 4, i = rho & 15; return 8 * (i >> 2) + 4 * n + (i & 3); }

struct Unit { int pm, pn; };
struct Gemm { const bf16_t* A; const bf16_t* Bt; int M, N, K; };

struct StaticOrder {
    int nM, nN, nwg, G, c;
    __host__ __device__ void init(int M, int N, int G_, int c_) { nM = M / BM; nN = N / BM; nwg = nM * nN; G = G_; c = c_; }
    __host__ __device__ bool next(int i, Unit& u) const {
        const long L = (long)i * G + c; if (L >= nwg) return false;
        int wgid = (int)L; { const int q = nwg / NXCD, r = nwg % NXCD, xcd = wgid % NXCD, off = wgid / NXCD; wgid = (xcd < r ? xcd * (q + 1) : r * (q + 1) + (xcd - r) * q) + off; }
        const int nig = WGM * nN, gid = wgid / nig, fm = gid * WGM, gsz = (nM - fm) < WGM ? (nM - fm) : WGM;
        u.pm = fm + ((wgid % nig) % gsz); u.pn = (wgid % nig) / gsz; return true;
    }
    __device__ __forceinline__ void a_ready(const Unit&) const {}
    __device__ __forceinline__ void done(const Unit&) const {}
};
__device__ __forceinline__ unsigned cvt_pk_bf16(float lo, float hi) { unsigned r; asm volatile("v_cvt_pk_bf16_f32 %0, %1, %2" : "=v"(r) : "v"(lo), "v"(hi)); return r; }
template <class Epi, class Sched, bool STAMP = false>
__device__ __forceinline__ void gemm_phase(PG8_LAS unsigned char* lds, const Gemm g, const Sched& S, const Epi& E, unsigned long long* stamps) {
    const int tid = threadIdx.x, wid = __builtin_amdgcn_readfirstlane(tid >> 6), lane = tid & 63, wr = wid >> 2, wc = wid & 3, fr = lane & 15, fq = lane >> 4;
    const int K = g.K, nt = K / BK;
    int ts_lo = 0, ts_hi = 0, nts = 0; const unsigned long long rt_entry = STAMP ? (unsigned long long)wall_clock64() : 0ull;
#define PG8_STAMP() do { if (STAMP && wid == 0 && nts < 64) { const unsigned long long _c = (unsigned long long)clock64(); \
        ts_lo = (lane == nts) ? (int)(unsigned)_c : ts_lo; ts_hi = (lane == nts) ? (int)(unsigned)(_c >> 32) : ts_hi; ++nts; } } while (0)
    PG8_STAMP();
    unsigned voffA[2], voffB[2];
#pragma unroll
    for (int i = 0; i < 2; ++i) { int R, C; stage_rc(tid * 16 + i * 8192, R, C); const int Rb = Epi::PERM ? ((R & ~31) + perm32(R & 31)) : R;
        voffA[i] = (unsigned)(R * K + C) * 2u; voffB[i] = (unsigned)(Rb * K + C) * 2u; }
    const size_t kstep = (size_t)(BK * 2);
    const size_t hstep = (size_t)HALF * K * 2;
    const size_t tstep = 2 * hstep;
    const unsigned ldsw = (unsigned)wid * 1024u;
    const int aoff = lds_byte(wr * 64 + fr, fq * 8), boff = lds_byte(wc * 32 + fr, fq * 8);
#define PG8_SA(b, h) (((b) * 2 + (h)) * HTB)
#define PG8_SB(b, h) ((4 + (b) * 2 + (h)) * HTB)
#define PG8_STAGE(bufoff, gbase, voff) do { _Pragma("unroll") for (int _i = 0; _i < 2; ++_i) \
        __builtin_amdgcn_global_load_lds((const unsigned*)((const char*)(gbase) + (voff)[_i]), (PG8_LAS unsigned*)(lds + (bufoff) + ldsw + _i * 8192), 16, 0, 0); } while (0)
#define PG8_LDA(dst, b, h) do { _Pragma("unroll") for (int m = 0; m < 4; ++m) _Pragma("unroll") for (int k = 0; k < 2; ++k) dst[m][k] = *(const PG8_LAS bf16x8*)(lds + PG8_SA(b, h) + aoff + m * 2048 + k * 1024); } while (0)
#define PG8_LDB(dst, b, h) do { _Pragma("unroll") for (int n = 0; n < 2; ++n) _Pragma("unroll") for (int k = 0; k < 2; ++k) dst[n][k] = *(const PG8_LAS bf16x8*)(lds + PG8_SB(b, h) + boff + n * 2048 + k * 1024); } while (0)
#define PG8_MMA(ai, bj, At, Bt) do { __builtin_amdgcn_s_setprio(1); _Pragma("unroll") for (int m = 0; m < 4; ++m) _Pragma("unroll") for (int n = 0; n < 2; ++n) _Pragma("unroll") for (int k = 0; k < 2; ++k) \
        acc[ai][bj][m][n] = __builtin_amdgcn_mfma_f32_16x16x32_bf16(Bt[n][k], At[m][k], acc[ai][bj][m][n], 0, 0, 0); __builtin_amdgcn_s_setprio(0); } while (0)
#define PG8_WAIT_V(n) asm volatile("s_waitcnt vmcnt(" #n ")" ::: "memory")
#define PG8_WAIT_L(n) asm volatile("s_waitcnt lgkmcnt(" #n ")" ::: "memory")
#define PG8_BAR __builtin_amdgcn_s_barrier()
#define PG8_SCHED __builtin_amdgcn_sched_barrier(0)
    Unit cur, nxt; int ui = 0;
    if (!S.next(0, cur)) return;
    f32x4 acc[2][2][4][2];
#pragma unroll
    for (int a = 0; a < 2; ++a)
#pragma unroll
        for (int b = 0; b < 2; ++b)
#pragma unroll
            for (int m = 0; m < 4; ++m)
#pragma unroll
                for (int n = 0; n < 2; ++n) acc[a][b][m][n] = (f32x4){0.f, 0.f, 0.f, 0.f};
    bf16x8 At[4][2], B0[2][2], B1[2][2];
    const char* cA = (const char*)g.A + (size_t)cur.pm * tstep; const char* cB = (const char*)g.Bt + (size_t)cur.pn * tstep;
    S.a_ready(cur);
    PG8_STAGE(PG8_SB(0, 0), cB, voffB); PG8_STAGE(PG8_SA(0, 0), cA, voffA); PG8_STAGE(PG8_SB(0, 1), cB + hstep, voffB); PG8_STAGE(PG8_SA(0, 1), cA + hstep, voffA);
    if (wr == 1) PG8_BAR;
    PG8_WAIT_V(4); PG8_BAR;
    PG8_STAGE(PG8_SB(1, 0), cB + kstep, voffB); PG8_STAGE(PG8_SA(1, 0), cA + kstep, voffA); PG8_STAGE(PG8_SB(1, 1), cB + hstep + kstep, voffB);
    PG8_WAIT_V(6); PG8_BAR;
    PG8_STAMP();
    for (;;) {
        const bool has_next = S.next(ui + 1, nxt);
        const char* nA = has_next ? (const char*)g.A + (size_t)nxt.pm * tstep : cA; const char* nB = has_next ? (const char*)g.Bt + (size_t)nxt.pn * tstep : cB;
        for (int t = 0; t < nt; t += 2) {
            const bool last = (t == nt - 2);
            const char* a1 = cA + (size_t)(t + 1) * kstep;
            const char* a2 = last ? nA : cA + (size_t)(t + 2) * kstep; const char* b2 = last ? nB : cB + (size_t)(t + 2) * kstep;
            const char* a3 = a2 + kstep; const char* b3 = b2 + kstep;
            if (last && has_next) S.a_ready(nxt);
            PG8_LDB(B0, 0, 0); PG8_SCHED; PG8_LDA(At, 0, 0); PG8_STAGE(PG8_SA(1, 1), a1 + hstep, voffA);
            PG8_WAIT_L(8); PG8_BAR; PG8_WAIT_L(0); PG8_MMA(0, 0, At, B0); PG8_BAR; PG8_SCHED;
            PG8_LDB(B1, 0, 1); PG8_STAGE(PG8_SB(0, 0), b2, voffB);
            PG8_BAR; PG8_WAIT_L(0); PG8_MMA(0, 1, At, B1); PG8_BAR;
            PG8_LDA(At, 0, 1); PG8_STAGE(PG8_SA(0, 0), a2, voffA);
            PG8_BAR; PG8_WAIT_L(0); PG8_MMA(1, 0, At, B0); PG8_BAR; PG8_SCHED;
            PG8_STAGE(PG8_SB(0, 1), b2 + hstep, voffB);
            PG8_WAIT_V(6); PG8_BAR; PG8_MMA(1, 1, At, B1); PG8_BAR;
            PG8_LDB(B0, 1, 0); PG8_SCHED; PG8_LDA(At, 1, 0); PG8_STAGE(PG8_SA(0, 1), a2 + hstep, voffA);
            PG8_WAIT_L(8); PG8_BAR; PG8_WAIT_L(0); PG8_MMA(0, 0, At, B0); PG8_BAR; PG8_SCHED;
            PG8_LDB(B1, 1, 1); PG8_STAGE(PG8_SB(1, 0), b3, voffB);
            PG8_BAR; PG8_WAIT_L(0); PG8_MMA(0, 1, At, B1); PG8_BAR;
            PG8_LDA(At, 1, 1); PG8_STAGE(PG8_SA(1, 0), a3, voffA);
            PG8_BAR; PG8_WAIT_L(0); PG8_MMA(1, 0, At, B0); PG8_BAR; PG8_SCHED;
            PG8_STAGE(PG8_SB(1, 1), b3 + hstep, voffB);
            PG8_WAIT_V(6); PG8_BAR; PG8_MMA(1, 1, At, B1); PG8_BAR;
        }
        PG8_STAMP();
        if constexpr (!Epi::AFTER_DRAIN) { E(acc, cur, wr, wc, fr, fq); S.done(cur); }
        PG8_STAMP();
        if (!has_next) break;
#pragma unroll
        for (int a = 0; a < 2; ++a)
#pragma unroll
            for (int b = 0; b < 2; ++b)
#pragma unroll
                for (int m = 0; m < 4; ++m)
#pragma unroll
                    for (int n = 0; n < 2; ++n) acc[a][b][m][n] = (f32x4){0.f, 0.f, 0.f, 0.f};
        cur = nxt; cA = nA; cB = nB; ++ui;
    }
    PG8_WAIT_V(0);
    if (wr == 0) PG8_BAR;
    PG8_BAR;
    if constexpr (Epi::AFTER_DRAIN) { E.fused(acc, cur, wr, wc, fr, fq, lds, wid, lane); S.done(cur); }
    PG8_STAMP();
    if (STAMP && wid == 0) { stamps[lane] = lane < nts ? (((unsigned long long)(unsigned)ts_hi << 32) | (unsigned)ts_lo) : 0ull;
        if (lane == 62) stamps[62] = rt_entry; if (lane == 63) stamps[63] = (unsigned long long)wall_clock64(); }
#undef PG8_STAMP
#undef PG8_SA
#undef PG8_SB
#undef PG8_STAGE
#undef PG8_LDA
#undef PG8_LDB
#undef PG8_MMA
#undef PG8_WAIT_V
#undef PG8_WAIT_L
#undef PG8_BAR
#undef PG8_SCHED
}
}

typedef unsigned short bf16_t;
typedef float f32x4 __attribute__((ext_vector_type(4)));
#define LAS __attribute__((address_space(3)))
typedef LAS float* ldsf;

constexpr int M_TOK = 8192, DM = 2048, SEQL = 2048, LDP = 7936, XSSN = 32;
constexpr int LDS_BYTES = 160 * 1024;
constexpr int N_PHASES = 12;
constexpr int LORA_L = 2 * 512 * 64 + 512 * 32, LORA_ELEMS = 2 * LORA_L;
constexpr int N_RW = 128, N_ITEMS = N_RW + 128;

enum { I_NORM_G = 0, I_W_IN, I_W_OUT, I_GK_W2, I_GK_B, I_GLA_NG, I_RW_MU, I_RW_W0, I_RW_W2, I_RW_A0, I_RW_A2, I_RW_KK, I_RW_KA, I_RW_RK, I_RW_LNG, I_RW_LNB,
       I_SSD_CW, I_SSD_CB, I_SSD_DTB, I_SSD_ALOG, I_SSD_D, I_SSD_NG, I_ML_CW, I_ML_CB, I_ML_IGB, I_ML_FGB, I_ML_NG };

struct Params {
    const float* in[58];
    float* out;
    bf16_t* Wi; bf16_t* Wo0; bf16_t* Wo1; bf16_t* actA; bf16_t* proj; bf16_t* xb1;
    float* rwA; float* rwB; float* rwV; float* xss0; float* xss1; float* xss2; unsigned* bar; bf16_t* lora; float* bon;
};
typedef const __attribute__((address_space(4))) Params* CP;
__device__ __forceinline__ const float* LP(CP P, int l, int idx) { return P->in[(l ? 28 : 1) + idx + ((l && idx >= I_RW_KK) ? 2 : 0)]; }

struct Cols { int rw, rwz, sx, sdt, sz, mqk, mv, mi, mf, mo, mz, nin; };
__device__ __forceinline__ Cols cols(int l) {
    const int RW = l ? 1696 : 1664; Cols c;
    c.rw = 1552; c.rwz = 1552 + RW; c.sx = c.rwz + 512; c.sdt = c.sx + 1024; c.sz = c.sdt + 8; c.mqk = c.sz + 512; c.mv = c.mqk + 1024;
    c.mi = c.mv + 512; c.mf = c.mi + 4; c.mo = c.mf + 4; c.mz = c.mo + 512; c.nin = c.mz + 512; return c;
}
constexpr int C_GQ = 0, C_GK = 256, C_GV = 512, C_GGK = 1024, C_GZ = 1040;

__device__ __forceinline__ float bf2f(bf16_t u) { return __uint_as_float(((unsigned)u) << 16); }
__device__ __forceinline__ bf16_t f2bf(float f) { unsigned u = __float_as_uint(f); u += 0x7FFFu + ((u >> 16) & 1u); return (bf16_t)(u >> 16); }
__device__ __forceinline__ unsigned pack2(float lo, float hi) { return (unsigned)f2bf(lo) | ((unsigned)f2bf(hi) << 16); }
__device__ __forceinline__ void unpack8(const uint4 u, float* f) {
    f[0] = __uint_as_float(u.x << 16); f[1] = __uint_as_float(u.x & 0xffff0000u); f[2] = __uint_as_float(u.y << 16); f[3] = __uint_as_float(u.y & 0xffff0000u);
    f[4] = __uint_as_float(u.z << 16); f[5] = __uint_as_float(u.z & 0xffff0000u); f[6] = __uint_as_float(u.w << 16); f[7] = __uint_as_float(u.w & 0xffff0000u);
}
__device__ __forceinline__ void load8(const bf16_t* p, float* f) { unpack8(*(const uint4*)p, f); }
__device__ __forceinline__ void store8(bf16_t* p, const float* f) { uint4 u; u.x = pack2(f[0], f[1]); u.y = pack2(f[2], f[3]); u.z = pack2(f[4], f[5]); u.w = pack2(f[6], f[7]); *(uint4*)p = u; }
__device__ __forceinline__ float softplusf(float x) { return fmaxf(x, 0.f) + log1pf(expf(-fabsf(x))); }
__device__ __forceinline__ float logsigmoidf(float x) { return fminf(x, 0.f) - log1pf(expf(-fabsf(x))); }
__device__ __forceinline__ float sigmoidf_(float x) { return __builtin_amdgcn_rcpf(1.f + __expf(-x)); }
__device__ __forceinline__ float siluf(float x) { return x * __builtin_amdgcn_rcpf(1.f + __expf(-x)); }
__device__ __forceinline__ float logsigmoid_fast(float x) { return fminf(x, 0.f) - __logf(1.f + __expf(-fabsf(x))); }
typedef float f32x2 __attribute__((ext_vector_type(2)));
__device__ __forceinline__ float wave_sum(float v) { for (int o = 32; o; o >>= 1) v += __shfl_xor(v, o); return v; }
__device__ __forceinline__ float wave_max(float v) { for (int o = 32; o; o >>= 1) v = fmaxf(v, __shfl_xor(v, o)); return v; }
template <int CTRL> __device__ __forceinline__ float dppf(float v) { return __int_as_float(__builtin_amdgcn_update_dpp(0, __float_as_int(v), CTRL, 0xF, 0xF, true)); }
__device__ __forceinline__ float reduce16(float v) { v += dppf<0xB1>(v); v += dppf<0x4E>(v); v += dppf<0x141>(v); v += dppf<0x140>(v); return v; }
__device__ __forceinline__ float reduce8(float v) { v += dppf<0xB1>(v); v += dppf<0x4E>(v); v += dppf<0x141>(v); return v; }

template <int CTRL> __device__ __forceinline__ float dpp_keep(float oldv, float v) { return __int_as_float(__builtin_amdgcn_update_dpp(__float_as_int(oldv), __float_as_int(v), CTRL, 0xF, 0xF, false)); }
__device__ __forceinline__ float rdlane(float v, int l) { return __int_as_float(__builtin_amdgcn_readlane(__float_as_int(v), l)); }
__device__ __forceinline__ float scan_add64(float v, int lane) {
    v += dppf<0x111>(v); v += dppf<0x112>(v); v += dppf<0x114>(v); v += dppf<0x118>(v);
    const float t0 = rdlane(v, 15), t1 = rdlane(v, 31), t2 = rdlane(v, 47); const int row = lane >> 4;
    return v + ((row >= 1) ? t0 : 0.f) + ((row >= 2) ? t1 : 0.f) + ((row >= 3) ? t2 : 0.f);
}
__device__ __forceinline__ float scan_max64(float v, int lane) {
    const float ninf = -__builtin_inff();
    v = fmaxf(v, dpp_keep<0x111>(ninf, v)); v = fmaxf(v, dpp_keep<0x112>(ninf, v)); v = fmaxf(v, dpp_keep<0x114>(ninf, v)); v = fmaxf(v, dpp_keep<0x118>(ninf, v));
    const float t0 = rdlane(v, 15), t1 = rdlane(v, 31), t2 = rdlane(v, 47); const int row = lane >> 4;
    return fmaxf(fmaxf(v, (row >= 1) ? t0 : ninf), fmaxf((row >= 2) ? t1 : ninf, (row >= 3) ? t2 : ninf));
}
__device__ __forceinline__ void lds_barrier() { asm volatile("s_waitcnt lgkmcnt(0)\n\ts_barrier" ::: "memory"); }
__device__ __forceinline__ int opaque_tid() { int t = threadIdx.x; asm volatile("" : "+v"(t)); return t; }
template <class FA, class FB> __device__ __forceinline__ f32x4 mm16(int K, FA fa, FB fb, f32x4 acc, int i, int kq) {
#pragma unroll 4
    for (int k0 = 0; k0 < K; k0 += 4) { const float a = fa(i, k0 + kq), b = fb(k0 + kq, i); acc = __builtin_amdgcn_mfma_f32_16x16x4f32(a, b, acc, 0, 0, 0); }
    return acc;
}
template <class FA, class FB1, class FB2> __device__ __forceinline__ void mm16_2(int K, FA fa, FB1 fb1, FB2 fb2, f32x4& acc1, f32x4& acc2, int i, int kq) {
#pragma unroll 4
    for (int k0 = 0; k0 < K; k0 += 4) { const float a = fa(i, k0 + kq), b1 = fb1(k0 + kq, i), b2 = fb2(k0 + kq, i);
        acc1 = __builtin_amdgcn_mfma_f32_16x16x4f32(a, b1, acc1, 0, 0, 0); acc2 = __builtin_amdgcn_mfma_f32_16x16x4f32(a, b2, acc2, 0, 0, 0); }
}
typedef short bf16x8 __attribute__((ext_vector_type(8)));
typedef LAS bf16_t* ldsh;
typedef unsigned u32x4 __attribute__((ext_vector_type(4)));
typedef unsigned u32x2 __attribute__((ext_vector_type(2)));
__device__ __forceinline__ void unpack8v(const u32x4 u, float* f) { unpack8(make_uint4(u.x, u.y, u.z, u.w), f); }
__device__ __forceinline__ unsigned pk2(float lo, float hi) { unsigned r; asm volatile("v_cvt_pk_bf16_f32 %0, %1, %2" : "=v"(r) : "v"(lo), "v"(hi)); return r; }
__device__ __forceinline__ f32x4 mmb(int K, const LAS bf16_t* pa, int lda, const LAS bf16_t* pb, int ldb, f32x4 acc, int li, int kq) {
    const LAS bf16_t* a = pa + li * lda + kq * 8; const LAS bf16_t* b = pb + li * ldb + kq * 8;
#pragma unroll 4
    for (int k0 = 0; k0 < K; k0 += 32) acc = __builtin_amdgcn_mfma_f32_16x16x32_bf16(*(const LAS bf16x8*)(a + k0), *(const LAS bf16x8*)(b + k0), acc, 0, 0, 0);
    return acc;
}
__device__ __forceinline__ void tri_tile(int idx, int& tl, int& ts) {
    tl = (idx >= 6) ? 3 : (idx >= 3) ? 2 : (idx >= 1) ? 1 : 0; ts = idx - (tl * (tl + 1)) / 2;
}

template <bool PRE> struct EpiProj {
    static constexpr bool PERM = true, AFTER_DRAIN = false;
    bf16_t* O; const float* xss;
    __device__ __forceinline__ void operator()(const f32x4 (&acc)[2][2][4][2], const pg8::Unit& u, int wr, int wc, int fr, int fq) const {
        const int row0 = u.pm * 256 + wr * 64 + fr, col0 = u.pn * 256 + wc * 32 + 8 * fq;
#pragma unroll
        for (int ai = 0; ai < 2; ++ai)
#pragma unroll
            for (int m = 0; m < 4; ++m) {
                const int row = row0 + ai * 128 + m * 16;
                float rstd;
                if (PRE) rstd = xss[row];
                else {
                    const float4* sp = (const float4*)(xss + (size_t)row * XSSN + fq * 8);
                    const float4 v0 = sp[0], v1 = sp[1];
                    float s = ((v0.x + v0.y) + (v0.z + v0.w)) + ((v1.x + v1.y) + (v1.z + v1.w));
                    s += __shfl_xor(s, 16); s += __shfl_xor(s, 32);
                    rstd = rsqrtf(s * (1.f / DM) + 1e-6f);
                }
                bf16_t* rowp = O + (size_t)row * LDP + col0;
#pragma unroll
                for (int bj = 0; bj < 2; ++bj) {
                    const f32x4 v0 = acc[ai][bj][m][0] * rstd, v1 = acc[ai][bj][m][1] * rstd;
                    uint4 o; o.x = pg8::cvt_pk_bf16(v0[0], v0[1]); o.y = pg8::cvt_pk_bf16(v0[2], v0[3]); o.z = pg8::cvt_pk_bf16(v1[0], v1[1]); o.w = pg8::cvt_pk_bf16(v1[2], v1[3]);
                    *(uint4*)(rowp + bj * 128) = o;
                }
            }
    }
};
struct EpiOut {
    static constexpr bool PERM = false, AFTER_DRAIN = false;
    const float* xin; float* xout; bf16_t* xb; float* xss;
    __device__ __forceinline__ void operator()(const f32x4 (&acc)[2][2][4][2], const pg8::Unit& u, int wr, int wc, int fr, int fq) const {
        const int row0 = u.pm * 256 + wr * 64 + fr, col0 = u.pn * 256 + wc * 32 + 4 * fq;
#pragma unroll
        for (int ai = 0; ai < 2; ++ai)
#pragma unroll
            for (int m = 0; m < 4; ++m) {
                const int row = row0 + ai * 128 + m * 16; float ss = 0.f;
#pragma unroll
                for (int bj = 0; bj < 2; ++bj)
#pragma unroll
                    for (int n = 0; n < 2; ++n) {
                        const size_t off = (size_t)row * DM + col0 + bj * 128 + n * 16;
                        const f32x4 v = acc[ai][bj][m][n] + *(const f32x4*)(xin + off);
                        *(f32x4*)(xout + off) = v; ss += v[0] * v[0] + v[1] * v[1] + v[2] * v[2] + v[3] * v[3];
                        if (xb) { uint2 o; o.x = pg8::cvt_pk_bf16(v[0], v[1]); o.y = pg8::cvt_pk_bf16(v[2], v[3]); *(uint2*)(xb + off) = o; }
                    }
                ss += __shfl_xor(ss, 16); ss += __shfl_xor(ss, 32);
                if (fq == 0) xss[(size_t)row * XSSN + u.pn * 4 + wc] = ss;
            }
    }
};

__device__ __forceinline__ void transpose_convert(const float* __restrict__ src, int K, int N, int Npad, bf16_t* __restrict__ dst, const float* __restrict__ rowscale, ldsf lds) {
    const int tid = threadIdx.x, nkt = K / 64, ntiles = nkt * (Npad / 64);
    const int kk = tid >> 4, nn4 = (tid & 15) * 4;
    float4 c0 = make_float4(0.f, 0.f, 0.f, 0.f), c1 = c0;
    int tile = blockIdx.x;
    if (tile < ntiles) {
        const int k0 = (tile % nkt) * 64, n0 = (tile / nkt) * 64;
        if (n0 + nn4 < N) { c0 = *(const float4*)(src + (size_t)(k0 + kk) * N + n0 + nn4); c1 = *(const float4*)(src + (size_t)(k0 + kk + 32) * N + n0 + nn4); }
    }
    for (; tile < ntiles; tile += gridDim.x) {
        const int k0 = (tile % nkt) * 64, n0 = (tile / nkt) * 64;
        float4 a0 = c0, a1 = c1;
        const int nt = tile + gridDim.x;
        c0 = make_float4(0.f, 0.f, 0.f, 0.f); c1 = c0;
        if (nt < ntiles) {
            const int k1 = (nt % nkt) * 64, n1 = (nt / nkt) * 64;
            if (n1 + nn4 < N) { c0 = *(const float4*)(src + (size_t)(k1 + kk) * N + n1 + nn4); c1 = *(const float4*)(src + (size_t)(k1 + kk + 32) * N + n1 + nn4); }
        }
        if (rowscale) { const float s0 = rowscale[k0 + kk], s1 = rowscale[k0 + kk + 32]; a0.x *= s0; a0.y *= s0; a0.z *= s0; a0.w *= s0; a1.x *= s1; a1.y *= s1; a1.z *= s1; a1.w *= s1; }
        lds[kk * 65 + nn4 + 0] = a0.x; lds[kk * 65 + nn4 + 1] = a0.y; lds[kk * 65 + nn4 + 2] = a0.z; lds[kk * 65 + nn4 + 3] = a0.w;
        lds[(kk + 32) * 65 + nn4 + 0] = a1.x; lds[(kk + 32) * 65 + nn4 + 1] = a1.y; lds[(kk + 32) * 65 + nn4 + 2] = a1.z; lds[(kk + 32) * 65 + nn4 + 3] = a1.w;
        __syncthreads();
        {
            const int nn = tid >> 3, k8 = (tid & 7) * 8;
            uint4 o;
            o.x = pack2(lds[(k8 + 0) * 65 + nn], lds[(k8 + 1) * 65 + nn]); o.y = pack2(lds[(k8 + 2) * 65 + nn], lds[(k8 + 3) * 65 + nn]);
            o.z = pack2(lds[(k8 + 4) * 65 + nn], lds[(k8 + 5) * 65 + nn]); o.w = pack2(lds[(k8 + 6) * 65 + nn], lds[(k8 + 7) * 65 + nn]);
            *(uint4*)(dst + (size_t)(n0 + nn) * K + k0 + k8) = o;
        }
        __syncthreads();
    }
}
__device__ __forceinline__ void x_convert(CP P) {
    const int wave = threadIdx.x >> 6, lane = threadIdx.x & 63;
    for (int row = blockIdx.x * 8 + wave; row < M_TOK; row += gridDim.x * 8) {
        const float4* xr = (const float4*)(P->in[0] + (size_t)row * DM); float ss = 0.f;
#pragma unroll
        for (int i = 0; i < 8; ++i) {
            const float4 v = xr[lane + i * 64]; ss += v.x * v.x + v.y * v.y + v.z * v.z + v.w * v.w;
            uint2 o; o.x = pack2(v.x, v.y); o.y = pack2(v.z, v.w); *(uint2*)(P->actA + (size_t)row * DM + (lane + i * 64) * 4) = o;
        }
        ss = wave_sum(ss);
        if (lane == 0) P->xss0[row] = rsqrtf(ss * (1.f / DM) + 1e-6f);
    }
}

__device__ __forceinline__ void lora_convert(CP P) {
    for (int l = 0; l < 2; ++l) {
        const float* w2 = LP(P, l, I_RW_W2); const float* a2 = LP(P, l, I_RW_A2); const float* v2 = P->in[40];
        bf16_t* W = P->lora + (size_t)l * LORA_L; bf16_t* A = W + 512 * 64; bf16_t* V = A + 512 * 64;
        for (int e = blockIdx.x * 512 + threadIdx.x; e < 512 * 64; e += gridDim.x * 512) { const int c = e >> 6, k = e & 63; W[e] = f2bf(w2[k * 512 + c]); A[e] = f2bf(a2[k * 512 + c]); }
        if (l) for (int e = blockIdx.x * 512 + threadIdx.x; e < 512 * 32; e += gridDim.x * 512) { const int c = e >> 5, k = e & 31; V[e] = f2bf(v2[k * 512 + c]); }
    }
}
__device__ __forceinline__ void rwkv_prep(CP P, int l, ldsf lds) {
    const Cols C = cols(l); const int tid = opaque_tid(), wave = tid >> 6, lane = tid & 63, li = lane & 15, kq = lane >> 4;
    const float* mu = LP(P, l, I_RW_MU); const float* w0 = LP(P, l, I_RW_W0); const float* a0 = LP(P, l, I_RW_A0); const float* v0 = P->in[39];
    const bf16_t* W2t = P->lora + (size_t)l * LORA_L; const bf16_t* A2t = W2t + 512 * 64; const bf16_t* V2t = A2t + 512 * 64;
    constexpr int AS = 72, VS = 40;
    const ldsh Wl = (ldsh)lds, Al = Wl + 32 * AS, Vl = Al + 32 * AS;
    for (int tile = blockIdx.x; tile < M_TOK / 32; tile += gridDim.x) {
        const int t0 = tile * 32;
        {
            const int tt = tid >> 4, g = tid & 15, t = t0 + tt;
            const bf16_t* pr = P->proj + (size_t)t * LDP + C.rw + 1536 + g * 8;
            const bool hasp = (t % SEQL) != 0;
            float cur[8], prev[8];
            load8(pr, cur);
            if (hasp) load8(pr - LDP, prev); else {
#pragma unroll
                for (int e = 0; e < 8; ++e) prev[e] = 0.f; }
            float f[8];
#pragma unroll
            for (int e = 0; e < 8; ++e) { f[e] = cur[e] + mu[1536 + g * 8 + e] * (prev[e] - cur[e]); if (g < 8) f[e] = tanhf(f[e]); }
            u32x4 o; o.x = pk2(f[0], f[1]); o.y = pk2(f[2], f[3]); o.z = pk2(f[4], f[5]); o.w = pk2(f[6], f[7]);
            *(LAS u32x4*)((g < 8 ? Wl : Al) + tt * AS + (g & 7) * 8) = o;
            if (l && g < 4) {
                load8(pr + 128, cur);
                if (hasp) load8(pr + 128 - LDP, prev);
#pragma unroll
                for (int e = 0; e < 8; ++e) f[e] = cur[e] + mu[1664 + g * 8 + e] * (prev[e] - cur[e]);
                o.x = pk2(f[0], f[1]); o.y = pk2(f[2], f[3]); o.z = pk2(f[4], f[5]); o.w = pk2(f[6], f[7]);
                *(LAS u32x4*)(Vl + tt * VS + g * 8) = o;
            }
        }
        __syncthreads();
        for (int tl = wave; tl < 64; tl += 8) {
            const int tt16 = tl & 1, cc = (tl >> 1) * 16, c = cc + li;
            f32x4 aW = {0.f, 0.f, 0.f, 0.f}, aA = aW, aV = aW;
            const LAS bf16_t* pw = Wl + (tt16 * 16 + li) * AS + kq * 8; const LAS bf16_t* pa = Al + (tt16 * 16 + li) * AS + kq * 8;
#pragma unroll
            for (int k0 = 0; k0 < 64; k0 += 32) {
                aW = __builtin_amdgcn_mfma_f32_16x16x32_bf16(*(const LAS bf16x8*)(pw + k0), *(const bf16x8*)(W2t + (size_t)c * 64 + k0 + kq * 8), aW, 0, 0, 0);
                aA = __builtin_amdgcn_mfma_f32_16x16x32_bf16(*(const LAS bf16x8*)(pa + k0), *(const bf16x8*)(A2t + (size_t)c * 64 + k0 + kq * 8), aA, 0, 0, 0);
            }
            if (l) aV = __builtin_amdgcn_mfma_f32_16x16x32_bf16(*(const LAS bf16x8*)(Vl + (tt16 * 16 + li) * VS + kq * 8), *(const bf16x8*)(V2t + (size_t)c * 32 + kq * 8), aV, 0, 0, 0);
            const float w0c = w0[c], a0c = a0[c], muc = mu[1024 + c]; const float v0c = l ? v0[c] : 0.f;
#pragma unroll
            for (int j = 0; j < 4; ++j) {
                const int t = t0 + tt16 * 16 + kq * 4 + j; const size_t o = (size_t)t * 512 + c;
                const float wl = w0c + aW[j];
                const float sp = fmaxf(-wl, 0.f) + __logf(1.f + __expf(-fabsf(wl)));
                P->rwA[o] = __expf(-__expf(-sp - 0.5f));
                P->rwB[o] = sigmoidf_(a0c + aA[j]);
                const float cur = bf2f(P->proj[(size_t)t * LDP + C.rw + 1024 + c]);
                const float prev = (t % SEQL == 0) ? 0.f : bf2f(P->proj[(size_t)(t - 1) * LDP + C.rw + 1024 + c]);
                float v = cur + muc * (prev - cur);
                if (l) { const float g = sigmoidf_(v0c + aV[j]); const float vf = P->rwV[o]; v = v + (vf - v) * g; }
                P->rwV[o] = v;
            }
        }
        __syncthreads();
    }
}

__device__ __forceinline__ void rwkv_scan_item(CP P, int l, int it, ldsf lds) {
    const Cols C = cols(l); const int tid = opaque_tid();
    const int b = it >> 5, h = (it >> 2) & 7, rq = it & 3;
    constexpr int BUF = 5 * 2048 + 512 + 512;
    const float* mu = LP(P, l, I_RW_MU); const float* k_k = LP(P, l, I_RW_KK); const float* k_a = LP(P, l, I_RW_KA);
    const bool producer = tid >= 256; const int ptid = tid & 255;
    const int tt = ptid >> 3, cg8 = (ptid & 7) * 8, ch0 = h * 64 + cg8, c2 = (ptid & 7) * 2;
    const int ri = ptid >> 4, js = (ptid & 15) * 4;
    const float* r_k = LP(P, l, I_RW_RK);
    float mur[8], muk[8], kkc[8], kac[8], rkc[8];
#pragma unroll
    for (int e = 0; e < 8; ++e) { mur[e] = mu[ch0 + e]; muk[e] = mu[512 + ch0 + e]; kkc[e] = k_k[ch0 + e]; kac[e] = k_a[ch0 + e]; rkc[e] = r_k[ch0 + e]; }
    uint4 rcu, kcu, rpu, kpu; float4 ra0, ra1, rd0, rd1; float2 rv2;
    auto issue = [&](int c) {
        const int t = b * SEQL + c * 32 + tt;
        const bf16_t* pr = P->proj + (size_t)t * LDP + C.rw + ch0;
        rcu = *(const uint4*)pr; kcu = *(const uint4*)(pr + 512);
        rpu = make_uint4(0u, 0u, 0u, 0u); kpu = rpu;
        if (c > 0 || tt > 0) { rpu = *(const uint4*)(pr - LDP); kpu = *(const uint4*)(pr - LDP + 512); }
        const float* ap = P->rwB + (size_t)t * 512 + ch0; const float* dp = P->rwA + (size_t)t * 512 + ch0;
        ra0 = *(const float4*)ap; ra1 = *(const float4*)(ap + 4); rd0 = *(const float4*)dp; rd1 = *(const float4*)(dp + 4);
        rv2 = *(const float2*)(P->rwV + (size_t)t * 512 + h * 64 + rq * 16 + c2);
    };
    auto fill = [&](int c, ldsf buf) {
        ldsf sR = buf, sK = buf + 2048, sW = buf + 4096, sNK = buf + 6144, sB = buf + 8192, sV = buf + 10240;
        float rc[8], kc[8], rp[8], kp[8];
        alignas(16) float av[8]; alignas(16) float dv[8]; float kkr[8], kl[8];
        *(float4*)av = ra0; *(float4*)(av + 4) = ra1; *(float4*)dv = rd0; *(float4*)(dv + 4) = rd1;
        unpack8(rcu, rc); unpack8(kcu, kc); unpack8(rpu, rp); unpack8(kpu, kp);
        float ss = 0.f; alignas(16) float o1[8]; alignas(16) float o2[8]; alignas(16) float o3[8]; alignas(16) float o4[8];
#pragma unroll
        for (int e = 0; e < 8; ++e) {
            o1[e] = rc[e] + mur[e] * (rp[e] - rc[e]);
            kl[e] = kc[e] + muk[e] * (kp[e] - kc[e]);
            kkr[e] = kl[e] * kkc[e]; ss += kkr[e] * kkr[e];
        }
        *(LAS f32x4*)(sR + tt * 64 + cg8) = *(f32x4*)o1; *(LAS f32x4*)(sR + tt * 64 + cg8 + 4) = *(f32x4*)(o1 + 4);
        *(LAS f32x4*)(sW + tt * 64 + cg8) = *(f32x4*)dv; *(LAS f32x4*)(sW + tt * 64 + cg8 + 4) = *(f32x4*)(dv + 4);
        ss += dppf<0xB1>(ss); ss += dppf<0x4E>(ss); ss += dppf<0x141>(ss);
        const float inv = 1.f / fmaxf(sqrtf(ss), 1e-12f);
#pragma unroll
        for (int e = 0; e < 8; ++e) {
            const float kk = kkr[e] * inv;
            o2[e] = kl[e] * (1.f + (av[e] - 1.f) * kac[e]); o3[e] = -kk; o4[e] = kk * av[e];
        }
        if (rq == 0) {
            float bs = 0.f;
#pragma unroll
            for (int e = 0; e < 8; ++e) bs += o1[e] * o2[e] * rkc[e];
            bs += dppf<0xB1>(bs); bs += dppf<0x4E>(bs); bs += dppf<0x141>(bs);
            if ((ptid & 7) == 0) P->bon[(size_t)(b * SEQL + c * 32 + tt) * 8 + h] = bs;
        }
        *(LAS f32x4*)(sK + tt * 64 + cg8) = *(f32x4*)o2; *(LAS f32x4*)(sK + tt * 64 + cg8 + 4) = *(f32x4*)(o2 + 4);
        *(LAS f32x4*)(sNK + tt * 64 + cg8) = *(f32x4*)o3; *(LAS f32x4*)(sNK + tt * 64 + cg8 + 4) = *(f32x4*)(o3 + 4);
        *(LAS f32x4*)(sB + tt * 64 + cg8) = *(f32x4*)o4; *(LAS f32x4*)(sB + tt * 64 + cg8 + 4) = *(f32x4*)(o4 + 4);
        *(LAS f32x2*)(sV + tt * 16 + c2) = (f32x2){rv2.x, rv2.y};
    };
    auto flush = [&](int c, ldsf buf) {
        const LAS float* yp = buf + 10752 + tt * 16 + c2;
        *(unsigned*)(P->proj + (size_t)(b * SEQL + c * 32 + tt) * LDP + C.rw + 1024 + h * 64 + rq * 16 + c2) = pack2(yp[0], yp[1]);
    };
    f32x2 S[2] = {{0.f, 0.f}, {0.f, 0.f}};
    if (producer) { issue(0); fill(0, lds); issue(1); }
    lds_barrier();
    for (int c = 0; c < 64; ++c) {
        const ldsf cur = lds + (c & 1) * BUF, nxt = lds + ((c + 1) & 1) * BUF;
        if (producer) {
            if (c > 0) flush(c - 1, nxt);
            if (c + 1 < 64) { fill(c + 1, nxt); if (c + 2 < 64) issue(c + 2); }
        } else {
            const ldsf sR = cur, sK = cur + 2048, sW = cur + 4096, sNK = cur + 6144, sB = cur + 8192, sV = cur + 10240, sY = cur + 10752;
            struct Vecs { f32x4 nk, w, b, k, r; float vi; };
            auto ldv = [&](int t) { Vecs v;
                v.nk = *(const LAS f32x4*)(sNK + t * 64 + js); v.w = *(const LAS f32x4*)(sW + t * 64 + js); v.b = *(const LAS f32x4*)(sB + t * 64 + js);
                v.k = *(const LAS f32x4*)(sK + t * 64 + js); v.r = *(const LAS f32x4*)(sR + t * 64 + js); v.vi = sV[t * 16 + ri]; return v; };
            Vecs cur_v = ldv(0), nx1 = ldv(1);
            for (int t16 = 0; t16 < 2; ++t16) {
                float ykeep = 0.f;
#pragma unroll
                for (int u = 0; u < 16; ++u) {
                    const int t = t16 * 16 + u;
                    const Vecs nxt = ldv((t + 2) & 31);
                    f32x2 s2 = S[0] * cur_v.nk.xy; s2 = S[1] * cur_v.nk.zw + s2;
                    const float sa = reduce16(s2.x + s2.y);
                    const f32x2 sav = {sa, sa}, viv = {cur_v.vi, cur_v.vi};
                    f32x2 t0 = viv * cur_v.k.xy; t0 = sav * cur_v.b.xy + t0; S[0] = S[0] * cur_v.w.xy + t0;
                    f32x2 t1 = viv * cur_v.k.zw; t1 = sav * cur_v.b.zw + t1; S[1] = S[1] * cur_v.w.zw + t1;
                    f32x2 y2 = S[0] * cur_v.r.xy; y2 = S[1] * cur_v.r.zw + y2;
                    const float y = reduce16(y2.x + y2.y);
                    ykeep = ((tid & 15) == u) ? y : ykeep;
                    cur_v = nx1; nx1 = nxt;
                }
                sY[(t16 * 16 + (tid & 15)) * 16 + ri] = ykeep;
            }
        }
        lds_barrier();
    }
    if (producer) flush(63, lds + BUF);
    __syncthreads();
}

__device__ __forceinline__ void mlstm_item(CP P, int l, int it, ldsf lds) {
    const Cols C = cols(l); const int tid = opaque_tid(), wave = tid >> 6, lane = tid & 63, li = lane & 15, kq = lane >> 4;
    const int b = it >> 4, h = (it >> 2) & 3, es = it & 3;
    constexpr int QS = 136, SS = 72;
    const ldsh Qb = (ldsh)lds, Kb = Qb + 64 * QS, Ktb = Kb + 64 * QS, Vtb = Ktb + 128 * SS, Vwtb = Vtb + 32 * SS, Attb = Vwtb + 32 * SS, Ctb = Attb + 64 * SS, nbb = Ctb + 2 * 32 * QS, wendb = nbb + 2 * 128;
    const ldsf sCum = (ldsf)(wendb + 64), sLi = sCum + 64, sWend = sLi + 64, sMl = sWend + 64, sWint = sMl + 64, sScal = sWint + 64;
    const float* cw = LP(P, l, I_ML_CW); const float* cb = LP(P, l, I_ML_CB);
    const float igb = LP(P, l, I_ML_IGB)[h], fgb = LP(P, l, I_ML_FGB)[h];
    for (int e = tid; e < 64 * SS / 2; e += 512) ((LAS unsigned*)Attb)[e] = 0u;
    for (int e = tid; e < (2 * 32 * QS + 2 * 128) / 2; e += 512) ((LAS unsigned*)Ctb)[e] = 0u;
    float m_prev = 0.f;
    f32x4 Cm[2], nm[2];
#pragma unroll
    for (int q = 0; q < 2; ++q) { Cm[q] = (f32x4){0.f, 0.f, 0.f, 0.f}; nm[q] = Cm[q]; }
    const int cgp = tid & 31, rseg = tid >> 5, isk = cgp >> 4, d0 = (cgp & 15) * 8, col0 = isk * 512 + h * 128 + d0;
    const ldsh cdst = isk ? Kb : Qb; const float cscale = isk ? 0.08838834764831845f : 1.f;
    const bf16x8 ones8 = {(short)0x3F80, (short)0x3F80, (short)0x3F80, (short)0x3F80, (short)0x3F80, (short)0x3F80, (short)0x3F80, (short)0x3F80};
    uint4 raw[7]; uint4 vraw = make_uint4(0u, 0u, 0u, 0u); float gi_raw = 0.f, gf_raw = 0.f;
    auto issue_loads = [&](int nn) {
#pragma unroll
        for (int i = 0; i < 7; ++i) {
            const int ts = nn * 64 + rseg * 4 - 3 + i;
            raw[i] = (ts >= 0) ? *(const uint4*)(P->proj + (size_t)(b * SEQL + ts) * LDP + C.mqk + col0) : make_uint4(0u, 0u, 0u, 0u);
        }
        if (tid < 256) vraw = *(const uint4*)(P->proj + (size_t)(b * SEQL + nn * 64 + (tid >> 2)) * LDP + C.mv + h * 128 + es * 32 + (tid & 3) * 8);
        if (wave == 0) { const bf16_t* gp = P->proj + (size_t)(b * SEQL + nn * 64 + lane) * LDP; gi_raw = bf2f(gp[C.mi + h]); gf_raw = bf2f(gp[C.mf + h]); }
    };
    issue_loads(0);
    alignas(16) float wreg[4][8]; alignas(16) float breg[8];
    *(float4*)breg = *(const float4*)(cb + col0); *(float4*)(breg + 4) = *(const float4*)(cb + col0 + 4);
#pragma unroll
    for (int j = 0; j < 4; ++j) { *(float4*)wreg[j] = *(const float4*)(cw + j * 1024 + col0); *(float4*)(wreg[j] + 4) = *(const float4*)(cw + j * 1024 + col0 + 4); }
    __syncthreads();
    for (int n = 0; n < 32; ++n) {
        const int t0 = b * SEQL + n * 64, pb = n & 1;
        {
            float acc[4][8];
#pragma unroll
            for (int r = 0; r < 4; ++r)
#pragma unroll
                for (int e = 0; e < 8; ++e) acc[r][e] = breg[e];
#pragma unroll
            for (int i = 0; i < 7; ++i) {
                float f[8]; unpack8(raw[i], f);
#pragma unroll
                for (int r = 0; r < 4; ++r) { const int j = i - r; if (j >= 0 && j < 4) {
#pragma unroll
                    for (int e = 0; e < 8; ++e) acc[r][e] += wreg[j][e] * f[e]; } }
            }
#pragma unroll
            for (int r = 0; r < 4; ++r) {
#pragma unroll
                for (int e = 0; e < 8; ++e) acc[r][e] = siluf(acc[r][e]) * cscale;
                u32x4 o; o.x = pk2(acc[r][0], acc[r][1]); o.y = pk2(acc[r][2], acc[r][3]); o.z = pk2(acc[r][4], acc[r][5]); o.w = pk2(acc[r][6], acc[r][7]);
                *(LAS u32x4*)(cdst + (rseg * 4 + r) * QS + d0) = o;
            }
            if (isk) {
#pragma unroll
                for (int e = 0; e < 8; ++e) { u32x2 o; o.x = pk2(acc[0][e], acc[1][e]); o.y = pk2(acc[2][e], acc[3][e]); *(LAS u32x2*)(Ktb + (d0 + e) * SS + rseg * 4) = o; }
            }
            if (tid < 256) {
                const LAS bf16_t* vs = (const LAS bf16_t*)0; (void)vs;
                const unsigned w4[4] = {vraw.x, vraw.y, vraw.z, vraw.w};
#pragma unroll
                for (int e = 0; e < 8; ++e) Vtb[((tid & 3) * 8 + e) * SS + (tid >> 2)] = (bf16_t)((e & 1) ? (w4[e >> 1] >> 16) : (w4[e >> 1] & 0xffffu));
            }
        }
        if (wave == 0) {
            const int s = lane;
            const float lgi = gi_raw + igb;
            const float lf = logsigmoidf(gf_raw + fgb);
            const float cum = scan_add64(lf, lane);
            const float last = rdlane(cum, 63);
            const float g = last - cum + lgi; const float gmax = rdlane(scan_max64(g, lane), 63);
            const float pm = scan_max64(lgi - cum, lane);
            const float minter = cum + m_prev; const float ml = fmaxf(minter, cum + pm);
            const float we = __expf(g - gmax);
            sCum[s] = cum; sLi[s] = lgi; sWend[s] = we; wendb[s] = f2bf(we); sMl[s] = ml; sWint[s] = __expf(minter - ml);
            if (lane == 0) { sScal[0] = last; sScal[1] = gmax; }
        }
        if (n + 1 < 32) issue_loads(n + 1);
        lds_barrier();
        if (tid < 256) {
            const int e = tid >> 3, sg = (tid & 7) * 8;
            float f[8]; unpack8v(*(const LAS u32x4*)(Vtb + e * SS + sg), f);
            u32x4 o; o.x = pk2(f[0] * sWend[sg], f[1] * sWend[sg + 1]); o.y = pk2(f[2] * sWend[sg + 2], f[3] * sWend[sg + 3]);
            o.z = pk2(f[4] * sWend[sg + 4], f[5] * sWend[sg + 5]); o.w = pk2(f[6] * sWend[sg + 6], f[7] * sWend[sg + 7]);
            *(LAS u32x4*)(Vwtb + e * SS + sg) = o;
        }
        for (int idx = wave; idx < 10; idx += 8) {
            int tl, ts; tri_tile(idx, tl, ts);
            const f32x4 a = mmb(128, Qb + tl * 16 * QS, QS, Kb + ts * 16 * QS, QS, (f32x4){0.f, 0.f, 0.f, 0.f}, li, kq);
#pragma unroll
            for (int j = 0; j < 4; ++j) {
                const int lr = tl * 16 + kq * 4 + j, sc = ts * 16 + li;
                Attb[lr * SS + sc] = f2bf((sc <= lr) ? a[j] * __expf(sCum[lr] - sCum[sc] + sLi[sc] - sMl[lr]) : 0.f);
            }
        }
        lds_barrier();
        {
            const int tl = wave >> 1, te = wave & 1;
            f32x4 a1 = {0.f, 0.f, 0.f, 0.f}, ad = a1, a2 = a1, aq = a1;
            {
                const LAS bf16_t* pa = Attb + (tl * 16 + li) * SS + kq * 8; const LAS bf16_t* pv = Vtb + (te * 16 + li) * SS + kq * 8;
#pragma unroll
                for (int k0 = 0; k0 < 64; k0 += 32) { const bf16x8 av = *(const LAS bf16x8*)(pa + k0);
                    a1 = __builtin_amdgcn_mfma_f32_16x16x32_bf16(av, *(const LAS bf16x8*)(pv + k0), a1, 0, 0, 0); ad = __builtin_amdgcn_mfma_f32_16x16x32_bf16(av, ones8, ad, 0, 0, 0); }
                const LAS bf16_t* pq = Qb + (tl * 16 + li) * QS + kq * 8; const LAS bf16_t* pc = Ctb + pb * 32 * QS + (te * 16 + li) * QS + kq * 8; const LAS bf16_t* pn = nbb + pb * 128 + kq * 8;
#pragma unroll
                for (int k0 = 0; k0 < 128; k0 += 32) { const bf16x8 av = *(const LAS bf16x8*)(pq + k0);
                    a2 = __builtin_amdgcn_mfma_f32_16x16x32_bf16(av, *(const LAS bf16x8*)(pc + k0), a2, 0, 0, 0); aq = __builtin_amdgcn_mfma_f32_16x16x32_bf16(av, *(const LAS bf16x8*)(pn + k0), aq, 0, 0, 0); }
            }
#pragma unroll
            for (int j = 0; j < 4; ++j) {
                const int lr = tl * 16 + kq * 4 + j, e = te * 16 + li;
                const float wi = sWint[lr];
                const float den = fmaxf(fabsf(ad[j] + wi * aq[j]), __expf(-sMl[lr]));
                const float hv = (a1[j] + wi * a2[j]) / den;
                P->proj[(size_t)(t0 + lr) * LDP + C.mv + h * 128 + es * 32 + e] = f2bf(hv);
            }
            const float last = sScal[0], gmax = sScal[1];
            const float m_new = fmaxf(last + m_prev, gmax), a_old = __expf(last + m_prev - m_new), a_new = __expf(gmax - m_new);
#pragma unroll
            for (int q = 0; q < 2; ++q) {
                const int tile = wave + q * 8, td = tile >> 1, te2 = tile & 1;
                const LAS bf16_t* pk = Ktb + (td * 16 + li) * SS + kq * 8; const LAS bf16_t* pv = Vwtb + (te2 * 16 + li) * SS + kq * 8; const LAS bf16_t* pw = wendb + kq * 8;
                f32x4 a = {0.f, 0.f, 0.f, 0.f}, an = a;
#pragma unroll
                for (int k0 = 0; k0 < 64; k0 += 32) { const bf16x8 av = *(const LAS bf16x8*)(pk + k0);
                    a = __builtin_amdgcn_mfma_f32_16x16x32_bf16(av, *(const LAS bf16x8*)(pv + k0), a, 0, 0, 0);
                    if (te2 == 0) an = __builtin_amdgcn_mfma_f32_16x16x32_bf16(av, *(const LAS bf16x8*)(pw + k0), an, 0, 0, 0); }
                Cm[q] = Cm[q] * a_old + a * a_new;
                u32x2 o; o.x = pk2(Cm[q][0], Cm[q][1]); o.y = pk2(Cm[q][2], Cm[q][3]);
                *(LAS u32x2*)(Ctb + (pb ^ 1) * 32 * QS + (te2 * 16 + li) * QS + td * 16 + kq * 4) = o;
                if (te2 == 0) {
                    nm[q] = nm[q] * a_old + an * a_new;
                    if (li == 0) { u32x2 o2; o2.x = pk2(nm[q][0], nm[q][1]); o2.y = pk2(nm[q][2], nm[q][3]); *(LAS u32x2*)(nbb + (pb ^ 1) * 128 + td * 16 + kq * 4) = o2; }
                }
            }
            m_prev = m_new;
        }
        lds_barrier();
    }
}

__device__ __forceinline__ void ssd_item(CP P, int l, int it, ldsf lds) {
    const Cols C = cols(l); const int tid = opaque_tid(), wave = tid >> 6, lane = tid & 63, li = lane & 15, kq = lane >> 4;
    const int b = it >> 3, hh = it & 7, g = hh >> 2;
    constexpr int QS = 136, SS = 72;
    const ldsh Cmb = (ldsh)lds, Bmb = Cmb + 64 * QS, Bmtb = Bmb + 64 * QS, Lcb = Bmtb + 128 * SS, Xdtt = Lcb + 64 * SS, Xett = Xdtt + 64 * SS, Sb = Xett + 64 * SS;
    const ldsf sXr = (ldsf)(Sb + 2 * 64 * QS), sX = sXr + 67 * 64, sCum = sX + 64 * 65, sDt = sCum + 64, sE = sDt + 64, sEc = sE + 64, sScal = sEc + 64;
    const float* cw = LP(P, l, I_SSD_CW); const float* cb = LP(P, l, I_SSD_CB);
    const float Aneg = -expf(LP(P, l, I_SSD_ALOG)[hh]), dtb = LP(P, l, I_SSD_DTB)[hh], dsk = LP(P, l, I_SSD_D)[hh];
    for (int e = tid; e < 64 * SS / 2; e += 512) ((LAS unsigned*)Lcb)[e] = 0u;
    for (int e = tid; e < 2 * 64 * QS / 2; e += 512) ((LAS unsigned*)Sb)[e] = 0u;
    float hv = 0.f;
    f32x4 Sm[4];
#pragma unroll
    for (int q = 0; q < 4; ++q) Sm[q] = (f32x4){0.f, 0.f, 0.f, 0.f};
    const int cgp = tid & 31, rseg = tid >> 5, isc = cgp >> 4, n0 = (cgp & 15) * 8, col0 = 512 + isc * 256 + g * 128 + n0;
    const ldsh cdst = isc ? Cmb : Bmb;
    const int xcol = hh * 64 + (tid & 63);
    uint4 raw[7]; uint4 xraw = make_uint4(0u, 0u, 0u, 0u); float dt_raw = 0.f;
    auto issue_loads = [&](int nn) {
#pragma unroll
        for (int i = 0; i < 7; ++i) {
            const int ts = nn * 64 + rseg * 4 - 3 + i;
            raw[i] = (ts >= 0) ? *(const uint4*)(P->proj + (size_t)(b * SEQL + ts) * LDP + C.sx + col0) : make_uint4(0u, 0u, 0u, 0u);
        }
        xraw = *(const uint4*)(P->proj + (size_t)(b * SEQL + nn * 64 + (tid >> 3)) * LDP + C.sx + hh * 64 + (tid & 7) * 8);
        if (wave == 0) dt_raw = bf2f(P->proj[(size_t)(b * SEQL + nn * 64 + lane) * LDP + C.sdt + hh]);
    };
    issue_loads(0);
    alignas(16) float wreg[4][8]; alignas(16) float breg[8];
    *(float4*)breg = *(const float4*)(cb + col0); *(float4*)(breg + 4) = *(const float4*)(cb + col0 + 4);
#pragma unroll
    for (int j = 0; j < 4; ++j) { *(float4*)wreg[j] = *(const float4*)(cw + j * 1024 + col0); *(float4*)(wreg[j] + 4) = *(const float4*)(cw + j * 1024 + col0 + 4); }
    __syncthreads();
    for (int n = 0; n < 32; ++n) {
        const int t0 = b * SEQL + n * 64, pb = n & 1;
        if (tid < 192) sXr[tid] = hv;
        {
            float acc[4][8];
#pragma unroll
            for (int r = 0; r < 4; ++r)
#pragma unroll
                for (int e = 0; e < 8; ++e) acc[r][e] = breg[e];
#pragma unroll
            for (int i = 0; i < 7; ++i) {
                float f[8]; unpack8(raw[i], f);
#pragma unroll
                for (int r = 0; r < 4; ++r) { const int j = i - r; if (j >= 0 && j < 4) {
#pragma unroll
                    for (int e = 0; e < 8; ++e) acc[r][e] += wreg[j][e] * f[e]; } }
            }
#pragma unroll
            for (int r = 0; r < 4; ++r) {
#pragma unroll
                for (int e = 0; e < 8; ++e) acc[r][e] = siluf(acc[r][e]);
                u32x4 o; o.x = pk2(acc[r][0], acc[r][1]); o.y = pk2(acc[r][2], acc[r][3]); o.z = pk2(acc[r][4], acc[r][5]); o.w = pk2(acc[r][6], acc[r][7]);
                *(LAS u32x4*)(cdst + (rseg * 4 + r) * QS + n0) = o;
            }
            if (!isc) {
#pragma unroll
                for (int e = 0; e < 8; ++e) { u32x2 o; o.x = pk2(acc[0][e], acc[1][e]); o.y = pk2(acc[2][e], acc[3][e]); *(LAS u32x2*)(Bmtb + (n0 + e) * SS + rseg * 4) = o; }
            }
            { float f[8]; unpack8(xraw, f);
#pragma unroll
                for (int e = 0; e < 8; ++e) sXr[((tid >> 3) + 3) * 64 + (tid & 7) * 8 + e] = f[e]; }
        }
        if (wave == 0) {
            const float dt = softplusf(dt_raw + dtb);
            const float cum = scan_add64(dt * Aneg, lane);
            const float last = rdlane(cum, 63);
            sDt[lane] = dt; sCum[lane] = cum; sE[lane] = __expf(last - cum); sEc[lane] = __expf(cum);
            if (lane == 0) sScal[0] = __expf(last);
        }
        if (n + 1 < 32) issue_loads(n + 1);
        lds_barrier();
        {
            const int p = tid & 63, mseg = tid >> 6;
            const float cb0 = cb[xcol], w0 = cw[xcol], w1 = cw[1024 + xcol], w2 = cw[2048 + xcol], w3 = cw[3072 + xcol];
            float xr[11];
#pragma unroll
            for (int i = 0; i < 11; ++i) xr[i] = sXr[(mseg * 8 + i) * 64 + p];
            float xd[8], xe[8];
#pragma unroll
            for (int r = 0; r < 8; ++r) {
                const int mm = mseg * 8 + r;
                const float x = siluf(cb0 + w0 * xr[r] + w1 * xr[r + 1] + w2 * xr[r + 2] + w3 * xr[r + 3]);
                sX[mm * 65 + p] = x; xd[r] = x * sDt[mm]; xe[r] = xd[r] * sE[mm];
            }
            u32x4 o; o.x = pk2(xd[0], xd[1]); o.y = pk2(xd[2], xd[3]); o.z = pk2(xd[4], xd[5]); o.w = pk2(xd[6], xd[7]); *(LAS u32x4*)(Xdtt + p * SS + mseg * 8) = o;
            o.x = pk2(xe[0], xe[1]); o.y = pk2(xe[2], xe[3]); o.z = pk2(xe[4], xe[5]); o.w = pk2(xe[6], xe[7]); *(LAS u32x4*)(Xett + p * SS + mseg * 8) = o;
        }
        for (int idx = wave; idx < 10; idx += 8) {
            int tl, ts; tri_tile(idx, tl, ts);
            const f32x4 a = mmb(128, Cmb + tl * 16 * QS, QS, Bmb + ts * 16 * QS, QS, (f32x4){0.f, 0.f, 0.f, 0.f}, li, kq);
#pragma unroll
            for (int j = 0; j < 4; ++j) {
                const int lr = tl * 16 + kq * 4 + j, sc = ts * 16 + li;
                Lcb[lr * SS + sc] = f2bf((sc <= lr) ? a[j] * __expf(sCum[lr] - sCum[sc]) : 0.f);
            }
        }
        lds_barrier();
        {
            const f32x4 z4 = {0.f, 0.f, 0.f, 0.f};
#pragma unroll
            for (int q = 0; q < 2; ++q) {
                const int tile = wave + q * 8, tl = tile >> 2, tp = tile & 3;
                const f32x4 a1 = mmb(64, Lcb + tl * 16 * SS, SS, Xdtt + tp * 16 * SS, SS, z4, li, kq);
                const f32x4 a2 = mmb(128, Cmb + tl * 16 * QS, QS, Sb + pb * 64 * QS + tp * 16 * QS, QS, z4, li, kq);
#pragma unroll
                for (int j = 0; j < 4; ++j) {
                    const int lr = tl * 16 + kq * 4 + j, p = tp * 16 + li;
                    const float y = a1[j] + sEc[lr] * a2[j] + dsk * sX[lr * 65 + p];
                    P->proj[(size_t)(t0 + lr) * LDP + C.sx + hh * 64 + p] = f2bf(y);
                }
            }
            const float elast = sScal[0];
#pragma unroll
            for (int q = 0; q < 4; ++q) {
                const int tile = wave + q * 8, tp2 = tile & 3, tn = tile >> 2;
                const f32x4 a = mmb(64, Xett + tp2 * 16 * SS, SS, Bmtb + tn * 16 * SS, SS, z4, li, kq);
                Sm[q] = Sm[q] * elast + a;
#pragma unroll
                for (int j = 0; j < 4; ++j) Sb[(pb ^ 1) * 64 * QS + (tp2 * 16 + kq * 4 + j) * QS + tn * 16 + li] = f2bf(Sm[q][j]);
            }
            if (tid < 192) hv = sXr[64 * 64 + tid];
        }
        lds_barrier();
    }
}

__device__ __forceinline__ void gla_item(CP P, int l, int it, ldsf lds) {
    const int tid = opaque_tid(), wave = tid >> 6, lane = tid & 63, li = lane & 15, kq = lane >> 4;
    const int b = it >> 3, h = (it >> 1) & 3, vs = it & 1;
    constexpr int SS = 72;
    const ldsh Qgb = (ldsh)lds, Kgb = Qgb + 64 * SS, Kgtb = Kgb + 64 * SS, Vtb = Kgtb + 64 * SS, Attb = Vtb + 64 * SS, Stb = Attb + 64 * SS;
    const ldsf sQ = (ldsf)(Stb + 2 * 64 * SS), sK = sQ + 64 * 65, sCum = sK + 64 * 65, sGl = sCum + 64 * 65, sW2 = sGl + 64 * 17, sGb = sW2 + 16 * 64, sSeg = sGb + 64, sDec = sSeg + 8 * 64;
    const float* gw2 = LP(P, l, I_GK_W2); const float* gb = LP(P, l, I_GK_B);
    for (int e = tid; e < 16 * 64; e += 512) sW2[e] = gw2[(e >> 6) * 256 + h * 64 + (e & 63)];
    if (tid < 64) sGb[tid] = gb[h * 64 + tid];
    for (int e = tid; e < 64 * SS / 2; e += 512) ((LAS unsigned*)Attb)[e] = 0u;
    for (int e = tid; e < 2 * 64 * SS / 2; e += 512) ((LAS unsigned*)Stb)[e] = 0u;
    f32x4 Sm[2] = {{0.f, 0.f, 0.f, 0.f}, {0.f, 0.f, 0.f, 0.f}};
    uint4 qraw, kraw, xr, gr = make_uint4(0u, 0u, 0u, 0u);
    auto issue_loads = [&](int nn) {
        const int row = tid >> 3, cg = (tid & 7) * 8; const bf16_t* pr = P->proj + (size_t)(b * SEQL + nn * 64 + row) * LDP + h * 64 + cg;
        qraw = *(const uint4*)(pr + C_GQ); kraw = *(const uint4*)(pr + C_GK);
        xr = *(const uint4*)(P->proj + (size_t)(b * SEQL + nn * 64 + row) * LDP + C_GV + h * 128 + vs * 64 + cg);
        if (tid < 128) gr = *(const uint4*)(P->proj + (size_t)(b * SEQL + nn * 64 + (tid >> 1)) * LDP + C_GGK + (tid & 1) * 8);
    };
    issue_loads(0);
    __syncthreads();
    for (int n = 0; n < 32; ++n) {
        const int t0 = b * SEQL + n * 64, pb = n & 1;
        {
            const int row = tid >> 3, cg = (tid & 7) * 8;
            float f[8]; unpack8(qraw, f);
#pragma unroll
            for (int e = 0; e < 8; ++e) sQ[row * 65 + cg + e] = f[e] * 0.125f;
            unpack8(kraw, f);
#pragma unroll
            for (int e = 0; e < 8; ++e) sK[row * 65 + cg + e] = f[e];
            {
                const unsigned w4[4] = {xr.x, xr.y, xr.z, xr.w};
#pragma unroll
                for (int e = 0; e < 8; ++e) Vtb[(cg + e) * SS + row] = (bf16_t)((e & 1) ? (w4[e >> 1] >> 16) : (w4[e >> 1] & 0xffffu));
            }
            if (tid < 128) {
                unpack8(gr, f);
#pragma unroll
                for (int e = 0; e < 8; ++e) sGl[(tid >> 1) * 17 + (tid & 1) * 8 + e] = f[e];
            }
        }
        if (n + 1 < 32) issue_loads(n + 1);
        lds_barrier();
        for (int e = tid; e < 4096; e += 512) {
            const int s = e >> 6, d = e & 63; float gk = sGb[d];
#pragma unroll
            for (int r = 0; r < 16; ++r) gk += sGl[s * 17 + r] * sW2[r * 64 + d];
            sCum[s * 65 + d] = logsigmoid_fast(gk) * 0.0625f;
        }
        lds_barrier();
        const int d = tid & 63, seg = tid >> 6;
        {
            float run = 0.f;
#pragma unroll
            for (int r = 0; r < 8; ++r) { run += sCum[(seg * 8 + r) * 65 + d]; sCum[(seg * 8 + r) * 65 + d] = run; }
            sSeg[seg * 64 + d] = run;
        }
        lds_barrier();
        {
            float off = 0.f;
            for (int s2 = 0; s2 < seg; ++s2) off += sSeg[s2 * 64 + d];
            float kg[8];
#pragma unroll
            for (int r = 0; r < 8; ++r) {
                const int s = seg * 8 + r; const float c = sCum[s * 65 + d] + off;
                const float ec = __expf(c);
                Qgb[s * SS + d] = f2bf(sQ[s * 65 + d] * ec);
                kg[r] = sK[s * 65 + d] * __expf(-c);
                Kgb[s * SS + d] = f2bf(kg[r]);
                if (s == 63) sDec[d] = ec;
            }
            u32x4 o; o.x = pk2(kg[0], kg[1]); o.y = pk2(kg[2], kg[3]); o.z = pk2(kg[4], kg[5]); o.w = pk2(kg[6], kg[7]);
            *(LAS u32x4*)(Kgtb + d * SS + seg * 8) = o;
        }
        lds_barrier();
        for (int idx = wave; idx < 10; idx += 8) {
            int tl, ts; tri_tile(idx, tl, ts);
            const f32x4 a = mmb(64, Qgb + tl * 16 * SS, SS, Kgb + ts * 16 * SS, SS, (f32x4){0.f, 0.f, 0.f, 0.f}, li, kq);
#pragma unroll
            for (int j = 0; j < 4; ++j) { const int lr = tl * 16 + kq * 4 + j, sc = ts * 16 + li; Attb[lr * SS + sc] = f2bf((sc <= lr) ? a[j] : 0.f); }
        }
        lds_barrier();
        {
            const f32x4 z4 = {0.f, 0.f, 0.f, 0.f};
#pragma unroll
            for (int q = 0; q < 2; ++q) {
                const int tile = wave + q * 8, tl = tile >> 2, tv = tile & 3;
                f32x4 a = mmb(64, Attb + tl * 16 * SS, SS, Vtb + tv * 16 * SS, SS, z4, li, kq);
                a = mmb(64, Qgb + tl * 16 * SS, SS, Stb + pb * 64 * SS + tv * 16 * SS, SS, a, li, kq);
#pragma unroll
                for (int j = 0; j < 4; ++j) { const int lr = tl * 16 + kq * 4 + j, v = tv * 16 + li; P->proj[(size_t)(t0 + lr) * LDP + C_GV + h * 128 + vs * 64 + v] = f2bf(a[j]); }
            }
#pragma unroll
            for (int q = 0; q < 2; ++q) {
                const int tile = wave + q * 8, td = tile >> 2, tv = tile & 3;
                const f32x4 u = mmb(64, Kgtb + td * 16 * SS, SS, Vtb + tv * 16 * SS, SS, z4, li, kq);
#pragma unroll
                for (int j = 0; j < 4; ++j) Sm[q][j] = sDec[td * 16 + kq * 4 + j] * (Sm[q][j] + u[j]);
                u32x2 o; o.x = pk2(Sm[q][0], Sm[q][1]); o.y = pk2(Sm[q][2], Sm[q][3]);
                *(LAS u32x2*)(Stb + (pb ^ 1) * 64 * SS + (tv * 16 + li) * SS + td * 16 + kq * 4) = o;
            }
        }
        lds_barrier();
    }
}

#ifndef ITEM_MASK
#define ITEM_MASK 15
#endif
template <int IM = ITEM_MASK> __device__ __forceinline__ void scan_phase(CP P, int l, ldsf lds) {
    for (int it = blockIdx.x; it < N_ITEMS; it += gridDim.x) {
        if (it < N_RW) { if (IM & 1) rwkv_scan_item(P, l, it, lds); }
        else if (it < N_RW + 64) { if (IM & 2) mlstm_item(P, l, it - N_RW, lds); }
        else if (it < N_RW + 96) { if (IM & 4) ssd_item(P, l, it - N_RW - 64, lds); }
        else { if (IM & 8) gla_item(P, l, it - N_RW - 96, lds); }
        __syncthreads();
    }
}

__device__ __forceinline__ void finalize_phase(CP P, int l) {
    const Cols C = cols(l); const int wave = threadIdx.x >> 6, lane = threadIdx.x & 63, c8 = lane * 8;
    const float* gla_g = LP(P, l, I_GLA_NG); const float* mu = LP(P, l, I_RW_MU); const float* k_a = LP(P, l, I_RW_KA); const float* r_k = LP(P, l, I_RW_RK);
    const float* ln_g = LP(P, l, I_RW_LNG); const float* ln_b = LP(P, l, I_RW_LNB); const float* ssd_g = LP(P, l, I_SSD_NG); const float* ml_g = LP(P, l, I_ML_NG);
    for (int t = blockIdx.x * 8 + wave; t < M_TOK; t += gridDim.x * 8) {
        const bf16_t* pr = P->proj + (size_t)t * LDP; bf16_t* yo = P->actA + (size_t)t * DM;
        float a[8], z[8], y[8];
        {
            load8(pr + C_GV + c8, a); load8(pr + C_GZ + c8, z);
            float ss = 0.f;
#pragma unroll
            for (int e = 0; e < 8; ++e) ss += a[e] * a[e];
            ss += __shfl_xor(ss, 1); ss += __shfl_xor(ss, 2); ss += __shfl_xor(ss, 4); ss += __shfl_xor(ss, 8);
            const float rstd = rsqrtf(ss * (1.f / 128.f) + 1e-6f);
#pragma unroll
            for (int e = 0; e < 8; ++e) y[e] = a[e] * rstd * gla_g[c8 + e] * siluf(z[e]);
            store8(yo + c8, y);
        }
        {
            load8(pr + C.rw + 1024 + c8, a); load8(pr + C.rwz + c8, z);
            float s = 0.f;
#pragma unroll
            for (int e = 0; e < 8; ++e) s += a[e];
            s += __shfl_xor(s, 1); s += __shfl_xor(s, 2); s += __shfl_xor(s, 4);
            const float mean = s * (1.f / 64.f); float vs = 0.f;
#pragma unroll
            for (int e = 0; e < 8; ++e) { a[e] -= mean; vs += a[e] * a[e]; }
            vs += __shfl_xor(vs, 1); vs += __shfl_xor(vs, 2); vs += __shfl_xor(vs, 4);
            const float rstd = rsqrtf(vs * (1.f / 64.f) + 64e-5f);
            alignas(16) float vv[8];
            *(float4*)vv = *(const float4*)(P->rwV + (size_t)t * 512 + c8); *(float4*)(vv + 4) = *(const float4*)(P->rwV + (size_t)t * 512 + c8 + 4);
            const float bs = P->bon[(size_t)t * 8 + (lane >> 3)];
#pragma unroll
            for (int e = 0; e < 8; ++e) y[e] = (a[e] * rstd * ln_g[c8 + e] + ln_b[c8 + e] + bs * vv[e]) * siluf(z[e]);
            store8(yo + 512 + c8, y);
        }
        {
            load8(pr + C.sx + c8, a); load8(pr + C.sz + c8, z);
            float ss = 0.f;
#pragma unroll
            for (int e = 0; e < 8; ++e) { a[e] *= siluf(z[e]); ss += a[e] * a[e]; }
            ss = wave_sum(ss);
            const float rstd = rsqrtf(ss * (1.f / 512.f) + 1e-6f);
#pragma unroll
            for (int e = 0; e < 8; ++e) y[e] = a[e] * rstd * ssd_g[c8 + e];
            store8(yo + 1024 + c8, y);
        }
        {
            float o[8];
            load8(pr + C.mv + c8, a); load8(pr + C.mo + c8, o); load8(pr + C.mz + c8, z);
            float s = 0.f;
#pragma unroll
            for (int e = 0; e < 8; ++e) { a[e] *= sigmoidf_(o[e]); s += a[e]; }
            s += __shfl_xor(s, 1); s += __shfl_xor(s, 2); s += __shfl_xor(s, 4); s += __shfl_xor(s, 8);
            const float mean = s * (1.f / 128.f); float vs = 0.f;
#pragma unroll
            for (int e = 0; e < 8; ++e) { a[e] -= mean; vs += a[e] * a[e]; }
            vs += __shfl_xor(vs, 1); vs += __shfl_xor(vs, 2); vs += __shfl_xor(vs, 4); vs += __shfl_xor(vs, 8);
            const float rstd = rsqrtf(vs * (1.f / 128.f) + 1e-6f);
#pragma unroll
            for (int e = 0; e < 8; ++e) y[e] = a[e] * rstd * ml_g[c8 + e] * siluf(z[e]);
            store8(yo + 1536 + c8, y);
        }
    }
}

__device__ __forceinline__ void final_norm(CP P) {
    const int wave = threadIdx.x >> 6, lane = threadIdx.x & 63; const float* g = P->in[57];
    for (int row = blockIdx.x * 8 + wave; row < M_TOK; row += gridDim.x * 8) {
        float s = (lane < XSSN) ? P->xss2[(size_t)row * XSSN + lane] : 0.f; s = wave_sum(s);
        const float rstd = rsqrtf(s * (1.f / DM) + 1e-6f);
        float4* xr = (float4*)(P->out + (size_t)row * DM); const float4* gr = (const float4*)g;
#pragma unroll
        for (int i = 0; i < 8; ++i) { float4 v = xr[lane + i * 64]; const float4 gg = gr[lane + i * 64]; v.x *= rstd * gg.x; v.y *= rstd * gg.y; v.z *= rstd * gg.z; v.w *= rstd * gg.w; xr[lane + i * 64] = v; }
    }
}

#define XB_TMO      128
#define XB_XCNT(j)  (256  + 64 * (j))
#define XB_XSUB(j)  (1280 + 64 * (j))
#define XB_XGEN(j)  (2304 + 64 * (j))
#define XB_TOP      3328
#define XB_TOPGEN   3392
#define XCD_BAR_WORDS 3456
#define XB_SPIN_CAP (1u << 18)

__device__ __forceinline__ unsigned xb_ld(unsigned* p)              { return __hip_atomic_load(p, __ATOMIC_RELAXED, __HIP_MEMORY_SCOPE_AGENT); }
__device__ __forceinline__ unsigned xb_add(unsigned* p, unsigned v) { return __hip_atomic_fetch_add(p, v, __ATOMIC_RELAXED, __HIP_MEMORY_SCOPE_AGENT); }
__device__ __forceinline__ unsigned xb_xcc_id() { return (unsigned)__builtin_amdgcn_s_getreg((3 << 11) | 20) & 0xFu; }
#define XB_SPIN(cond, bar) do { unsigned _sp = 0; while (cond) { __builtin_amdgcn_s_sleep(1); \
    if ((++_sp & 255u) == 0u) { if (xb_ld(&(bar)[XB_TMO])) break; if (_sp > XB_SPIN_CAP) { atomicAdd(&(bar)[XB_TMO], 1u); break; } } } } while (0)

struct XcdBarrier {
    unsigned* bar; unsigned x;
    volatile LAS unsigned* st;
};

__device__ __forceinline__ XcdBarrier xcd_barrier_post(unsigned* bar, volatile LAS unsigned* st) {
    XcdBarrier b; b.bar = bar; b.x = xb_xcc_id(); b.st = st;
    if (threadIdx.x == 0) (void)xb_add(&bar[XB_XCNT(b.x)], 1u);
    return b;
}
__device__ __forceinline__ void xcd_barrier_complete(unsigned* bar, unsigned x, unsigned& nloc, unsigned& nx) {
    const unsigned G = gridDim.x * gridDim.y * gridDim.z;
    unsigned sum, cnt, mine, sp = 0u;
    for (;;) {
        sum = 0u; cnt = 0u; mine = 0u;
#pragma unroll
        for (unsigned j = 0; j < 16; ++j) { const unsigned c = xb_ld(&bar[XB_XCNT(j)]); sum += c; cnt += (c > 0u) ? 1u : 0u; mine = (j == x) ? c : mine; }
        if (sum == G) break;
        __builtin_amdgcn_s_sleep(1);
        if ((++sp & 255u) == 0u) { if (xb_ld(&bar[XB_TMO])) break; if (sp > XB_SPIN_CAP) { atomicAdd(&bar[XB_TMO], 1u); break; } }
    }
    nloc = mine > 0u ? mine : 1u; nx = cnt > 0u ? cnt : 1u;
}

__device__ __forceinline__ void xcd_barrier(const XcdBarrier& b) {
    asm volatile("s_waitcnt vmcnt(0)" ::: "memory");
    __syncthreads();
    if (threadIdx.x == 0) {
        unsigned* bar = b.bar;
        __builtin_amdgcn_s_waitcnt(0);
        unsigned nloc = b.st[0], nx = b.st[1];
        if (nloc == 0u) { xcd_barrier_complete(bar, b.x, nloc, nx); b.st[0] = nloc; b.st[1] = nx; }
        const unsigned old = xb_add(&bar[XB_XSUB(b.x)], 1u);
        const unsigned gen = old / nloc;
        if (old + 1u == (gen + 1u) * nloc) {
            __builtin_amdgcn_fence(__ATOMIC_RELEASE, "agent");
            asm volatile("s_waitcnt vmcnt(0)" ::: "memory");
            const unsigned og = xb_add(&bar[XB_TOP], 1u);
            const unsigned tg = og / nx;
            if (og + 1u == (tg + 1u) * nx) xb_add(&bar[XB_TOPGEN], 1u);
            else XB_SPIN(xb_ld(&bar[XB_TOPGEN]) == tg, bar);
            __builtin_amdgcn_fence(__ATOMIC_ACQUIRE, "agent");
            xb_add(&bar[XB_XGEN(b.x)], 1u);
            asm volatile("s_waitcnt vmcnt(0)" ::: "memory");
        } else {
            XB_SPIN(xb_ld(&bar[XB_XGEN(b.x)]) == gen, bar);
            __builtin_amdgcn_fence(__ATOMIC_ACQUIRE, "agent");
            asm volatile("s_waitcnt vmcnt(0)" ::: "memory");
        }
    }
    __syncthreads();
}


template <bool PRE> __device__ __forceinline__ void gemm_inproj(CP P, const bf16_t* A, const float* xss, PG8_LAS unsigned char* lds) {
    pg8::Gemm g; g.A = A; g.Bt = P->Wi; g.M = M_TOK; g.N = LDP; g.K = DM;
    pg8::StaticOrder S; S.init(g.M, g.N, (int)gridDim.x, (int)blockIdx.x);
    EpiProj<PRE> E; E.O = P->proj; E.xss = xss;
    pg8::gemm_phase<EpiProj<PRE>, pg8::StaticOrder, false>(lds, g, S, E, nullptr);
}
__device__ __forceinline__ void gemm_outproj(CP P, const bf16_t* Wo, const float* xin, bf16_t* xb, float* xss, PG8_LAS unsigned char* lds) {
    pg8::Gemm g; g.A = P->actA; g.Bt = Wo; g.M = M_TOK; g.N = DM; g.K = DM;
    pg8::StaticOrder S; S.init(g.M, g.N, (int)gridDim.x, (int)blockIdx.x);
    EpiOut E; E.xin = xin; E.xout = P->out; E.xb = xb; E.xss = xss;
    pg8::gemm_phase<EpiOut, pg8::StaticOrder, false>(lds, g, S, E, nullptr);
}

#ifndef PROBE_DUP
#define PROBE_DUP 0
#endif
#ifndef PH_MASK
#define PH_MASK 0xFFF
#endif
#define RUN_PHASE(k, body) do { if ((PH_MASK >> (k)) & 1) { if (ph_lo <= (k) && (k) < ph_hi) { CP P = Pc; asm volatile("" : "+s"(P)); body; if ((PROBE_DUP >> (k)) & 1) { __syncthreads(); body; } if (coop && (k) + 1 < ph_hi) { if (coop == 2) grid.sync(); else xcd_barrier(xb); } } } } while (0)
__global__ void __launch_bounds__(512, 2) mega(Params Pk, int ph_lo, int ph_hi, int coop) {
    extern __shared__ __attribute__((aligned(16))) unsigned char shm[];
    PG8_LAS unsigned char* ldsb = (PG8_LAS unsigned char*)shm; ldsf lds = (ldsf)shm;
    cg::grid_group grid = cg::this_grid();
    const CP Pc = (CP)__builtin_amdgcn_kernarg_segment_ptr();
    volatile LAS unsigned* stw = (volatile LAS unsigned*)(shm + LDS_BYTES - 16);
    if (threadIdx.x < 4) stw[threadIdx.x] = 0u;
    __syncthreads();
    XcdBarrier xb = xcd_barrier_post(Pc->bar, stw);
    RUN_PHASE(0, { transpose_convert(P->in[2], DM, 7840, LDP, P->Wi, P->in[1], lds); transpose_convert(P->in[3], DM, DM, DM, P->Wo0, nullptr, lds);
                   transpose_convert(P->in[30], DM, DM, DM, P->Wo1, nullptr, lds); x_convert(P); lora_convert(P); });
#ifdef PROBE_PRE
    { CP P = Pc; asm volatile("" : "+s"(P)); gemm_inproj<true>(P, P->actA, P->xss0, ldsb); grid.sync(); rwkv_prep(P, 0, lds); grid.sync(); scan_phase<PROBE_PRE>(P, 0, lds); grid.sync(); }
#endif
    RUN_PHASE(1, gemm_inproj<true>(P, P->actA, P->xss0, ldsb));
    RUN_PHASE(2, rwkv_prep(P, 0, lds));
    RUN_PHASE(3, scan_phase(P, 0, lds));
    RUN_PHASE(4, { finalize_phase(P, 0); transpose_convert(P->in[29], DM, 7872, LDP, P->Wi, P->in[28], lds); });
    RUN_PHASE(5, gemm_outproj(P, P->Wo0, P->in[0], P->xb1, P->xss1, ldsb));
    RUN_PHASE(6, gemm_inproj<false>(P, P->xb1, P->xss1, ldsb));
    RUN_PHASE(7, rwkv_prep(P, 1, lds));
    RUN_PHASE(8, scan_phase(P, 1, lds));
    RUN_PHASE(9, finalize_phase(P, 1));
    RUN_PHASE(10, gemm_outproj(P, P->Wo1, P->out, nullptr, P->xss2, ldsb));
    RUN_PHASE(11, final_norm(P));
}

#ifndef MK_COOP
#define MK_COOP 1
#endif
extern "C" void kernel_launch(void* const* d_in, const int* in_sizes, int n_in, void* d_out, int out_size, void* d_ws, size_t ws_size, hipStream_t stream) {
    Params p{};
    for (int i = 0; i < 58; ++i) p.in[i] = (const float*)d_in[i];
    p.out = (float*)d_out;
    char* w = (char*)d_ws; size_t off = 0;
    auto take = [&](size_t bytes) { char* r = w + off; off += (bytes + 255) & ~(size_t)255; return r; };
    p.Wi = (bf16_t*)take((size_t)LDP * DM * 2);
    p.Wo0 = (bf16_t*)take((size_t)DM * DM * 2);
    p.Wo1 = (bf16_t*)take((size_t)DM * DM * 2);
    p.actA = (bf16_t*)take((size_t)M_TOK * DM * 2);
    p.proj = (bf16_t*)take((size_t)M_TOK * LDP * 2);
    p.rwA = (float*)take((size_t)M_TOK * 512 * 4);
    p.rwB = (float*)take((size_t)M_TOK * 512 * 4);
    p.xb1 = (bf16_t*)p.rwA;
    p.rwV = (float*)take((size_t)M_TOK * 512 * 4);
    p.xss0 = (float*)take((size_t)M_TOK * XSSN * 4);
    p.xss1 = (float*)take((size_t)M_TOK * XSSN * 4);
    p.xss2 = (float*)take((size_t)M_TOK * XSSN * 4);
    p.bar = (unsigned*)take((size_t)XCD_BAR_WORDS * 4);
    p.lora = (bf16_t*)take((size_t)LORA_ELEMS * 2);
    p.bon = (float*)take((size_t)M_TOK * 8 * 4);
    if (off > ws_size) { fprintf(stderr, "workspace too small: need %zu have %zu\n", off, ws_size); return; }
    static int grid_blocks = 0;
    if (!grid_blocks) {
        hipFuncSetAttribute((const void*)mega, hipFuncAttributeMaxDynamicSharedMemorySize, LDS_BYTES);
        int dev = 0, cus = 0, per_cu = 0;
        hipGetDevice(&dev);
        hipDeviceGetAttribute(&cus, hipDeviceAttributeMultiprocessorCount, dev);
        hipOccupancyMaxActiveBlocksPerMultiprocessor(&per_cu, mega, 512, LDS_BYTES);
        if (per_cu > 1) per_cu = 1;
        grid_blocks = cus * per_cu;
        if (grid_blocks <= 0) grid_blocks = 256;
    }
#if MK_COOP
    hipMemsetAsync(p.bar, 0, (size_t)XCD_BAR_WORDS * 4, stream);
    int lo = 0, hi = N_PHASES, coop = 1;
    void* args[] = {&p, &lo, &hi, &coop};
    hipError_t e = hipLaunchCooperativeKernel((const void*)mega, dim3(grid_blocks), dim3(512), args, LDS_BYTES, stream);
    if (e != hipSuccess) fprintf(stderr, "cooperative launch failed: %s (grid %d)\n", hipGetErrorString(e), grid_blocks);
#else
    for (int ph = 0; ph < N_PHASES; ++ph) hipLaunchKernelGGL(mega, dim3(grid_blocks), dim3(512), LDS_BYTES, stream, p, ph, ph + 1, 0);
#endif
}
```

```cpp
#include <hip/hip_runtime.h>
#include <hip/hip_cooperative_groups.h>
#include <cstdio>
namespace cg = cooperative_groups;

namespace pg8 {
#define PG8_LAS __attribute__((address_space(3)))
typedef unsigned short bf16_t;
typedef short bf16x8 __attribute__((ext_vector_type(8)));
typedef float f32x4 __attribute__((ext_vector_type(4)));
typedef unsigned u32x4 __attribute__((ext_vector_type(4)));
constexpr int BM = 256, BK = 64, HALF = 128, HTB = HALF * BK * 2  , STAGE_BYTES = 8 * HTB, NXCD = 8, WGM = 8;

__host__ __device__ __forceinline__ int lds_byte(int r, int c) { const int st = (r >> 4) * 2 + (c >> 5), rr = r & 15, cc = c & 31, ob = rr * 64 + cc * 2; return st * 1024 + (ob ^ (((ob >> 9) & 1) << 5)); }
__host__ __device__ __forceinline__ void stage_rc(int b, int& R, int& C) { const int st = b / 1024, sb = b % 1024, swz = sb ^ (((sb >> 9) & 1) << 5); R = (st >> 1) * 16 + swz / 64; C = (st & 1) * 32 + (swz % 64) / 2; }
__host__ __device__ __forceinline__ int perm32(int rho) { const int n = rho >> 4, i = rho & 15; return 8 * (i >> 2) + 4 * n + (i & 3); }

struct Unit { int pm, pn; };
struct Gemm { const bf16_t* A; const bf16_t* Bt; int M, N, K; };

struct StaticOrder {
    int nM, nN, nwg, G, c;
    __host__ __device__ void init(int M, int N, int G_, int c_) { nM = M / BM; nN = N / BM; nwg = nM * nN; G = G_; c = c_; }
    __host__ __device__ bool next(int i, Unit& u) const {
        const long L = (long)i * G + c; if (L >= nwg) return false;
        int wgid = (int)L; { const int q = nwg / NXCD, r = nwg % NXCD, xcd = wgid % NXCD, off = wgid / NXCD; wgid = (xcd < r ? xcd * (q + 1) : r * (q + 1) + (xcd - r) * q) + off; }
        const int nig = WGM * nN, gid = wgid / nig, fm = gid * WGM, gsz = (nM - fm) < WGM ? (nM - fm) : WGM;
        u.pm = fm + ((wgid % nig) % gsz); u.pn = (wgid % nig) / gsz; return true;
    }
    __device__ __forceinline__ void a_ready(const Unit&) const {}
    __device__ __forceinline__ void done(const Unit&) const {}
};
__device__ __forceinline__ unsigned cvt_pk_bf16(float lo, float hi) { unsigned r; asm volatile("v_cvt_pk_bf16_f32 %0, %1, %2" : "=v"(r) : "v"(lo), "v"(hi)); return r; }
template <class Epi, class Sched, bool STAMP = false>
__device__ __forceinline__ void gemm_phase(PG8_LAS unsigned char* lds, const Gemm g, const Sched& S, const Epi& E, unsigned long long* stamps) {
    const int tid = threadIdx.x, wid = __builtin_amdgcn_readfirstlane(tid >> 6), lane = tid & 63, wr = wid >> 2, wc = wid & 3, fr = lane & 15, fq = lane >> 4;
    const int K = g.K, nt = K / BK;
    int ts_lo = 0, ts_hi = 0, nts = 0; const unsigned long long rt_entry = STAMP ? (unsigned long long)wall_clock64() : 0ull;
#define PG8_STAMP() do { if (STAMP && wid == 0 && nts < 64) { const unsigned long long _c = (unsigned long long)clock64(); \
        ts_lo = (lane == nts) ? (int)(unsigned)_c : ts_lo; ts_hi = (lane == nts) ? (int)(unsigned)(_c >> 32) : ts_hi; ++nts; } } while (0)
    PG8_STAMP();
    unsigned voffA[2], voffB[2];
#pragma unroll
    for (int i = 0; i < 2; ++i) { int R, C; stage_rc(tid * 16 + i * 8192, R, C); const int Rb = Epi::PERM ? ((R & ~31) + perm32(R & 31)) : R;
        voffA[i] = (unsigned)(R * K + C) * 2u; voffB[i] = (unsigned)(Rb * K + C) * 2u; }
    const size_t kstep = (size_t)(BK * 2);
    const size_t hstep = (size_t)HALF * K * 2;
    const size_t tstep = 2 * hstep;
    const unsigned ldsw = (unsigned)wid * 1024u;
    const int aoff = lds_byte(wr * 64 + fr, fq * 8), boff = lds_byte(wc * 32 + fr, fq * 8);
#define PG8_SA(b, h) (((b) * 2 + (h)) * HTB)
#define PG8_SB(b, h) ((4 + (b) * 2 + (h)) * HTB)
#define PG8_STAGE(bufoff, gbase, voff) do { _Pragma("unroll") for (int _i = 0; _i < 2; ++_i) \
        __builtin_amdgcn_global_load_lds((const unsigned*)((const char*)(gbase) + (voff)[_i]), (PG8_LAS unsigned*)(lds + (bufoff) + ldsw + _i * 8192), 16, 0, 0); } while (0)
#define PG8_LDA(dst, b, h) do { _Pragma("unroll") for (int m = 0; m < 4; ++m) _Pragma("unroll") for (int k = 0; k < 2; ++k) dst[m][k] = *(const PG8_LAS bf16x8*)(lds + PG8_SA(b, h) + aoff + m * 2048 + k * 1024); } while (0)
#define PG8_LDB(dst, b, h) do { _Pragma("unroll") for (int n = 0; n < 2; ++n) _Pragma("unroll") for (int k = 0; k < 2; ++k) dst[n][k] = *(const PG8_LAS bf16x8*)(lds + PG8_SB(b, h) + boff + n * 2048 + k * 1024); } while (0)
#define PG8_MMA(ai, bj, At, Bt) do { __builtin_amdgcn_s_setprio(1); _Pragma("unroll") for (int m = 0; m < 4; ++m) _Pragma("unroll") for (int n = 0; n < 2; ++n) _Pragma("unroll") for (int k = 0; k < 2; ++k) \
        acc[ai][bj][m][n] = __builtin_amdgcn_mfma_f32_16x16x32_bf16(Bt[n][k], At[m][k], acc[ai][bj][m][n], 0, 0, 0); __builtin_amdgcn_s_setprio(0); } while (0)
#define PG8_WAIT_V(n) asm volatile("s_waitcnt vmcnt(" #n ")" ::: "memory")
#define PG8_WAIT_L(n) asm volatile("s_waitcnt lgkmcnt(" #n ")" ::: "memory")
#define PG8_BAR __builtin_amdgcn_s_barrier()
#define PG8_SCHED __builtin_amdgcn_sched_barrier(0)
    Unit cur, nxt; int ui = 0;
    if (!S.next(0, cur)) return;
    f32x4 acc[2][2][4][2];
#pragma unroll
    for (int a = 0; a < 2; ++a)
#pragma unroll
        for (int b = 0; b < 2; ++b)
#pragma unroll
            for (int m = 0; m < 4; ++m)
#pragma unroll
                for (int n = 0; n < 2; ++n) acc[a][b][m][n] = (f32x4){0.f, 0.f, 0.f, 0.f};
    bf16x8 At[4][2], B0[2][2], B1[2][2];
    const char* cA = (const char*)g.A + (size_t)cur.pm * tstep; const char* cB = (const char*)g.Bt + (size_t)cur.pn * tstep;
    S.a_ready(cur);
    PG8_STAGE(PG8_SB(0, 0), cB, voffB); PG8_STAGE(PG8_SA(0, 0), cA, voffA); PG8_STAGE(PG8_SB(0, 1), cB + hstep, voffB); PG8_STAGE(PG8_SA(0, 1), cA + hstep, voffA);
    if (wr == 1) PG8_BAR;
    PG8_WAIT_V(4); PG8_BAR;
    PG8_STAGE(PG8_SB(1, 0), cB + kstep, voffB); PG8_STAGE(PG8_SA(1, 0), cA + kstep, voffA); PG8_STAGE(PG8_SB(1, 1), cB + hstep + kstep, voffB);
    PG8_WAIT_V(6); PG8_BAR;
    PG8_STAMP();
    for (;;) {
        const bool has_next = S.next(ui + 1, nxt);
        const char* nA = has_next ? (const char*)g.A + (size_t)nxt.pm * tstep : cA; const char* nB = has_next ? (const char*)g.Bt + (size_t)nxt.pn * tstep : cB;
        for (int t = 0; t < nt; t += 2) {
            const bool last = (t == nt - 2);
            const char* a1 = cA + (size_t)(t + 1) * kstep;
            const char* a2 = last ? nA : cA + (size_t)(t + 2) * kstep; const char* b2 = last ? nB : cB + (size_t)(t + 2) * kstep;
            const char* a3 = a2 + kstep; const char* b3 = b2 + kstep;
            if (last && has_next) S.a_ready(nxt);
            PG8_LDB(B0, 0, 0); PG8_SCHED; PG8_LDA(At, 0, 0); PG8_STAGE(PG8_SA(1, 1), a1 + hstep, voffA);
            PG8_WAIT_L(8); PG8_BAR; PG8_WAIT_L(0); PG8_MMA(0, 0, At, B0); PG8_BAR; PG8_SCHED;
            PG8_LDB(B1, 0, 1); PG8_STAGE(PG8_SB(0, 0), b2, voffB);
            PG8_BAR; PG8_WAIT_L(0); PG8_MMA(0, 1, At, B1); PG8_BAR;
            PG8_LDA(At, 0, 1); PG8_STAGE(PG8_SA(0, 0), a2, voffA);
            PG8_BAR; PG8_WAIT_L(0); PG8_MMA(1, 0, At, B0); PG8_BAR; PG8_SCHED;
            PG8_STAGE(PG8_SB(0, 1), b2 + hstep, voffB);
            PG8_WAIT_V(6); PG8_BAR; PG8_MMA(1, 1, At, B1); PG8_BAR;
            PG8_LDB(B0, 1, 0); PG8_SCHED; PG8_LDA(At, 1, 0); PG8_STAGE(PG8_SA(0, 1), a2 + hstep, voffA);
            PG8_WAIT_L(8); PG8_BAR; PG8_WAIT_L(0); PG8_MMA(0, 0, At, B0); PG8_BAR; PG8_SCHED;
            PG8_LDB(B1, 1, 1); PG8_STAGE(PG8_SB(1, 0), b3, voffB);
            PG8_BAR; PG8_WAIT_L(0); PG8_MMA(0, 1, At, B1); PG8_BAR;
            PG8_LDA(At, 1, 1); PG8_STAGE(PG8_SA(1, 0), a3, voffA);
            PG8_BAR; PG8_WAIT_L(0); PG8_MMA(1, 0, At, B0); PG8_BAR; PG8_SCHED;
            PG8_STAGE(PG8_SB(1, 1), b3 + hstep, voffB);
            PG8_WAIT_V(6); PG8_BAR; PG8_MMA(1, 1, At, B1); PG8_BAR;
        }
        PG8_STAMP();
        if constexpr (!Epi::AFTER_DRAIN) { E(acc, cur, wr, wc, fr, fq); S.done(cur); }
        PG8_STAMP();
        if (!has_next) break;
#pragma unroll
        for (int a = 0; a < 2; ++a)
#pragma unroll
            for (int b = 0; b < 2; ++b)
#pragma unroll
                for (int m = 0; m < 4; ++m)
#pragma unroll
                    for (int n = 0; n < 2; ++n) acc[a][b][m][n] = (f32x4){0.f, 0.f, 0.f, 0.f};
        cur = nxt; cA = nA; cB = nB; ++ui;
    }
    PG8_WAIT_V(0);
    if (wr == 0) PG8_BAR;
    PG8_BAR;
    if constexpr (Epi::AFTER_DRAIN) { E.fused(acc, cur, wr, wc, fr, fq, lds, wid, lane); S.done(cur); }
    PG8_STAMP();
    if (STAMP && wid == 0) { stamps[lane] = lane < nts ? (((unsigned long long)(unsigned)ts_hi << 32) | (unsigned)ts_lo) : 0ull;
        if (lane == 62) stamps[62] = rt_entry; if (lane == 63) stamps[63] = (unsigned long long)wall_clock64(); }
#undef PG8_STAMP
#undef PG8_SA
#undef PG8_SB
#undef PG8_STAGE
#undef PG8_LDA
#undef PG8_LDB
#undef PG8_MMA
#undef PG8_WAIT_V
#undef PG8_WAIT_L
#undef PG8_BAR
#undef PG8_SCHED
}
}

typedef unsigned short bf16_t;
typedef float f32x4 __attribute__((ext_vector_type(4)));
#define LAS __attribute__((address_space(3)))
typedef LAS float* ldsf;

constexpr int M_TOK = 8192, DM = 2048, SEQL = 2048, LDP = 7936, XSSN = 32;
constexpr int LDS_BYTES = 160 * 1024;
constexpr int N_PHASES = 12;
constexpr int LORA_L = 2 * 512 * 64 + 512 * 32, LORA_ELEMS = 2 * LORA_L;
constexpr int N_RW = 128, N_ITEMS = N_RW + 128;

enum { I_NORM_G = 0, I_W_IN, I_W_OUT, I_GK_W2, I_GK_B, I_GLA_NG, I_RW_MU, I_RW_W0, I_RW_W2, I_RW_A0, I_RW_A2, I_RW_KK, I_RW_KA, I_RW_RK, I_RW_LNG, I_RW_LNB,
       I_SSD_CW, I_SSD_CB, I_SSD_DTB, I_SSD_ALOG, I_SSD_D, I_SSD_NG, I_ML_CW, I_ML_CB, I_ML_IGB, I_ML_FGB, I_ML_NG };

struct Params {
    const float* in[58];
    float* out;
    bf16_t* Wi; bf16_t* Wo0; bf16_t* Wo1; bf16_t* actA; bf16_t* proj; bf16_t* xb1;
    float* rwA; float* rwB; float* rwV; float* xss0; float* xss1; float* xss2; unsigned* bar; bf16_t* lora; float* bon;
};
typedef const __attribute__((address_space(4))) Params* CP;
__device__ __forceinline__ const float* LP(CP P, int l, int idx) { return P->in[(l ? 28 : 1) + idx + ((l && idx >= I_RW_KK) ? 2 : 0)]; }

struct Cols { int rw, rwz, sx, sdt, sz, mqk, mv, mi, mf, mo, mz, nin; };
__device__ __forceinline__ Cols cols(int l) {
    const int RW = l ? 1696 : 1664; Cols c;
    c.rw = 1552; c.rwz = 1552 + RW; c.sx = c.rwz + 512; c.sdt = c.sx + 1024; c.sz = c.sdt + 8; c.mqk = c.sz + 512; c.mv = c.mqk + 1024;
    c.mi = c.mv + 512; c.mf = c.mi + 4; c.mo = c.mf + 4; c.mz = c.mo + 512; c.nin = c.mz + 512; return c;
}
constexpr int C_GQ = 0, C_GK = 256, C_GV = 512, C_GGK = 1024, C_GZ = 1040;

__device__ __forceinline__ float bf2f(bf16_t u) { return __uint_as_float(((unsigned)u) << 16); }
__device__ __forceinline__ bf16_t f2bf(float f) { unsigned u = __float_as_uint(f); u += 0x7FFFu + ((u >> 16) & 1u); return (bf16_t)(u >> 16); }
__device__ __forceinline__ unsigned pack2(float lo, float hi) { return (unsigned)f2bf(lo) | ((unsigned)f2bf(hi) << 16); }
__device__ __forceinline__ void unpack8(const uint4 u, float* f) {
    f[0] = __uint_as_float(u.x << 16); f[1] = __uint_as_float(u.x & 0xffff0000u); f[2] = __uint_as_float(u.y << 16); f[3] = __uint_as_float(u.y & 0xffff0000u);
    f[4] = __uint_as_float(u.z << 16); f[5] = __uint_as_float(u.z & 0xffff0000u); f[6] = __uint_as_float(u.w << 16); f[7] = __uint_as_float(u.w & 0xffff0000u);
}
__device__ __forceinline__ void load8(const bf16_t* p, float* f) { unpack8(*(const uint4*)p, f); }
__device__ __forceinline__ void store8(bf16_t* p, const float* f) { uint4 u; u.x = pack2(f[0], f[1]); u.y = pack2(f[2], f[3]); u.z = pack2(f[4], f[5]); u.w = pack2(f[6], f[7]); *(uint4*)p = u; }
__device__ __forceinline__ float softplusf(float x) { return fmaxf(x, 0.f) + log1pf(expf(-fabsf(x))); }
__device__ __forceinline__ float logsigmoidf(float x) { return fminf(x, 0.f) - log1pf(expf(-fabsf(x))); }
__device__ __forceinline__ float sigmoidf_(float x) { return __builtin_amdgcn_rcpf(1.f + __expf(-x)); }
__device__ __forceinline__ float siluf(float x) { return x * __builtin_amdgcn_rcpf(1.f + __expf(-x)); }
__device__ __forceinline__ float logsigmoid_fast(float x) { return fminf(x, 0.f) - __logf(1.f + __expf(-fabsf(x))); }
typedef float f32x2 __attribute__((ext_vector_type(2)));
__device__ __forceinline__ float wave_sum(float v) { for (int o = 32; o; o >>= 1) v += __shfl_xor(v, o); return v; }
__device__ __forceinline__ float wave_max(float v) { for (int o = 32; o; o >>= 1) v = fmaxf(v, __shfl_xor(v, o)); return v; }
template <int CTRL> __device__ __forceinline__ float dppf(float v) { return __int_as_float(__builtin_amdgcn_update_dpp(0, __float_as_int(v), CTRL, 0xF, 0xF, true)); }
__device__ __forceinline__ float reduce16(float v) { v += dppf<0xB1>(v); v += dppf<0x4E>(v); v += dppf<0x141>(v); v += dppf<0x140>(v); return v; }
__device__ __forceinline__ float reduce8(float v) { v += dppf<0xB1>(v); v += dppf<0x4E>(v); v += dppf<0x141>(v); return v; }

template <int CTRL> __device__ __forceinline__ float dpp_keep(float oldv, float v) { return __int_as_float(__builtin_amdgcn_update_dpp(__float_as_int(oldv), __float_as_int(v), CTRL, 0xF, 0xF, false)); }
__device__ __forceinline__ float rdlane(float v, int l) { return __int_as_float(__builtin_amdgcn_readlane(__float_as_int(v), l)); }
__device__ __forceinline__ float scan_add64(float v, int lane) {
    v += dppf<0x111>(v); v += dppf<0x112>(v); v += dppf<0x114>(v); v += dppf<0x118>(v);
    const float t0 = rdlane(v, 15), t1 = rdlane(v, 31), t2 = rdlane(v, 47); const int row = lane >> 4;
    return v + ((row >= 1) ? t0 : 0.f) + ((row >= 2) ? t1 : 0.f) + ((row >= 3) ? t2 : 0.f);
}
__device__ __forceinline__ float scan_max64(float v, int lane) {
    const float ninf = -__builtin_inff();
    v = fmaxf(v, dpp_keep<0x111>(ninf, v)); v = fmaxf(v, dpp_keep<0x112>(ninf, v)); v = fmaxf(v, dpp_keep<0x114>(ninf, v)); v = fmaxf(v, dpp_keep<0x118>(ninf, v));
    const float t0 = rdlane(v, 15), t1 = rdlane(v, 31), t2 = rdlane(v, 47); const int row = lane >> 4;
    return fmaxf(fmaxf(v, (row >= 1) ? t0 : ninf), fmaxf((row >= 2) ? t1 : ninf, (row >= 3) ? t2 : ninf));
}
__device__ __forceinline__ void lds_barrier() { asm volatile("s_waitcnt lgkmcnt(0)\n\ts_barrier" ::: "memory"); }
__device__ __forceinline__ int opaque_tid() { int t = threadIdx.x; asm volatile("" : "+v"(t)); return t; }
template <class FA, class FB> __device__ __forceinline__ f32x4 mm16(int K, FA fa, FB fb, f32x4 acc, int i, int kq) {
#pragma unroll 4
    for (int k0 = 0; k0 < K; k0 += 4) { const float a = fa(i, k0 + kq), b = fb(k0 + kq, i); acc = __builtin_amdgcn_mfma_f32_16x16x4f32(a, b, acc, 0, 0, 0); }
    return acc;
}
template <class FA, class FB1, class FB2> __device__ __forceinline__ void mm16_2(int K, FA fa, FB1 fb1, FB2 fb2, f32x4& acc1, f32x4& acc2, int i, int kq) {
#pragma unroll 4
    for (int k0 = 0; k0 < K; k0 += 4) { const float a = fa(i, k0 + kq), b1 = fb1(k0 + kq, i), b2 = fb2(k0 + kq, i);
        acc1 = __builtin_amdgcn_mfma_f32_16x16x4f32(a, b1, acc1, 0, 0, 0); acc2 = __builtin_amdgcn_mfma_f32_16x16x4f32(a, b2, acc2, 0, 0, 0); }
}
typedef short bf16x8 __attribute__((ext_vector_type(8)));
typedef LAS bf16_t* ldsh;
typedef unsigned u32x4 __attribute__((ext_vector_type(4)));
typedef unsigned u32x2 __attribute__((ext_vector_type(2)));
__device__ __forceinline__ void unpack8v(const u32x4 u, float* f) { unpack8(make_uint4(u.x, u.y, u.z, u.w), f); }
__device__ __forceinline__ unsigned pk2(float lo, float hi) { unsigned r; asm volatile("v_cvt_pk_bf16_f32 %0, %1, %2" : "=v"(r) : "v"(lo), "v"(hi)); return r; }
__device__ __forceinline__ f32x4 mmb(int K, const LAS bf16_t* pa, int lda, const LAS bf16_t* pb, int ldb, f32x4 acc, int li, int kq) {
    const LAS bf16_t* a = pa + li * lda + kq * 8; const LAS bf16_t* b = pb + li * ldb + kq * 8;
#pragma unroll 4
    for (int k0 = 0; k0 < K; k0 += 32) acc = __builtin_amdgcn_mfma_f32_16x16x32_bf16(*(const LAS bf16x8*)(a + k0), *(const LAS bf16x8*)(b + k0), acc, 0, 0, 0);
    return acc;
}
__device__ __forceinline__ void tri_tile(int idx, int& tl, int& ts) {
    tl = (idx >= 6) ? 3 : (idx >= 3) ? 2 : (idx >= 1) ? 1 : 0; ts = idx - (tl * (tl + 1)) / 2;
}

template <bool PRE> struct EpiProj {
    static constexpr bool PERM = true, AFTER_DRAIN = false;
    bf16_t* O; const float* xss;
    __device__ __forceinline__ void operator()(const f32x4 (&acc)[2][2][4][2], const pg8::Unit& u, int wr, int wc, int fr, int fq) const {
        const int row0 = u.pm * 256 + wr * 64 + fr, col0 = u.pn * 256 + wc * 32 + 8 * fq;
#pragma unroll
        for (int ai = 0; ai < 2; ++ai)
#pragma unroll
            for (int m = 0; m < 4; ++m) {
                const int row = row0 + ai * 128 + m * 16;
                float rstd;
                if (PRE) rstd = xss[row];
                else {
                    const float4* sp = (const float4*)(xss + (size_t)row * XSSN + fq * 8);
                    const float4 v0 = sp[0], v1 = sp[1];
                    float s = ((v0.x + v0.y) + (v0.z + v0.w)) + ((v1.x + v1.y) + (v1.z + v1.w));
                    s += __shfl_xor(s, 16); s += __shfl_xor(s, 32);
                    rstd = rsqrtf(s * (1.f / DM) + 1e-6f);
                }
                bf16_t* rowp = O + (size_t)row * LDP + col0;
#pragma unroll
                for (int bj = 0; bj < 2; ++bj) {
                    const f32x4 v0 = acc[ai][bj][m][0] * rstd, v1 = acc[ai][bj][m][1] * rstd;
                    uint4 o; o.x = pg8::cvt_pk_bf16(v0[0], v0[1]); o.y = pg8::cvt_pk_bf16(v0[2], v0[3]); o.z = pg8::cvt_pk_bf16(v1[0], v1[1]); o.w = pg8::cvt_pk_bf16(v1[2], v1[3]);
                    *(uint4*)(rowp + bj * 128) = o;
                }
            }
    }
};
struct EpiOut {
    static constexpr bool PERM = false, AFTER_DRAIN = false;
    const float* xin; float* xout; bf16_t* xb; float* xss;
    __device__ __forceinline__ void operator()(const f32x4 (&acc)[2][2][4][2], const pg8::Unit& u, int wr, int wc, int fr, int fq) const {
        const int row0 = u.pm * 256 + wr * 64 + fr, col0 = u.pn * 256 + wc * 32 + 4 * fq;
#pragma unroll
        for (int ai = 0; ai < 2; ++ai)
#pragma unroll
            for (int m = 0; m < 4; ++m) {
                const int row = row0 + ai * 128 + m * 16; float ss = 0.f;
#pragma unroll
                for (int bj = 0; bj < 2; ++bj)
#pragma unroll
                    for (int n = 0; n < 2; ++n) {
                        const size_t off = (size_t)row * DM + col0 + bj * 128 + n * 16;
                        const f32x4 v = acc[ai][bj][m][n] + *(const f32x4*)(xin + off);
                        *(f32x4*)(xout + off) = v; ss += v[0] * v[0] + v[1] * v[1] + v[2] * v[2] + v[3] * v[3];
                        if (xb) { uint2 o; o.x = pg8::cvt_pk_bf16(v[0], v[1]); o.y = pg8::cvt_pk_bf16(v[2], v[3]); *(uint2*)(xb + off) = o; }
                    }
                ss += __shfl_xor(ss, 16); ss += __shfl_xor(ss, 32);
                if (fq == 0) xss[(size_t)row * XSSN + u.pn * 4 + wc] = ss;
            }
    }
};

__device__ __forceinline__ void transpose_convert(const float* __restrict__ src, int K, int N, int Npad, bf16_t* __restrict__ dst, const float* __restrict__ rowscale, ldsf lds) {
    const int tid = threadIdx.x, nkt = K / 64, ntiles = nkt * (Npad / 64);
    const int kk = tid >> 4, nn4 = (tid & 15) * 4;
    float4 c0 = make_float4(0.f, 0.f, 0.f, 0.f), c1 = c0;
    int tile = blockIdx.x;
    if (tile < ntiles) {
        const int k0 = (tile % nkt) * 64, n0 = (tile / nkt) * 64;
        if (n0 + nn4 < N) { c0 = *(const float4*)(src + (size_t)(k0 + kk) * N + n0 + nn4); c1 = *(const float4*)(src + (size_t)(k0 + kk + 32) * N + n0 + nn4); }
    }
    for (; tile < ntiles; tile += gridDim.x) {
        const int k0 = (tile % nkt) * 64, n0 = (tile / nkt) * 64;
        float4 a0 = c0, a1 = c1;
        const int nt = tile + gridDim.x;
        c0 = make_float4(0.f, 0.f, 0.f, 0.f); c1 = c0;
        if (nt < ntiles) {
            const int k1 = (nt % nkt) * 64, n1 = (nt / nkt) * 64;
            if (n1 + nn4 < N) { c0 = *(const float4*)(src + (size_t)(k1 + kk) * N + n1 + nn4); c1 = *(const float4*)(src + (size_t)(k1 + kk + 32) * N + n1 + nn4); }
        }
        if (rowscale) { const float s0 = rowscale[k0 + kk], s1 = rowscale[k0 + kk + 32]; a0.x *= s0; a0.y *= s0; a0.z *= s0; a0.w *= s0; a1.x *= s1; a1.y *= s1; a1.z *= s1; a1.w *= s1; }
        lds[kk * 65 + nn4 + 0] = a0.x; lds[kk * 65 + nn4 + 1] = a0.y; lds[kk * 65 + nn4 + 2] = a0.z; lds[kk * 65 + nn4 + 3] = a0.w;
        lds[(kk + 32) * 65 + nn4 + 0] = a1.x; lds[(kk + 32) * 65 + nn4 + 1] = a1.y; lds[(kk + 32) * 65 + nn4 + 2] = a1.z; lds[(kk + 32) * 65 + nn4 + 3] = a1.w;
        __syncthreads();
        {
            const int nn = tid >> 3, k8 = (tid & 7) * 8;
            uint4 o;
            o.x = pack2(lds[(k8 + 0) * 65 + nn], lds[(k8 + 1) * 65 + nn]); o.y = pack2(lds[(k8 + 2) * 65 + nn], lds[(k8 + 3) * 65 + nn]);
            o.z = pack2(lds[(k8 + 4) * 65 + nn], lds[(k8 + 5) * 65 + nn]); o.w = pack2(lds[(k8 + 6) * 65 + nn], lds[(k8 + 7) * 65 + nn]);
            *(uint4*)(dst + (size_t)(n0 + nn) * K + k0 + k8) = o;
        }
        __syncthreads();
    }
}
__device__ __forceinline__ void x_convert(CP P) {
    const int wave = threadIdx.x >> 6, lane = threadIdx.x & 63;
    for (int row = blockIdx.x * 8 + wave; row < M_TOK; row += gridDim.x * 8) {
        const float4* xr = (const float4*)(P->in[0] + (size_t)row * DM); float ss = 0.f;
#pragma unroll
        for (int i = 0; i < 8; ++i) {
            const float4 v = xr[lane + i * 64]; ss += v.x * v.x + v.y * v.y + v.z * v.z + v.w * v.w;
            uint2 o; o.x = pack2(v.x, v.y); o.y = pack2(v.z, v.w); *(uint2*)(P->actA + (size_t)row * DM + (lane + i * 64) * 4) = o;
        }
        ss = wave_sum(ss);
        if (lane == 0) P->xss0[row] = rsqrtf(ss * (1.f / DM) + 1e-6f);
    }
}

__device__ __forceinline__ void lora_convert(CP P) {
    for (int l = 0; l < 2; ++l) {
        const float* w2 = LP(P, l, I_RW_W2); const float* a2 = LP(P, l, I_RW_A2); const float* v2 = P->in[40];
        bf16_t* W = P->lora + (size_t)l * LORA_L; bf16_t* A = W + 512 * 64; bf16_t* V = A + 512 * 64;
        for (int e = blockIdx.x * 512 + threadIdx.x; e < 512 * 64; e += gridDim.x * 512) { const int c = e >> 6, k = e & 63; W[e] = f2bf(w2[k * 512 + c]); A[e] = f2bf(a2[k * 512 + c]); }
        if (l) for (int e = blockIdx.x * 512 + threadIdx.x; e < 512 * 32; e += gridDim.x * 512) { const int c = e >> 5, k = e & 31; V[e] = f2bf(v2[k * 512 + c]); }
    }
}
__device__ __forceinline__ void rwkv_prep(CP P, int l, ldsf lds) {
    const Cols C = cols(l); const int tid = opaque_tid(), wave = tid >> 6, lane = tid & 63, li = lane & 15, kq = lane >> 4;
    const float* mu = LP(P, l, I_RW_MU); const float* w0 = LP(P, l, I_RW_W0); const float* a0 = LP(P, l, I_RW_A0); const float* v0 = P->in[39];
    const bf16_t* W2t = P->lora + (size_t)l * LORA_L; const bf16_t* A2t = W2t + 512 * 64; const bf16_t* V2t = A2t + 512 * 64;
    constexpr int AS = 72, VS = 40;
    const ldsh Wl = (ldsh)lds, Al = Wl + 32 * AS, Vl = Al + 32 * AS;
    for (int tile = blockIdx.x; tile < M_TOK / 32; tile += gridDim.x) {
        const int t0 = tile * 32;
        {
            const int tt = tid >> 4, g = tid & 15, t = t0 + tt;
            const bf16_t* pr = P->proj + (size_t)t * LDP + C.rw + 1536 + g * 8;
            const bool hasp = (t % SEQL) != 0;
            float cur[8], prev[8];
            load8(pr, cur);
            if (hasp) load8(pr - LDP, prev); else {
#pragma unroll
                for (int e = 0; e < 8; ++e) prev[e] = 0.f; }
            float f[8];
#pragma unroll
            for (int e = 0; e < 8; ++e) { f[e] = cur[e] + mu[1536 + g * 8 + e] * (prev[e] - cur[e]); if (g < 8) f[e] = tanhf(f[e]); }
            u32x4 o; o.x = pk2(f[0], f[1]); o.y = pk2(f[2], f[3]); o.z = pk2(f[4], f[5]); o.w = pk2(f[6], f[7]);
            *(LAS u32x4*)((g < 8 ? Wl : Al) + tt * AS + (g & 7) * 8) = o;
            if (l && g < 4) {
                load8(pr + 128, cur);
                if (hasp) load8(pr + 128 - LDP, prev);
#pragma unroll
                for (int e = 0; e < 8; ++e) f[e] = cur[e] + mu[1664 + g * 8 + e] * (prev[e] - cur[e]);
                o.x = pk2(f[0], f[1]); o.y = pk2(f[2], f[3]); o.z = pk2(f[4], f[5]); o.w = pk2(f[6], f[7]);
                *(LAS u32x4*)(Vl + tt * VS + g * 8) = o;
            }
        }
        __syncthreads();
        for (int tl = wave; tl < 64; tl += 8) {
            const int tt16 = tl & 1, cc = (tl >> 1) * 16, c = cc + li;
            f32x4 aW = {0.f, 0.f, 0.f, 0.f}, aA = aW, aV = aW;
            const LAS bf16_t* pw = Wl + (tt16 * 16 + li) * AS + kq * 8; const LAS bf16_t* pa = Al + (tt16 * 16 + li) * AS + kq * 8;
#pragma unroll
            for (int k0 = 0; k0 < 64; k0 += 32) {
                aW = __builtin_amdgcn_mfma_f32_16x16x32_bf16(*(const LAS bf16x8*)(pw + k0), *(const bf16x8*)(W2t + (size_t)c * 64 + k0 + kq * 8), aW, 0, 0, 0);
                aA = __builtin_amdgcn_mfma_f32_16x16x32_bf16(*(const LAS bf16x8*)(pa + k0), *(const bf16x8*)(A2t + (size_t)c * 64 + k0 + kq * 8), aA, 0, 0, 0);
            }
            if (l) aV = __builtin_amdgcn_mfma_f32_16x16x32_bf16(*(const LAS bf16x8*)(Vl + (tt16 * 16 + li) * VS + kq * 8), *(const bf16x8*)(V2t + (size_t)c * 32 + kq * 8), aV, 0, 0, 0);
            const float w0c = w0[c], a0c = a0[c], muc = mu[1024 + c]; const float v0c = l ? v0[c] : 0.f;
#pragma unroll
            for (int j = 0; j < 4; ++j) {
                const int t = t0 + tt16 * 16 + kq * 4 + j; const size_t o = (size_t)t * 512 + c;
                const float wl = w0c + aW[j];
                const float sp = fmaxf(-wl, 0.f) + __logf(1.f + __expf(-fabsf(wl)));
                P->rwA[o] = __expf(-__expf(-sp - 0.5f));
                P->rwB[o] = sigmoidf_(a0c + aA[j]);
                const float cur = bf2f(P->proj[(size_t)t * LDP + C.rw + 1024 + c]);
                const float prev = (t % SEQL == 0) ? 0.f : bf2f(P->proj[(size_t)(t - 1) * LDP + C.rw + 1024 + c]);
                float v = cur + muc * (prev - cur);
                if (l) { const float g = sigmoidf_(v0c + aV[j]); const float vf = P->rwV[o]; v = v + (vf - v) * g; }
                P->rwV[o] = v;
            }
        }
        __syncthreads();
    }
}

__device__ __forceinline__ void rwkv_scan_item(CP P, int l, int it, ldsf lds) {
    const Cols C = cols(l); const int tid = opaque_tid();
    const int b = it >> 5, h = (it >> 2) & 7, rq = it & 3;
    constexpr int BUF = 5 * 2048 + 512 + 8192;
    const float* mu = LP(P, l, I_RW_MU); const float* k_k = LP(P, l, I_RW_KK); const float* k_a = LP(P, l, I_RW_KA);
    const bool producer = tid >= 256; const int ptid = tid & 255;
    const int tt = ptid >> 3, cg8 = (ptid & 7) * 8, ch0 = h * 64 + cg8, c2 = (ptid & 7) * 2;
    const int ri = ptid >> 4, js = (ptid & 15) * 4;
    const float* r_k = LP(P, l, I_RW_RK);
    float mur[8], muk[8], kkc[8], kac[8], rkc[8];
#pragma unroll
    for (int e = 0; e < 8; ++e) { mur[e] = mu[ch0 + e]; muk[e] = mu[512 + ch0 + e]; kkc[e] = k_k[ch0 + e]; kac[e] = k_a[ch0 + e]; rkc[e] = r_k[ch0 + e]; }
    uint4 rcu, kcu, rpu, kpu; float4 ra0, ra1, rd0, rd1; float2 rv2;
    auto issue = [&](int c) {
        const int t = b * SEQL + c * 32 + tt;
        const bf16_t* pr = P->proj + (size_t)t * LDP + C.rw + ch0;
        rcu = *(const uint4*)pr; kcu = *(const uint4*)(pr + 512);
        rpu = make_uint4(0u, 0u, 0u, 0u); kpu = rpu;
        if (c > 0 || tt > 0) { rpu = *(const uint4*)(pr - LDP); kpu = *(const uint4*)(pr - LDP + 512); }
        const float* ap = P->rwB + (size_t)t * 512 + ch0; const float* dp = P->rwA + (size_t)t * 512 + ch0;
        ra0 = *(const float4*)ap; ra1 = *(const float4*)(ap + 4); rd0 = *(const float4*)dp; rd1 = *(const float4*)(dp + 4);
        rv2 = *(const float2*)(P->rwV + (size_t)t * 512 + h * 64 + rq * 16 + c2);
    };
    auto fill = [&](int c, ldsf buf) {
        ldsf sR = buf, sK = buf + 2048, sW = buf + 4096, sNK = buf + 6144, sB = buf + 8192, sV = buf + 10240;
        float rc[8], kc[8], rp[8], kp[8];
        alignas(16) float av[8]; alignas(16) float dv[8]; float kkr[8], kl[8];
        *(float4*)av = ra0; *(float4*)(av + 4) = ra1; *(float4*)dv = rd0; *(float4*)(dv + 4) = rd1;
        unpack8(rcu, rc); unpack8(kcu, kc); unpack8(rpu, rp); unpack8(kpu, kp);
        float ss = 0.f; alignas(16) float o1[8]; alignas(16) float o2[8]; alignas(16) float o3[8]; alignas(16) float o4[8];
#pragma unroll
        for (int e = 0; e < 8; ++e) {
            o1[e] = rc[e] + mur[e] * (rp[e] - rc[e]);
            kl[e] = kc[e] + muk[e] * (kp[e] - kc[e]);
            kkr[e] = kl[e] * kkc[e]; ss += kkr[e] * kkr[e];
        }
        *(LAS f32x4*)(sR + tt * 64 + cg8) = *(f32x4*)o1; *(LAS f32x4*)(sR + tt * 64 + cg8 + 4) = *(f32x4*)(o1 + 4);
        *(LAS f32x4*)(sW + tt * 64 + cg8) = *(f32x4*)dv; *(LAS f32x4*)(sW + tt * 64 + cg8 + 4) = *(f32x4*)(dv + 4);
        ss += dppf<0xB1>(ss); ss += dppf<0x4E>(ss); ss += dppf<0x141>(ss);
        const float inv = 1.f / fmaxf(sqrtf(ss), 1e-12f);
#pragma unroll
        for (int e = 0; e < 8; ++e) {
            const float kk = kkr[e] * inv;
            o2[e] = kl[e] * (1.f + (av[e] - 1.f) * kac[e]); o3[e] = -kk; o4[e] = kk * av[e];
        }
        if (rq == 0) {
            float bs = 0.f;
#pragma unroll
            for (int e = 0; e < 8; ++e) bs += o1[e] * o2[e] * rkc[e];
            bs += dppf<0xB1>(bs); bs += dppf<0x4E>(bs); bs += dppf<0x141>(bs);
            if ((ptid & 7) == 0) P->bon[(size_t)(b * SEQL + c * 32 + tt) * 8 + h] = bs;
        }
        *(LAS f32x4*)(sK + tt * 64 + cg8) = *(f32x4*)o2; *(LAS f32x4*)(sK + tt * 64 + cg8 + 4) = *(f32x4*)(o2 + 4);
        *(LAS f32x4*)(sNK + tt * 64 + cg8) = *(f32x4*)o3; *(LAS f32x4*)(sNK + tt * 64 + cg8 + 4) = *(f32x4*)(o3 + 4);
        *(LAS f32x4*)(sB + tt * 64 + cg8) = *(f32x4*)o4; *(LAS f32x4*)(sB + tt * 64 + cg8 + 4) = *(f32x4*)(o4 + 4);
        *(LAS f32x2*)(sV + tt * 16 + c2) = (f32x2){rv2.x, rv2.y};
    };
    auto flush = [&](int c, ldsf buf) {
        const LAS f32x4* yp = (const LAS f32x4*)(buf + 10752 + (tt * 16 + c2) * 16);
        const f32x4 s0 = (yp[0] + yp[1]) + (yp[2] + yp[3]), s1 = (yp[4] + yp[5]) + (yp[6] + yp[7]);
        *(unsigned*)(P->proj + (size_t)(b * SEQL + c * 32 + tt) * LDP + C.rw + 1024 + h * 64 + rq * 16 + c2) = pack2((s0.x + s0.y) + (s0.z + s0.w), (s1.x + s1.y) + (s1.z + s1.w));
    };
    f32x2 S[2] = {{0.f, 0.f}, {0.f, 0.f}};
    if (producer) { issue(0); fill(0, lds); issue(1); }
    lds_barrier();
    for (int c = 0; c < 64; ++c) {
        const ldsf cur = lds + (c & 1) * BUF, nxt = lds + ((c + 1) & 1) * BUF;
        if (producer) {
            if (c > 0) flush(c - 1, nxt);
            if (c + 1 < 64) { fill(c + 1, nxt); if (c + 2 < 64) issue(c + 2); }
        } else {
            const ldsf sR = cur, sK = cur + 2048, sW = cur + 4096, sNK = cur + 6144, sB = cur + 8192, sV = cur + 10240, sYp = cur + 10752 + ri * 16 + (tid & 15);
            struct Vecs { f32x4 nk, w, b, k, r; float vi; };
            auto ldv = [&](int t) { Vecs v;
                v.nk = *(const LAS f32x4*)(sNK + t * 64 + js); v.w = *(const LAS f32x4*)(sW + t * 64 + js); v.b = *(const LAS f32x4*)(sB + t * 64 + js);
                v.k = *(const LAS f32x4*)(sK + t * 64 + js); v.r = *(const LAS f32x4*)(sR + t * 64 + js); v.vi = sV[t * 16 + ri]; return v; };
            Vecs cur_v = ldv(0), nx1 = ldv(1);
            for (int t16 = 0; t16 < 2; ++t16) {
#pragma unroll
                for (int u = 0; u < 16; ++u) {
                    const int t = t16 * 16 + u;
                    const Vecs nxt = ldv((t + 2) & 31);
                    f32x2 s2 = S[0] * cur_v.nk.xy; s2 = S[1] * cur_v.nk.zw + s2;
                    const float sa = reduce16(s2.x + s2.y);
                    const f32x2 sav = {sa, sa}, viv = {cur_v.vi, cur_v.vi};
                    f32x2 t0 = viv * cur_v.k.xy; t0 = sav * cur_v.b.xy + t0; S[0] = S[0] * cur_v.w.xy + t0;
                    f32x2 t1 = viv * cur_v.k.zw; t1 = sav * cur_v.b.zw + t1; S[1] = S[1] * cur_v.w.zw + t1;
                    f32x2 y2 = S[0] * cur_v.r.xy; y2 = S[1] * cur_v.r.zw + y2;
                    sYp[t * 256] = y2.x + y2.y;
                    cur_v = nx1; nx1 = nxt;
                }
            }
        }
        lds_barrier();
    }
    if (producer) flush(63, lds + BUF);
    __syncthreads();
}

__device__ __forceinline__ void mlstm_item(CP P, int l, int it, ldsf lds) {
    const Cols C = cols(l); const int tid = opaque_tid(), wave = tid >> 6, lane = tid & 63, li = lane & 15, kq = lane >> 4;
    const int b = it >> 4, h = (it >> 2) & 3, es = it & 3;
    constexpr int QS = 136, SS = 72;
    const ldsh Qb = (ldsh)lds, Kb = Qb + 64 * QS, Ktb = Kb + 64 * QS, Vtb = Ktb + 128 * SS, Vwtb = Vtb + 32 * SS, Attb = Vwtb + 32 * SS, Ctb = Attb + 64 * SS, nbb = Ctb + 2 * 32 * QS, wendb = nbb + 2 * 128;
    const ldsf sCum = (ldsf)(wendb + 64), sLi = sCum + 64, sWend = sLi + 64, sMl = sWend + 64, sWint = sMl + 64, sScal = sWint + 64;
    const float* cw = LP(P, l, I_ML_CW); const float* cb = LP(P, l, I_ML_CB);
    const float igb = LP(P, l, I_ML_IGB)[h], fgb = LP(P, l, I_ML_FGB)[h];
    for (int e = tid; e < 64 * SS / 2; e += 512) ((LAS unsigned*)Attb)[e] = 0u;
    for (int e = tid; e < (2 * 32 * QS + 2 * 128) / 2; e += 512) ((LAS unsigned*)Ctb)[e] = 0u;
    float m_prev = 0.f;
    f32x4 Cm[2], nm[2];
#pragma unroll
    for (int q = 0; q < 2; ++q) { Cm[q] = (f32x4){0.f, 0.f, 0.f, 0.f}; nm[q] = Cm[q]; }
    const int cgp = tid & 31, rseg = tid >> 5, isk = cgp >> 4, d0 = (cgp & 15) * 8, col0 = isk * 512 + h * 128 + d0;
    const ldsh cdst = isk ? Kb : Qb; const float cscale = isk ? 0.08838834764831845f : 1.f;
    const bf16x8 ones8 = {(short)0x3F80, (short)0x3F80, (short)0x3F80, (short)0x3F80, (short)0x3F80, (short)0x3F80, (short)0x3F80, (short)0x3F80};
    uint4 raw[7]; uint4 vraw = make_uint4(0u, 0u, 0u, 0u); float gi_raw = 0.f, gf_raw = 0.f;
    auto issue_loads = [&](int nn) {
#pragma unroll
        for (int i = 0; i < 7; ++i) {
            const int ts = nn * 64 + rseg * 4 - 3 + i;
            raw[i] = (ts >= 0) ? *(const uint4*)(P->proj + (size_t)(b * SEQL + ts) * LDP + C.mqk + col0) : make_uint4(0u, 0u, 0u, 0u);
        }
        if (tid < 256) vraw = *(const uint4*)(P->proj + (size_t)(b * SEQL + nn * 64 + (tid >> 2)) * LDP + C.mv + h * 128 + es * 32 + (tid & 3) * 8);
        if (wave == 0) { const bf16_t* gp = P->proj + (size_t)(b * SEQL + nn * 64 + lane) * LDP; gi_raw = bf2f(gp[C.mi + h]); gf_raw = bf2f(gp[C.mf + h]); }
    };
    issue_loads(0);
    alignas(16) float wreg[4][8]; alignas(16) float breg[8];
    *(float4*)breg = *(const float4*)(cb + col0); *(float4*)(breg + 4) = *(const float4*)(cb + col0 + 4);
#pragma unroll
    for (int j = 0; j < 4; ++j) { *(float4*)wreg[j] = *(const float4*)(cw + j * 1024 + col0); *(float4*)(wreg[j] + 4) = *(const float4*)(cw + j * 1024 + col0 + 4); }
    __syncthreads();
    for (int n = 0; n < 32; ++n) {
        const int t0 = b * SEQL + n * 64, pb = n & 1;
        {
            float acc[4][8];
#pragma unroll
            for (int r = 0; r < 4; ++r)
#pragma unroll
                for (int e = 0; e < 8; ++e) acc[r][e] = breg[e];
#pragma unroll
            for (int i = 0; i < 7; ++i) {
                float f[8]; unpack8(raw[i], f);
#pragma unroll
                for (int r = 0; r < 4; ++r) { const int j = i - r; if (j >= 0 && j < 4) {
#pragma unroll
                    for (int e = 0; e < 8; ++e) acc[r][e] += wreg[j][e] * f[e]; } }
            }
#pragma unroll
            for (int r = 0; r < 4; ++r) {
#pragma unroll
                for (int e = 0; e < 8; ++e) acc[r][e] = siluf(acc[r][e]) * cscale;
                u32x4 o; o.x = pk2(acc[r][0], acc[r][1]); o.y = pk2(acc[r][2], acc[r][3]); o.z = pk2(acc[r][4], acc[r][5]); o.w = pk2(acc[r][6], acc[r][7]);
                *(LAS u32x4*)(cdst + (rseg * 4 + r) * QS + d0) = o;
            }
            if (isk) {
#pragma unroll
                for (int e = 0; e < 8; ++e) { u32x2 o; o.x = pk2(acc[0][e], acc[1][e]); o.y = pk2(acc[2][e], acc[3][e]); *(LAS u32x2*)(Ktb + (d0 + e) * SS + rseg * 4) = o; }
            }
            if (tid < 256) {
                const LAS bf16_t* vs = (const LAS bf16_t*)0; (void)vs;
                const unsigned w4[4] = {vraw.x, vraw.y, vraw.z, vraw.w};
#pragma unroll
                for (int e = 0; e < 8; ++e) Vtb[((tid & 3) * 8 + e) * SS + (tid >> 2)] = (bf16_t)((e & 1) ? (w4[e >> 1] >> 16) : (w4[e >> 1] & 0xffffu));
            }
        }
        if (wave == 0) {
            const int s = lane;
            const float lgi = gi_raw + igb;
            const float lf = logsigmoidf(gf_raw + fgb);
            const float cum = scan_add64(lf, lane);
            const float last = rdlane(cum, 63);
            const float g = last - cum + lgi; const float gmax = rdlane(scan_max64(g, lane), 63);
            const float pm = scan_max64(lgi - cum, lane);
            const float minter = cum + m_prev; const float ml = fmaxf(minter, cum + pm);
            const float we = __expf(g - gmax);
            sCum[s] = cum; sLi[s] = lgi; sWend[s] = we; wendb[s] = f2bf(we); sMl[s] = ml; sWint[s] = __expf(minter - ml);
            if (lane == 0) { sScal[0] = last; sScal[1] = gmax; }
        }
        if (n + 1 < 32) issue_loads(n + 1);
        lds_barrier();
        if (tid < 256) {
            const int e = tid >> 3, sg = (tid & 7) * 8;
            float f[8]; unpack8v(*(const LAS u32x4*)(Vtb + e * SS + sg), f);
            u32x4 o; o.x = pk2(f[0] * sWend[sg], f[1] * sWend[sg + 1]); o.y = pk2(f[2] * sWend[sg + 2], f[3] * sWend[sg + 3]);
            o.z = pk2(f[4] * sWend[sg + 4], f[5] * sWend[sg + 5]); o.w = pk2(f[6] * sWend[sg + 6], f[7] * sWend[sg + 7]);
            *(LAS u32x4*)(Vwtb + e * SS + sg) = o;
        }
        for (int idx = wave; idx < 10; idx += 8) {
            int tl, ts; tri_tile(idx, tl, ts);
            const f32x4 a = mmb(128, Qb + tl * 16 * QS, QS, Kb + ts * 16 * QS, QS, (f32x4){0.f, 0.f, 0.f, 0.f}, li, kq);
#pragma unroll
            for (int j = 0; j < 4; ++j) {
                const int lr = tl * 16 + kq * 4 + j, sc = ts * 16 + li;
                Attb[lr * SS + sc] = f2bf((sc <= lr) ? a[j] * __expf(sCum[lr] - sCum[sc] + sLi[sc] - sMl[lr]) : 0.f);
            }
        }
        lds_barrier();
        {
            const int tl = wave >> 1, te = wave & 1;
            f32x4 a1 = {0.f, 0.f, 0.f, 0.f}, ad = a1, a2 = a1, aq = a1;
            {
                const LAS bf16_t* pa = Attb + (tl * 16 + li) * SS + kq * 8; const LAS bf16_t* pv = Vtb + (te * 16 + li) * SS + kq * 8;
#pragma unroll
                for (int k0 = 0; k0 < 64; k0 += 32) { const bf16x8 av = *(const LAS bf16x8*)(pa + k0);
                    a1 = __builtin_amdgcn_mfma_f32_16x16x32_bf16(av, *(const LAS bf16x8*)(pv + k0), a1, 0, 0, 0); ad = __builtin_amdgcn_mfma_f32_16x16x32_bf16(av, ones8, ad, 0, 0, 0); }
                const LAS bf16_t* pq = Qb + (tl * 16 + li) * QS + kq * 8; const LAS bf16_t* pc = Ctb + pb * 32 * QS + (te * 16 + li) * QS + kq * 8; const LAS bf16_t* pn = nbb + pb * 128 + kq * 8;
#pragma unroll
                for (int k0 = 0; k0 < 128; k0 += 32) { const bf16x8 av = *(const LAS bf16x8*)(pq + k0);
                    a2 = __builtin_amdgcn_mfma_f32_16x16x32_bf16(av, *(const LAS bf16x8*)(pc + k0), a2, 0, 0, 0); aq = __builtin_amdgcn_mfma_f32_16x16x32_bf16(av, *(const LAS bf16x8*)(pn + k0), aq, 0, 0, 0); }
            }
#pragma unroll
            for (int j = 0; j < 4; ++j) {
                const int lr = tl * 16 + kq * 4 + j, e = te * 16 + li;
                const float wi = sWint[lr];
                const float den = fmaxf(fabsf(ad[j] + wi * aq[j]), __expf(-sMl[lr]));
                const float hv = (a1[j] + wi * a2[j]) / den;
                P->proj[(size_t)(t0 + lr) * LDP + C.mv + h * 128 + es * 32 + e] = f2bf(hv);
            }
            const float last = sScal[0], gmax = sScal[1];
            const float m_new = fmaxf(last + m_prev, gmax), a_old = __expf(last + m_prev - m_new), a_new = __expf(gmax - m_new);
#pragma unroll
            for (int q = 0; q < 2; ++q) {
                const int tile = wave + q * 8, td = tile >> 1, te2 = tile & 1;
                const LAS bf16_t* pk = Ktb + (td * 16 + li) * SS + kq * 8; const LAS bf16_t* pv = Vwtb + (te2 * 16 + li) * SS + kq * 8; const LAS bf16_t* pw = wendb + kq * 8;
                f32x4 a = {0.f, 0.f, 0.f, 0.f}, an = a;
#pragma unroll
                for (int k0 = 0; k0 < 64; k0 += 32) { const bf16x8 av = *(const LAS bf16x8*)(pk + k0);
                    a = __builtin_amdgcn_mfma_f32_16x16x32_bf16(av, *(const LAS bf16x8*)(pv + k0), a, 0, 0, 0);
                    if (te2 == 0) an = __builtin_amdgcn_mfma_f32_16x16x32_bf16(av, *(const LAS bf16x8*)(pw + k0), an, 0, 0, 0); }
                Cm[q] = Cm[q] * a_old + a * a_new;
                u32x2 o; o.x = pk2(Cm[q][0], Cm[q][1]); o.y = pk2(Cm[q][2], Cm[q][3]);
                *(LAS u32x2*)(Ctb + (pb ^ 1) * 32 * QS + (te2 * 16 + li) * QS + td * 16 + kq * 4) = o;
                if (te2 == 0) {
                    nm[q] = nm[q] * a_old + an * a_new;
                    if (li == 0) { u32x2 o2; o2.x = pk2(nm[q][0], nm[q][1]); o2.y = pk2(nm[q][2], nm[q][3]); *(LAS u32x2*)(nbb + (pb ^ 1) * 128 + td * 16 + kq * 4) = o2; }
                }
            }
            m_prev = m_new;
        }
        lds_barrier();
    }
}

__device__ __forceinline__ void ssd_item(CP P, int l, int it, ldsf lds) {
    const Cols C = cols(l); const int tid = opaque_tid(), wave = tid >> 6, lane = tid & 63, li = lane & 15, kq = lane >> 4;
    const int b = it >> 3, hh = it & 7, g = hh >> 2;
    constexpr int QS = 136, SS = 72;
    const ldsh Cmb = (ldsh)lds, Bmb = Cmb + 64 * QS, Bmtb = Bmb + 64 * QS, Lcb = Bmtb + 128 * SS, Xdtt = Lcb + 64 * SS, Xett = Xdtt + 64 * SS, Sb = Xett + 64 * SS;
    const ldsf sXr = (ldsf)(Sb + 2 * 64 * QS), sX = sXr + 67 * 64, sCum = sX + 64 * 65, sDt = sCum + 64, sE = sDt + 64, sEc = sE + 64, sScal = sEc + 64;
    const float* cw = LP(P, l, I_SSD_CW); const float* cb = LP(P, l, I_SSD_CB);
    const float Aneg = -expf(LP(P, l, I_SSD_ALOG)[hh]), dtb = LP(P, l, I_SSD_DTB)[hh], dsk = LP(P, l, I_SSD_D)[hh];
    for (int e = tid; e < 64 * SS / 2; e += 512) ((LAS unsigned*)Lcb)[e] = 0u;
    for (int e = tid; e < 2 * 64 * QS / 2; e += 512) ((LAS unsigned*)Sb)[e] = 0u;
    float hv = 0.f;
    f32x4 Sm[4];
#pragma unroll
    for (int q = 0; q < 4; ++q) Sm[q] = (f32x4){0.f, 0.f, 0.f, 0.f};
    const int cgp = tid & 31, rseg = tid >> 5, isc = cgp >> 4, n0 = (cgp & 15) * 8, col0 = 512 + isc * 256 + g * 128 + n0;
    const ldsh cdst = isc ? Cmb : Bmb;
    const int xcol = hh * 64 + (tid & 63);
    uint4 raw[7]; uint4 xraw = make_uint4(0u, 0u, 0u, 0u); float dt_raw = 0.f;
    auto issue_loads = [&](int nn) {
#pragma unroll
        for (int i = 0; i < 7; ++i) {
            const int ts = nn * 64 + rseg * 4 - 3 + i;
            raw[i] = (ts >= 0) ? *(const uint4*)(P->proj + (size_t)(b * SEQL + ts) * LDP + C.sx + col0) : make_uint4(0u, 0u, 0u, 0u);
        }
        xraw = *(const uint4*)(P->proj + (size_t)(b * SEQL + nn * 64 + (tid >> 3)) * LDP + C.sx + hh * 64 + (tid & 7) * 8);
        if (wave == 0) dt_raw = bf2f(P->proj[(size_t)(b * SEQL + nn * 64 + lane) * LDP + C.sdt + hh]);
    };
    issue_loads(0);
    alignas(16) float wreg[4][8]; alignas(16) float breg[8];
    *(float4*)breg = *(const float4*)(cb + col0); *(float4*)(breg + 4) = *(const float4*)(cb + col0 + 4);
#pragma unroll
    for (int j = 0; j < 4; ++j) { *(float4*)wreg[j] = *(const float4*)(cw + j * 1024 + col0); *(float4*)(wreg[j] + 4) = *(const float4*)(cw + j * 1024 + col0 + 4); }
    __syncthreads();
    for (int n = 0; n < 32; ++n) {
        const int t0 = b * SEQL + n * 64, pb = n & 1;
        if (tid < 192) sXr[tid] = hv;
        {
            float acc[4][8];
#pragma unroll
            for (int r = 0; r < 4; ++r)
#pragma unroll
                for (int e = 0; e < 8; ++e) acc[r][e] = breg[e];
#pragma unroll
            for (int i = 0; i < 7; ++i) {
                float f[8]; unpack8(raw[i], f);
#pragma unroll
                for (int r = 0; r < 4; ++r) { const int j = i - r; if (j >= 0 && j < 4) {
#pragma unroll
                    for (int e = 0; e < 8; ++e) acc[r][e] += wreg[j][e] * f[e]; } }
            }
#pragma unroll
            for (int r = 0; r < 4; ++r) {
#pragma unroll
                for (int e = 0; e < 8; ++e) acc[r][e] = siluf(acc[r][e]);
                u32x4 o; o.x = pk2(acc[r][0], acc[r][1]); o.y = pk2(acc[r][2], acc[r][3]); o.z = pk2(acc[r][4], acc[r][5]); o.w = pk2(acc[r][6], acc[r][7]);
                *(LAS u32x4*)(cdst + (rseg * 4 + r) * QS + n0) = o;
            }
            if (!isc) {
#pragma unroll
                for (int e = 0; e < 8; ++e) { u32x2 o; o.x = pk2(acc[0][e], acc[1][e]); o.y = pk2(acc[2][e], acc[3][e]); *(LAS u32x2*)(Bmtb + (n0 + e) * SS + rseg * 4) = o; }
            }
            { float f[8]; unpack8(xraw, f);
#pragma unroll
                for (int e = 0; e < 8; ++e) sXr[((tid >> 3) + 3) * 64 + (tid & 7) * 8 + e] = f[e]; }
        }
        if (wave == 0) {
            const float dt = softplusf(dt_raw + dtb);
            const float cum = scan_add64(dt * Aneg, lane);
            const float last = rdlane(cum, 63);
            sDt[lane] = dt; sCum[lane] = cum; sE[lane] = __expf(last - cum); sEc[lane] = __expf(cum);
            if (lane == 0) sScal[0] = __expf(last);
        }
        if (n + 1 < 32) issue_loads(n + 1);
        lds_barrier();
        {
            const int p = tid & 63, mseg = tid >> 6;
            const float cb0 = cb[xcol], w0 = cw[xcol], w1 = cw[1024 + xcol], w2 = cw[2048 + xcol], w3 = cw[3072 + xcol];
            float xr[11];
#pragma unroll
            for (int i = 0; i < 11; ++i) xr[i] = sXr[(mseg * 8 + i) * 64 + p];
            float xd[8], xe[8];
#pragma unroll
            for (int r = 0; r < 8; ++r) {
                const int mm = mseg * 8 + r;
                const float x = siluf(cb0 + w0 * xr[r] + w1 * xr[r + 1] + w2 * xr[r + 2] + w3 * xr[r + 3]);
                sX[mm * 65 + p] = x; xd[r] = x * sDt[mm]; xe[r] = xd[r] * sE[mm];
            }
            u32x4 o; o.x = pk2(xd[0], xd[1]); o.y = pk2(xd[2], xd[3]); o.z = pk2(xd[4], xd[5]); o.w = pk2(xd[6], xd[7]); *(LAS u32x4*)(Xdtt + p * SS + mseg * 8) = o;
            o.x = pk2(xe[0], xe[1]); o.y = pk2(xe[2], xe[3]); o.z = pk2(xe[4], xe[5]); o.w = pk2(xe[6], xe[7]); *(LAS u32x4*)(Xett + p * SS + mseg * 8) = o;
        }
        for (int idx = wave; idx < 10; idx += 8) {
            int tl, ts; tri_tile(idx, tl, ts);
            const f32x4 a = mmb(128, Cmb + tl * 16 * QS, QS, Bmb + ts * 16 * QS, QS, (f32x4){0.f, 0.f, 0.f, 0.f}, li, kq);
#pragma unroll
            for (int j = 0; j < 4; ++j) {
                const int lr = tl * 16 + kq * 4 + j, sc = ts * 16 + li;
                Lcb[lr * SS + sc] = f2bf((sc <= lr) ? a[j] * __expf(sCum[lr] - sCum[sc]) : 0.f);
            }
        }
        lds_barrier();
        {
            const f32x4 z4 = {0.f, 0.f, 0.f, 0.f};
#pragma unroll
            for (int q = 0; q < 2; ++q) {
                const int tile = wave + q * 8, tl = tile >> 2, tp = tile & 3;
                const f32x4 a1 = mmb(64, Lcb + tl * 16 * SS, SS, Xdtt + tp * 16 * SS, SS, z4, li, kq);
                const f32x4 a2 = mmb(128, Cmb + tl * 16 * QS, QS, Sb + pb * 64 * QS + tp * 16 * QS, QS, z4, li, kq);
#pragma unroll
                for (int j = 0; j < 4; ++j) {
                    const int lr = tl * 16 + kq * 4 + j, p = tp * 16 + li;
                    const float y = a1[j] + sEc[lr] * a2[j] + dsk * sX[lr * 65 + p];
                    P->proj[(size_t)(t0 + lr) * LDP + C.sx + hh * 64 + p] = f2bf(y);
                }
            }
            const float elast = sScal[0];
#pragma unroll
            for (int q = 0; q < 4; ++q) {
                const int tile = wave + q * 8, tp2 = tile & 3, tn = tile >> 2;
                const f32x4 a = mmb(64, Xett + tp2 * 16 * SS, SS, Bmtb + tn * 16 * SS, SS, z4, li, kq);
                Sm[q] = Sm[q] * elast + a;
#pragma unroll
                for (int j = 0; j < 4; ++j) Sb[(pb ^ 1) * 64 * QS + (tp2 * 16 + kq * 4 + j) * QS + tn * 16 + li] = f2bf(Sm[q][j]);
            }
            if (tid < 192) hv = sXr[64 * 64 + tid];
        }
        lds_barrier();
    }
}

__device__ __forceinline__ void gla_item(CP P, int l, int it, ldsf lds) {
    const int tid = opaque_tid(), wave = tid >> 6, lane = tid & 63, li = lane & 15, kq = lane >> 4;
    const int b = it >> 3, h = (it >> 1) & 3, vs = it & 1;
    constexpr int SS = 72;
    const ldsh Qgb = (ldsh)lds, Kgb = Qgb + 64 * SS, Kgtb = Kgb + 64 * SS, Vtb = Kgtb + 64 * SS, Attb = Vtb + 64 * SS, Stb = Attb + 64 * SS;
    const ldsf sQ = (ldsf)(Stb + 2 * 64 * SS), sK = sQ + 64 * 65, sCum = sK + 64 * 65, sGl = sCum + 64 * 65, sW2 = sGl + 64 * 17, sGb = sW2 + 16 * 64, sSeg = sGb + 64, sDec = sSeg + 8 * 64;
    const float* gw2 = LP(P, l, I_GK_W2); const float* gb = LP(P, l, I_GK_B);
    for (int e = tid; e < 16 * 64; e += 512) sW2[e] = gw2[(e >> 6) * 256 + h * 64 + (e & 63)];
    if (tid < 64) sGb[tid] = gb[h * 64 + tid];
    for (int e = tid; e < 64 * SS / 2; e += 512) ((LAS unsigned*)Attb)[e] = 0u;
    for (int e = tid; e < 2 * 64 * SS / 2; e += 512) ((LAS unsigned*)Stb)[e] = 0u;
    f32x4 Sm[2] = {{0.f, 0.f, 0.f, 0.f}, {0.f, 0.f, 0.f, 0.f}};
    uint4 qraw, kraw, xr, gr = make_uint4(0u, 0u, 0u, 0u);
    auto issue_loads = [&](int nn) {
        const int row = tid >> 3, cg = (tid & 7) * 8; const bf16_t* pr = P->proj + (size_t)(b * SEQL + nn * 64 + row) * LDP + h * 64 + cg;
        qraw = *(const uint4*)(pr + C_GQ); kraw = *(const uint4*)(pr + C_GK);
        xr = *(const uint4*)(P->proj + (size_t)(b * SEQL + nn * 64 + row) * LDP + C_GV + h * 128 + vs * 64 + cg);
        if (tid < 128) gr = *(const uint4*)(P->proj + (size_t)(b * SEQL + nn * 64 + (tid >> 1)) * LDP + C_GGK + (tid & 1) * 8);
    };
    issue_loads(0);
    __syncthreads();
    for (int n = 0; n < 32; ++n) {
        const int t0 = b * SEQL + n * 64, pb = n & 1;
        {
            const int row = tid >> 3, cg = (tid & 7) * 8;
            float f[8]; unpack8(qraw, f);
#pragma unroll
            for (int e = 0; e < 8; ++e) sQ[row * 65 + cg + e] = f[e] * 0.125f;
            unpack8(kraw, f);
#pragma unroll
            for (int e = 0; e < 8; ++e) sK[row * 65 + cg + e] = f[e];
            {
                const unsigned w4[4] = {xr.x, xr.y, xr.z, xr.w};
#pragma unroll
                for (int e = 0; e < 8; ++e) Vtb[(cg + e) * SS + row] = (bf16_t)((e & 1) ? (w4[e >> 1] >> 16) : (w4[e >> 1] & 0xffffu));
            }
            if (tid < 128) {
                unpack8(gr, f);
#pragma unroll
                for (int e = 0; e < 8; ++e) sGl[(tid >> 1) * 17 + (tid & 1) * 8 + e] = f[e];
            }
        }
        if (n + 1 < 32) issue_loads(n + 1);
        lds_barrier();
        for (int e = tid; e < 4096; e += 512) {
            const int s = e >> 6, d = e & 63; float gk = sGb[d];
#pragma unroll
            for (int r = 0; r < 16; ++r) gk += sGl[s * 17 + r] * sW2[r * 64 + d];
            sCum[s * 65 + d] = logsigmoid_fast(gk) * 0.0625f;
        }
        lds_barrier();
        const int d = tid & 63, seg = tid >> 6;
        {
            float run = 0.f;
#pragma unroll
            for (int r = 0; r < 8; ++r) { run += sCum[(seg * 8 + r) * 65 + d]; sCum[(seg * 8 + r) * 65 + d] = run; }
            sSeg[seg * 64 + d] = run;
        }
        lds_barrier();
        {
            float off = 0.f;
            for (int s2 = 0; s2 < seg; ++s2) off += sSeg[s2 * 64 + d];
            float kg[8];
#pragma unroll
            for (int r = 0; r < 8; ++r) {
                const int s = seg * 8 + r; const float c = sCum[s * 65 + d] + off;
                const float ec = __expf(c);
                Qgb[s * SS + d] = f2bf(sQ[s * 65 + d] * ec);
                kg[r] = sK[s * 65 + d] * __expf(-c);
                Kgb[s * SS + d] = f2bf(kg[r]);
                if (s == 63) sDec[d] = ec;
            }
            u32x4 o; o.x = pk2(kg[0], kg[1]); o.y = pk2(kg[2], kg[3]); o.z = pk2(kg[4], kg[5]); o.w = pk2(kg[6], kg[7]);
            *(LAS u32x4*)(Kgtb + d * SS + seg * 8) = o;
        }
        lds_barrier();
        for (int idx = wave; idx < 10; idx += 8) {
            int tl, ts; tri_tile(idx, tl, ts);
            const f32x4 a = mmb(64, Qgb + tl * 16 * SS, SS, Kgb + ts * 16 * SS, SS, (f32x4){0.f, 0.f, 0.f, 0.f}, li, kq);
#pragma unroll
            for (int j = 0; j < 4; ++j) { const int lr = tl * 16 + kq * 4 + j, sc = ts * 16 + li; Attb[lr * SS + sc] = f2bf((sc <= lr) ? a[j] : 0.f); }
        }
        lds_barrier();
        {
            const f32x4 z4 = {0.f, 0.f, 0.f, 0.f};
#pragma unroll
            for (int q = 0; q < 2; ++q) {
                const int tile = wave + q * 8, tl = tile >> 2, tv = tile & 3;
                f32x4 a = mmb(64, Attb + tl * 16 * SS, SS, Vtb + tv * 16 * SS, SS, z4, li, kq);
                a = mmb(64, Qgb + tl * 16 * SS, SS, Stb + pb * 64 * SS + tv * 16 * SS, SS, a, li, kq);
#pragma unroll
                for (int j = 0; j < 4; ++j) { const int lr = tl * 16 + kq * 4 + j, v = tv * 16 + li; P->proj[(size_t)(t0 + lr) * LDP + C_GV + h * 128 + vs * 64 + v] = f2bf(a[j]); }
            }
#pragma unroll
            for (int q = 0; q < 2; ++q) {
                const int tile = wave + q * 8, td = tile >> 2, tv = tile & 3;
                const f32x4 u = mmb(64, Kgtb + td * 16 * SS, SS, Vtb + tv * 16 * SS, SS, z4, li, kq);
#pragma unroll
                for (int j = 0; j < 4; ++j) Sm[q][j] = sDec[td * 16 + kq * 4 + j] * (Sm[q][j] + u[j]);
                u32x2 o; o.x = pk2(Sm[q][0], Sm[q][1]); o.y = pk2(Sm[q][2], Sm[q][3]);
                *(LAS u32x2*)(Stb + (pb ^ 1) * 64 * SS + (tv * 16 + li) * SS + td * 16 + kq * 4) = o;
            }
        }
        lds_barrier();
    }
}

#ifndef ITEM_MASK
#define ITEM_MASK 15
#endif
template <int IM = ITEM_MASK> __device__ __forceinline__ void scan_phase(CP P, int l, ldsf lds) {
    for (int it = blockIdx.x; it < N_ITEMS; it += gridDim.x) {
        if (it < N_RW) { if (IM & 1) rwkv_scan_item(P, l, it, lds); }
        else if (it < N_RW + 64) { if (IM & 2) mlstm_item(P, l, it - N_RW, lds); }
        else if (it < N_RW + 96) { if (IM & 4) ssd_item(P, l, it - N_RW - 64, lds); }
        else { if (IM & 8) gla_item(P, l, it - N_RW - 96, lds); }
        __syncthreads();
    }
}

__device__ __forceinline__ void finalize_phase(CP P, int l) {
    const Cols C = cols(l); const int wave = threadIdx.x >> 6, lane = threadIdx.x & 63, c8 = lane * 8;
    const float* gla_g = LP(P, l, I_GLA_NG); const float* mu = LP(P, l, I_RW_MU); const float* k_a = LP(P, l, I_RW_KA); const float* r_k = LP(P, l, I_RW_RK);
    const float* ln_g = LP(P, l, I_RW_LNG); const float* ln_b = LP(P, l, I_RW_LNB); const float* ssd_g = LP(P, l, I_SSD_NG); const float* ml_g = LP(P, l, I_ML_NG);
    for (int t = blockIdx.x * 8 + wave; t < M_TOK; t += gridDim.x * 8) {
        const bf16_t* pr = P->proj + (size_t)t * LDP; bf16_t* yo = P->actA + (size_t)t * DM;
        float a[8], z[8], y[8];
        {
            load8(pr + C_GV + c8, a); load8(pr + C_GZ + c8, z);
            float ss = 0.f;
#pragma unroll
            for (int e = 0; e < 8; ++e) ss += a[e] * a[e];
            ss += __shfl_xor(ss, 1); ss += __shfl_xor(ss, 2); ss += __shfl_xor(ss, 4); ss += __shfl_xor(ss, 8);
            const float rstd = rsqrtf(ss * (1.f / 128.f) + 1e-6f);
#pragma unroll
            for (int e = 0; e < 8; ++e) y[e] = a[e] * rstd * gla_g[c8 + e] * siluf(z[e]);
            store8(yo + c8, y);
        }
        {
            load8(pr + C.rw + 1024 + c8, a); load8(pr + C.rwz + c8, z);
            float s = 0.f;
#pragma unroll
            for (int e = 0; e < 8; ++e) s += a[e];
            s += __shfl_xor(s, 1); s += __shfl_xor(s, 2); s += __shfl_xor(s, 4);
            const float mean = s * (1.f / 64.f); float vs = 0.f;
#pragma unroll
            for (int e = 0; e < 8; ++e) { a[e] -= mean; vs += a[e] * a[e]; }
            vs += __shfl_xor(vs, 1); vs += __shfl_xor(vs, 2); vs += __shfl_xor(vs, 4);
            const float rstd = rsqrtf(vs * (1.f / 64.f) + 64e-5f);
            alignas(16) float vv[8];
            *(float4*)vv = *(const float4*)(P->rwV + (size_t)t * 512 + c8); *(float4*)(vv + 4) = *(const float4*)(P->rwV + (size_t)t * 512 + c8 + 4);
            const float bs = P->bon[(size_t)t * 8 + (lane >> 3)];
#pragma unroll
            for (int e = 0; e < 8; ++e) y[e] = (a[e] * rstd * ln_g[c8 + e] + ln_b[c8 + e] + bs * vv[e]) * siluf(z[e]);
            store8(yo + 512 + c8, y);
        }
        {
            load8(pr + C.sx + c8, a); load8(pr + C.sz + c8, z);
            float ss = 0.f;
#pragma unroll
            for (int e = 0; e < 8; ++e) { a[e] *= siluf(z[e]); ss += a[e] * a[e]; }
            ss = wave_sum(ss);
            const float rstd = rsqrtf(ss * (1.f / 512.f) + 1e-6f);
#pragma unroll
            for (int e = 0; e < 8; ++e) y[e] = a[e] * rstd * ssd_g[c8 + e];
            store8(yo + 1024 + c8, y);
        }
        {
            float o[8];
            load8(pr + C.mv + c8, a); load8(pr + C.mo + c8, o); load8(pr + C.mz + c8, z);
            float s = 0.f;
#pragma unroll
            for (int e = 0; e < 8; ++e) { a[e] *= sigmoidf_(o[e]); s += a[e]; }
            s += __shfl_xor(s, 1); s += __shfl_xor(s, 2); s += __shfl_xor(s, 4); s += __shfl_xor(s, 8);
            const float mean = s * (1.f / 128.f); float vs = 0.f;
#pragma unroll
            for (int e = 0; e < 8; ++e) { a[e] -= mean; vs += a[e] * a[e]; }
            vs += __shfl_xor(vs, 1); vs += __shfl_xor(vs, 2); vs += __shfl_xor(vs, 4); vs += __shfl_xor(vs, 8);
            const float rstd = rsqrtf(vs * (1.f / 128.f) + 1e-6f);
#pragma unroll
            for (int e = 0; e < 8; ++e) y[e] = a[e] * rstd * ml_g[c8 + e] * siluf(z[e]);
            store8(yo + 1536 + c8, y);
        }
    }
}

__device__ __forceinline__ void final_norm(CP P) {
    const int wave = threadIdx.x >> 6, lane = threadIdx.x & 63; const float* g = P->in[57];
    for (int row = blockIdx.x * 8 + wave; row < M_TOK; row += gridDim.x * 8) {
        float s = (lane < XSSN) ? P->xss2[(size_t)row * XSSN + lane] : 0.f; s = wave_sum(s);
        const float rstd = rsqrtf(s * (1.f / DM) + 1e-6f);
        float4* xr = (float4*)(P->out + (size_t)row * DM); const float4* gr = (const float4*)g;
#pragma unroll
        for (int i = 0; i < 8; ++i) { float4 v = xr[lane + i * 64]; const float4 gg = gr[lane + i * 64]; v.x *= rstd * gg.x; v.y *= rstd * gg.y; v.z *= rstd * gg.z; v.w *= rstd * gg.w; xr[lane + i * 64] = v; }
    }
}

#define XB_TMO      128
#define XB_XCNT(j)  (256  + 64 * (j))
#define XB_XSUB(j)  (1280 + 64 * (j))
#define XB_XGEN(j)  (2304 + 64 * (j))
#define XB_TOP      3328
#define XB_TOPGEN   3392
#define XCD_BAR_WORDS 3456
#define XB_SPIN_CAP (1u << 18)

__device__ __forceinline__ unsigned xb_ld(unsigned* p)              { return __hip_atomic_load(p, __ATOMIC_RELAXED, __HIP_MEMORY_SCOPE_AGENT); }
__device__ __forceinline__ unsigned xb_add(unsigned* p, unsigned v) { return __hip_atomic_fetch_add(p, v, __ATOMIC_RELAXED, __HIP_MEMORY_SCOPE_AGENT); }
__device__ __forceinline__ unsigned xb_xcc_id() { return (unsigned)__builtin_amdgcn_s_getreg((3 << 11) | 20) & 0xFu; }
#define XB_SPIN(cond, bar) do { unsigned _sp = 0; while (cond) { __builtin_amdgcn_s_sleep(1); \
    if ((++_sp & 255u) == 0u) { if (xb_ld(&(bar)[XB_TMO])) break; if (_sp > XB_SPIN_CAP) { atomicAdd(&(bar)[XB_TMO], 1u); break; } } } } while (0)

struct XcdBarrier {
    unsigned* bar; unsigned x;
    volatile LAS unsigned* st;
};

__device__ __forceinline__ XcdBarrier xcd_barrier_post(unsigned* bar, volatile LAS unsigned* st) {
    XcdBarrier b; b.bar = bar; b.x = xb_xcc_id(); b.st = st;
    if (threadIdx.x == 0) (void)xb_add(&bar[XB_XCNT(b.x)], 1u);
    return b;
}
__device__ __forceinline__ void xcd_barrier_complete(unsigned* bar, unsigned x, unsigned& nloc, unsigned& nx) {
    const unsigned G = gridDim.x * gridDim.y * gridDim.z;
    unsigned sum, cnt, mine, sp = 0u;
    for (;;) {
        sum = 0u; cnt = 0u; mine = 0u;
#pragma unroll
        for (unsigned j = 0; j < 16; ++j) { const unsigned c = xb_ld(&bar[XB_XCNT(j)]); sum += c; cnt += (c > 0u) ? 1u : 0u; mine = (j == x) ? c : mine; }
        if (sum == G) break;
        __builtin_amdgcn_s_sleep(1);
        if ((++sp & 255u) == 0u) { if (xb_ld(&bar[XB_TMO])) break; if (sp > XB_SPIN_CAP) { atomicAdd(&bar[XB_TMO], 1u); break; } }
    }
    nloc = mine > 0u ? mine : 1u; nx = cnt > 0u ? cnt : 1u;
}

__device__ __forceinline__ void xcd_barrier(const XcdBarrier& b) {
    asm volatile("s_waitcnt vmcnt(0)" ::: "memory");
    __syncthreads();
    if (threadIdx.x == 0) {
        unsigned* bar = b.bar;
        __builtin_amdgcn_s_waitcnt(0);
        unsigned nloc = b.st[0], nx = b.st[1];
        if (nloc == 0u) { xcd_barrier_complete(bar, b.x, nloc, nx); b.st[0] = nloc; b.st[1] = nx; }
        const unsigned old = xb_add(&bar[XB_XSUB(b.x)], 1u);
        const unsigned gen = old / nloc;
        if (old + 1u == (gen + 1u) * nloc) {
            __builtin_amdgcn_fence(__ATOMIC_RELEASE, "agent");
            asm volatile("s_waitcnt vmcnt(0)" ::: "memory");
            const unsigned og = xb_add(&bar[XB_TOP], 1u);
            const unsigned tg = og / nx;
            if (og + 1u == (tg + 1u) * nx) xb_add(&bar[XB_TOPGEN], 1u);
            else XB_SPIN(xb_ld(&bar[XB_TOPGEN]) == tg, bar);
            __builtin_amdgcn_fence(__ATOMIC_ACQUIRE, "agent");
            xb_add(&bar[XB_XGEN(b.x)], 1u);
            asm volatile("s_waitcnt vmcnt(0)" ::: "memory");
        } else {
            XB_SPIN(xb_ld(&bar[XB_XGEN(b.x)]) == gen, bar);
            __builtin_amdgcn_fence(__ATOMIC_ACQUIRE, "agent");
            asm volatile("s_waitcnt vmcnt(0)" ::: "memory");
        }
    }
    __syncthreads();
}


template <bool PRE> __device__ __forceinline__ void gemm_inproj(CP P, const bf16_t* A, const float* xss, PG8_LAS unsigned char* lds) {
    pg8::Gemm g; g.A = A; g.Bt = P->Wi; g.M = M_TOK; g.N = LDP; g.K = DM;
    pg8::StaticOrder S; S.init(g.M, g.N, (int)gridDim.x, (int)blockIdx.x);
    EpiProj<PRE> E; E.O = P->proj; E.xss = xss;
    pg8::gemm_phase<EpiProj<PRE>, pg8::StaticOrder, false>(lds, g, S, E, nullptr);
}
__device__ __forceinline__ void gemm_outproj(CP P, const bf16_t* Wo, const float* xin, bf16_t* xb, float* xss, PG8_LAS unsigned char* lds) {
    pg8::Gemm g; g.A = P->actA; g.Bt = Wo; g.M = M_TOK; g.N = DM; g.K = DM;
    pg8::StaticOrder S; S.init(g.M, g.N, (int)gridDim.x, (int)blockIdx.x);
    EpiOut E; E.xin = xin; E.xout = P->out; E.xb = xb; E.xss = xss;
    pg8::gemm_phase<EpiOut, pg8::StaticOrder, false>(lds, g, S, E, nullptr);
}

#ifndef PROBE_DUP
#define PROBE_DUP 0
#endif
#ifndef PH_MASK
#define PH_MASK 0xFFF
#endif
#define RUN_PHASE(k, body) do { if ((PH_MASK >> (k)) & 1) { if (ph_lo <= (k) && (k) < ph_hi) { CP P = Pc; asm volatile("" : "+s"(P)); body; if ((PROBE_DUP >> (k)) & 1) { __syncthreads(); body; } if (coop && (k) + 1 < ph_hi) { if (coop == 2) grid.sync(); else xcd_barrier(xb); } } } } while (0)
__global__ void __launch_bounds__(512, 2) mega(Params Pk, int ph_lo, int ph_hi, int coop) {
    extern __shared__ __attribute__((aligned(16))) unsigned char shm[];
    PG8_LAS unsigned char* ldsb = (PG8_LAS unsigned char*)shm; ldsf lds = (ldsf)shm;
    cg::grid_group grid = cg::this_grid();
    const CP Pc = (CP)__builtin_amdgcn_kernarg_segment_ptr();
    volatile LAS unsigned* stw = (volatile LAS unsigned*)(shm + LDS_BYTES - 16);
    if (threadIdx.x < 4) stw[threadIdx.x] = 0u;
    __syncthreads();
    XcdBarrier xb = xcd_barrier_post(Pc->bar, stw);
    RUN_PHASE(0, { transpose_convert(P->in[2], DM, 7840, LDP, P->Wi, P->in[1], lds); transpose_convert(P->in[3], DM, DM, DM, P->Wo0, nullptr, lds);
                   transpose_convert(P->in[30], DM, DM, DM, P->Wo1, nullptr, lds); x_convert(P); lora_convert(P); });
#ifdef PROBE_PRE
    { CP P = Pc; asm volatile("" : "+s"(P)); gemm_inproj<true>(P, P->actA, P->xss0, ldsb); grid.sync(); rwkv_prep(P, 0, lds); grid.sync(); scan_phase<PROBE_PRE>(P, 0, lds); grid.sync(); }
#endif
    RUN_PHASE(1, gemm_inproj<true>(P, P->actA, P->xss0, ldsb));
    RUN_PHASE(2, rwkv_prep(P, 0, lds));
    RUN_PHASE(3, scan_phase(P, 0, lds));
    RUN_PHASE(4, { finalize_phase(P, 0); transpose_convert(P->in[29], DM, 7872, LDP, P->Wi, P->in[28], lds); });
    RUN_PHASE(5, gemm_outproj(P, P->Wo0, P->in[0], P->xb1, P->xss1, ldsb));
    RUN_PHASE(6, gemm_inproj<false>(P, P->xb1, P->xss1, ldsb));
    RUN_PHASE(7, rwkv_prep(P, 1, lds));
    RUN_PHASE(8, scan_phase(P, 1, lds));
    RUN_PHASE(9, finalize_phase(P, 1));
    RUN_PHASE(10, gemm_outproj(P, P->Wo1, P->out, nullptr, P->xss2, ldsb));
    RUN_PHASE(11, final_norm(P));
}

#ifndef MK_COOP
#define MK_COOP 1
#endif
extern "C" void kernel_launch(void* const* d_in, const int* in_sizes, int n_in, void* d_out, int out_size, void* d_ws, size_t ws_size, hipStream_t stream) {
    Params p{};
    for (int i = 0; i < 58; ++i) p.in[i] = (const float*)d_in[i];
    p.out = (float*)d_out;
    char* w = (char*)d_ws; size_t off = 0;
    auto take = [&](size_t bytes) { char* r = w + off; off += (bytes + 255) & ~(size_t)255; return r; };
    p.Wi = (bf16_t*)take((size_t)LDP * DM * 2);
    p.Wo0 = (bf16_t*)take((size_t)DM * DM * 2);
    p.Wo1 = (bf16_t*)take((size_t)DM * DM * 2);
    p.actA = (bf16_t*)take((size_t)M_TOK * DM * 2);
    p.proj = (bf16_t*)take((size_t)M_TOK * LDP * 2);
    p.rwA = (float*)take((size_t)M_TOK * 512 * 4);
    p.rwB = (float*)take((size_t)M_TOK * 512 * 4);
    p.xb1 = (bf16_t*)p.rwA;
    p.rwV = (float*)take((size_t)M_TOK * 512 * 4);
    p.xss0 = (float*)take((size_t)M_TOK * XSSN * 4);
    p.xss1 = (float*)take((size_t)M_TOK * XSSN * 4);
    p.xss2 = (float*)take((size_t)M_TOK * XSSN * 4);
    p.bar = (unsigned*)take((size_t)XCD_BAR_WORDS * 4);
    p.lora = (bf16_t*)take((size_t)LORA_ELEMS * 2);
    p.bon = (float*)take((size_t)M_TOK * 8 * 4);
    if (off > ws_size) { fprintf(stderr, "workspace too small: need %zu have %zu\n", off, ws_size); return; }
    static int grid_blocks = 0;
    if (!grid_blocks) {
        hipFuncSetAttribute((const void*)mega, hipFuncAttributeMaxDynamicSharedMemorySize, LDS_BYTES);
        int dev = 0, cus = 0, per_cu = 0;
        hipGetDevice(&dev);
        hipDeviceGetAttribute(&cus, hipDeviceAttributeMultiprocessorCount, dev);
        hipOccupancyMaxActiveBlocksPerMultiprocessor(&per_cu, mega, 512, LDS_BYTES);
        if (per_cu > 1) per_cu = 1;
        grid_blocks = cus * per_cu;
        if (grid_blocks <= 0) grid_blocks = 256;
    }
#if MK_COOP
    hipMemsetAsync(p.bar, 0, (size_t)XCD_BAR_WORDS * 4, stream);
    int lo = 0, hi = N_PHASES, coop = 1;
    void* args[] = {&p, &lo, &hi, &coop};
    hipError_t e = hipLaunchCooperativeKernel((const void*)mega, dim3(grid_blocks), dim3(512), args, LDS_BYTES, stream);
    if (e != hipSuccess) fprintf(stderr, "cooperative launch failed: %s (grid %d)\n", hipGetErrorString(e), grid_blocks);
#else
    for (int ph = 0; ph < N_PHASES; ++ph) hipLaunchKernelGGL(mega, dim3(grid_blocks), dim3(512), LDS_BYTES, stream, p, ph, ph + 1, 0);
#endif
}
```

```cpp
#include <hip/hip_runtime.h>
#include <hip/hip_cooperative_groups.h>
#include <cstdio>
namespace cg = cooperative_groups;

namespace pg8 {
#define PG8_LAS __attribute__((address_space(3)))
typedef unsigned short bf16_t;
typedef short bf16x8 __attribute__((ext_vector_type(8)));
typedef float f32x4 __attribute__((ext_vector_type(4)));
typedef unsigned u32x4 __attribute__((ext_vector_type(4)));
constexpr int BM = 256, BK = 64, HALF = 128, HTB = HALF * BK * 2  , STAGE_BYTES = 8 * HTB, NXCD = 8, WGM = 8;

__host__ __device__ __forceinline__ int lds_byte(int r, int c) { const int st = (r >> 4) * 2 + (c >> 5), rr = r & 15, cc = c & 31, ob = rr * 64 + cc * 2; return st * 1024 + (ob ^ (((ob >> 9) & 1) << 5)); }
__host__ __device__ __forceinline__ void stage_rc(int b, int& R, int& C) { const int st = b / 1024, sb = b % 1024, swz = sb ^ (((sb >> 9) & 1) << 5); R = (st >> 1) * 16 + swz / 64; C = (st & 1) * 32 + (swz % 64) / 2; }
__host__ __device__ __forceinline__ int perm32(int rho) { const int n = rho >> 4, i = rho & 15; return 8 * (i >> 2) + 4 * n + (i & 3); }

struct Unit { int pm, pn; };
struct Gemm { const bf16_t* A; const bf16_t* Bt; int M, N, K; };

struct StaticOrder {
    int nM, nN, nwg, G, c;
    __host__ __device__ void init(int M, int N, int G_, int c_) { nM = M / BM; nN = N / BM; nwg = nM * nN; G = G_; c = c_; }
    __host__ __device__ bool next(int i, Unit& u) const {
        const long L = (long)i * G + c; if (L >= nwg) return false;
        int wgid = (int)L; { const int q = nwg / NXCD, r = nwg % NXCD, xcd = wgid % NXCD, off = wgid / NXCD; wgid = (xcd < r ? xcd * (q + 1) : r * (q + 1) + (xcd - r) * q) + off; }
        const int nig = WGM * nN, gid = wgid / nig, fm = gid * WGM, gsz = (nM - fm) < WGM ? (nM - fm) : WGM;
        u.pm = fm + ((wgid % nig) % gsz); u.pn = (wgid % nig) / gsz; return true;
    }
    __device__ __forceinline__ void a_ready(const Unit&) const {}
    __device__ __forceinline__ void done(const Unit&) const {}
};
__device__ __forceinline__ unsigned cvt_pk_bf16(float lo, float hi) { unsigned r; asm volatile("v_cvt_pk_bf16_f32 %0, %1, %2" : "=v"(r) : "v"(lo), "v"(hi)); return r; }
template <class Epi, class Sched, bool STAMP = false>
__device__ __forceinline__ void gemm_phase(PG8_LAS unsigned char* lds, const Gemm g, const Sched& S, const Epi& E, unsigned long long* stamps) {
    const int tid = threadIdx.x, wid = __builtin_amdgcn_readfirstlane(tid >> 6), lane = tid & 63, wr = wid >> 2, wc = wid & 3, fr = lane & 15, fq = lane >> 4;
    const int K = g.K, nt = K / BK;
    int ts_lo = 0, ts_hi = 0, nts = 0; const unsigned long long rt_entry = STAMP ? (unsigned long long)wall_clock64() : 0ull;
#define PG8_STAMP() do { if (STAMP && wid == 0 && nts < 64) { const unsigned long long _c = (unsigned long long)clock64(); \
        ts_lo = (lane == nts) ? (int)(unsigned)_c : ts_lo; ts_hi = (lane == nts) ? (int)(unsigned)(_c >> 32) : ts_hi; ++nts; } } while (0)
    PG8_STAMP();
    unsigned voffA[2], voffB[2];
#pragma unroll
    for (int i = 0; i < 2; ++i) { int R, C; stage_rc(tid * 16 + i * 8192, R, C); const int Rb = Epi::PERM ? ((R & ~31) + perm32(R & 31)) : R;
        voffA[i] = (unsigned)(R * K + C) * 2u; voffB[i] = (unsigned)(Rb * K + C) * 2u; }
    const size_t kstep = (size_t)(BK * 2);
    const size_t hstep = (size_t)HALF * K * 2;
    const size_t tstep = 2 * hstep;
    const unsigned ldsw = (unsigned)wid * 1024u;
    const int aoff = lds_byte(wr * 64 + fr, fq * 8), boff = lds_byte(wc * 32 + fr, fq * 8);
#define PG8_SA(b, h) (((b) * 2 + (h)) * HTB)
#define PG8_SB(b, h) ((4 + (b) * 2 + (h)) * HTB)
#define PG8_STAGE(bufoff, gbase, voff) do { _Pragma("unroll") for (int _i = 0; _i < 2; ++_i) \
        __builtin_amdgcn_global_load_lds((const unsigned*)((const char*)(gbase) + (voff)[_i]), (PG8_LAS unsigned*)(lds + (bufoff) + ldsw + _i * 8192), 16, 0, 0); } while (0)
#define PG8_LDA(dst, b, h) do { _Pragma("unroll") for (int m = 0; m < 4; ++m) _Pragma("unroll") for (int k = 0; k < 2; ++k) dst[m][k] = *(const PG8_LAS bf16x8*)(lds + PG8_SA(b, h) + aoff + m * 2048 + k * 1024); } while (0)
#define PG8_LDB(dst, b, h) do { _Pragma("unroll") for (int n = 0; n < 2; ++n) _Pragma("unroll") for (int k = 0; k < 2; ++k) dst[n][k] = *(const PG8_LAS bf16x8*)(lds + PG8_SB(b, h) + boff + n * 2048 + k * 1024); } while (0)
#define PG8_MMA(ai, bj, At, Bt) do { __builtin_amdgcn_s_setprio(1); _Pragma("unroll") for (int m = 0; m < 4; ++m) _Pragma("unroll") for (int n = 0; n < 2; ++n) _Pragma("unroll") for (int k = 0; k < 2; ++k) \
        acc[ai][bj][m][n] = __builtin_amdgcn_mfma_f32_16x16x32_bf16(Bt[n][k], At[m][k], acc[ai][bj][m][n], 0, 0, 0); __builtin_amdgcn_s_setprio(0); } while (0)
#define PG8_WAIT_V(n) asm volatile("s_waitcnt vmcnt(" #n ")" ::: "memory")
#define PG8_WAIT_L(n) asm volatile("s_waitcnt lgkmcnt(" #n ")" ::: "memory")
#define PG8_BAR __builtin_amdgcn_s_barrier()
#define PG8_SCHED __builtin_amdgcn_sched_barrier(0)
    Unit cur, nxt; int ui = 0;
    if (!S.next(0, cur)) return;
    f32x4 acc[2][2][4][2];
#pragma unroll
    for (int a = 0; a < 2; ++a)
#pragma unroll
        for (int b = 0; b < 2; ++b)
#pragma unroll
            for (int m = 0; m < 4; ++m)
#pragma unroll
                for (int n = 0; n < 2; ++n) acc[a][b][m][n] = (f32x4){0.f, 0.f, 0.f, 0.f};
    bf16x8 At[4][2], B0[2][2], B1[2][2];
    const char* cA = (const char*)g.A + (size_t)cur.pm * tstep; const char* cB = (const char*)g.Bt + (size_t)cur.pn * tstep;
    S.a_ready(cur);
    PG8_STAGE(PG8_SB(0, 0), cB, voffB); PG8_STAGE(PG8_SA(0, 0), cA, voffA); PG8_STAGE(PG8_SB(0, 1), cB + hstep, voffB); PG8_STAGE(PG8_SA(0, 1), cA + hstep, voffA);
    if (wr == 1) PG8_BAR;
    PG8_WAIT_V(4); PG8_BAR;
    PG8_STAGE(PG8_SB(1, 0), cB + kstep, voffB); PG8_STAGE(PG8_SA(1, 0), cA + kstep, voffA); PG8_STAGE(PG8_SB(1, 1), cB + hstep + kstep, voffB);
    PG8_WAIT_V(6); PG8_BAR;
    PG8_STAMP();
    for (;;) {
        const bool has_next = S.next(ui + 1, nxt);
        const char* nA = has_next ? (const char*)g.A + (size_t)nxt.pm * tstep : cA; const char* nB = has_next ? (const char*)g.Bt + (size_t)nxt.pn * tstep : cB;
        for (int t = 0; t < nt; t += 2) {
            const bool last = (t == nt - 2);
            const char* a1 = cA + (size_t)(t + 1) * kstep;
            const char* a2 = last ? nA : cA + (size_t)(t + 2) * kstep; const char* b2 = last ? nB : cB + (size_t)(t + 2) * kstep;
            const char* a3 = a2 + kstep; const char* b3 = b2 + kstep;
            if (last && has_next) S.a_ready(nxt);
            PG8_LDB(B0, 0, 0); PG8_SCHED; PG8_LDA(At, 0, 0); PG8_STAGE(PG8_SA(1, 1), a1 + hstep, voffA);
            PG8_WAIT_L(8); PG8_BAR; PG8_WAIT_L(0); PG8_MMA(0, 0, At, B0); PG8_BAR; PG8_SCHED;
            PG8_LDB(B1, 0, 1); PG8_STAGE(PG8_SB(0, 0), b2, voffB);
            PG8_BAR; PG8_WAIT_L(0); PG8_MMA(0, 1, At, B1); PG8_BAR;
            PG8_LDA(At, 0, 1); PG8_STAGE(PG8_SA(0, 0), a2, voffA);
            PG8_BAR; PG8_WAIT_L(0); PG8_MMA(1, 0, At, B0); PG8_BAR; PG8_SCHED;
            PG8_STAGE(PG8_SB(0, 1), b2 + hstep, voffB);
            PG8_WAIT_V(6); PG8_BAR; PG8_MMA(1, 1, At, B1); PG8_BAR;
            PG8_LDB(B0, 1, 0); PG8_SCHED; PG8_LDA(At, 1, 0); PG8_STAGE(PG8_SA(0, 1), a2 + hstep, voffA);
            PG8_WAIT_L(8); PG8_BAR; PG8_WAIT_L(0); PG8_MMA(0, 0, At, B0); PG8_BAR; PG8_SCHED;
            PG8_LDB(B1, 1, 1); PG8_STAGE(PG8_SB(1, 0), b3, voffB);
            PG8_BAR; PG8_WAIT_L(0); PG8_MMA(0, 1, At, B1); PG8_BAR;
            PG8_LDA(At, 1, 1); PG8_STAGE(PG8_SA(1, 0), a3, voffA);
            PG8_BAR; PG8_WAIT_L(0); PG8_MMA(1, 0, At, B0); PG8_BAR; PG8_SCHED;
            PG8_STAGE(PG8_SB(1, 1), b3 + hstep, voffB);
            PG8_WAIT_V(6); PG8_BAR; PG8_MMA(1, 1, At, B1); PG8_BAR;
        }
        PG8_STAMP();
        if constexpr (!Epi::AFTER_DRAIN) { E(acc, cur, wr, wc, fr, fq); S.done(cur); }
        PG8_STAMP();
        if (!has_next) break;
#pragma unroll
        for (int a = 0; a < 2; ++a)
#pragma unroll
            for (int b = 0; b < 2; ++b)
#pragma unroll
                for (int m = 0; m < 4; ++m)
#pragma unroll
                    for (int n = 0; n < 2; ++n) acc[a][b][m][n] = (f32x4){0.f, 0.f, 0.f, 0.f};
        cur = nxt; cA = nA; cB = nB; ++ui;
    }
    PG8_WAIT_V(0);
    if (wr == 0) PG8_BAR;
    PG8_BAR;
    if constexpr (Epi::AFTER_DRAIN) { E.fused(acc, cur, wr, wc, fr, fq, lds, wid, lane); S.done(cur); }
    PG8_STAMP();
    if (STAMP && wid == 0) { stamps[lane] = lane < nts ? (((unsigned long long)(unsigned)ts_hi << 32) | (unsigned)ts_lo) : 0ull;
        if (lane == 62) stamps[62] = rt_entry; if (lane == 63) stamps[63] = (unsigned long long)wall_clock64(); }
#undef PG8_STAMP
#undef PG8_SA
#undef PG8_SB
#undef PG8_STAGE
#undef PG8_LDA
#undef PG8_LDB
#undef PG8_MMA
#undef PG8_WAIT_V
#undef PG8_WAIT_L
#undef PG8_BAR
#undef PG8_SCHED
}
}

typedef unsigned short bf16_t;
typedef float f32x4 __attribute__((ext_vector_type(4)));
#define LAS __attribute__((address_space(3)))
typedef LAS float* ldsf;

constexpr int M_TOK = 8192, DM = 2048, SEQL = 2048, LDP = 7936, XSSN = 32;
constexpr int LDS_BYTES = 160 * 1024;
constexpr int N_PHASES = 12;
constexpr int LORA_L = 2 * 512 * 64 + 512 * 32, LORA_ELEMS = 2 * LORA_L;
constexpr int N_RW = 128, N_ITEMS = N_RW + 128;

enum { I_NORM_G = 0, I_W_IN, I_W_OUT, I_GK_W2, I_GK_B, I_GLA_NG, I_RW_MU, I_RW_W0, I_RW_W2, I_RW_A0, I_RW_A2, I_RW_KK, I_RW_KA, I_RW_RK, I_RW_LNG, I_RW_LNB,
       I_SSD_CW, I_SSD_CB, I_SSD_DTB, I_SSD_ALOG, I_SSD_D, I_SSD_NG, I_ML_CW, I_ML_CB, I_ML_IGB, I_ML_FGB, I_ML_NG };

struct Params {
    const float* in[58];
    float* out;
    bf16_t* Wi; bf16_t* Wo0; bf16_t* Wo1; bf16_t* actA; bf16_t* proj; bf16_t* xb1;
    float* rwA; float* rwB; float* rwV; float* xss0; float* xss1; float* xss2; unsigned* bar; bf16_t* lora; float* bon;
};
typedef const __attribute__((address_space(4))) Params* CP;
__device__ __forceinline__ const float* LP(CP P, int l, int idx) { return P->in[(l ? 28 : 1) + idx + ((l && idx >= I_RW_KK) ? 2 : 0)]; }

struct Cols { int rw, rwz, sx, sdt, sz, mqk, mv, mi, mf, mo, mz, nin; };
__device__ __forceinline__ Cols cols(int l) {
    const int RW = l ? 1696 : 1664; Cols c;
    c.rw = 1552; c.rwz = 1552 + RW; c.sx = c.rwz + 512; c.sdt = c.sx + 1024; c.sz = c.sdt + 8; c.mqk = c.sz + 512; c.mv = c.mqk + 1024;
    c.mi = c.mv + 512; c.mf = c.mi + 4; c.mo = c.mf + 4; c.mz = c.mo + 512; c.nin = c.mz + 512; return c;
}
constexpr int C_GQ = 0, C_GK = 256, C_GV = 512, C_GGK = 1024, C_GZ = 1040;

__device__ __forceinline__ float bf2f(bf16_t u) { return __uint_as_float(((unsigned)u) << 16); }
__device__ __forceinline__ bf16_t f2bf(float f) { unsigned u = __float_as_uint(f); u += 0x7FFFu + ((u >> 16) & 1u); return (bf16_t)(u >> 16); }
__device__ __forceinline__ unsigned pack2(float lo, float hi) { return (unsigned)f2bf(lo) | ((unsigned)f2bf(hi) << 16); }
__device__ __forceinline__ void unpack8(const uint4 u, float* f) {
    f[0] = __uint_as_float(u.x << 16); f[1] = __uint_as_float(u.x & 0xffff0000u); f[2] = __uint_as_float(u.y << 16); f[3] = __uint_as_float(u.y & 0xffff0000u);
    f[4] = __uint_as_float(u.z << 16); f[5] = __uint_as_float(u.z & 0xffff0000u); f[6] = __uint_as_float(u.w << 16); f[7] = __uint_as_float(u.w & 0xffff0000u);
}
__device__ __forceinline__ void load8(const bf16_t* p, float* f) { unpack8(*(const uint4*)p, f); }
__device__ __forceinline__ void store8(bf16_t* p, const float* f) { uint4 u; u.x = pack2(f[0], f[1]); u.y = pack2(f[2], f[3]); u.z = pack2(f[4], f[5]); u.w = pack2(f[6], f[7]); *(uint4*)p = u; }
__device__ __forceinline__ float softplusf(float x) { return fmaxf(x, 0.f) + log1pf(expf(-fabsf(x))); }
__device__ __forceinline__ float logsigmoidf(float x) { return fminf(x, 0.f) - log1pf(expf(-fabsf(x))); }
__device__ __forceinline__ float sigmoidf_(float x) { return __builtin_amdgcn_rcpf(1.f + __expf(-x)); }
__device__ __forceinline__ float siluf(float x) { return x * __builtin_amdgcn_rcpf(1.f + __expf(-x)); }
__device__ __forceinline__ float logsigmoid_fast(float x) { return fminf(x, 0.f) - __logf(1.f + __expf(-fabsf(x))); }
typedef float f32x2 __attribute__((ext_vector_type(2)));
__device__ __forceinline__ float wave_sum(float v) { for (int o = 32; o; o >>= 1) v += __shfl_xor(v, o); return v; }
__device__ __forceinline__ float wave_max(float v) { for (int o = 32; o; o >>= 1) v = fmaxf(v, __shfl_xor(v, o)); return v; }
template <int CTRL> __device__ __forceinline__ float dppf(float v) { return __int_as_float(__builtin_amdgcn_update_dpp(0, __float_as_int(v), CTRL, 0xF, 0xF, true)); }
__device__ __forceinline__ float reduce16(float v) { v += dppf<0xB1>(v); v += dppf<0x4E>(v); v += dppf<0x141>(v); v += dppf<0x140>(v); return v; }
__device__ __forceinline__ float reduce8(float v) { v += dppf<0xB1>(v); v += dppf<0x4E>(v); v += dppf<0x141>(v); return v; }

template <int CTRL> __device__ __forceinline__ float dpp_keep(float oldv, float v) { return __int_as_float(__builtin_amdgcn_update_dpp(__float_as_int(oldv), __float_as_int(v), CTRL, 0xF, 0xF, false)); }
__device__ __forceinline__ float rdlane(float v, int l) { return __int_as_float(__builtin_amdgcn_readlane(__float_as_int(v), l)); }
__device__ __forceinline__ float scan_add64(float v, int lane) {
    v += dppf<0x111>(v); v += dppf<0x112>(v); v += dppf<0x114>(v); v += dppf<0x118>(v);
    const float t0 = rdlane(v, 15), t1 = rdlane(v, 31), t2 = rdlane(v, 47); const int row = lane >> 4;
    return v + ((row >= 1) ? t0 : 0.f) + ((row >= 2) ? t1 : 0.f) + ((row >= 3) ? t2 : 0.f);
}
__device__ __forceinline__ float scan_max64(float v, int lane) {
    const float ninf = -__builtin_inff();
    v = fmaxf(v, dpp_keep<0x111>(ninf, v)); v = fmaxf(v, dpp_keep<0x112>(ninf, v)); v = fmaxf(v, dpp_keep<0x114>(ninf, v)); v = fmaxf(v, dpp_keep<0x118>(ninf, v));
    const float t0 = rdlane(v, 15), t1 = rdlane(v, 31), t2 = rdlane(v, 47); const int row = lane >> 4;
    return fmaxf(fmaxf(v, (row >= 1) ? t0 : ninf), fmaxf((row >= 2) ? t1 : ninf, (row >= 3) ? t2 : ninf));
}
__device__ __forceinline__ void lds_barrier() { asm volatile("s_waitcnt lgkmcnt(0)\n\ts_barrier" ::: "memory"); }
__device__ __forceinline__ int opaque_tid() { int t = threadIdx.x; asm volatile("" : "+v"(t)); return t; }
template <class FA, class FB> __device__ __forceinline__ f32x4 mm16(int K, FA fa, FB fb, f32x4 acc, int i, int kq) {
#pragma unroll 4
    for (int k0 = 0; k0 < K; k0 += 4) { const float a = fa(i, k0 + kq), b = fb(k0 + kq, i); acc = __builtin_amdgcn_mfma_f32_16x16x4f32(a, b, acc, 0, 0, 0); }
    return acc;
}
template <class FA, class FB1, class FB2> __device__ __forceinline__ void mm16_2(int K, FA fa, FB1 fb1, FB2 fb2, f32x4& acc1, f32x4& acc2, int i, int kq) {
#pragma unroll 4
    for (int k0 = 0; k0 < K; k0 += 4) { const float a = fa(i, k0 + kq), b1 = fb1(k0 + kq, i), b2 = fb2(k0 + kq, i);
        acc1 = __builtin_amdgcn_mfma_f32_16x16x4f32(a, b1, acc1, 0, 0, 0); acc2 = __builtin_amdgcn_mfma_f32_16x16x4f32(a, b2, acc2, 0, 0, 0); }
}
typedef short bf16x8 __attribute__((ext_vector_type(8)));
typedef LAS bf16_t* ldsh;
typedef unsigned u32x4 __attribute__((ext_vector_type(4)));
typedef unsigned u32x2 __attribute__((ext_vector_type(2)));
__device__ __forceinline__ void unpack8v(const u32x4 u, float* f) { unpack8(make_uint4(u.x, u.y, u.z, u.w), f); }
__device__ __forceinline__ unsigned pk2(float lo, float hi) { unsigned r; asm volatile("v_cvt_pk_bf16_f32 %0, %1, %2" : "=v"(r) : "v"(lo), "v"(hi)); return r; }
__device__ __forceinline__ f32x4 mmb(int K, const LAS bf16_t* pa, int lda, const LAS bf16_t* pb, int ldb, f32x4 acc, int li, int kq) {
    const LAS bf16_t* a = pa + li * lda + kq * 8; const LAS bf16_t* b = pb + li * ldb + kq * 8;
#pragma unroll 4
    for (int k0 = 0; k0 < K; k0 += 32) acc = __builtin_amdgcn_mfma_f32_16x16x32_bf16(*(const LAS bf16x8*)(a + k0), *(const LAS bf16x8*)(b + k0), acc, 0, 0, 0);
    return acc;
}
__device__ __forceinline__ void tri_tile(int idx, int& tl, int& ts) {
    tl = (idx >= 6) ? 3 : (idx >= 3) ? 2 : (idx >= 1) ? 1 : 0; ts = idx - (tl * (tl + 1)) / 2;
}

template <bool PRE> struct EpiProj {
    static constexpr bool PERM = true, AFTER_DRAIN = false;
    bf16_t* O; const float* xss;
    __device__ __forceinline__ void operator()(const f32x4 (&acc)[2][2][4][2], const pg8::Unit& u, int wr, int wc, int fr, int fq) const {
        const int row0 = u.pm * 256 + wr * 64 + fr, col0 = u.pn * 256 + wc * 32 + 8 * fq;
#pragma unroll
        for (int ai = 0; ai < 2; ++ai)
#pragma unroll
            for (int m = 0; m < 4; ++m) {
                const int row = row0 + ai * 128 + m * 16;
                float rstd;
                if (PRE) rstd = xss[row];
                else {
                    const float4* sp = (const float4*)(xss + (size_t)row * XSSN + fq * 8);
                    const float4 v0 = sp[0], v1 = sp[1];
                    float s = ((v0.x + v0.y) + (v0.z + v0.w)) + ((v1.x + v1.y) + (v1.z + v1.w));
                    s += __shfl_xor(s, 16); s += __shfl_xor(s, 32);
                    rstd = rsqrtf(s * (1.f / DM) + 1e-6f);
                }
                bf16_t* rowp = O + (size_t)row * LDP + col0;
#pragma unroll
                for (int bj = 0; bj < 2; ++bj) {
                    const f32x4 v0 = acc[ai][bj][m][0] * rstd, v1 = acc[ai][bj][m][1] * rstd;
                    uint4 o; o.x = pg8::cvt_pk_bf16(v0[0], v0[1]); o.y = pg8::cvt_pk_bf16(v0[2], v0[3]); o.z = pg8::cvt_pk_bf16(v1[0], v1[1]); o.w = pg8::cvt_pk_bf16(v1[2], v1[3]);
                    *(uint4*)(rowp + bj * 128) = o;
                }
            }
    }
};
struct EpiOut {
    static constexpr bool PERM = false, AFTER_DRAIN = false;
    const float* xin; float* xout; bf16_t* xb; float* xss;
    __device__ __forceinline__ void operator()(const f32x4 (&acc)[2][2][4][2], const pg8::Unit& u, int wr, int wc, int fr, int fq) const {
        const int row0 = u.pm * 256 + wr * 64 + fr, col0 = u.pn * 256 + wc * 32 + 4 * fq;
#pragma unroll
        for (int ai = 0; ai < 2; ++ai)
#pragma unroll
            for (int m = 0; m < 4; ++m) {
                const int row = row0 + ai * 128 + m * 16; float ss = 0.f;
#pragma unroll
                for (int bj = 0; bj < 2; ++bj)
#pragma unroll
                    for (int n = 0; n < 2; ++n) {
                        const size_t off = (size_t)row * DM + col0 + bj * 128 + n * 16;
                        const f32x4 v = acc[ai][bj][m][n] + *(const f32x4*)(xin + off);
                        *(f32x4*)(xout + off) = v; ss += v[0] * v[0] + v[1] * v[1] + v[2] * v[2] + v[3] * v[3];
                        if (xb) { uint2 o; o.x = pg8::cvt_pk_bf16(v[0], v[1]); o.y = pg8::cvt_pk_bf16(v[2], v[3]); *(uint2*)(xb + off) = o; }
                    }
                ss += __shfl_xor(ss, 16); ss += __shfl_xor(ss, 32);
                if (fq == 0) xss[(size_t)row * XSSN + u.pn * 4 + wc] = ss;
            }
    }
};

__device__ __forceinline__ void transpose_convert(const float* __restrict__ src, int K, int N, int Npad, bf16_t* __restrict__ dst, const float* __restrict__ rowscale, ldsf lds) {
    const int tid = threadIdx.x, nkt = K / 64, ntiles = nkt * (Npad / 64);
    const int kk = tid >> 4, nn4 = (tid & 15) * 4;
    float4 c0 = make_float4(0.f, 0.f, 0.f, 0.f), c1 = c0;
    int tile = blockIdx.x;
    if (tile < ntiles) {
        const int k0 = (tile % nkt) * 64, n0 = (tile / nkt) * 64;
        if (n0 + nn4 < N) { c0 = *(const float4*)(src + (size_t)(k0 + kk) * N + n0 + nn4); c1 = *(const float4*)(src + (size_t)(k0 + kk + 32) * N + n0 + nn4); }
    }
    for (; tile < ntiles; tile += gridDim.x) {
        const int k0 = (tile % nkt) * 64, n0 = (tile / nkt) * 64;
        float4 a0 = c0, a1 = c1;
        const int nt = tile + gridDim.x;
        c0 = make_float4(0.f, 0.f, 0.f, 0.f); c1 = c0;
        if (nt < ntiles) {
            const int k1 = (nt % nkt) * 64, n1 = (nt / nkt) * 64;
            if (n1 + nn4 < N) { c0 = *(const float4*)(src + (size_t)(k1 + kk) * N + n1 + nn4); c1 = *(const float4*)(src + (size_t)(k1 + kk + 32) * N + n1 + nn4); }
        }
        if (rowscale) { const float s0 = rowscale[k0 + kk], s1 = rowscale[k0 + kk + 32]; a0.x *= s0; a0.y *= s0; a0.z *= s0; a0.w *= s0; a1.x *= s1; a1.y *= s1; a1.z *= s1; a1.w *= s1; }
        lds[kk * 65 + nn4 + 0] = a0.x; lds[kk * 65 + nn4 + 1] = a0.y; lds[kk * 65 + nn4 + 2] = a0.z; lds[kk * 65 + nn4 + 3] = a0.w;
        lds[(kk + 32) * 65 + nn4 + 0] = a1.x; lds[(kk + 32) * 65 + nn4 + 1] = a1.y; lds[(kk + 32) * 65 + nn4 + 2] = a1.z; lds[(kk + 32) * 65 + nn4 + 3] = a1.w;
        __syncthreads();
        {
            const int nn = tid >> 3, k8 = (tid & 7) * 8;
            uint4 o;
            o.x = pack2(lds[(k8 + 0) * 65 + nn], lds[(k8 + 1) * 65 + nn]); o.y = pack2(lds[(k8 + 2) * 65 + nn], lds[(k8 + 3) * 65 + nn]);
            o.z = pack2(lds[(k8 + 4) * 65 + nn], lds[(k8 + 5) * 65 + nn]); o.w = pack2(lds[(k8 + 6) * 65 + nn], lds[(k8 + 7) * 65 + nn]);
            *(uint4*)(dst + (size_t)(n0 + nn) * K + k0 + k8) = o;
        }
        __syncthreads();
    }
}
__device__ __forceinline__ void x_convert(CP P) {
    const int wave = threadIdx.x >> 6, lane = threadIdx.x & 63;
    for (int row = blockIdx.x * 8 + wave; row < M_TOK; row += gridDim.x * 8) {
        const float4* xr = (const float4*)(P->in[0] + (size_t)row * DM); float ss = 0.f;
#pragma unroll
        for (int i = 0; i < 8; ++i) {
            const float4 v = xr[lane + i * 64]; ss += v.x * v.x + v.y * v.y + v.z * v.z + v.w * v.w;
            uint2 o; o.x = pack2(v.x, v.y); o.y = pack2(v.z, v.w); *(uint2*)(P->actA + (size_t)row * DM + (lane + i * 64) * 4) = o;
        }
        ss = wave_sum(ss);
        if (lane == 0) P->xss0[row] = rsqrtf(ss * (1.f / DM) + 1e-6f);
    }
}

__device__ __forceinline__ void lora_convert(CP P) {
    for (int l = 0; l < 2; ++l) {
        const float* w2 = LP(P, l, I_RW_W2); const float* a2 = LP(P, l, I_RW_A2); const float* v2 = P->in[40];
        bf16_t* W = P->lora + (size_t)l * LORA_L; bf16_t* A = W + 512 * 64; bf16_t* V = A + 512 * 64;
        for (int e = blockIdx.x * 512 + threadIdx.x; e < 512 * 64; e += gridDim.x * 512) { const int c = e >> 6, k = e & 63; W[e] = f2bf(w2[k * 512 + c]); A[e] = f2bf(a2[k * 512 + c]); }
        if (l) for (int e = blockIdx.x * 512 + threadIdx.x; e < 512 * 32; e += gridDim.x * 512) { const int c = e >> 5, k = e & 31; V[e] = f2bf(v2[k * 512 + c]); }
    }
}
__device__ __forceinline__ void rwkv_prep(CP P, int l, ldsf lds) {
    const Cols C = cols(l); const int tid = opaque_tid(), wave = tid >> 6, lane = tid & 63, li = lane & 15, kq = lane >> 4;
    const float* mu = LP(P, l, I_RW_MU); const float* w0 = LP(P, l, I_RW_W0); const float* a0 = LP(P, l, I_RW_A0); const float* v0 = P->in[39];
    const bf16_t* W2t = P->lora + (size_t)l * LORA_L; const bf16_t* A2t = W2t + 512 * 64; const bf16_t* V2t = A2t + 512 * 64;
    constexpr int AS = 72, VS = 40;
    const ldsh Wl = (ldsh)lds, Al = Wl + 32 * AS, Vl = Al + 32 * AS;
    for (int tile = blockIdx.x; tile < M_TOK / 32; tile += gridDim.x) {
        const int t0 = tile * 32;
        {
            const int tt = tid >> 4, g = tid & 15, t = t0 + tt;
            const bf16_t* pr = P->proj + (size_t)t * LDP + C.rw + 1536 + g * 8;
            const bool hasp = (t % SEQL) != 0;
            float cur[8], prev[8];
            load8(pr, cur);
            if (hasp) load8(pr - LDP, prev); else {
#pragma unroll
                for (int e = 0; e < 8; ++e) prev[e] = 0.f; }
            float f[8];
#pragma unroll
            for (int e = 0; e < 8; ++e) { f[e] = cur[e] + mu[1536 + g * 8 + e] * (prev[e] - cur[e]); if (g < 8) f[e] = tanhf(f[e]); }
            u32x4 o; o.x = pk2(f[0], f[1]); o.y = pk2(f[2], f[3]); o.z = pk2(f[4], f[5]); o.w = pk2(f[6], f[7]);
            *(LAS u32x4*)((g < 8 ? Wl : Al) + tt * AS + (g & 7) * 8) = o;
            if (l && g < 4) {
                load8(pr + 128, cur);
                if (hasp) load8(pr + 128 - LDP, prev);
#pragma unroll
                for (int e = 0; e < 8; ++e) f[e] = cur[e] + mu[1664 + g * 8 + e] * (prev[e] - cur[e]);
                o.x = pk2(f[0], f[1]); o.y = pk2(f[2], f[3]); o.z = pk2(f[4], f[5]); o.w = pk2(f[6], f[7]);
                *(LAS u32x4*)(Vl + tt * VS + g * 8) = o;
            }
        }
        __syncthreads();
        for (int tl = wave; tl < 64; tl += 8) {
            const int tt16 = tl & 1, cc = (tl >> 1) * 16, c = cc + li;
            f32x4 aW = {0.f, 0.f, 0.f, 0.f}, aA = aW, aV = aW;
            const LAS bf16_t* pw = Wl + (tt16 * 16 + li) * AS + kq * 8; const LAS bf16_t* pa = Al + (tt16 * 16 + li) * AS + kq * 8;
#pragma unroll
            for (int k0 = 0; k0 < 64; k0 += 32) {
                aW = __builtin_amdgcn_mfma_f32_16x16x32_bf16(*(const LAS bf16x8*)(pw + k0), *(const bf16x8*)(W2t + (size_t)c * 64 + k0 + kq * 8), aW, 0, 0, 0);
                aA = __builtin_amdgcn_mfma_f32_16x16x32_bf16(*(const LAS bf16x8*)(pa + k0), *(const bf16x8*)(A2t + (size_t)c * 64 + k0 + kq * 8), aA, 0, 0, 0);
            }
            if (l) aV = __builtin_amdgcn_mfma_f32_16x16x32_bf16(*(const LAS bf16x8*)(Vl + (tt16 * 16 + li) * VS + kq * 8), *(const bf16x8*)(V2t + (size_t)c * 32 + kq * 8), aV, 0, 0, 0);
            const float w0c = w0[c], a0c = a0[c], muc = mu[1024 + c]; const float v0c = l ? v0[c] : 0.f;
#pragma unroll
            for (int j = 0; j < 4; ++j) {
                const int t = t0 + tt16 * 16 + kq * 4 + j; const size_t o = (size_t)t * 512 + c;
                const float wl = w0c + aW[j];
                const float sp = fmaxf(-wl, 0.f) + __logf(1.f + __expf(-fabsf(wl)));
                P->rwA[o] = __expf(-__expf(-sp - 0.5f));
                P->rwB[o] = sigmoidf_(a0c + aA[j]);
                const float cur = bf2f(P->proj[(size_t)t * LDP + C.rw + 1024 + c]);
                const float prev = (t % SEQL == 0) ? 0.f : bf2f(P->proj[(size_t)(t - 1) * LDP + C.rw + 1024 + c]);
                float v = cur + muc * (prev - cur);
                if (l) { const float g = sigmoidf_(v0c + aV[j]); const float vf = P->rwV[o]; v = v + (vf - v) * g; }
                P->rwV[o] = v;
            }
        }
        __syncthreads();
    }
}

__device__ __forceinline__ void rwkv_scan_item(CP P, int l, int it, ldsf lds) {
    const Cols C = cols(l); const int tid = opaque_tid();
    const int b = it >> 5, h = (it >> 2) & 7, rq = it & 3;
    constexpr int BUF = 5 * 2048 + 512 + 8192;
    const float* mu = LP(P, l, I_RW_MU); const float* k_k = LP(P, l, I_RW_KK); const float* k_a = LP(P, l, I_RW_KA);
    const bool producer = tid >= 256; const int ptid = tid & 255;
    const int tt = ptid >> 3, cg8 = (ptid & 7) * 8, ch0 = h * 64 + cg8, c2 = (ptid & 7) * 2;
    const int ri = ptid >> 4, js = (ptid & 15) * 4;
    const float* r_k = LP(P, l, I_RW_RK);
    float mur[8], muk[8], kkc[8], kac[8], rkc[8];
#pragma unroll
    for (int e = 0; e < 8; ++e) { mur[e] = mu[ch0 + e]; muk[e] = mu[512 + ch0 + e]; kkc[e] = k_k[ch0 + e]; kac[e] = k_a[ch0 + e]; rkc[e] = r_k[ch0 + e]; }
    uint4 rcu, kcu, rpu, kpu; float4 ra0, ra1, rd0, rd1; float2 rv2;
    auto issue = [&](int c) {
        const int t = b * SEQL + c * 32 + tt;
        const bf16_t* pr = P->proj + (size_t)t * LDP + C.rw + ch0;
        rcu = *(const uint4*)pr; kcu = *(const uint4*)(pr + 512);
        rpu = make_uint4(0u, 0u, 0u, 0u); kpu = rpu;
        if (c > 0 || tt > 0) { rpu = *(const uint4*)(pr - LDP); kpu = *(const uint4*)(pr - LDP + 512); }
        const float* ap = P->rwB + (size_t)t * 512 + ch0; const float* dp = P->rwA + (size_t)t * 512 + ch0;
        ra0 = *(const float4*)ap; ra1 = *(const float4*)(ap + 4); rd0 = *(const float4*)dp; rd1 = *(const float4*)(dp + 4);
        rv2 = *(const float2*)(P->rwV + (size_t)t * 512 + h * 64 + rq * 16 + c2);
    };
    auto fill = [&](int c, ldsf buf) {
        ldsf sR = buf, sK = buf + 2048, sW = buf + 4096, sNK = buf + 6144, sB = buf + 8192, sV = buf + 10240;
        float rc[8], kc[8], rp[8], kp[8];
        alignas(16) float av[8]; alignas(16) float dv[8]; float kkr[8], kl[8];
        *(float4*)av = ra0; *(float4*)(av + 4) = ra1; *(float4*)dv = rd0; *(float4*)(dv + 4) = rd1;
        unpack8(rcu, rc); unpack8(kcu, kc); unpack8(rpu, rp); unpack8(kpu, kp);
        float ss = 0.f; alignas(16) float o1[8]; alignas(16) float o2[8]; alignas(16) float o3[8]; alignas(16) float o4[8];
#pragma unroll
        for (int e = 0; e < 8; ++e) {
            o1[e] = rc[e] + mur[e] * (rp[e] - rc[e]);
            kl[e] = kc[e] + muk[e] * (kp[e] - kc[e]);
            kkr[e] = kl[e] * kkc[e]; ss += kkr[e] * kkr[e];
        }
        *(LAS f32x4*)(sR + tt * 64 + cg8) = *(f32x4*)o1; *(LAS f32x4*)(sR + tt * 64 + cg8 + 4) = *(f32x4*)(o1 + 4);
        *(LAS f32x4*)(sW + tt * 64 + cg8) = *(f32x4*)dv; *(LAS f32x4*)(sW + tt * 64 + cg8 + 4) = *(f32x4*)(dv + 4);
        ss += dppf<0xB1>(ss); ss += dppf<0x4E>(ss); ss += dppf<0x141>(ss);
        const float inv = 1.f / fmaxf(sqrtf(ss), 1e-12f);
#pragma unroll
        for (int e = 0; e < 8; ++e) {
            const float kk = kkr[e] * inv;
            o2[e] = kl[e] * (1.f + (av[e] - 1.f) * kac[e]); o3[e] = -kk; o4[e] = kk * av[e];
        }
        if (rq == 0) {
            float bs = 0.f;
#pragma unroll
            for (int e = 0; e < 8; ++e) bs += o1[e] * o2[e] * rkc[e];
            bs += dppf<0xB1>(bs); bs += dppf<0x4E>(bs); bs += dppf<0x141>(bs);
            if ((ptid & 7) == 0) P->bon[(size_t)(b * SEQL + c * 32 + tt) * 8 + h] = bs;
        }
        *(LAS f32x4*)(sK + tt * 64 + cg8) = *(f32x4*)o2; *(LAS f32x4*)(sK + tt * 64 + cg8 + 4) = *(f32x4*)(o2 + 4);
        *(LAS f32x4*)(sNK + tt * 64 + cg8) = *(f32x4*)o3; *(LAS f32x4*)(sNK + tt * 64 + cg8 + 4) = *(f32x4*)(o3 + 4);
        *(LAS f32x4*)(sB + tt * 64 + cg8) = *(f32x4*)o4; *(LAS f32x4*)(sB + tt * 64 + cg8 + 4) = *(f32x4*)(o4 + 4);
        *(LAS f32x2*)(sV + tt * 16 + c2) = (f32x2){rv2.x, rv2.y};
    };
    auto flush = [&](int c, ldsf buf) {
        const LAS f32x4* yp = (const LAS f32x4*)(buf + 10752 + (tt * 16 + c2) * 16);
        const f32x4 s0 = (yp[0] + yp[1]) + (yp[2] + yp[3]), s1 = (yp[4] + yp[5]) + (yp[6] + yp[7]);
        *(unsigned*)(P->proj + (size_t)(b * SEQL + c * 32 + tt) * LDP + C.rw + 1024 + h * 64 + rq * 16 + c2) = pack2((s0.x + s0.y) + (s0.z + s0.w), (s1.x + s1.y) + (s1.z + s1.w));
    };
    f32x2 S[2] = {{0.f, 0.f}, {0.f, 0.f}};
    if (producer) { issue(0); fill(0, lds); issue(1); }
    lds_barrier();
    for (int c = 0; c < 64; ++c) {
        const ldsf cur = lds + (c & 1) * BUF, nxt = lds + ((c + 1) & 1) * BUF;
        if (producer) {
            if (c + 1 < 64) fill(c + 1, nxt);
            if (c > 0) flush(c - 1, nxt);
            if (c + 2 < 64) issue(c + 2);
        } else {
            const ldsf sR = cur, sK = cur + 2048, sW = cur + 4096, sNK = cur + 6144, sB = cur + 8192, sV = cur + 10240, sYp = cur + 10752 + ri * 16 + (tid & 15);
            struct Vecs { f32x4 nk, w, b, k, r; float vi; };
            auto ldv = [&](int t) { Vecs v;
                v.nk = *(const LAS f32x4*)(sNK + t * 64 + js); v.w = *(const LAS f32x4*)(sW + t * 64 + js); v.b = *(const LAS f32x4*)(sB + t * 64 + js);
                v.k = *(const LAS f32x4*)(sK + t * 64 + js); v.r = *(const LAS f32x4*)(sR + t * 64 + js); v.vi = sV[t * 16 + ri]; return v; };
            Vecs cur_v = ldv(0), nx1 = ldv(1);
            for (int t16 = 0; t16 < 2; ++t16) {
#pragma unroll
                for (int u = 0; u < 16; ++u) {
                    const int t = t16 * 16 + u;
                    const Vecs nxt = ldv((t + 2) & 31);
                    f32x2 s2 = S[0] * cur_v.nk.xy; s2 = S[1] * cur_v.nk.zw + s2;
                    const float sa = reduce16(s2.x + s2.y);
                    const f32x2 sav = {sa, sa}, viv = {cur_v.vi, cur_v.vi};
                    f32x2 t0 = viv * cur_v.k.xy; t0 = sav * cur_v.b.xy + t0; S[0] = S[0] * cur_v.w.xy + t0;
                    f32x2 t1 = viv * cur_v.k.zw; t1 = sav * cur_v.b.zw + t1; S[1] = S[1] * cur_v.w.zw + t1;
                    f32x2 y2 = S[0] * cur_v.r.xy; y2 = S[1] * cur_v.r.zw + y2;
                    sYp[t * 256] = y2.x + y2.y;
                    cur_v = nx1; nx1 = nxt;
                }
            }
        }
        lds_barrier();
    }
    if (producer) flush(63, lds + BUF);
    __syncthreads();
}

__device__ __forceinline__ void mlstm_item(CP P, int l, int it, ldsf lds) {
    const Cols C = cols(l); const int tid = opaque_tid(), wave = tid >> 6, lane = tid & 63, li = lane & 15, kq = lane >> 4;
    const int b = it >> 4, h = (it >> 2) & 3, es = it & 3;
    constexpr int QS = 136, SS = 72;
    const ldsh Qb = (ldsh)lds, Kb = Qb + 64 * QS, Ktb = Kb + 64 * QS, Vtb = Ktb + 128 * SS, Vwtb = Vtb + 32 * SS, Attb = Vwtb + 32 * SS, Ctb = Attb + 64 * SS, nbb = Ctb + 2 * 32 * QS, wendb = nbb + 2 * 128;
    const ldsf sCum = (ldsf)(wendb + 64), sLi = sCum + 64, sWend = sLi + 64, sMl = sWend + 64, sWint = sMl + 64, sScal = sWint + 64;
    const float* cw = LP(P, l, I_ML_CW); const float* cb = LP(P, l, I_ML_CB);
    const float igb = LP(P, l, I_ML_IGB)[h], fgb = LP(P, l, I_ML_FGB)[h];
    for (int e = tid; e < 64 * SS / 2; e += 512) ((LAS unsigned*)Attb)[e] = 0u;
    for (int e = tid; e < (2 * 32 * QS + 2 * 128) / 2; e += 512) ((LAS unsigned*)Ctb)[e] = 0u;
    float m_prev = 0.f;
    f32x4 Cm[2], nm[2];
#pragma unroll
    for (int q = 0; q < 2; ++q) { Cm[q] = (f32x4){0.f, 0.f, 0.f, 0.f}; nm[q] = Cm[q]; }
    const int cgp = tid & 31, rseg = tid >> 5, isk = cgp >> 4, d0 = (cgp & 15) * 8, col0 = isk * 512 + h * 128 + d0;
    const ldsh cdst = isk ? Kb : Qb; const float cscale = isk ? 0.08838834764831845f : 1.f;
    const bf16x8 ones8 = {(short)0x3F80, (short)0x3F80, (short)0x3F80, (short)0x3F80, (short)0x3F80, (short)0x3F80, (short)0x3F80, (short)0x3F80};
    uint4 raw[7]; uint4 vraw = make_uint4(0u, 0u, 0u, 0u); bf16_t gi_bits = 0, gf_bits = 0;
    auto issue_loads = [&](int nn) {
#pragma unroll
        for (int i = 0; i < 7; ++i) {
            const int ts = nn * 64 + rseg * 4 - 3 + i;
            raw[i] = (ts >= 0) ? *(const uint4*)(P->proj + (size_t)(b * SEQL + ts) * LDP + C.mqk + col0) : make_uint4(0u, 0u, 0u, 0u);
        }
        if (tid < 256) vraw = *(const uint4*)(P->proj + (size_t)(b * SEQL + nn * 64 + (tid >> 2)) * LDP + C.mv + h * 128 + es * 32 + (tid & 3) * 8);
        if (wave == 0) { const bf16_t* gp = P->proj + (size_t)(b * SEQL + nn * 64 + lane) * LDP; gi_bits = gp[C.mi + h]; gf_bits = gp[C.mf + h]; }
    };
    bf16_t pend[4] = {0, 0, 0, 0};
    auto store_pend = [&](int nprev) {
        const int tl = wave >> 1, te = wave & 1;
#pragma unroll
        for (int j = 0; j < 4; ++j) P->proj[(size_t)(b * SEQL + nprev * 64 + tl * 16 + kq * 4 + j) * LDP + C.mv + h * 128 + es * 32 + te * 16 + li] = pend[j];
    };
    issue_loads(0);
    alignas(16) float wreg[4][8]; alignas(16) float breg[8];
    *(float4*)breg = *(const float4*)(cb + col0); *(float4*)(breg + 4) = *(const float4*)(cb + col0 + 4);
#pragma unroll
    for (int j = 0; j < 4; ++j) { *(float4*)wreg[j] = *(const float4*)(cw + j * 1024 + col0); *(float4*)(wreg[j] + 4) = *(const float4*)(cw + j * 1024 + col0 + 4); }
    __syncthreads();
    for (int n = 0; n < 32; ++n) {
        const int t0 = b * SEQL + n * 64, pb = n & 1;
        {
            float acc[4][8];
#pragma unroll
            for (int r = 0; r < 4; ++r)
#pragma unroll
                for (int e = 0; e < 8; ++e) acc[r][e] = breg[e];
#pragma unroll
            for (int i = 0; i < 7; ++i) {
                float f[8]; unpack8(raw[i], f);
#pragma unroll
                for (int r = 0; r < 4; ++r) { const int j = i - r; if (j >= 0 && j < 4) {
#pragma unroll
                    for (int e = 0; e < 8; ++e) acc[r][e] += wreg[j][e] * f[e]; } }
            }
#pragma unroll
            for (int r = 0; r < 4; ++r) {
#pragma unroll
                for (int e = 0; e < 8; ++e) acc[r][e] = siluf(acc[r][e]) * cscale;
                u32x4 o; o.x = pk2(acc[r][0], acc[r][1]); o.y = pk2(acc[r][2], acc[r][3]); o.z = pk2(acc[r][4], acc[r][5]); o.w = pk2(acc[r][6], acc[r][7]);
                *(LAS u32x4*)(cdst + (rseg * 4 + r) * QS + d0) = o;
            }
            if (isk) {
#pragma unroll
                for (int e = 0; e < 8; ++e) { u32x2 o; o.x = pk2(acc[0][e], acc[1][e]); o.y = pk2(acc[2][e], acc[3][e]); *(LAS u32x2*)(Ktb + (d0 + e) * SS + rseg * 4) = o; }
            }
            if (tid < 256) {
                const LAS bf16_t* vs = (const LAS bf16_t*)0; (void)vs;
                const unsigned w4[4] = {vraw.x, vraw.y, vraw.z, vraw.w};
#pragma unroll
                for (int e = 0; e < 8; ++e) Vtb[((tid & 3) * 8 + e) * SS + (tid >> 2)] = (bf16_t)((e & 1) ? (w4[e >> 1] >> 16) : (w4[e >> 1] & 0xffffu));
            }
        }
        if (wave == 0) {
            const int s = lane;
            const float lgi = bf2f(gi_bits) + igb;
            const float lf = logsigmoidf(bf2f(gf_bits) + fgb);
            const float cum = scan_add64(lf, lane);
            const float last = rdlane(cum, 63);
            const float g = last - cum + lgi; const float gmax = rdlane(scan_max64(g, lane), 63);
            const float pm = scan_max64(lgi - cum, lane);
            const float minter = cum + m_prev; const float ml = fmaxf(minter, cum + pm);
            const float we = __expf(g - gmax);
            sCum[s] = cum; sLi[s] = lgi; sWend[s] = we; wendb[s] = f2bf(we); sMl[s] = ml; sWint[s] = __expf(minter - ml);
            if (lane == 0) { sScal[0] = last; sScal[1] = gmax; }
        }
        if (n > 0) store_pend(n - 1);
        if (n + 1 < 32) issue_loads(n + 1);
        lds_barrier();
        if (tid < 256) {
            const int e = tid >> 3, sg = (tid & 7) * 8;
            float f[8]; unpack8v(*(const LAS u32x4*)(Vtb + e * SS + sg), f);
            u32x4 o; o.x = pk2(f[0] * sWend[sg], f[1] * sWend[sg + 1]); o.y = pk2(f[2] * sWend[sg + 2], f[3] * sWend[sg + 3]);
            o.z = pk2(f[4] * sWend[sg + 4], f[5] * sWend[sg + 5]); o.w = pk2(f[6] * sWend[sg + 6], f[7] * sWend[sg + 7]);
            *(LAS u32x4*)(Vwtb + e * SS + sg) = o;
        }
        for (int idx = wave; idx < 10; idx += 8) {
            int tl, ts; tri_tile(idx, tl, ts);
            const f32x4 a = mmb(128, Qb + tl * 16 * QS, QS, Kb + ts * 16 * QS, QS, (f32x4){0.f, 0.f, 0.f, 0.f}, li, kq);
#pragma unroll
            for (int j = 0; j < 4; ++j) {
                const int lr = tl * 16 + kq * 4 + j, sc = ts * 16 + li;
                Attb[lr * SS + sc] = f2bf((sc <= lr) ? a[j] * __expf(sCum[lr] - sCum[sc] + sLi[sc] - sMl[lr]) : 0.f);
            }
        }
        lds_barrier();
        {
            const int tl = wave >> 1, te = wave & 1;
            f32x4 a1 = {0.f, 0.f, 0.f, 0.f}, ad = a1, a2 = a1, aq = a1;
            {
                const LAS bf16_t* pa = Attb + (tl * 16 + li) * SS + kq * 8; const LAS bf16_t* pv = Vtb + (te * 16 + li) * SS + kq * 8;
#pragma unroll
                for (int k0 = 0; k0 < 64; k0 += 32) { const bf16x8 av = *(const LAS bf16x8*)(pa + k0);
                    a1 = __builtin_amdgcn_mfma_f32_16x16x32_bf16(av, *(const LAS bf16x8*)(pv + k0), a1, 0, 0, 0); ad = __builtin_amdgcn_mfma_f32_16x16x32_bf16(av, ones8, ad, 0, 0, 0); }
                const LAS bf16_t* pq = Qb + (tl * 16 + li) * QS + kq * 8; const LAS bf16_t* pc = Ctb + pb * 32 * QS + (te * 16 + li) * QS + kq * 8; const LAS bf16_t* pn = nbb + pb * 128 + kq * 8;
#pragma unroll
                for (int k0 = 0; k0 < 128; k0 += 32) { const bf16x8 av = *(const LAS bf16x8*)(pq + k0);
                    a2 = __builtin_amdgcn_mfma_f32_16x16x32_bf16(av, *(const LAS bf16x8*)(pc + k0), a2, 0, 0, 0); aq = __builtin_amdgcn_mfma_f32_16x16x32_bf16(av, *(const LAS bf16x8*)(pn + k0), aq, 0, 0, 0); }
            }
#pragma unroll
            for (int j = 0; j < 4; ++j) {
                const int lr = tl * 16 + kq * 4 + j, e = te * 16 + li;
                const float wi = sWint[lr];
                const float den = fmaxf(fabsf(ad[j] + wi * aq[j]), __expf(-sMl[lr]));
                const float hv = (a1[j] + wi * a2[j]) / den;
                pend[j] = f2bf(hv);
            }
            const float last = sScal[0], gmax = sScal[1];
            const float m_new = fmaxf(last + m_prev, gmax), a_old = __expf(last + m_prev - m_new), a_new = __expf(gmax - m_new);
#pragma unroll
            for (int q = 0; q < 2; ++q) {
                const int tile = wave + q * 8, td = tile >> 1, te2 = tile & 1;
                const LAS bf16_t* pk = Ktb + (td * 16 + li) * SS + kq * 8; const LAS bf16_t* pv = Vwtb + (te2 * 16 + li) * SS + kq * 8; const LAS bf16_t* pw = wendb + kq * 8;
                f32x4 a = {0.f, 0.f, 0.f, 0.f}, an = a;
#pragma unroll
                for (int k0 = 0; k0 < 64; k0 += 32) { const bf16x8 av = *(const LAS bf16x8*)(pk + k0);
                    a = __builtin_amdgcn_mfma_f32_16x16x32_bf16(av, *(const LAS bf16x8*)(pv + k0), a, 0, 0, 0);
                    if (te2 == 0) an = __builtin_amdgcn_mfma_f32_16x16x32_bf16(av, *(const LAS bf16x8*)(pw + k0), an, 0, 0, 0); }
                Cm[q] = Cm[q] * a_old + a * a_new;
                u32x2 o; o.x = pk2(Cm[q][0], Cm[q][1]); o.y = pk2(Cm[q][2], Cm[q][3]);
                *(LAS u32x2*)(Ctb + (pb ^ 1) * 32 * QS + (te2 * 16 + li) * QS + td * 16 + kq * 4) = o;
                if (te2 == 0) {
                    nm[q] = nm[q] * a_old + an * a_new;
                    if (li == 0) { u32x2 o2; o2.x = pk2(nm[q][0], nm[q][1]); o2.y = pk2(nm[q][2], nm[q][3]); *(LAS u32x2*)(nbb + (pb ^ 1) * 128 + td * 16 + kq * 4) = o2; }
                }
            }
            m_prev = m_new;
        }
        lds_barrier();
    }
    store_pend(31);
}

__device__ __forceinline__ void ssd_item(CP P, int l, int it, ldsf lds) {
    const Cols C = cols(l); const int tid = opaque_tid(), wave = tid >> 6, lane = tid & 63, li = lane & 15, kq = lane >> 4;
    const int b = it >> 3, hh = it & 7, g = hh >> 2;
    constexpr int QS = 136, SS = 72;
    const ldsh Cmb = (ldsh)lds, Bmb = Cmb + 64 * QS, Bmtb = Bmb + 64 * QS, Lcb = Bmtb + 128 * SS, Xdtt = Lcb + 64 * SS, Xett = Xdtt + 64 * SS, Sb = Xett + 64 * SS;
    const ldsf sXr = (ldsf)(Sb + 2 * 64 * QS), sX = sXr + 67 * 64, sCum = sX + 64 * 65, sDt = sCum + 64, sE = sDt + 64, sEc = sE + 64, sScal = sEc + 64;
    const float* cw = LP(P, l, I_SSD_CW); const float* cb = LP(P, l, I_SSD_CB);
    const float Aneg = -expf(LP(P, l, I_SSD_ALOG)[hh]), dtb = LP(P, l, I_SSD_DTB)[hh], dsk = LP(P, l, I_SSD_D)[hh];
    for (int e = tid; e < 64 * SS / 2; e += 512) ((LAS unsigned*)Lcb)[e] = 0u;
    for (int e = tid; e < 2 * 64 * QS / 2; e += 512) ((LAS unsigned*)Sb)[e] = 0u;
    float hv = 0.f;
    f32x4 Sm[4];
#pragma unroll
    for (int q = 0; q < 4; ++q) Sm[q] = (f32x4){0.f, 0.f, 0.f, 0.f};
    const int cgp = tid & 31, rseg = tid >> 5, isc = cgp >> 4, n0 = (cgp & 15) * 8, col0 = 512 + isc * 256 + g * 128 + n0;
    const ldsh cdst = isc ? Cmb : Bmb;
    const int xcol = hh * 64 + (tid & 63);
    const float cb0 = cb[xcol], w0 = cw[xcol], w1 = cw[1024 + xcol], w2 = cw[2048 + xcol], w3 = cw[3072 + xcol];
    uint4 raw[7]; uint4 xraw = make_uint4(0u, 0u, 0u, 0u); bf16_t dt_bits = 0;
    auto issue_loads = [&](int nn) {
#pragma unroll
        for (int i = 0; i < 7; ++i) {
            const int ts = nn * 64 + rseg * 4 - 3 + i;
            raw[i] = (ts >= 0) ? *(const uint4*)(P->proj + (size_t)(b * SEQL + ts) * LDP + C.sx + col0) : make_uint4(0u, 0u, 0u, 0u);
        }
        xraw = *(const uint4*)(P->proj + (size_t)(b * SEQL + nn * 64 + (tid >> 3)) * LDP + C.sx + hh * 64 + (tid & 7) * 8);
        if (wave == 0) dt_bits = P->proj[(size_t)(b * SEQL + nn * 64 + lane) * LDP + C.sdt + hh];
    };
    bf16_t pend[2][4] = {{0, 0, 0, 0}, {0, 0, 0, 0}};
    auto store_pend = [&](int nprev) {
#pragma unroll
        for (int q = 0; q < 2; ++q) { const int tile = wave + q * 8, tl = tile >> 2, tp = tile & 3;
#pragma unroll
            for (int j = 0; j < 4; ++j) P->proj[(size_t)(b * SEQL + nprev * 64 + tl * 16 + kq * 4 + j) * LDP + C.sx + hh * 64 + tp * 16 + li] = pend[q][j]; }
    };
    issue_loads(0);
    alignas(16) float wreg[4][8]; alignas(16) float breg[8];
    *(float4*)breg = *(const float4*)(cb + col0); *(float4*)(breg + 4) = *(const float4*)(cb + col0 + 4);
#pragma unroll
    for (int j = 0; j < 4; ++j) { *(float4*)wreg[j] = *(const float4*)(cw + j * 1024 + col0); *(float4*)(wreg[j] + 4) = *(const float4*)(cw + j * 1024 + col0 + 4); }
    __syncthreads();
    for (int n = 0; n < 32; ++n) {
        const int t0 = b * SEQL + n * 64, pb = n & 1;
        if (tid < 192) sXr[tid] = hv;
        {
            float acc[4][8];
#pragma unroll
            for (int r = 0; r < 4; ++r)
#pragma unroll
                for (int e = 0; e < 8; ++e) acc[r][e] = breg[e];
#pragma unroll
            for (int i = 0; i < 7; ++i) {
                float f[8]; unpack8(raw[i], f);
#pragma unroll
                for (int r = 0; r < 4; ++r) { const int j = i - r; if (j >= 0 && j < 4) {
#pragma unroll
                    for (int e = 0; e < 8; ++e) acc[r][e] += wreg[j][e] * f[e]; } }
            }
#pragma unroll
            for (int r = 0; r < 4; ++r) {
#pragma unroll
                for (int e = 0; e < 8; ++e) acc[r][e] = siluf(acc[r][e]);
                u32x4 o; o.x = pk2(acc[r][0], acc[r][1]); o.y = pk2(acc[r][2], acc[r][3]); o.z = pk2(acc[r][4], acc[r][5]); o.w = pk2(acc[r][6], acc[r][7]);
                *(LAS u32x4*)(cdst + (rseg * 4 + r) * QS + n0) = o;
            }
            if (!isc) {
#pragma unroll
                for (int e = 0; e < 8; ++e) { u32x2 o; o.x = pk2(acc[0][e], acc[1][e]); o.y = pk2(acc[2][e], acc[3][e]); *(LAS u32x2*)(Bmtb + (n0 + e) * SS + rseg * 4) = o; }
            }
            { float f[8]; unpack8(xraw, f);
#pragma unroll
                for (int e = 0; e < 8; ++e) sXr[((tid >> 3) + 3) * 64 + (tid & 7) * 8 + e] = f[e]; }
        }
        if (wave == 0) {
            const float dt = softplusf(bf2f(dt_bits) + dtb);
            const float cum = scan_add64(dt * Aneg, lane);
            const float last = rdlane(cum, 63);
            sDt[lane] = dt; sCum[lane] = cum; sE[lane] = __expf(last - cum); sEc[lane] = __expf(cum);
            if (lane == 0) sScal[0] = __expf(last);
        }
        if (n > 0) store_pend(n - 1);
        if (n + 1 < 32) issue_loads(n + 1);
        lds_barrier();
        {
            const int p = tid & 63, mseg = tid >> 6;
            float xr[11];
#pragma unroll
            for (int i = 0; i < 11; ++i) xr[i] = sXr[(mseg * 8 + i) * 64 + p];
            float xd[8], xe[8];
#pragma unroll
            for (int r = 0; r < 8; ++r) {
                const int mm = mseg * 8 + r;
                const float x = siluf(cb0 + w0 * xr[r] + w1 * xr[r + 1] + w2 * xr[r + 2] + w3 * xr[r + 3]);
                sX[mm * 65 + p] = x; xd[r] = x * sDt[mm]; xe[r] = xd[r] * sE[mm];
            }
            u32x4 o; o.x = pk2(xd[0], xd[1]); o.y = pk2(xd[2], xd[3]); o.z = pk2(xd[4], xd[5]); o.w = pk2(xd[6], xd[7]); *(LAS u32x4*)(Xdtt + p * SS + mseg * 8) = o;
            o.x = pk2(xe[0], xe[1]); o.y = pk2(xe[2], xe[3]); o.z = pk2(xe[4], xe[5]); o.w = pk2(xe[6], xe[7]); *(LAS u32x4*)(Xett + p * SS + mseg * 8) = o;
        }
        for (int idx = wave; idx < 10; idx += 8) {
            int tl, ts; tri_tile(idx, tl, ts);
            const f32x4 a = mmb(128, Cmb + tl * 16 * QS, QS, Bmb + ts * 16 * QS, QS, (f32x4){0.f, 0.f, 0.f, 0.f}, li, kq);
#pragma unroll
            for (int j = 0; j < 4; ++j) {
                const int lr = tl * 16 + kq * 4 + j, sc = ts * 16 + li;
                Lcb[lr * SS + sc] = f2bf((sc <= lr) ? a[j] * __expf(sCum[lr] - sCum[sc]) : 0.f);
            }
        }
        lds_barrier();
        {
            const f32x4 z4 = {0.f, 0.f, 0.f, 0.f};
#pragma unroll
            for (int q = 0; q < 2; ++q) {
                const int tile = wave + q * 8, tl = tile >> 2, tp = tile & 3;
                const f32x4 a1 = mmb(64, Lcb + tl * 16 * SS, SS, Xdtt + tp * 16 * SS, SS, z4, li, kq);
                const f32x4 a2 = mmb(128, Cmb + tl * 16 * QS, QS, Sb + pb * 64 * QS + tp * 16 * QS, QS, z4, li, kq);
#pragma unroll
                for (int j = 0; j < 4; ++j) {
                    const int lr = tl * 16 + kq * 4 + j, p = tp * 16 + li;
                    const float y = a1[j] + sEc[lr] * a2[j] + dsk * sX[lr * 65 + p];
                    pend[q][j] = f2bf(y);
                }
            }
            const float elast = sScal[0];
#pragma unroll
            for (int q = 0; q < 4; ++q) {
                const int tile = wave + q * 8, tp2 = tile & 3, tn = tile >> 2;
                const f32x4 a = mmb(64, Xett + tp2 * 16 * SS, SS, Bmtb + tn * 16 * SS, SS, z4, li, kq);
                Sm[q] = Sm[q] * elast + a;
#pragma unroll
                for (int j = 0; j < 4; ++j) Sb[(pb ^ 1) * 64 * QS + (tp2 * 16 + kq * 4 + j) * QS + tn * 16 + li] = f2bf(Sm[q][j]);
            }
            if (tid < 192) hv = sXr[64 * 64 + tid];
        }
        lds_barrier();
    }
    store_pend(31);
}

__device__ __forceinline__ void gla_item(CP P, int l, int it, ldsf lds) {
    const int tid = opaque_tid(), wave = tid >> 6, lane = tid & 63, li = lane & 15, kq = lane >> 4;
    const int b = it >> 3, h = (it >> 1) & 3, vs = it & 1;
    constexpr int SS = 72;
    const ldsh Qgb = (ldsh)lds, Kgb = Qgb + 64 * SS, Kgtb = Kgb + 64 * SS, Vtb = Kgtb + 64 * SS, Attb = Vtb + 64 * SS, Stb = Attb + 64 * SS;
    const ldsf sQ = (ldsf)(Stb + 2 * 64 * SS), sK = sQ + 64 * 65, sCum = sK + 64 * 65, sGl = sCum + 64 * 65, sW2 = sGl + 64 * 17, sGb = sW2 + 16 * 64, sSeg = sGb + 64, sDec = sSeg + 8 * 64;
    const float* gw2 = LP(P, l, I_GK_W2); const float* gb = LP(P, l, I_GK_B);
    for (int e = tid; e < 16 * 64; e += 512) sW2[e] = gw2[(e >> 6) * 256 + h * 64 + (e & 63)];
    if (tid < 64) sGb[tid] = gb[h * 64 + tid];
    for (int e = tid; e < 64 * SS / 2; e += 512) ((LAS unsigned*)Attb)[e] = 0u;
    for (int e = tid; e < 2 * 64 * SS / 2; e += 512) ((LAS unsigned*)Stb)[e] = 0u;
    f32x4 Sm[2] = {{0.f, 0.f, 0.f, 0.f}, {0.f, 0.f, 0.f, 0.f}};
    uint4 qraw, kraw, xr, gr = make_uint4(0u, 0u, 0u, 0u);
    auto issue_loads = [&](int nn) {
        const int row = tid >> 3, cg = (tid & 7) * 8; const bf16_t* pr = P->proj + (size_t)(b * SEQL + nn * 64 + row) * LDP + h * 64 + cg;
        qraw = *(const uint4*)(pr + C_GQ); kraw = *(const uint4*)(pr + C_GK);
        xr = *(const uint4*)(P->proj + (size_t)(b * SEQL + nn * 64 + row) * LDP + C_GV + h * 128 + vs * 64 + cg);
        if (tid < 128) gr = *(const uint4*)(P->proj + (size_t)(b * SEQL + nn * 64 + (tid >> 1)) * LDP + C_GGK + (tid & 1) * 8);
    };
    bf16_t pend[2][4] = {{0, 0, 0, 0}, {0, 0, 0, 0}};
    auto store_pend = [&](int nprev) {
#pragma unroll
        for (int q = 0; q < 2; ++q) { const int tile = wave + q * 8, tl = tile >> 2, tv = tile & 3;
#pragma unroll
            for (int j = 0; j < 4; ++j) P->proj[(size_t)(b * SEQL + nprev * 64 + tl * 16 + kq * 4 + j) * LDP + C_GV + h * 128 + vs * 64 + tv * 16 + li] = pend[q][j]; }
    };
    issue_loads(0);
    __syncthreads();
    for (int n = 0; n < 32; ++n) {
        const int t0 = b * SEQL + n * 64, pb = n & 1;
        {
            const int row = tid >> 3, cg = (tid & 7) * 8;
            float f[8]; unpack8(qraw, f);
#pragma unroll
            for (int e = 0; e < 8; ++e) sQ[row * 65 + cg + e] = f[e] * 0.125f;
            unpack8(kraw, f);
#pragma unroll
            for (int e = 0; e < 8; ++e) sK[row * 65 + cg + e] = f[e];
            {
                const unsigned w4[4] = {xr.x, xr.y, xr.z, xr.w};
#pragma unroll
                for (int e = 0; e < 8; ++e) Vtb[(cg + e) * SS + row] = (bf16_t)((e & 1) ? (w4[e >> 1] >> 16) : (w4[e >> 1] & 0xffffu));
            }
            if (tid < 128) {
                unpack8(gr, f);
#pragma unroll
                for (int e = 0; e < 8; ++e) sGl[(tid >> 1) * 17 + (tid & 1) * 8 + e] = f[e];
            }
        }
        if (n > 0) store_pend(n - 1);
        if (n + 1 < 32) issue_loads(n + 1);
        lds_barrier();
        for (int e = tid; e < 4096; e += 512) {
            const int s = e >> 6, d = e & 63; float gk = sGb[d];
#pragma unroll
            for (int r = 0; r < 16; ++r) gk += sGl[s * 17 + r] * sW2[r * 64 + d];
            sCum[s * 65 + d] = logsigmoid_fast(gk) * 0.0625f;
        }
        lds_barrier();
        const int d = tid & 63, seg = tid >> 6;
        {
            float run = 0.f;
#pragma unroll
            for (int r = 0; r < 8; ++r) { run += sCum[(seg * 8 + r) * 65 + d]; sCum[(seg * 8 + r) * 65 + d] = run; }
            sSeg[seg * 64 + d] = run;
        }
        lds_barrier();
        {
            float off = 0.f;
            for (int s2 = 0; s2 < seg; ++s2) off += sSeg[s2 * 64 + d];
            float kg[8];
#pragma unroll
            for (int r = 0; r < 8; ++r) {
                const int s = seg * 8 + r; const float c = sCum[s * 65 + d] + off;
                const float ec = __expf(c);
                Qgb[s * SS + d] = f2bf(sQ[s * 65 + d] * ec);
                kg[r] = sK[s * 65 + d] * __expf(-c);
                Kgb[s * SS + d] = f2bf(kg[r]);
                if (s == 63) sDec[d] = ec;
            }
            u32x4 o; o.x = pk2(kg[0], kg[1]); o.y = pk2(kg[2], kg[3]); o.z = pk2(kg[4], kg[5]); o.w = pk2(kg[6], kg[7]);
            *(LAS u32x4*)(Kgtb + d * SS + seg * 8) = o;
        }
        lds_barrier();
        for (int idx = wave; idx < 10; idx += 8) {
            int tl, ts; tri_tile(idx, tl, ts);
            const f32x4 a = mmb(64, Qgb + tl * 16 * SS, SS, Kgb + ts * 16 * SS, SS, (f32x4){0.f, 0.f, 0.f, 0.f}, li, kq);
#pragma unroll
            for (int j = 0; j < 4; ++j) { const int lr = tl * 16 + kq * 4 + j, sc = ts * 16 + li; Attb[lr * SS + sc] = f2bf((sc <= lr) ? a[j] : 0.f); }
        }
        lds_barrier();
        {
            const f32x4 z4 = {0.f, 0.f, 0.f, 0.f};
#pragma unroll
            for (int q = 0; q < 2; ++q) {
                const int tile = wave + q * 8, tl = tile >> 2, tv = tile & 3;
                f32x4 a = mmb(64, Attb + tl * 16 * SS, SS, Vtb + tv * 16 * SS, SS, z4, li, kq);
                a = mmb(64, Qgb + tl * 16 * SS, SS, Stb + pb * 64 * SS + tv * 16 * SS, SS, a, li, kq);
#pragma unroll
                for (int j = 0; j < 4; ++j) pend[q][j] = f2bf(a[j]);
            }
#pragma unroll
            for (int q = 0; q < 2; ++q) {
                const int tile = wave + q * 8, td = tile >> 2, tv = tile & 3;
                const f32x4 u = mmb(64, Kgtb + td * 16 * SS, SS, Vtb + tv * 16 * SS, SS, z4, li, kq);
#pragma unroll
                for (int j = 0; j < 4; ++j) Sm[q][j] = sDec[td * 16 + kq * 4 + j] * (Sm[q][j] + u[j]);
                u32x2 o; o.x = pk2(Sm[q][0], Sm[q][1]); o.y = pk2(Sm[q][2], Sm[q][3]);
                *(LAS u32x2*)(Stb + (pb ^ 1) * 64 * SS + (tv * 16 + li) * SS + td * 16 + kq * 4) = o;
            }
        }
        lds_barrier();
    }
    store_pend(31);
}

#ifndef ITEM_MASK
#define ITEM_MASK 15
#endif
template <int IM = ITEM_MASK> __device__ __forceinline__ void scan_phase(CP P, int l, ldsf lds) {
    for (int it = blockIdx.x; it < N_ITEMS; it += gridDim.x) {
        if (it < N_RW) { if (IM & 1) rwkv_scan_item(P, l, it, lds); }
        else if (it < N_RW + 64) { if (IM & 2) mlstm_item(P, l, it - N_RW, lds); }
        else if (it < N_RW + 96) { if (IM & 4) ssd_item(P, l, it - N_RW - 64, lds); }
        else { if (IM & 8) gla_item(P, l, it - N_RW - 96, lds); }
        __syncthreads();
    }
}

__device__ __forceinline__ void finalize_phase(CP P, int l) {
    const Cols C = cols(l); const int wave = threadIdx.x >> 6, lane = threadIdx.x & 63, c8 = lane * 8;
    const float* gla_g = LP(P, l, I_GLA_NG); const float* mu = LP(P, l, I_RW_MU); const float* k_a = LP(P, l, I_RW_KA); const float* r_k = LP(P, l, I_RW_RK);
    const float* ln_g = LP(P, l, I_RW_LNG); const float* ln_b = LP(P, l, I_RW_LNB); const float* ssd_g = LP(P, l, I_SSD_NG); const float* ml_g = LP(P, l, I_ML_NG);
    for (int t = blockIdx.x * 8 + wave; t < M_TOK; t += gridDim.x * 8) {
        const bf16_t* pr = P->proj + (size_t)t * LDP; bf16_t* yo = P->actA + (size_t)t * DM;
        float a[8], z[8], y[8];
        {
            load8(pr + C_GV + c8, a); load8(pr + C_GZ + c8, z);
            float ss = 0.f;
#pragma unroll
            for (int e = 0; e < 8; ++e) ss += a[e] * a[e];
            ss += __shfl_xor(ss, 1); ss += __shfl_xor(ss, 2); ss += __shfl_xor(ss, 4); ss += __shfl_xor(ss, 8);
            const float rstd = rsqrtf(ss * (1.f / 128.f) + 1e-6f);
#pragma unroll
            for (int e = 0; e < 8; ++e) y[e] = a[e] * rstd * gla_g[c8 + e] * siluf(z[e]);
            store8(yo + c8, y);
        }
        {
            load8(pr + C.rw + 1024 + c8, a); load8(pr + C.rwz + c8, z);
            float s = 0.f;
#pragma unroll
            for (int e = 0; e < 8; ++e) s += a[e];
            s += __shfl_xor(s, 1); s += __shfl_xor(s, 2); s += __shfl_xor(s, 4);
            const float mean = s * (1.f / 64.f); float vs = 0.f;
#pragma unroll
            for (int e = 0; e < 8; ++e) { a[e] -= mean; vs += a[e] * a[e]; }
            vs += __shfl_xor(vs, 1); vs += __shfl_xor(vs, 2); vs += __shfl_xor(vs, 4);
            const float rstd = rsqrtf(vs * (1.f / 64.f) + 64e-5f);
            alignas(16) float vv[8];
            *(float4*)vv = *(const float4*)(P->rwV + (size_t)t * 512 + c8); *(float4*)(vv + 4) = *(const float4*)(P->rwV + (size_t)t * 512 + c8 + 4);
            const float bs = P->bon[(size_t)t * 8 + (lane >> 3)];
#pragma unroll
            for (int e = 0; e < 8; ++e) y[e] = (a[e] * rstd * ln_g[c8 + e] + ln_b[c8 + e] + bs * vv[e]) * siluf(z[e]);
            store8(yo + 512 + c8, y);
        }
        {
            load8(pr + C.sx + c8, a); load8(pr + C.sz + c8, z);
            float ss = 0.f;
#pragma unroll
            for (int e = 0; e < 8; ++e) { a[e] *= siluf(z[e]); ss += a[e] * a[e]; }
            ss = wave_sum(ss);
            const float rstd = rsqrtf(ss * (1.f / 512.f) + 1e-6f);
#pragma unroll
            for (int e = 0; e < 8; ++e) y[e] = a[e] * rstd * ssd_g[c8 + e];
            store8(yo + 1024 + c8, y);
        }
        {
            float o[8];
            load8(pr + C.mv + c8, a); load8(pr + C.mo + c8, o); load8(pr + C.mz + c8, z);
            float s = 0.f;
#pragma unroll
            for (int e = 0; e < 8; ++e) { a[e] *= sigmoidf_(o[e]); s += a[e]; }
            s += __shfl_xor(s, 1); s += __shfl_xor(s, 2); s += __shfl_xor(s, 4); s += __shfl_xor(s, 8);
            const float mean = s * (1.f / 128.f); float vs = 0.f;
#pragma unroll
            for (int e = 0; e < 8; ++e) { a[e] -= mean; vs += a[e] * a[e]; }
            vs += __shfl_xor(vs, 1); vs += __shfl_xor(vs, 2); vs += __shfl_xor(vs, 4); vs += __shfl_xor(vs, 8);
            const float rstd = rsqrtf(vs * (1.f / 128.f) + 1e-6f);
#pragma unroll
            for (int e = 0; e < 8; ++e) y[e] = a[e] * rstd * ml_g[c8 + e] * siluf(z[e]);
            store8(yo + 1536 + c8, y);
        }
    }
}

__device__ __forceinline__ void final_norm(CP P) {
    const int wave = threadIdx.x >> 6, lane = threadIdx.x & 63; const float* g = P->in[57];
    for (int row = blockIdx.x * 8 + wave; row < M_TOK; row += gridDim.x * 8) {
        float s = (lane < XSSN) ? P->xss2[(size_t)row * XSSN + lane] : 0.f; s = wave_sum(s);
        const float rstd = rsqrtf(s * (1.f / DM) + 1e-6f);
        float4* xr = (float4*)(P->out + (size_t)row * DM); const float4* gr = (const float4*)g;
#pragma unroll
        for (int i = 0; i < 8; ++i) { float4 v = xr[lane + i * 64]; const float4 gg = gr[lane + i * 64]; v.x *= rstd * gg.x; v.y *= rstd * gg.y; v.z *= rstd * gg.z; v.w *= rstd * gg.w; xr[lane + i * 64] = v; }
    }
}

#define XB_TMO      128
#define XB_XCNT(j)  (256  + 64 * (j))
#define XB_XSUB(j)  (1280 + 64 * (j))
#define XB_XGEN(j)  (2304 + 64 * (j))
#define XB_TOP      3328
#define XB_TOPGEN   3392
#define XCD_BAR_WORDS 3456
#define XB_SPIN_CAP (1u << 18)

__device__ __forceinline__ unsigned xb_ld(unsigned* p)              { return __hip_atomic_load(p, __ATOMIC_RELAXED, __HIP_MEMORY_SCOPE_AGENT); }
__device__ __forceinline__ unsigned xb_add(unsigned* p, unsigned v) { return __hip_atomic_fetch_add(p, v, __ATOMIC_RELAXED, __HIP_MEMORY_SCOPE_AGENT); }
__device__ __forceinline__ unsigned xb_xcc_id() { return (unsigned)__builtin_amdgcn_s_getreg((3 << 11) | 20) & 0xFu; }
#define XB_SPIN(cond, bar) do { unsigned _sp = 0; while (cond) { __builtin_amdgcn_s_sleep(1); \
    if ((++_sp & 255u) == 0u) { if (xb_ld(&(bar)[XB_TMO])) break; if (_sp > XB_SPIN_CAP) { atomicAdd(&(bar)[XB_TMO], 1u); break; } } } } while (0)

struct XcdBarrier {
    unsigned* bar; unsigned x;
    volatile LAS unsigned* st;
};

__device__ __forceinline__ XcdBarrier xcd_barrier_post(unsigned* bar, volatile LAS unsigned* st) {
    XcdBarrier b; b.bar = bar; b.x = xb_xcc_id(); b.st = st;
    if (threadIdx.x == 0) (void)xb_add(&bar[XB_XCNT(b.x)], 1u);
    return b;
}
__device__ __forceinline__ void xcd_barrier_complete(unsigned* bar, unsigned x, unsigned& nloc, unsigned& nx) {
    const unsigned G = gridDim.x * gridDim.y * gridDim.z;
    unsigned sum, cnt, mine, sp = 0u;
    for (;;) {
        sum = 0u; cnt = 0u; mine = 0u;
#pragma unroll
        for (unsigned j = 0; j < 16; ++j) { const unsigned c = xb_ld(&bar[XB_XCNT(j)]); sum += c; cnt += (c > 0u) ? 1u : 0u; mine = (j == x) ? c : mine; }
        if (sum == G) break;
        __builtin_amdgcn_s_sleep(1);
        if ((++sp & 255u) == 0u) { if (xb_ld(&bar[XB_TMO])) break; if (sp > XB_SPIN_CAP) { atomicAdd(&bar[XB_TMO], 1u); break; } }
    }
    nloc = mine > 0u ? mine : 1u; nx = cnt > 0u ? cnt : 1u;
}

__device__ __forceinline__ void xcd_barrier(const XcdBarrier& b) {
    asm volatile("s_waitcnt vmcnt(0)" ::: "memory");
    __syncthreads();
    if (threadIdx.x == 0) {
        unsigned* bar = b.bar;
        __builtin_amdgcn_s_waitcnt(0);
        unsigned nloc = b.st[0], nx = b.st[1];
        if (nloc == 0u) { xcd_barrier_complete(bar, b.x, nloc, nx); b.st[0] = nloc; b.st[1] = nx; }
        const unsigned old = xb_add(&bar[XB_XSUB(b.x)], 1u);
        const unsigned gen = old / nloc;
        if (old + 1u == (gen + 1u) * nloc) {
            __builtin_amdgcn_fence(__ATOMIC_RELEASE, "agent");
            asm volatile("s_waitcnt vmcnt(0)" ::: "memory");
            const unsigned og = xb_add(&bar[XB_TOP], 1u);
            const unsigned tg = og / nx;
            if (og + 1u == (tg + 1u) * nx) xb_add(&bar[XB_TOPGEN], 1u);
            else XB_SPIN(xb_ld(&bar[XB_TOPGEN]) == tg, bar);
            __builtin_amdgcn_fence(__ATOMIC_ACQUIRE, "agent");
            xb_add(&bar[XB_XGEN(b.x)], 1u);
            asm volatile("s_waitcnt vmcnt(0)" ::: "memory");
        } else {
            XB_SPIN(xb_ld(&bar[XB_XGEN(b.x)]) == gen, bar);
            __builtin_amdgcn_fence(__ATOMIC_ACQUIRE, "agent");
            asm volatile("s_waitcnt vmcnt(0)" ::: "memory");
        }
    }
    __syncthreads();
}


template <bool PRE> __device__ __forceinline__ void gemm_inproj(CP P, const bf16_t* A, const float* xss, PG8_LAS unsigned char* lds) {
    pg8::Gemm g; g.A = A; g.Bt = P->Wi; g.M = M_TOK; g.N = LDP; g.K = DM;
    pg8::StaticOrder S; S.init(g.M, g.N, (int)gridDim.x, (int)blockIdx.x);
    EpiProj<PRE> E; E.O = P->proj; E.xss = xss;
    pg8::gemm_phase<EpiProj<PRE>, pg8::StaticOrder, false>(lds, g, S, E, nullptr);
}
__device__ __forceinline__ void gemm_outproj(CP P, const bf16_t* Wo, const float* xin, bf16_t* xb, float* xss, PG8_LAS unsigned char* lds) {
    pg8::Gemm g; g.A = P->actA; g.Bt = Wo; g.M = M_TOK; g.N = DM; g.K = DM;
    pg8::StaticOrder S; S.init(g.M, g.N, (int)gridDim.x, (int)blockIdx.x);
    EpiOut E; E.xin = xin; E.xout = P->out; E.xb = xb; E.xss = xss;
    pg8::gemm_phase<EpiOut, pg8::StaticOrder, false>(lds, g, S, E, nullptr);
}

#ifndef PROBE_DUP
#define PROBE_DUP 0
#endif
#ifndef PH_MASK
#define PH_MASK 0xFFF
#endif
#define RUN_PHASE(k, body) do { if ((PH_MASK >> (k)) & 1) { if (ph_lo <= (k) && (k) < ph_hi) { CP P = Pc; asm volatile("" : "+s"(P)); body; if ((PROBE_DUP >> (k)) & 1) { __syncthreads(); body; } if (coop && (k) + 1 < ph_hi) { if (coop == 2) grid.sync(); else xcd_barrier(xb); } } } } while (0)
__global__ void __launch_bounds__(512, 2) mega(Params Pk, int ph_lo, int ph_hi, int coop) {
    extern __shared__ __attribute__((aligned(16))) unsigned char shm[];
    PG8_LAS unsigned char* ldsb = (PG8_LAS unsigned char*)shm; ldsf lds = (ldsf)shm;
    cg::grid_group grid = cg::this_grid();
    const CP Pc = (CP)__builtin_amdgcn_kernarg_segment_ptr();
    volatile LAS unsigned* stw = (volatile LAS unsigned*)(shm + LDS_BYTES - 16);
    if (threadIdx.x < 4) stw[threadIdx.x] = 0u;
    __syncthreads();
    XcdBarrier xb = xcd_barrier_post(Pc->bar, stw);
    RUN_PHASE(0, { transpose_convert(P->in[2], DM, 7840, LDP, P->Wi, P->in[1], lds); transpose_convert(P->in[3], DM, DM, DM, P->Wo0, nullptr, lds);
                   transpose_convert(P->in[30], DM, DM, DM, P->Wo1, nullptr, lds); x_convert(P); lora_convert(P); });
#ifdef PROBE_PRE
    { CP P = Pc; asm volatile("" : "+s"(P)); gemm_inproj<true>(P, P->actA, P->xss0, ldsb); grid.sync(); rwkv_prep(P, 0, lds); grid.sync(); scan_phase<PROBE_PRE>(P, 0, lds); grid.sync(); }
#endif
    RUN_PHASE(1, gemm_inproj<true>(P, P->actA, P->xss0, ldsb));
    RUN_PHASE(2, rwkv_prep(P, 0, lds));
    RUN_PHASE(3, scan_phase(P, 0, lds));
    RUN_PHASE(4, { finalize_phase(P, 0); transpose_convert(P->in[29], DM, 7872, LDP, P->Wi, P->in[28], lds); });
    RUN_PHASE(5, gemm_outproj(P, P->Wo0, P->in[0], P->xb1, P->xss1, ldsb));
    RUN_PHASE(6, gemm_inproj<false>(P, P->xb1, P->xss1, ldsb));
    RUN_PHASE(7, rwkv_prep(P, 1, lds));
    RUN_PHASE(8, scan_phase(P, 1, lds));
    RUN_PHASE(9, finalize_phase(P, 1));
    RUN_PHASE(10, gemm_outproj(P, P->Wo1, P->out, nullptr, P->xss2, ldsb));
    RUN_PHASE(11, final_norm(P));
}

#ifndef MK_COOP
#define MK_COOP 1
#endif
extern "C" void kernel_launch(void* const* d_in, const int* in_sizes, int n_in, void* d_out, int out_size, void* d_ws, size_t ws_size, hipStream_t stream) {
    Params p{};
    for (int i = 0; i < 58; ++i) p.in[i] = (const float*)d_in[i];
    p.out = (float*)d_out;
    char* w = (char*)d_ws; size_t off = 0;
    auto take = [&](size_t bytes) { char* r = w + off; off += (bytes + 255) & ~(size_t)255; return r; };
    p.Wi = (bf16_t*)take((size_t)LDP * DM * 2);
    p.Wo0 = (bf16_t*)take((size_t)DM * DM * 2);
    p.Wo1 = (bf16_t*)take((size_t)DM * DM * 2);
    p.actA = (bf16_t*)take((size_t)M_TOK * DM * 2);
    p.proj = (bf16_t*)take((size_t)M_TOK * LDP * 2);
    p.rwA = (float*)take((size_t)M_TOK * 512 * 4);
    p.rwB = (float*)take((size_t)M_TOK * 512 * 4);
    p.xb1 = (bf16_t*)p.rwA;
    p.rwV = (float*)take((size_t)M_TOK * 512 * 4);
    p.xss0 = (float*)take((size_t)M_TOK * XSSN * 4);
    p.xss1 = (float*)take((size_t)M_TOK * XSSN * 4);
    p.xss2 = (float*)take((size_t)M_TOK * XSSN * 4);
    p.bar = (unsigned*)take((size_t)XCD_BAR_WORDS * 4);
    p.lora = (bf16_t*)take((size_t)LORA_ELEMS * 2);
    p.bon = (float*)take((size_t)M_TOK * 8 * 4);
    if (off > ws_size) { fprintf(stderr, "workspace too small: need %zu have %zu\n", off, ws_size); return; }
    static int grid_blocks = 0;
    if (!grid_blocks) {
        hipFuncSetAttribute((const void*)mega, hipFuncAttributeMaxDynamicSharedMemorySize, LDS_BYTES);
        int dev = 0, cus = 0, per_cu = 0;
        hipGetDevice(&dev);
        hipDeviceGetAttribute(&cus, hipDeviceAttributeMultiprocessorCount, dev);
        hipOccupancyMaxActiveBlocksPerMultiprocessor(&per_cu, mega, 512, LDS_BYTES);
        if (per_cu > 1) per_cu = 1;
        grid_blocks = cus * per_cu;
        if (grid_blocks <= 0) grid_blocks = 256;
    }
#if MK_COOP
    hipMemsetAsync(p.bar, 0, (size_t)XCD_BAR_WORDS * 4, stream);
    int lo = 0, hi = N_PHASES, coop = 1;
    void* args[] = {&p, &lo, &hi, &coop};
    hipError_t e = hipLaunchCooperativeKernel((const void*)mega, dim3(grid_blocks), dim3(512), args, LDS_BYTES, stream);
    if (e != hipSuccess) fprintf(stderr, "cooperative launch failed: %s (grid %d)\n", hipGetErrorString(e), grid_blocks);
#else
    for (int ph = 0; ph < N_PHASES; ++ph) hipLaunchKernelGGL(mega, dim3(grid_blocks), dim3(512), LDS_BYTES, stream, p, ph, ph + 1, 0);
#endif
}
```

```cpp
#include <hip/hip_runtime.h>
#include <hip/hip_cooperative_groups.h>
#include <cstdio>
namespace cg = cooperative_groups;

namespace pg8 {
#define PG8_LAS __attribute__((address_space(3)))
typedef unsigned short bf16_t;
typedef short bf16x8 __attribute__((ext_vector_type(8)));
typedef float f32x4 __attribute__((ext_vector_type(4)));
typedef unsigned u32x4 __attribute__((ext_vector_type(4)));
constexpr int BM = 256, BK = 64, HALF = 128, HTB = HALF * BK * 2  , STAGE_BYTES = 8 * HTB, NXCD = 8, WGM = 8;

__host__ __device__ __forceinline__ int lds_byte(int r, int c) { const int st = (r >> 4) * 2 + (c >> 5), rr = r & 15, cc = c & 31, ob = rr * 64 + cc * 2; return st * 1024 + (ob ^ (((ob >> 9) & 1) << 5)); }
__host__ __device__ __forceinline__ void stage_rc(int b, int& R, int& C) { const int st = b / 1024, sb = b % 1024, swz = sb ^ (((sb >> 9) & 1) << 5); R = (st >> 1) * 16 + swz / 64; C = (st & 1) * 32 + (swz % 64) / 2; }
__host__ __device__ __forceinline__ int perm32(int rho) { const int n = rho >> 4, i = rho & 15; return 8 * (i >> 2) + 4 * n + (i & 3); }

struct Unit { int pm, pn; };
struct Gemm { const bf16_t* A; const bf16_t* Bt; int M, N, K; };

struct StaticOrder {
    int nM, nN, nwg, G, c;
    __host__ __device__ void init(int M, int N, int G_, int c_) { nM = M / BM; nN = N / BM; nwg = nM * nN; G = G_; c = c_; }
    __host__ __device__ bool next(int i, Unit& u) const {
        const long L = (long)i * G + c; if (L >= nwg) return false;
        int wgid = (int)L; { const int q = nwg / NXCD, r = nwg % NXCD, xcd = wgid % NXCD, off = wgid / NXCD; wgid = (xcd < r ? xcd * (q + 1) : r * (q + 1) + (xcd - r) * q) + off; }
        const int nig = WGM * nN, gid = wgid / nig, fm = gid * WGM, gsz = (nM - fm) < WGM ? (nM - fm) : WGM;
        u.pm = fm + ((wgid % nig) % gsz); u.pn = (wgid % nig) / gsz; return true;
    }
    __device__ __forceinline__ void a_ready(const Unit&) const {}
    __device__ __forceinline__ void done(const Unit&) const {}
};
__device__ __forceinline__ unsigned cvt_pk_bf16(float lo, float hi) { unsigned r; asm volatile("v_cvt_pk_bf16_f32 %0, %1, %2" : "=v"(r) : "v"(lo), "v"(hi)); return r; }
template <class Epi, class Sched, bool STAMP = false>
__device__ __forceinline__ void gemm_phase(PG8_LAS unsigned char* lds, const Gemm g, const Sched& S, const Epi& E, unsigned long long* stamps) {
    const int tid = threadIdx.x, wid = __builtin_amdgcn_readfirstlane(tid >> 6), lane = tid & 63, wr = wid >> 2, wc = wid & 3, fr = lane & 15, fq = lane >> 4;
    const int K = g.K, nt = K / BK;
    int ts_lo = 0, ts_hi = 0, nts = 0; const unsigned long long rt_entry = STAMP ? (unsigned long long)wall_clock64() : 0ull;
#define PG8_STAMP() do { if (STAMP && wid == 0 && nts < 64) { const unsigned long long _c = (unsigned long long)clock64(); \
        ts_lo = (lane == nts) ? (int)(unsigned)_c : ts_lo; ts_hi = (lane == nts) ? (int)(unsigned)(_c >> 32) : ts_hi; ++nts; } } while (0)
    PG8_STAMP();
    unsigned voffA[2], voffB[2];
#pragma unroll
    for (int i = 0; i < 2; ++i) { int R, C; stage_rc(tid * 16 + i * 8192, R, C); const int Rb = Epi::PERM ? ((R & ~31) + perm32(R & 31)) : R;
        voffA[i] = (unsigned)(R * K + C) * 2u; voffB[i] = (unsigned)(Rb * K + C) * 2u; }
    const size_t kstep = (size_t)(BK * 2);
    const size_t hstep = (size_t)HALF * K * 2;
    const size_t tstep = 2 * hstep;
    const unsigned ldsw = (unsigned)wid * 1024u;
    const int aoff = lds_byte(wr * 64 + fr, fq * 8), boff = lds_byte(wc * 32 + fr, fq * 8);
#define PG8_SA(b, h) (((b) * 2 + (h)) * HTB)
#define PG8_SB(b, h) ((4 + (b) * 2 + (h)) * HTB)
#define PG8_STAGE(bufoff, gbase, voff) do { _Pragma("unroll") for (int _i = 0; _i < 2; ++_i) \
        __builtin_amdgcn_global_load_lds((const unsigned*)((const char*)(gbase) + (voff)[_i]), (PG8_LAS unsigned*)(lds + (bufoff) + ldsw + _i * 8192), 16, 0, 0); } while (0)
#define PG8_LDA(dst, b, h) do { _Pragma("unroll") for (int m = 0; m < 4; ++m) _Pragma("unroll") for (int k = 0; k < 2; ++k) dst[m][k] = *(const PG8_LAS bf16x8*)(lds + PG8_SA(b, h) + aoff + m * 2048 + k * 1024); } while (0)
#define PG8_LDB(dst, b, h) do { _Pragma("unroll") for (int n = 0; n < 2; ++n) _Pragma("unroll") for (int k = 0; k < 2; ++k) dst[n][k] = *(const PG8_LAS bf16x8*)(lds + PG8_SB(b, h) + boff + n * 2048 + k * 1024); } while (0)
#define PG8_MMA(ai, bj, At, Bt) do { __builtin_amdgcn_s_setprio(1); _Pragma("unroll") for (int m = 0; m < 4; ++m) _Pragma("unroll") for (int n = 0; n < 2; ++n) _Pragma("unroll") for (int k = 0; k < 2; ++k) \
        acc[ai][bj][m][n] = __builtin_amdgcn_mfma_f32_16x16x32_bf16(Bt[n][k], At[m][k], acc[ai][bj][m][n], 0, 0, 0); __builtin_amdgcn_s_setprio(0); } while (0)
#define PG8_WAIT_V(n) asm volatile("s_waitcnt vmcnt(" #n ")" ::: "memory")
#define PG8_WAIT_L(n) asm volatile("s_waitcnt lgkmcnt(" #n ")" ::: "memory")
#define PG8_BAR __builtin_amdgcn_s_barrier()
#define PG8_SCHED __builtin_amdgcn_sched_barrier(0)
    Unit cur, nxt; int ui = 0;
    if (!S.next(0, cur)) return;
    f32x4 acc[2][2][4][2];
#pragma unroll
    for (int a = 0; a < 2; ++a)
#pragma unroll
        for (int b = 0; b < 2; ++b)
#pragma unroll
            for (int m = 0; m < 4; ++m)
#pragma unroll
                for (int n = 0; n < 2; ++n) acc[a][b][m][n] = (f32x4){0.f, 0.f, 0.f, 0.f};
    bf16x8 At[4][2], B0[2][2], B1[2][2];
    const char* cA = (const char*)g.A + (size_t)cur.pm * tstep; const char* cB = (const char*)g.Bt + (size_t)cur.pn * tstep;
    S.a_ready(cur);
    PG8_STAGE(PG8_SB(0, 0), cB, voffB); PG8_STAGE(PG8_SA(0, 0), cA, voffA); PG8_STAGE(PG8_SB(0, 1), cB + hstep, voffB); PG8_STAGE(PG8_SA(0, 1), cA + hstep, voffA);
    if (wr == 1) PG8_BAR;
    PG8_WAIT_V(4); PG8_BAR;
    PG8_STAGE(PG8_SB(1, 0), cB + kstep, voffB); PG8_STAGE(PG8_SA(1, 0), cA + kstep, voffA); PG8_STAGE(PG8_SB(1, 1), cB + hstep + kstep, voffB);
    PG8_WAIT_V(6); PG8_BAR;
    PG8_STAMP();
    for (;;) {
        const bool has_next = S.next(ui + 1, nxt);
        const char* nA = has_next ? (const char*)g.A + (size_t)nxt.pm * tstep : cA; const char* nB = has_next ? (const char*)g.Bt + (size_t)nxt.pn * tstep : cB;
        for (int t = 0; t < nt; t += 2) {
            const bool last = (t == nt - 2);
            const char* a1 = cA + (size_t)(t + 1) * kstep;
            const char* a2 = last ? nA : cA + (size_t)(t + 2) * kstep; const char* b2 = last ? nB : cB + (size_t)(t + 2) * kstep;
            const char* a3 = a2 + kstep; const char* b3 = b2 + kstep;
            if (last && has_next) S.a_ready(nxt);
            PG8_LDB(B0, 0, 0); PG8_SCHED; PG8_LDA(At, 0, 0); PG8_STAGE(PG8_SA(1, 1), a1 + hstep, voffA);
            PG8_WAIT_L(8); PG8_BAR; PG8_WAIT_L(0); PG8_MMA(0, 0, At, B0); PG8_BAR; PG8_SCHED;
            PG8_LDB(B1, 0, 1); PG8_STAGE(PG8_SB(0, 0), b2, voffB);
            PG8_BAR; PG8_WAIT_L(0); PG8_MMA(0, 1, At, B1); PG8_BAR;
            PG8_LDA(At, 0, 1); PG8_STAGE(PG8_SA(0, 0), a2, voffA);
            PG8_BAR; PG8_WAIT_L(0); PG8_MMA(1, 0, At, B0); PG8_BAR; PG8_SCHED;
            PG8_STAGE(PG8_SB(0, 1), b2 + hstep, voffB);
            PG8_WAIT_V(6); PG8_BAR; PG8_MMA(1, 1, At, B1); PG8_BAR;
            PG8_LDB(B0, 1, 0); PG8_SCHED; PG8_LDA(At, 1, 0); PG8_STAGE(PG8_SA(0, 1), a2 + hstep, voffA);
            PG8_WAIT_L(8); PG8_BAR; PG8_WAIT_L(0); PG8_MMA(0, 0, At, B0); PG8_BAR; PG8_SCHED;
            PG8_LDB(B1, 1, 1); PG8_STAGE(PG8_SB(1, 0), b3, voffB);
            PG8_BAR; PG8_WAIT_L(0); PG8_MMA(0, 1, At, B1); PG8_BAR;
            PG8_LDA(At, 1, 1); PG8_STAGE(PG8_SA(1, 0), a3, voffA);
            PG8_BAR; PG8_WAIT_L(0); PG8_MMA(1, 0, At, B0); PG8_BAR; PG8_SCHED;
            PG8_STAGE(PG8_SB(1, 1), b3 + hstep, voffB);
            PG8_WAIT_V(6); PG8_BAR; PG8_MMA(1, 1, At, B1); PG8_BAR;
        }
        PG8_STAMP();
        if constexpr (!Epi::AFTER_DRAIN) { E(acc, cur, wr, wc, fr, fq); S.done(cur); }
        PG8_STAMP();
        if (!has_next) break;
#pragma unroll
        for (int a = 0; a < 2; ++a)
#pragma unroll
            for (int b = 0; b < 2; ++b)
#pragma unroll
                for (int m = 0; m < 4; ++m)
#pragma unroll
                    for (int n = 0; n < 2; ++n) acc[a][b][m][n] = (f32x4){0.f, 0.f, 0.f, 0.f};
        cur = nxt; cA = nA; cB = nB; ++ui;
    }
    PG8_WAIT_V(0);
    if (wr == 0) PG8_BAR;
    PG8_BAR;
    if constexpr (Epi::AFTER_DRAIN) { E.fused(acc, cur, wr, wc, fr, fq, lds, wid, lane); S.done(cur); }
    PG8_STAMP();
    if (STAMP && wid == 0) { stamps[lane] = lane < nts ? (((unsigned long long)(unsigned)ts_hi << 32) | (unsigned)ts_lo) : 0ull;
        if (lane == 62) stamps[62] = rt_entry; if (lane == 63) stamps[63] = (unsigned long long)wall_clock64(); }
#undef PG8_STAMP
#undef PG8_SA
#undef PG8_SB
#undef PG8_STAGE
#undef PG8_LDA
#undef PG8_LDB
#undef PG8_MMA
#undef PG8_WAIT_V
#undef PG8_WAIT_L
#undef PG8_BAR
#undef PG8_SCHED
}
}

typedef unsigned short bf16_t;
typedef float f32x4 __attribute__((ext_vector_type(4)));
#define LAS __attribute__((address_space(3)))
typedef LAS float* ldsf;

constexpr int M_TOK = 8192, DM = 2048, SEQL = 2048, LDP = 7936, XSSN = 32;
constexpr int LDS_BYTES = 160 * 1024;
constexpr int N_PHASES = 12;
constexpr int LORA_L = 2 * 512 * 64 + 512 * 32, LORA_ELEMS = 2 * LORA_L;
constexpr int N_RW = 128, N_ITEMS = N_RW + 128;

enum { I_NORM_G = 0, I_W_IN, I_W_OUT, I_GK_W2, I_GK_B, I_GLA_NG, I_RW_MU, I_RW_W0, I_RW_W2, I_RW_A0, I_RW_A2, I_RW_KK, I_RW_KA, I_RW_RK, I_RW_LNG, I_RW_LNB,
       I_SSD_CW, I_SSD_CB, I_SSD_DTB, I_SSD_ALOG, I_SSD_D, I_SSD_NG, I_ML_CW, I_ML_CB, I_ML_IGB, I_ML_FGB, I_ML_NG };

struct Params {
    const float* in[58];
    float* out;
    bf16_t* Wi; bf16_t* Wo0; bf16_t* Wo1; bf16_t* actA; bf16_t* proj; bf16_t* xb1;
    float* rwA; float* rwB; float* rwV; float* xss0; float* xss1; float* xss2; unsigned* bar; bf16_t* lora; float* bon;
};
typedef const __attribute__((address_space(4))) Params* CP;
__device__ __forceinline__ const float* LP(CP P, int l, int idx) { return P->in[(l ? 28 : 1) + idx + ((l && idx >= I_RW_KK) ? 2 : 0)]; }

struct Cols { int rw, rwz, sx, sdt, sz, mqk, mv, mi, mf, mo, mz, nin; };
__device__ __forceinline__ Cols cols(int l) {
    const int RW = l ? 1696 : 1664; Cols c;
    c.rw = 1552; c.rwz = 1552 + RW; c.sx = c.rwz + 512; c.sdt = c.sx + 1024; c.sz = c.sdt + 8; c.mqk = c.sz + 512; c.mv = c.mqk + 1024;
    c.mi = c.mv + 512; c.mf = c.mi + 4; c.mo = c.mf + 4; c.mz = c.mo + 512; c.nin = c.mz + 512; return c;
}
constexpr int C_GQ = 0, C_GK = 256, C_GV = 512, C_GGK = 1024, C_GZ = 1040;

__device__ __forceinline__ float bf2f(bf16_t u) { return __uint_as_float(((unsigned)u) << 16); }
__device__ __forceinline__ bf16_t f2bf(float f) { unsigned u = __float_as_uint(f); u += 0x7FFFu + ((u >> 16) & 1u); return (bf16_t)(u >> 16); }
__device__ __forceinline__ unsigned pack2(float lo, float hi) { return (unsigned)f2bf(lo) | ((unsigned)f2bf(hi) << 16); }
__device__ __forceinline__ void unpack8(const uint4 u, float* f) {
    f[0] = __uint_as_float(u.x << 16); f[1] = __uint_as_float(u.x & 0xffff0000u); f[2] = __uint_as_float(u.y << 16); f[3] = __uint_as_float(u.y & 0xffff0000u);
    f[4] = __uint_as_float(u.z << 16); f[5] = __uint_as_float(u.z & 0xffff0000u); f[6] = __uint_as_float(u.w << 16); f[7] = __uint_as_float(u.w & 0xffff0000u);
}
__device__ __forceinline__ void load8(const bf16_t* p, float* f) { unpack8(*(const uint4*)p, f); }
__device__ __forceinline__ void store8(bf16_t* p, const float* f) { uint4 u; u.x = pack2(f[0], f[1]); u.y = pack2(f[2], f[3]); u.z = pack2(f[4], f[5]); u.w = pack2(f[6], f[7]); *(uint4*)p = u; }
__device__ __forceinline__ float softplusf(float x) { return fmaxf(x, 0.f) + log1pf(expf(-fabsf(x))); }
__device__ __forceinline__ float logsigmoidf(float x) { return fminf(x, 0.f) - log1pf(expf(-fabsf(x))); }
__device__ __forceinline__ float sigmoidf_(float x) { return __builtin_amdgcn_rcpf(1.f + __expf(-x)); }
__device__ __forceinline__ float siluf(float x) { return x * __builtin_amdgcn_rcpf(1.f + __expf(-x)); }
__device__ __forceinline__ float logsigmoid_fast(float x) { return fminf(x, 0.f) - __logf(1.f + __expf(-fabsf(x))); }
typedef float f32x2 __attribute__((ext_vector_type(2)));
__device__ __forceinline__ float wave_sum(float v) { for (int o = 32; o; o >>= 1) v += __shfl_xor(v, o); return v; }
__device__ __forceinline__ float wave_max(float v) { for (int o = 32; o; o >>= 1) v = fmaxf(v, __shfl_xor(v, o)); return v; }
template <int CTRL> __device__ __forceinline__ float dppf(float v) { return __int_as_float(__builtin_amdgcn_update_dpp(0, __float_as_int(v), CTRL, 0xF, 0xF, true)); }
__device__ __forceinline__ float reduce16(float v) { v += dppf<0xB1>(v); v += dppf<0x4E>(v); v += dppf<0x141>(v); v += dppf<0x140>(v); return v; }
__device__ __forceinline__ float reduce8(float v) { v += dppf<0xB1>(v); v += dppf<0x4E>(v); v += dppf<0x141>(v); return v; }

template <int CTRL> __device__ __forceinline__ float dpp_keep(float oldv, float v) { return __int_as_float(__builtin_amdgcn_update_dpp(__float_as_int(oldv), __float_as_int(v), CTRL, 0xF, 0xF, false)); }
__device__ __forceinline__ float rdlane(float v, int l) { return __int_as_float(__builtin_amdgcn_readlane(__float_as_int(v), l)); }
__device__ __forceinline__ float scan_add64(float v, int lane) {
    v += dppf<0x111>(v); v += dppf<0x112>(v); v += dppf<0x114>(v); v += dppf<0x118>(v);
    const float t0 = rdlane(v, 15), t1 = rdlane(v, 31), t2 = rdlane(v, 47); const int row = lane >> 4;
    return v + ((row >= 1) ? t0 : 0.f) + ((row >= 2) ? t1 : 0.f) + ((row >= 3) ? t2 : 0.f);
}
__device__ __forceinline__ float scan_max64(float v, int lane) {
    const float ninf = -__builtin_inff();
    v = fmaxf(v, dpp_keep<0x111>(ninf, v)); v = fmaxf(v, dpp_keep<0x112>(ninf, v)); v = fmaxf(v, dpp_keep<0x114>(ninf, v)); v = fmaxf(v, dpp_keep<0x118>(ninf, v));
    const float t0 = rdlane(v, 15), t1 = rdlane(v, 31), t2 = rdlane(v, 47); const int row = lane >> 4;
    return fmaxf(fmaxf(v, (row >= 1) ? t0 : ninf), fmaxf((row >= 2) ? t1 : ninf, (row >= 3) ? t2 : ninf));
}
__device__ __forceinline__ void lds_barrier() { asm volatile("s_waitcnt lgkmcnt(0)\n\ts_barrier" ::: "memory"); }
__device__ __forceinline__ int opaque_tid() { int t = threadIdx.x; asm volatile("" : "+v"(t)); return t; }
template <class FA, class FB> __device__ __forceinline__ f32x4 mm16(int K, FA fa, FB fb, f32x4 acc, int i, int kq) {
#pragma unroll 4
    for (int k0 = 0; k0 < K; k0 += 4) { const float a = fa(i, k0 + kq), b = fb(k0 + kq, i); acc = __builtin_amdgcn_mfma_f32_16x16x4f32(a, b, acc, 0, 0, 0); }
    return acc;
}
template <class FA, class FB1, class FB2> __device__ __forceinline__ void mm16_2(int K, FA fa, FB1 fb1, FB2 fb2, f32x4& acc1, f32x4& acc2, int i, int kq) {
#pragma unroll 4
    for (int k0 = 0; k0 < K; k0 += 4) { const float a = fa(i, k0 + kq), b1 = fb1(k0 + kq, i), b2 = fb2(k0 + kq, i);
        acc1 = __builtin_amdgcn_mfma_f32_16x16x4f32(a, b1, acc1, 0, 0, 0); acc2 = __builtin_amdgcn_mfma_f32_16x16x4f32(a, b2, acc2, 0, 0, 0); }
}
typedef short bf16x8 __attribute__((ext_vector_type(8)));
typedef LAS bf16_t* ldsh;
typedef unsigned u32x4 __attribute__((ext_vector_type(4)));
typedef unsigned u32x2 __attribute__((ext_vector_type(2)));
__device__ __forceinline__ void unpack8v(const u32x4 u, float* f) { unpack8(make_uint4(u.x, u.y, u.z, u.w), f); }
__device__ __forceinline__ unsigned pk2(float lo, float hi) { unsigned r; asm volatile("v_cvt_pk_bf16_f32 %0, %1, %2" : "=v"(r) : "v"(lo), "v"(hi)); return r; }
__device__ __forceinline__ f32x4 mmb(int K, const LAS bf16_t* pa, int lda, const LAS bf16_t* pb, int ldb, f32x4 acc, int li, int kq) {
    const LAS bf16_t* a = pa + li * lda + kq * 8; const LAS bf16_t* b = pb + li * ldb + kq * 8;
#pragma unroll 4
    for (int k0 = 0; k0 < K; k0 += 32) acc = __builtin_amdgcn_mfma_f32_16x16x32_bf16(*(const LAS bf16x8*)(a + k0), *(const LAS bf16x8*)(b + k0), acc, 0, 0, 0);
    return acc;
}
__device__ __forceinline__ void tri_tile(int idx, int& tl, int& ts) {
    tl = (idx >= 6) ? 3 : (idx >= 3) ? 2 : (idx >= 1) ? 1 : 0; ts = idx - (tl * (tl + 1)) / 2;
}

template <bool PRE> struct EpiProj {
    static constexpr bool PERM = true, AFTER_DRAIN = false;
    bf16_t* O; const float* xss;
    __device__ __forceinline__ void operator()(const f32x4 (&acc)[2][2][4][2], const pg8::Unit& u, int wr, int wc, int fr, int fq) const {
        const int row0 = u.pm * 256 + wr * 64 + fr, col0 = u.pn * 256 + wc * 32 + 8 * fq;
#pragma unroll
        for (int ai = 0; ai < 2; ++ai)
#pragma unroll
            for (int m = 0; m < 4; ++m) {
                const int row = row0 + ai * 128 + m * 16;
                float rstd;
                if (PRE) rstd = xss[row];
                else {
                    const float4* sp = (const float4*)(xss + (size_t)row * XSSN + fq * 8);
                    const float4 v0 = sp[0], v1 = sp[1];
                    float s = ((v0.x + v0.y) + (v0.z + v0.w)) + ((v1.x + v1.y) + (v1.z + v1.w));
                    s += __shfl_xor(s, 16); s += __shfl_xor(s, 32);
                    rstd = rsqrtf(s * (1.f / DM) + 1e-6f);
                }
                bf16_t* rowp = O + (size_t)row * LDP + col0;
#pragma unroll
                for (int bj = 0; bj < 2; ++bj) {
                    const f32x4 v0 = acc[ai][bj][m][0] * rstd, v1 = acc[ai][bj][m][1] * rstd;
                    uint4 o; o.x = pg8::cvt_pk_bf16(v0[0], v0[1]); o.y = pg8::cvt_pk_bf16(v0[2], v0[3]); o.z = pg8::cvt_pk_bf16(v1[0], v1[1]); o.w = pg8::cvt_pk_bf16(v1[2], v1[3]);
                    *(uint4*)(rowp + bj * 128) = o;
                }
            }
    }
};
struct EpiOut {
    static constexpr bool PERM = false, AFTER_DRAIN = false;
    const float* xin; float* xout; bf16_t* xb; float* xss;
    __device__ __forceinline__ void operator()(const f32x4 (&acc)[2][2][4][2], const pg8::Unit& u, int wr, int wc, int fr, int fq) const {
        const int row0 = u.pm * 256 + wr * 64 + fr, col0 = u.pn * 256 + wc * 32 + 4 * fq;
#pragma unroll
        for (int ai = 0; ai < 2; ++ai)
#pragma unroll
            for (int m = 0; m < 4; ++m) {
                const int row = row0 + ai * 128 + m * 16; float ss = 0.f;
#pragma unroll
                for (int bj = 0; bj < 2; ++bj)
#pragma unroll
                    for (int n = 0; n < 2; ++n) {
                        const size_t off = (size_t)row * DM + col0 + bj * 128 + n * 16;
                        const f32x4 v = acc[ai][bj][m][n] + *(const f32x4*)(xin + off);
                        *(f32x4*)(xout + off) = v; ss += v[0] * v[0] + v[1] * v[1] + v[2] * v[2] + v[3] * v[3];
                        if (xb) { uint2 o; o.x = pg8::cvt_pk_bf16(v[0], v[1]); o.y = pg8::cvt_pk_bf16(v[2], v[3]); *(uint2*)(xb + off) = o; }
                    }
                ss += __shfl_xor(ss, 16); ss += __shfl_xor(ss, 32);
                if (fq == 0) xss[(size_t)row * XSSN + u.pn * 4 + wc] = ss;
            }
    }
};

__device__ __forceinline__ void transpose_convert(const float* __restrict__ src, int K, int N, int Npad, bf16_t* __restrict__ dst, const float* __restrict__ rowscale, ldsf lds, int wg = -1, int nwg = 0) {
    if (wg < 0) { wg = blockIdx.x; nwg = gridDim.x; }
    const int tid = threadIdx.x, nkt = K / 64, ntiles = nkt * (Npad / 64);
    const int kk = tid >> 4, nn4 = (tid & 15) * 4;
    float4 c0 = make_float4(0.f, 0.f, 0.f, 0.f), c1 = c0;
    int tile = wg;
    if (tile < ntiles) {
        const int k0 = (tile % nkt) * 64, n0 = (tile / nkt) * 64;
        if (n0 + nn4 < N) { c0 = *(const float4*)(src + (size_t)(k0 + kk) * N + n0 + nn4); c1 = *(const float4*)(src + (size_t)(k0 + kk + 32) * N + n0 + nn4); }
    }
    for (; tile < ntiles; tile += nwg) {
        const int k0 = (tile % nkt) * 64, n0 = (tile / nkt) * 64;
        float4 a0 = c0, a1 = c1;
        const int nt = tile + nwg;
        c0 = make_float4(0.f, 0.f, 0.f, 0.f); c1 = c0;
        if (nt < ntiles) {
            const int k1 = (nt % nkt) * 64, n1 = (nt / nkt) * 64;
            if (n1 + nn4 < N) { c0 = *(const float4*)(src + (size_t)(k1 + kk) * N + n1 + nn4); c1 = *(const float4*)(src + (size_t)(k1 + kk + 32) * N + n1 + nn4); }
        }
        if (rowscale) { const float s0 = rowscale[k0 + kk], s1 = rowscale[k0 + kk + 32]; a0.x *= s0; a0.y *= s0; a0.z *= s0; a0.w *= s0; a1.x *= s1; a1.y *= s1; a1.z *= s1; a1.w *= s1; }
        lds[kk * 65 + nn4 + 0] = a0.x; lds[kk * 65 + nn4 + 1] = a0.y; lds[kk * 65 + nn4 + 2] = a0.z; lds[kk * 65 + nn4 + 3] = a0.w;
        lds[(kk + 32) * 65 + nn4 + 0] = a1.x; lds[(kk + 32) * 65 + nn4 + 1] = a1.y; lds[(kk + 32) * 65 + nn4 + 2] = a1.z; lds[(kk + 32) * 65 + nn4 + 3] = a1.w;
        __syncthreads();
        {
            const int nn = tid >> 3, k8 = (tid & 7) * 8;
            uint4 o;
            o.x = pack2(lds[(k8 + 0) * 65 + nn], lds[(k8 + 1) * 65 + nn]); o.y = pack2(lds[(k8 + 2) * 65 + nn], lds[(k8 + 3) * 65 + nn]);
            o.z = pack2(lds[(k8 + 4) * 65 + nn], lds[(k8 + 5) * 65 + nn]); o.w = pack2(lds[(k8 + 6) * 65 + nn], lds[(k8 + 7) * 65 + nn]);
            *(uint4*)(dst + (size_t)(n0 + nn) * K + k0 + k8) = o;
        }
        __syncthreads();
    }
}
__device__ __forceinline__ void x_convert(CP P) {
    const int wave = threadIdx.x >> 6, lane = threadIdx.x & 63;
    for (int row = blockIdx.x * 8 + wave; row < M_TOK; row += gridDim.x * 8) {
        const float4* xr = (const float4*)(P->in[0] + (size_t)row * DM); float ss = 0.f;
#pragma unroll
        for (int i = 0; i < 8; ++i) {
            const float4 v = xr[lane + i * 64]; ss += v.x * v.x + v.y * v.y + v.z * v.z + v.w * v.w;
            uint2 o; o.x = pack2(v.x, v.y); o.y = pack2(v.z, v.w); *(uint2*)(P->actA + (size_t)row * DM + (lane + i * 64) * 4) = o;
        }
        ss = wave_sum(ss);
        if (lane == 0) P->xss0[row] = rsqrtf(ss * (1.f / DM) + 1e-6f);
    }
}

__device__ __forceinline__ void lora_convert(CP P) {
    for (int l = 0; l < 2; ++l) {
        const float* w2 = LP(P, l, I_RW_W2); const float* a2 = LP(P, l, I_RW_A2); const float* v2 = P->in[40];
        bf16_t* W = P->lora + (size_t)l * LORA_L; bf16_t* A = W + 512 * 64; bf16_t* V = A + 512 * 64;
        for (int e = blockIdx.x * 512 + threadIdx.x; e < 512 * 64; e += gridDim.x * 512) { const int c = e >> 6, k = e & 63; W[e] = f2bf(w2[k * 512 + c]); A[e] = f2bf(a2[k * 512 + c]); }
        if (l) for (int e = blockIdx.x * 512 + threadIdx.x; e < 512 * 32; e += gridDim.x * 512) { const int c = e >> 5, k = e & 31; V[e] = f2bf(v2[k * 512 + c]); }
    }
}
__device__ __forceinline__ void rwkv_prep(CP P, int l, ldsf lds) {
    const Cols C = cols(l); const int tid = opaque_tid(), wave = tid >> 6, lane = tid & 63, li = lane & 15, kq = lane >> 4;
    const float* mu = LP(P, l, I_RW_MU); const float* w0 = LP(P, l, I_RW_W0); const float* a0 = LP(P, l, I_RW_A0); const float* v0 = P->in[39];
    const bf16_t* W2t = P->lora + (size_t)l * LORA_L; const bf16_t* A2t = W2t + 512 * 64; const bf16_t* V2t = A2t + 512 * 64;
    constexpr int AS = 72, VS = 40;
    const ldsh Wl = (ldsh)lds, Al = Wl + 32 * AS, Vl = Al + 32 * AS;
    for (int tile = blockIdx.x; tile < M_TOK / 32; tile += gridDim.x) {
        const int t0 = tile * 32;
        {
            const int tt = tid >> 4, g = tid & 15, t = t0 + tt;
            const bf16_t* pr = P->proj + (size_t)t * LDP + C.rw + 1536 + g * 8;
            const bool hasp = (t % SEQL) != 0;
            float cur[8], prev[8];
            load8(pr, cur);
            if (hasp) load8(pr - LDP, prev); else {
#pragma unroll
                for (int e = 0; e < 8; ++e) prev[e] = 0.f; }
            float f[8];
#pragma unroll
            for (int e = 0; e < 8; ++e) { f[e] = cur[e] + mu[1536 + g * 8 + e] * (prev[e] - cur[e]); if (g < 8) f[e] = tanhf(f[e]); }
            u32x4 o; o.x = pk2(f[0], f[1]); o.y = pk2(f[2], f[3]); o.z = pk2(f[4], f[5]); o.w = pk2(f[6], f[7]);
            *(LAS u32x4*)((g < 8 ? Wl : Al) + tt * AS + (g & 7) * 8) = o;
            if (l && g < 4) {
                load8(pr + 128, cur);
                if (hasp) load8(pr + 128 - LDP, prev);
#pragma unroll
                for (int e = 0; e < 8; ++e) f[e] = cur[e] + mu[1664 + g * 8 + e] * (prev[e] - cur[e]);
                o.x = pk2(f[0], f[1]); o.y = pk2(f[2], f[3]); o.z = pk2(f[4], f[5]); o.w = pk2(f[6], f[7]);
                *(LAS u32x4*)(Vl + tt * VS + g * 8) = o;
            }
        }
        __syncthreads();
        for (int tl = wave; tl < 64; tl += 8) {
            const int tt16 = tl & 1, cc = (tl >> 1) * 16, c = cc + li;
            f32x4 aW = {0.f, 0.f, 0.f, 0.f}, aA = aW, aV = aW;
            const LAS bf16_t* pw = Wl + (tt16 * 16 + li) * AS + kq * 8; const LAS bf16_t* pa = Al + (tt16 * 16 + li) * AS + kq * 8;
#pragma unroll
            for (int k0 = 0; k0 < 64; k0 += 32) {
                aW = __builtin_amdgcn_mfma_f32_16x16x32_bf16(*(const LAS bf16x8*)(pw + k0), *(const bf16x8*)(W2t + (size_t)c * 64 + k0 + kq * 8), aW, 0, 0, 0);
                aA = __builtin_amdgcn_mfma_f32_16x16x32_bf16(*(const LAS bf16x8*)(pa + k0), *(const bf16x8*)(A2t + (size_t)c * 64 + k0 + kq * 8), aA, 0, 0, 0);
            }
            if (l) aV = __builtin_amdgcn_mfma_f32_16x16x32_bf16(*(const LAS bf16x8*)(Vl + (tt16 * 16 + li) * VS + kq * 8), *(const bf16x8*)(V2t + (size_t)c * 32 + kq * 8), aV, 0, 0, 0);
            const float w0c = w0[c], a0c = a0[c], muc = mu[1024 + c]; const float v0c = l ? v0[c] : 0.f;
#pragma unroll
            for (int j = 0; j < 4; ++j) {
                const int t = t0 + tt16 * 16 + kq * 4 + j; const size_t o = (size_t)t * 512 + c;
                const float wl = w0c + aW[j];
                const float sp = fmaxf(-wl, 0.f) + __logf(1.f + __expf(-fabsf(wl)));
                P->rwA[o] = __expf(-__expf(-sp - 0.5f));
                P->rwB[o] = sigmoidf_(a0c + aA[j]);
                const float cur = bf2f(P->proj[(size_t)t * LDP + C.rw + 1024 + c]);
                const float prev = (t % SEQL == 0) ? 0.f : bf2f(P->proj[(size_t)(t - 1) * LDP + C.rw + 1024 + c]);
                float v = cur + muc * (prev - cur);
                if (l) { const float g = sigmoidf_(v0c + aV[j]); const float vf = P->rwV[o]; v = v + (vf - v) * g; }
                P->rwV[o] = v;
            }
        }
        __syncthreads();
    }
}

__device__ __forceinline__ void rwkv_scan_item(CP P, int l, int it, ldsf lds) {
    const Cols C = cols(l); const int tid = opaque_tid();
    const int b = it >> 5, h = (it >> 2) & 7, rq = it & 3;
    constexpr int BUF = 5 * 2048 + 512 + 8192;
    const float* mu = LP(P, l, I_RW_MU); const float* k_k = LP(P, l, I_RW_KK); const float* k_a = LP(P, l, I_RW_KA);
    const bool producer = tid >= 256; const int ptid = tid & 255;
    const int tt = ptid >> 3, cg8 = (ptid & 7) * 8, ch0 = h * 64 + cg8, c2 = (ptid & 7) * 2;
    const int ri = ptid >> 4, js = (ptid & 15) * 4;
    const float* r_k = LP(P, l, I_RW_RK);
    float mur[8], muk[8], kkc[8], kac[8], rkc[8];
#pragma unroll
    for (int e = 0; e < 8; ++e) { mur[e] = mu[ch0 + e]; muk[e] = mu[512 + ch0 + e]; kkc[e] = k_k[ch0 + e]; kac[e] = k_a[ch0 + e]; rkc[e] = r_k[ch0 + e]; }
    uint4 rcu, kcu, rpu, kpu; float4 ra0, ra1, rd0, rd1; float2 rv2;
    auto issue = [&](int c) {
        const int t = b * SEQL + c * 32 + tt;
        const bf16_t* pr = P->proj + (size_t)t * LDP + C.rw + ch0;
        rcu = *(const uint4*)pr; kcu = *(const uint4*)(pr + 512);
        rpu = make_uint4(0u, 0u, 0u, 0u); kpu = rpu;
        if (c > 0 || tt > 0) { rpu = *(const uint4*)(pr - LDP); kpu = *(const uint4*)(pr - LDP + 512); }
        const float* ap = P->rwB + (size_t)t * 512 + ch0; const float* dp = P->rwA + (size_t)t * 512 + ch0;
        ra0 = *(const float4*)ap; ra1 = *(const float4*)(ap + 4); rd0 = *(const float4*)dp; rd1 = *(const float4*)(dp + 4);
        rv2 = *(const float2*)(P->rwV + (size_t)t * 512 + h * 64 + rq * 16 + c2);
    };
    auto fill = [&](int c, ldsf buf) {
        ldsf sR = buf, sK = buf + 2048, sW = buf + 4096, sNK = buf + 6144, sB = buf + 8192, sV = buf + 10240;
        float rc[8], kc[8], rp[8], kp[8];
        alignas(16) float av[8]; alignas(16) float dv[8]; float kkr[8], kl[8];
        *(float4*)av = ra0; *(float4*)(av + 4) = ra1; *(float4*)dv = rd0; *(float4*)(dv + 4) = rd1;
        unpack8(rcu, rc); unpack8(kcu, kc); unpack8(rpu, rp); unpack8(kpu, kp);
        float ss = 0.f; alignas(16) float o1[8]; alignas(16) float o2[8]; alignas(16) float o3[8]; alignas(16) float o4[8];
#pragma unroll
        for (int e = 0; e < 8; ++e) {
            o1[e] = rc[e] + mur[e] * (rp[e] - rc[e]);
            kl[e] = kc[e] + muk[e] * (kp[e] - kc[e]);
            kkr[e] = kl[e] * kkc[e]; ss += kkr[e] * kkr[e];
        }
        *(LAS f32x4*)(sR + tt * 64 + cg8) = *(f32x4*)o1; *(LAS f32x4*)(sR + tt * 64 + cg8 + 4) = *(f32x4*)(o1 + 4);
        *(LAS f32x4*)(sW + tt * 64 + cg8) = *(f32x4*)dv; *(LAS f32x4*)(sW + tt * 64 + cg8 + 4) = *(f32x4*)(dv + 4);
        ss += dppf<0xB1>(ss); ss += dppf<0x4E>(ss); ss += dppf<0x141>(ss);
        const float inv = 1.f / fmaxf(sqrtf(ss), 1e-12f);
#pragma unroll
        for (int e = 0; e < 8; ++e) {
            const float kk = kkr[e] * inv;
            o2[e] = kl[e] * (1.f + (av[e] - 1.f) * kac[e]); o3[e] = -kk; o4[e] = kk * av[e];
        }
        if (rq == 0) {
            float bs = 0.f;
#pragma unroll
            for (int e = 0; e < 8; ++e) bs += o1[e] * o2[e] * rkc[e];
            bs += dppf<0xB1>(bs); bs += dppf<0x4E>(bs); bs += dppf<0x141>(bs);
            if ((ptid & 7) == 0) P->bon[(size_t)(b * SEQL + c * 32 + tt) * 8 + h] = bs;
        }
        *(LAS f32x4*)(sK + tt * 64 + cg8) = *(f32x4*)o2; *(LAS f32x4*)(sK + tt * 64 + cg8 + 4) = *(f32x4*)(o2 + 4);
        *(LAS f32x4*)(sNK + tt * 64 + cg8) = *(f32x4*)o3; *(LAS f32x4*)(sNK + tt * 64 + cg8 + 4) = *(f32x4*)(o3 + 4);
        *(LAS f32x4*)(sB + tt * 64 + cg8) = *(f32x4*)o4; *(LAS f32x4*)(sB + tt * 64 + cg8 + 4) = *(f32x4*)(o4 + 4);
        *(LAS f32x2*)(sV + tt * 16 + c2) = (f32x2){rv2.x, rv2.y};
    };
    auto flush = [&](int c, ldsf buf) {
        const LAS f32x4* yp = (const LAS f32x4*)(buf + 10752 + (tt * 16 + c2) * 16);
        const f32x4 s0 = (yp[0] + yp[1]) + (yp[2] + yp[3]), s1 = (yp[4] + yp[5]) + (yp[6] + yp[7]);
        *(unsigned*)(P->proj + (size_t)(b * SEQL + c * 32 + tt) * LDP + C.rw + 1024 + h * 64 + rq * 16 + c2) = pack2((s0.x + s0.y) + (s0.z + s0.w), (s1.x + s1.y) + (s1.z + s1.w));
    };
    f32x2 S[2] = {{0.f, 0.f}, {0.f, 0.f}};
    if (producer) { issue(0); fill(0, lds); issue(1); }
    lds_barrier();
    for (int c = 0; c < 64; ++c) {
        const ldsf cur = lds + (c & 1) * BUF, nxt = lds + ((c + 1) & 1) * BUF;
        if (producer) {
            if (c + 1 < 64) fill(c + 1, nxt);
            if (c > 0) flush(c - 1, nxt);
            if (c + 2 < 64) issue(c + 2);
        } else {
            const ldsf sR = cur, sK = cur + 2048, sW = cur + 4096, sNK = cur + 6144, sB = cur + 8192, sV = cur + 10240, sYp = cur + 10752 + ri * 16 + (tid & 15);
            struct Vecs { f32x4 nk, w, b, k, r; float vi; };
            auto ldv = [&](int t) { Vecs v;
                v.nk = *(const LAS f32x4*)(sNK + t * 64 + js); v.w = *(const LAS f32x4*)(sW + t * 64 + js); v.b = *(const LAS f32x4*)(sB + t * 64 + js);
                v.k = *(const LAS f32x4*)(sK + t * 64 + js); v.r = *(const LAS f32x4*)(sR + t * 64 + js); v.vi = sV[t * 16 + ri]; return v; };
            Vecs cur_v = ldv(0), nx1 = ldv(1);
            for (int t16 = 0; t16 < 2; ++t16) {
#pragma unroll
                for (int u = 0; u < 16; ++u) {
                    const int t = t16 * 16 + u;
                    const Vecs nxt = ldv((t + 2) & 31);
                    f32x2 s2 = S[0] * cur_v.nk.xy; s2 = S[1] * cur_v.nk.zw + s2;
                    const float sa = reduce16(s2.x + s2.y);
                    const f32x2 sav = {sa, sa}, viv = {cur_v.vi, cur_v.vi};
                    f32x2 t0 = viv * cur_v.k.xy; t0 = sav * cur_v.b.xy + t0; S[0] = S[0] * cur_v.w.xy + t0;
                    f32x2 t1 = viv * cur_v.k.zw; t1 = sav * cur_v.b.zw + t1; S[1] = S[1] * cur_v.w.zw + t1;
                    f32x2 y2 = S[0] * cur_v.r.xy; y2 = S[1] * cur_v.r.zw + y2;
                    sYp[t * 256] = y2.x + y2.y;
                    cur_v = nx1; nx1 = nxt;
                }
            }
        }
        lds_barrier();
    }
    if (producer) flush(63, lds + BUF);
    __syncthreads();
}

__device__ __forceinline__ void mlstm_item(CP P, int l, int it, ldsf lds) {
    const Cols C = cols(l); const int tid = opaque_tid(), wave = tid >> 6, lane = tid & 63, li = lane & 15, kq = lane >> 4;
    const int b = it >> 4, h = (it >> 2) & 3, es = it & 3;
    constexpr int QS = 136, SS = 72;
    const ldsh Qb = (ldsh)lds, Kb = Qb + 64 * QS, Ktb = Kb + 64 * QS, Vtb = Ktb + 128 * SS, Vwtb = Vtb + 32 * SS, Attb = Vwtb + 32 * SS, Ctb = Attb + 64 * SS, nbb = Ctb + 2 * 32 * QS, wendb = nbb + 2 * 128;
    const ldsf sCum = (ldsf)(wendb + 64), sLi = sCum + 64, sWend = sLi + 64, sMl = sWend + 64, sWint = sMl + 64, sScal = sWint + 64;
    const float* cw = LP(P, l, I_ML_CW); const float* cb = LP(P, l, I_ML_CB);
    const float igb = LP(P, l, I_ML_IGB)[h], fgb = LP(P, l, I_ML_FGB)[h];
    for (int e = tid; e < 64 * SS / 2; e += 512) ((LAS unsigned*)Attb)[e] = 0u;
    for (int e = tid; e < (2 * 32 * QS + 2 * 128) / 2; e += 512) ((LAS unsigned*)Ctb)[e] = 0u;
    float m_prev = 0.f;
    f32x4 Cm[2], nm[2];
#pragma unroll
    for (int q = 0; q < 2; ++q) { Cm[q] = (f32x4){0.f, 0.f, 0.f, 0.f}; nm[q] = Cm[q]; }
    const int cgp = tid & 31, rseg = tid >> 5, isk = cgp >> 4, d0 = (cgp & 15) * 8, col0 = isk * 512 + h * 128 + d0;
    const ldsh cdst = isk ? Kb : Qb; const float cscale = isk ? 0.08838834764831845f : 1.f;
    const bf16x8 ones8 = {(short)0x3F80, (short)0x3F80, (short)0x3F80, (short)0x3F80, (short)0x3F80, (short)0x3F80, (short)0x3F80, (short)0x3F80};
    uint4 raw[7]; uint4 vraw = make_uint4(0u, 0u, 0u, 0u); bf16_t gi_bits = 0, gf_bits = 0;
    auto issue_loads = [&](int nn) {
#pragma unroll
        for (int i = 0; i < 7; ++i) {
            const int ts = nn * 64 + rseg * 4 - 3 + i;
            raw[i] = (ts >= 0) ? *(const uint4*)(P->proj + (size_t)(b * SEQL + ts) * LDP + C.mqk + col0) : make_uint4(0u, 0u, 0u, 0u);
        }
        if (tid < 256) vraw = *(const uint4*)(P->proj + (size_t)(b * SEQL + nn * 64 + (tid >> 2)) * LDP + C.mv + h * 128 + es * 32 + (tid & 3) * 8);
        if (wave == 0) { const bf16_t* gp = P->proj + (size_t)(b * SEQL + nn * 64 + lane) * LDP; gi_bits = gp[C.mi + h]; gf_bits = gp[C.mf + h]; }
    };
    bf16_t pend[4] = {0, 0, 0, 0};
    auto store_pend = [&](int nprev) {
        const int tl = wave >> 1, te = wave & 1;
#pragma unroll
        for (int j = 0; j < 4; ++j) P->proj[(size_t)(b * SEQL + nprev * 64 + tl * 16 + kq * 4 + j) * LDP + C.mv + h * 128 + es * 32 + te * 16 + li] = pend[j];
    };
    issue_loads(0);
    alignas(16) float wreg[4][8]; alignas(16) float breg[8];
    *(float4*)breg = *(const float4*)(cb + col0); *(float4*)(breg + 4) = *(const float4*)(cb + col0 + 4);
#pragma unroll
    for (int j = 0; j < 4; ++j) { *(float4*)wreg[j] = *(const float4*)(cw + j * 1024 + col0); *(float4*)(wreg[j] + 4) = *(const float4*)(cw + j * 1024 + col0 + 4); }
    __syncthreads();
    for (int n = 0; n < 32; ++n) {
        const int t0 = b * SEQL + n * 64, pb = n & 1;
        {
            float acc[4][8];
#pragma unroll
            for (int r = 0; r < 4; ++r)
#pragma unroll
                for (int e = 0; e < 8; ++e) acc[r][e] = breg[e];
#pragma unroll
            for (int i = 0; i < 7; ++i) {
                float f[8]; unpack8(raw[i], f);
#pragma unroll
                for (int r = 0; r < 4; ++r) { const int j = i - r; if (j >= 0 && j < 4) {
#pragma unroll
                    for (int e = 0; e < 8; ++e) acc[r][e] += wreg[j][e] * f[e]; } }
            }
#pragma unroll
            for (int r = 0; r < 4; ++r) {
#pragma unroll
                for (int e = 0; e < 8; ++e) acc[r][e] = siluf(acc[r][e]) * cscale;
                u32x4 o; o.x = pk2(acc[r][0], acc[r][1]); o.y = pk2(acc[r][2], acc[r][3]); o.z = pk2(acc[r][4], acc[r][5]); o.w = pk2(acc[r][6], acc[r][7]);
                *(LAS u32x4*)(cdst + (rseg * 4 + r) * QS + d0) = o;
            }
            if (isk) {
#pragma unroll
                for (int e = 0; e < 8; ++e) { u32x2 o; o.x = pk2(acc[0][e], acc[1][e]); o.y = pk2(acc[2][e], acc[3][e]); *(LAS u32x2*)(Ktb + (d0 + e) * SS + rseg * 4) = o; }
            }
            if (tid < 256) {
                const LAS bf16_t* vs = (const LAS bf16_t*)0; (void)vs;
                const unsigned w4[4] = {vraw.x, vraw.y, vraw.z, vraw.w};
#pragma unroll
                for (int e = 0; e < 8; ++e) Vtb[((tid & 3) * 8 + e) * SS + (tid >> 2)] = (bf16_t)((e & 1) ? (w4[e >> 1] >> 16) : (w4[e >> 1] & 0xffffu));
            }
        }
        if (wave == 0) {
            const int s = lane;
            const float lgi = bf2f(gi_bits) + igb;
            const float lf = logsigmoidf(bf2f(gf_bits) + fgb);
            const float cum = scan_add64(lf, lane);
            const float last = rdlane(cum, 63);
            const float g = last - cum + lgi; const float gmax = rdlane(scan_max64(g, lane), 63);
            const float pm = scan_max64(lgi - cum, lane);
            const float minter = cum + m_prev; const float ml = fmaxf(minter, cum + pm);
            const float we = __expf(g - gmax);
            sCum[s] = cum; sLi[s] = lgi; sWend[s] = we; wendb[s] = f2bf(we); sMl[s] = ml; sWint[s] = __expf(minter - ml);
            if (lane == 0) { sScal[0] = last; sScal[1] = gmax; }
        }
        if (n > 0) store_pend(n - 1);
        if (n + 1 < 32) issue_loads(n + 1);
        lds_barrier();
        if (tid < 256) {
            const int e = tid >> 3, sg = (tid & 7) * 8;
            float f[8]; unpack8v(*(const LAS u32x4*)(Vtb + e * SS + sg), f);
            u32x4 o; o.x = pk2(f[0] * sWend[sg], f[1] * sWend[sg + 1]); o.y = pk2(f[2] * sWend[sg + 2], f[3] * sWend[sg + 3]);
            o.z = pk2(f[4] * sWend[sg + 4], f[5] * sWend[sg + 5]); o.w = pk2(f[6] * sWend[sg + 6], f[7] * sWend[sg + 7]);
            *(LAS u32x4*)(Vwtb + e * SS + sg) = o;
        }
        for (int idx = wave; idx < 10; idx += 8) {
            int tl, ts; tri_tile(idx, tl, ts);
            const f32x4 a = mmb(128, Qb + tl * 16 * QS, QS, Kb + ts * 16 * QS, QS, (f32x4){0.f, 0.f, 0.f, 0.f}, li, kq);
#pragma unroll
            for (int j = 0; j < 4; ++j) {
                const int lr = tl * 16 + kq * 4 + j, sc = ts * 16 + li;
                Attb[lr * SS + sc] = f2bf((sc <= lr) ? a[j] * __expf(sCum[lr] - sCum[sc] + sLi[sc] - sMl[lr]) : 0.f);
            }
        }
        lds_barrier();
        {
            const int tl = wave >> 1, te = wave & 1;
            f32x4 a1 = {0.f, 0.f, 0.f, 0.f}, ad = a1, a2 = a1, aq = a1;
            {
                const LAS bf16_t* pa = Attb + (tl * 16 + li) * SS + kq * 8; const LAS bf16_t* pv = Vtb + (te * 16 + li) * SS + kq * 8;
#pragma unroll
                for (int k0 = 0; k0 < 64; k0 += 32) { const bf16x8 av = *(const LAS bf16x8*)(pa + k0);
                    a1 = __builtin_amdgcn_mfma_f32_16x16x32_bf16(av, *(const LAS bf16x8*)(pv + k0), a1, 0, 0, 0); ad = __builtin_amdgcn_mfma_f32_16x16x32_bf16(av, ones8, ad, 0, 0, 0); }
                const LAS bf16_t* pq = Qb + (tl * 16 + li) * QS + kq * 8; const LAS bf16_t* pc = Ctb + pb * 32 * QS + (te * 16 + li) * QS + kq * 8; const LAS bf16_t* pn = nbb + pb * 128 + kq * 8;
#pragma unroll
                for (int k0 = 0; k0 < 128; k0 += 32) { const bf16x8 av = *(const LAS bf16x8*)(pq + k0);
                    a2 = __builtin_amdgcn_mfma_f32_16x16x32_bf16(av, *(const LAS bf16x8*)(pc + k0), a2, 0, 0, 0); aq = __builtin_amdgcn_mfma_f32_16x16x32_bf16(av, *(const LAS bf16x8*)(pn + k0), aq, 0, 0, 0); }
            }
#pragma unroll
            for (int j = 0; j < 4; ++j) {
                const int lr = tl * 16 + kq * 4 + j, e = te * 16 + li;
                const float wi = sWint[lr];
                const float den = fmaxf(fabsf(ad[j] + wi * aq[j]), __expf(-sMl[lr]));
                const float hv = (a1[j] + wi * a2[j]) / den;
                pend[j] = f2bf(hv);
            }
            const float last = sScal[0], gmax = sScal[1];
            const float m_new = fmaxf(last + m_prev, gmax), a_old = __expf(last + m_prev - m_new), a_new = __expf(gmax - m_new);
#pragma unroll
            for (int q = 0; q < 2; ++q) {
                const int tile = wave + q * 8, td = tile >> 1, te2 = tile & 1;
                const LAS bf16_t* pk = Ktb + (td * 16 + li) * SS + kq * 8; const LAS bf16_t* pv = Vwtb + (te2 * 16 + li) * SS + kq * 8; const LAS bf16_t* pw = wendb + kq * 8;
                f32x4 a = {0.f, 0.f, 0.f, 0.f}, an = a;
#pragma unroll
                for (int k0 = 0; k0 < 64; k0 += 32) { const bf16x8 av = *(const LAS bf16x8*)(pk + k0);
                    a = __builtin_amdgcn_mfma_f32_16x16x32_bf16(av, *(const LAS bf16x8*)(pv + k0), a, 0, 0, 0);
                    if (te2 == 0) an = __builtin_amdgcn_mfma_f32_16x16x32_bf16(av, *(const LAS bf16x8*)(pw + k0), an, 0, 0, 0); }
                Cm[q] = Cm[q] * a_old + a * a_new;
                u32x2 o; o.x = pk2(Cm[q][0], Cm[q][1]); o.y = pk2(Cm[q][2], Cm[q][3]);
                *(LAS u32x2*)(Ctb + (pb ^ 1) * 32 * QS + (te2 * 16 + li) * QS + td * 16 + kq * 4) = o;
                if (te2 == 0) {
                    nm[q] = nm[q] * a_old + an * a_new;
                    if (li == 0) { u32x2 o2; o2.x = pk2(nm[q][0], nm[q][1]); o2.y = pk2(nm[q][2], nm[q][3]); *(LAS u32x2*)(nbb + (pb ^ 1) * 128 + td * 16 + kq * 4) = o2; }
                }
            }
            m_prev = m_new;
        }
        lds_barrier();
    }
    store_pend(31);
}

__device__ __forceinline__ void ssd_item(CP P, int l, int it, ldsf lds) {
    const Cols C = cols(l); const int tid = opaque_tid(), wave = tid >> 6, lane = tid & 63, li = lane & 15, kq = lane >> 4;
    const int b = it >> 3, hh = it & 7, g = hh >> 2;
    constexpr int QS = 136, SS = 72;
    const ldsh Cmb = (ldsh)lds, Bmb = Cmb + 64 * QS, Bmtb = Bmb + 64 * QS, Lcb = Bmtb + 128 * SS, Xdtt = Lcb + 64 * SS, Xett = Xdtt + 64 * SS, Sb = Xett + 64 * SS;
    const ldsf sXr = (ldsf)(Sb + 2 * 64 * QS), sX = sXr + 67 * 64, sCum = sX + 64 * 65, sDt = sCum + 64, sE = sDt + 64, sEc = sE + 64, sScal = sEc + 64;
    const float* cw = LP(P, l, I_SSD_CW); const float* cb = LP(P, l, I_SSD_CB);
    const float Aneg = -expf(LP(P, l, I_SSD_ALOG)[hh]), dtb = LP(P, l, I_SSD_DTB)[hh], dsk = LP(P, l, I_SSD_D)[hh];
    for (int e = tid; e < 64 * SS / 2; e += 512) ((LAS unsigned*)Lcb)[e] = 0u;
    for (int e = tid; e < 2 * 64 * QS / 2; e += 512) ((LAS unsigned*)Sb)[e] = 0u;
    float hv = 0.f;
    f32x4 Sm[4];
#pragma unroll
    for (int q = 0; q < 4; ++q) Sm[q] = (f32x4){0.f, 0.f, 0.f, 0.f};
    const int cgp = tid & 31, rseg = tid >> 5, isc = cgp >> 4, n0 = (cgp & 15) * 8, col0 = 512 + isc * 256 + g * 128 + n0;
    const ldsh cdst = isc ? Cmb : Bmb;
    const int xcol = hh * 64 + (tid & 63);
    const float cb0 = cb[xcol], w0 = cw[xcol], w1 = cw[1024 + xcol], w2 = cw[2048 + xcol], w3 = cw[3072 + xcol];
    uint4 raw[7]; uint4 xraw = make_uint4(0u, 0u, 0u, 0u); bf16_t dt_bits = 0;
    auto issue_loads = [&](int nn) {
#pragma unroll
        for (int i = 0; i < 7; ++i) {
            const int ts = nn * 64 + rseg * 4 - 3 + i;
            raw[i] = (ts >= 0) ? *(const uint4*)(P->proj + (size_t)(b * SEQL + ts) * LDP + C.sx + col0) : make_uint4(0u, 0u, 0u, 0u);
        }
        xraw = *(const uint4*)(P->proj + (size_t)(b * SEQL + nn * 64 + (tid >> 3)) * LDP + C.sx + hh * 64 + (tid & 7) * 8);
        if (wave == 0) dt_bits = P->proj[(size_t)(b * SEQL + nn * 64 + lane) * LDP + C.sdt + hh];
    };
    bf16_t pend[2][4] = {{0, 0, 0, 0}, {0, 0, 0, 0}};
    auto store_pend = [&](int nprev) {
#pragma unroll
        for (int q = 0; q < 2; ++q) { const int tile = wave + q * 8, tl = tile >> 2, tp = tile & 3;
#pragma unroll
            for (int j = 0; j < 4; ++j) P->proj[(size_t)(b * SEQL + nprev * 64 + tl * 16 + kq * 4 + j) * LDP + C.sx + hh * 64 + tp * 16 + li] = pend[q][j]; }
    };
    issue_loads(0);
    alignas(16) float wreg[4][8]; alignas(16) float breg[8];
    *(float4*)breg = *(const float4*)(cb + col0); *(float4*)(breg + 4) = *(const float4*)(cb + col0 + 4);
#pragma unroll
    for (int j = 0; j < 4; ++j) { *(float4*)wreg[j] = *(const float4*)(cw + j * 1024 + col0); *(float4*)(wreg[j] + 4) = *(const float4*)(cw + j * 1024 + col0 + 4); }
    __syncthreads();
    for (int n = 0; n < 32; ++n) {
        const int t0 = b * SEQL + n * 64, pb = n & 1;
        if (tid < 192) sXr[tid] = hv;
        {
            float acc[4][8];
#pragma unroll
            for (int r = 0; r < 4; ++r)
#pragma unroll
                for (int e = 0; e < 8; ++e) acc[r][e] = breg[e];
#pragma unroll
            for (int i = 0; i < 7; ++i) {
                float f[8]; unpack8(raw[i], f);
#pragma unroll
                for (int r = 0; r < 4; ++r) { const int j = i - r; if (j >= 0 && j < 4) {
#pragma unroll
                    for (int e = 0; e < 8; ++e) acc[r][e] += wreg[j][e] * f[e]; } }
            }
#pragma unroll
            for (int r = 0; r < 4; ++r) {
#pragma unroll
                for (int e = 0; e < 8; ++e) acc[r][e] = siluf(acc[r][e]);
                u32x4 o; o.x = pk2(acc[r][0], acc[r][1]); o.y = pk2(acc[r][2], acc[r][3]); o.z = pk2(acc[r][4], acc[r][5]); o.w = pk2(acc[r][6], acc[r][7]);
                *(LAS u32x4*)(cdst + (rseg * 4 + r) * QS + n0) = o;
            }
            if (!isc) {
#pragma unroll
                for (int e = 0; e < 8; ++e) { u32x2 o; o.x = pk2(acc[0][e], acc[1][e]); o.y = pk2(acc[2][e], acc[3][e]); *(LAS u32x2*)(Bmtb + (n0 + e) * SS + rseg * 4) = o; }
            }
            { float f[8]; unpack8(xraw, f);
#pragma unroll
                for (int e = 0; e < 8; ++e) sXr[((tid >> 3) + 3) * 64 + (tid & 7) * 8 + e] = f[e]; }
        }
        if (wave == 0) {
            const float dt = softplusf(bf2f(dt_bits) + dtb);
            const float cum = scan_add64(dt * Aneg, lane);
            const float last = rdlane(cum, 63);
            sDt[lane] = dt; sCum[lane] = cum; sE[lane] = __expf(last - cum); sEc[lane] = __expf(cum);
            if (lane == 0) sScal[0] = __expf(last);
        }
        if (n > 0) store_pend(n - 1);
        if (n + 1 < 32) issue_loads(n + 1);
        lds_barrier();
        {
            const int p = tid & 63, mseg = tid >> 6;
            float xr[11];
#pragma unroll
            for (int i = 0; i < 11; ++i) xr[i] = sXr[(mseg * 8 + i) * 64 + p];
            float xd[8], xe[8];
#pragma unroll
            for (int r = 0; r < 8; ++r) {
                const int mm = mseg * 8 + r;
                const float x = siluf(cb0 + w0 * xr[r] + w1 * xr[r + 1] + w2 * xr[r + 2] + w3 * xr[r + 3]);
                sX[mm * 65 + p] = x; xd[r] = x * sDt[mm]; xe[r] = xd[r] * sE[mm];
            }
            u32x4 o; o.x = pk2(xd[0], xd[1]); o.y = pk2(xd[2], xd[3]); o.z = pk2(xd[4], xd[5]); o.w = pk2(xd[6], xd[7]); *(LAS u32x4*)(Xdtt + p * SS + mseg * 8) = o;
            o.x = pk2(xe[0], xe[1]); o.y = pk2(xe[2], xe[3]); o.z = pk2(xe[4], xe[5]); o.w = pk2(xe[6], xe[7]); *(LAS u32x4*)(Xett + p * SS + mseg * 8) = o;
        }
        for (int idx = wave; idx < 10; idx += 8) {
            int tl, ts; tri_tile(idx, tl, ts);
            const f32x4 a = mmb(128, Cmb + tl * 16 * QS, QS, Bmb + ts * 16 * QS, QS, (f32x4){0.f, 0.f, 0.f, 0.f}, li, kq);
#pragma unroll
            for (int j = 0; j < 4; ++j) {
                const int lr = tl * 16 + kq * 4 + j, sc = ts * 16 + li;
                Lcb[lr * SS + sc] = f2bf((sc <= lr) ? a[j] * __expf(sCum[lr] - sCum[sc]) : 0.f);
            }
        }
        lds_barrier();
        {
            const f32x4 z4 = {0.f, 0.f, 0.f, 0.f};
#pragma unroll
            for (int q = 0; q < 2; ++q) {
                const int tile = wave + q * 8, tl = tile >> 2, tp = tile & 3;
                const f32x4 a1 = mmb(64, Lcb + tl * 16 * SS, SS, Xdtt + tp * 16 * SS, SS, z4, li, kq);
                const f32x4 a2 = mmb(128, Cmb + tl * 16 * QS, QS, Sb + pb * 64 * QS + tp * 16 * QS, QS, z4, li, kq);
#pragma unroll
                for (int j = 0; j < 4; ++j) {
                    const int lr = tl * 16 + kq * 4 + j, p = tp * 16 + li;
                    const float y = a1[j] + sEc[lr] * a2[j] + dsk * sX[lr * 65 + p];
                    pend[q][j] = f2bf(y);
                }
            }
            const float elast = sScal[0];
#pragma unroll
            for (int q = 0; q < 4; ++q) {
                const int tile = wave + q * 8, tp2 = tile & 3, tn = tile >> 2;
                const f32x4 a = mmb(64, Xett + tp2 * 16 * SS, SS, Bmtb + tn * 16 * SS, SS, z4, li, kq);
                Sm[q] = Sm[q] * elast + a;
#pragma unroll
                for (int j = 0; j < 4; ++j) Sb[(pb ^ 1) * 64 * QS + (tp2 * 16 + kq * 4 + j) * QS + tn * 16 + li] = f2bf(Sm[q][j]);
            }
            if (tid < 192) hv = sXr[64 * 64 + tid];
        }
        lds_barrier();
    }
    store_pend(31);
}

__device__ __forceinline__ void gla_item(CP P, int l, int it, ldsf lds) {
    const int tid = opaque_tid(), wave = tid >> 6, lane = tid & 63, li = lane & 15, kq = lane >> 4;
    const int b = it >> 3, h = (it >> 1) & 3, vs = it & 1;
    constexpr int SS = 72;
    const ldsh Qgb = (ldsh)lds, Kgb = Qgb + 64 * SS, Kgtb = Kgb + 64 * SS, Vtb = Kgtb + 64 * SS, Attb = Vtb + 64 * SS, Stb = Attb + 64 * SS;
    const ldsf sQ = (ldsf)(Stb + 2 * 64 * SS), sK = sQ + 64 * 65, sCum = sK + 64 * 65, sGl = sCum + 64 * 65, sW2 = sGl + 64 * 17, sGb = sW2 + 16 * 64, sSeg = sGb + 64, sDec = sSeg + 8 * 64;
    const float* gw2 = LP(P, l, I_GK_W2); const float* gb = LP(P, l, I_GK_B);
    for (int e = tid; e < 16 * 64; e += 512) sW2[e] = gw2[(e >> 6) * 256 + h * 64 + (e & 63)];
    if (tid < 64) sGb[tid] = gb[h * 64 + tid];
    for (int e = tid; e < 64 * SS / 2; e += 512) ((LAS unsigned*)Attb)[e] = 0u;
    for (int e = tid; e < 2 * 64 * SS / 2; e += 512) ((LAS unsigned*)Stb)[e] = 0u;
    f32x4 Sm[2] = {{0.f, 0.f, 0.f, 0.f}, {0.f, 0.f, 0.f, 0.f}};
    uint4 qraw, kraw, xr, gr = make_uint4(0u, 0u, 0u, 0u);
    auto issue_loads = [&](int nn) {
        const int row = tid >> 3, cg = (tid & 7) * 8; const bf16_t* pr = P->proj + (size_t)(b * SEQL + nn * 64 + row) * LDP + h * 64 + cg;
        qraw = *(const uint4*)(pr + C_GQ); kraw = *(const uint4*)(pr + C_GK);
        xr = *(const uint4*)(P->proj + (size_t)(b * SEQL + nn * 64 + row) * LDP + C_GV + h * 128 + vs * 64 + cg);
        if (tid < 128) gr = *(const uint4*)(P->proj + (size_t)(b * SEQL + nn * 64 + (tid >> 1)) * LDP + C_GGK + (tid & 1) * 8);
    };
    bf16_t pend[2][4] = {{0, 0, 0, 0}, {0, 0, 0, 0}};
    auto store_pend = [&](int nprev) {
#pragma unroll
        for (int q = 0; q < 2; ++q) { const int tile = wave + q * 8, tl = tile >> 2, tv = tile & 3;
#pragma unroll
            for (int j = 0; j < 4; ++j) P->proj[(size_t)(b * SEQL + nprev * 64 + tl * 16 + kq * 4 + j) * LDP + C_GV + h * 128 + vs * 64 + tv * 16 + li] = pend[q][j]; }
    };
    issue_loads(0);
    __syncthreads();
    for (int n = 0; n < 32; ++n) {
        const int t0 = b * SEQL + n * 64, pb = n & 1;
        {
            const int row = tid >> 3, cg = (tid & 7) * 8;
            float f[8]; unpack8(qraw, f);
#pragma unroll
            for (int e = 0; e < 8; ++e) sQ[row * 65 + cg + e] = f[e] * 0.125f;
            unpack8(kraw, f);
#pragma unroll
            for (int e = 0; e < 8; ++e) sK[row * 65 + cg + e] = f[e];
            {
                const unsigned w4[4] = {xr.x, xr.y, xr.z, xr.w};
#pragma unroll
                for (int e = 0; e < 8; ++e) Vtb[(cg + e) * SS + row] = (bf16_t)((e & 1) ? (w4[e >> 1] >> 16) : (w4[e >> 1] & 0xffffu));
            }
            if (tid < 128) {
                unpack8(gr, f);
#pragma unroll
                for (int e = 0; e < 8; ++e) sGl[(tid >> 1) * 17 + (tid & 1) * 8 + e] = f[e];
            }
        }
        if (n > 0) store_pend(n - 1);
        if (n + 1 < 32) issue_loads(n + 1);
        lds_barrier();
        for (int e = tid; e < 4096; e += 512) {
            const int s = e >> 6, d = e & 63; float gk = sGb[d];
#pragma unroll
            for (int r = 0; r < 16; ++r) gk += sGl[s * 17 + r] * sW2[r * 64 + d];
            sCum[s * 65 + d] = logsigmoid_fast(gk) * 0.0625f;
        }
        lds_barrier();
        const int d = tid & 63, seg = tid >> 6;
        {
            float run = 0.f;
#pragma unroll
            for (int r = 0; r < 8; ++r) { run += sCum[(seg * 8 + r) * 65 + d]; sCum[(seg * 8 + r) * 65 + d] = run; }
            sSeg[seg * 64 + d] = run;
        }
        lds_barrier();
        {
            float off = 0.f;
            for (int s2 = 0; s2 < seg; ++s2) off += sSeg[s2 * 64 + d];
            float kg[8];
#pragma unroll
            for (int r = 0; r < 8; ++r) {
                const int s = seg * 8 + r; const float c = sCum[s * 65 + d] + off;
                const float ec = __expf(c);
                Qgb[s * SS + d] = f2bf(sQ[s * 65 + d] * ec);
                kg[r] = sK[s * 65 + d] * __expf(-c);
                Kgb[s * SS + d] = f2bf(kg[r]);
                if (s == 63) sDec[d] = ec;
            }
            u32x4 o; o.x = pk2(kg[0], kg[1]); o.y = pk2(kg[2], kg[3]); o.z = pk2(kg[4], kg[5]); o.w = pk2(kg[6], kg[7]);
            *(LAS u32x4*)(Kgtb + d * SS + seg * 8) = o;
        }
        lds_barrier();
        for (int idx = wave; idx < 10; idx += 8) {
            int tl, ts; tri_tile(idx, tl, ts);
            const f32x4 a = mmb(64, Qgb + tl * 16 * SS, SS, Kgb + ts * 16 * SS, SS, (f32x4){0.f, 0.f, 0.f, 0.f}, li, kq);
#pragma unroll
            for (int j = 0; j < 4; ++j) { const int lr = tl * 16 + kq * 4 + j, sc = ts * 16 + li; Attb[lr * SS + sc] = f2bf((sc <= lr) ? a[j] : 0.f); }
        }
        lds_barrier();
        {
            const f32x4 z4 = {0.f, 0.f, 0.f, 0.f};
#pragma unroll
            for (int q = 0; q < 2; ++q) {
                const int tile = wave + q * 8, tl = tile >> 2, tv = tile & 3;
                f32x4 a = mmb(64, Attb + tl * 16 * SS, SS, Vtb + tv * 16 * SS, SS, z4, li, kq);
                a = mmb(64, Qgb + tl * 16 * SS, SS, Stb + pb * 64 * SS + tv * 16 * SS, SS, a, li, kq);
#pragma unroll
                for (int j = 0; j < 4; ++j) pend[q][j] = f2bf(a[j]);
            }
#pragma unroll
            for (int q = 0; q < 2; ++q) {
                const int tile = wave + q * 8, td = tile >> 2, tv = tile & 3;
                const f32x4 u = mmb(64, Kgtb + td * 16 * SS, SS, Vtb + tv * 16 * SS, SS, z4, li, kq);
#pragma unroll
                for (int j = 0; j < 4; ++j) Sm[q][j] = sDec[td * 16 + kq * 4 + j] * (Sm[q][j] + u[j]);
                u32x2 o; o.x = pk2(Sm[q][0], Sm[q][1]); o.y = pk2(Sm[q][2], Sm[q][3]);
                *(LAS u32x2*)(Stb + (pb ^ 1) * 64 * SS + (tv * 16 + li) * SS + td * 16 + kq * 4) = o;
            }
        }
        lds_barrier();
    }
    store_pend(31);
}

#ifndef ITEM_MASK
#define ITEM_MASK 15
#endif
template <int IM = ITEM_MASK> __device__ __forceinline__ void scan_phase(CP P, int l, ldsf lds) {
    for (int it = blockIdx.x; it < N_ITEMS; it += gridDim.x) {
        if (it < N_RW) { if (IM & 1) rwkv_scan_item(P, l, it, lds); }
        else if (it < N_RW + 64) { if (IM & 2) mlstm_item(P, l, it - N_RW, lds); }
        else if (it < N_RW + 96) { if (IM & 4) ssd_item(P, l, it - N_RW - 64, lds); }
        else { if (IM & 8) gla_item(P, l, it - N_RW - 96, lds); }
        __syncthreads();
    }
}

__device__ __forceinline__ void finalize_phase(CP P, int l) {
    const Cols C = cols(l); const int wave = threadIdx.x >> 6, lane = threadIdx.x & 63, c8 = lane * 8;
    const float* gla_g = LP(P, l, I_GLA_NG); const float* mu = LP(P, l, I_RW_MU); const float* k_a = LP(P, l, I_RW_KA); const float* r_k = LP(P, l, I_RW_RK);
    const float* ln_g = LP(P, l, I_RW_LNG); const float* ln_b = LP(P, l, I_RW_LNB); const float* ssd_g = LP(P, l, I_SSD_NG); const float* ml_g = LP(P, l, I_ML_NG);
    for (int t = blockIdx.x * 8 + wave; t < M_TOK; t += gridDim.x * 8) {
        const bf16_t* pr = P->proj + (size_t)t * LDP; bf16_t* yo = P->actA + (size_t)t * DM;
        float a[8], z[8], y[8];
        {
            load8(pr + C_GV + c8, a); load8(pr + C_GZ + c8, z);
            float ss = 0.f;
#pragma unroll
            for (int e = 0; e < 8; ++e) ss += a[e] * a[e];
            ss += __shfl_xor(ss, 1); ss += __shfl_xor(ss, 2); ss += __shfl_xor(ss, 4); ss += __shfl_xor(ss, 8);
            const float rstd = rsqrtf(ss * (1.f / 128.f) + 1e-6f);
#pragma unroll
            for (int e = 0; e < 8; ++e) y[e] = a[e] * rstd * gla_g[c8 + e] * siluf(z[e]);
            store8(yo + c8, y);
        }
        {
            load8(pr + C.rw + 1024 + c8, a); load8(pr + C.rwz + c8, z);
            float s = 0.f;
#pragma unroll
            for (int e = 0; e < 8; ++e) s += a[e];
            s += __shfl_xor(s, 1); s += __shfl_xor(s, 2); s += __shfl_xor(s, 4);
            const float mean = s * (1.f / 64.f); float vs = 0.f;
#pragma unroll
            for (int e = 0; e < 8; ++e) { a[e] -= mean; vs += a[e] * a[e]; }
            vs += __shfl_xor(vs, 1); vs += __shfl_xor(vs, 2); vs += __shfl_xor(vs, 4);
            const float rstd = rsqrtf(vs * (1.f / 64.f) + 64e-5f);
            alignas(16) float vv[8];
            *(float4*)vv = *(const float4*)(P->rwV + (size_t)t * 512 + c8); *(float4*)(vv + 4) = *(const float4*)(P->rwV + (size_t)t * 512 + c8 + 4);
            const float bs = P->bon[(size_t)t * 8 + (lane >> 3)];
#pragma unroll
            for (int e = 0; e < 8; ++e) y[e] = (a[e] * rstd * ln_g[c8 + e] + ln_b[c8 + e] + bs * vv[e]) * siluf(z[e]);
            store8(yo + 512 + c8, y);
        }
        {
            load8(pr + C.sx + c8, a); load8(pr + C.sz + c8, z);
            float ss = 0.f;
#pragma unroll
            for (int e = 0; e < 8; ++e) { a[e] *= siluf(z[e]); ss += a[e] * a[e]; }
            ss = wave_sum(ss);
            const float rstd = rsqrtf(ss * (1.f / 512.f) + 1e-6f);
#pragma unroll
            for (int e = 0; e < 8; ++e) y[e] = a[e] * rstd * ssd_g[c8 + e];
            store8(yo + 1024 + c8, y);
        }
        {
            float o[8];
            load8(pr + C.mv + c8, a); load8(pr + C.mo + c8, o); load8(pr + C.mz + c8, z);
            float s = 0.f;
#pragma unroll
            for (int e = 0; e < 8; ++e) { a[e] *= sigmoidf_(o[e]); s += a[e]; }
            s += __shfl_xor(s, 1); s += __shfl_xor(s, 2); s += __shfl_xor(s, 4); s += __shfl_xor(s, 8);
            const float mean = s * (1.f / 128.f); float vs = 0.f;
#pragma unroll
            for (int e = 0; e < 8; ++e) { a[e] -= mean; vs += a[e] * a[e]; }
            vs += __shfl_xor(vs, 1); vs += __shfl_xor(vs, 2); vs += __shfl_xor(vs, 4); vs += __shfl_xor(vs, 8);
            const float rstd = rsqrtf(vs * (1.f / 128.f) + 1e-6f);
#pragma unroll
            for (int e = 0; e < 8; ++e) y[e] = a[e] * rstd * ml_g[c8 + e] * siluf(z[e]);
            store8(yo + 1536 + c8, y);
        }
    }
}

__device__ __forceinline__ void final_norm(CP P) {
    const int wave = threadIdx.x >> 6, lane = threadIdx.x & 63; const float* g = P->in[57];
    for (int row = blockIdx.x * 8 + wave; row < M_TOK; row += gridDim.x * 8) {
        float s = (lane < XSSN) ? P->xss2[(size_t)row * XSSN + lane] : 0.f; s = wave_sum(s);
        const float rstd = rsqrtf(s * (1.f / DM) + 1e-6f);
        float4* xr = (float4*)(P->out + (size_t)row * DM); const float4* gr = (const float4*)g;
#pragma unroll
        for (int i = 0; i < 8; ++i) { float4 v = xr[lane + i * 64]; const float4 gg = gr[lane + i * 64]; v.x *= rstd * gg.x; v.y *= rstd * gg.y; v.z *= rstd * gg.z; v.w *= rstd * gg.w; xr[lane + i * 64] = v; }
    }
}

#define XB_TMO      128
#define XB_XCNT(j)  (256  + 64 * (j))
#define XB_XSUB(j)  (1280 + 64 * (j))
#define XB_XGEN(j)  (2304 + 64 * (j))
#define XB_TOP      3328
#define XB_TOPGEN   3392
#define XCD_BAR_WORDS 3456
#define XB_SPIN_CAP (1u << 18)

__device__ __forceinline__ unsigned xb_ld(unsigned* p)              { return __hip_atomic_load(p, __ATOMIC_RELAXED, __HIP_MEMORY_SCOPE_AGENT); }
__device__ __forceinline__ unsigned xb_add(unsigned* p, unsigned v) { return __hip_atomic_fetch_add(p, v, __ATOMIC_RELAXED, __HIP_MEMORY_SCOPE_AGENT); }
__device__ __forceinline__ unsigned xb_xcc_id() { return (unsigned)__builtin_amdgcn_s_getreg((3 << 11) | 20) & 0xFu; }
#define XB_SPIN(cond, bar) do { unsigned _sp = 0; while (cond) { __builtin_amdgcn_s_sleep(1); \
    if ((++_sp & 255u) == 0u) { if (xb_ld(&(bar)[XB_TMO])) break; if (_sp > XB_SPIN_CAP) { atomicAdd(&(bar)[XB_TMO], 1u); break; } } } } while (0)

struct XcdBarrier {
    unsigned* bar; unsigned x;
    volatile LAS unsigned* st;
};

__device__ __forceinline__ XcdBarrier xcd_barrier_post(unsigned* bar, volatile LAS unsigned* st) {
    XcdBarrier b; b.bar = bar; b.x = xb_xcc_id(); b.st = st;
    if (threadIdx.x == 0) (void)xb_add(&bar[XB_XCNT(b.x)], 1u);
    return b;
}
__device__ __forceinline__ void xcd_barrier_complete(unsigned* bar, unsigned x, unsigned& nloc, unsigned& nx) {
    const unsigned G = gridDim.x * gridDim.y * gridDim.z;
    unsigned sum, cnt, mine, sp = 0u;
    for (;;) {
        sum = 0u; cnt = 0u; mine = 0u;
#pragma unroll
        for (unsigned j = 0; j < 16; ++j) { const unsigned c = xb_ld(&bar[XB_XCNT(j)]); sum += c; cnt += (c > 0u) ? 1u : 0u; mine = (j == x) ? c : mine; }
        if (sum == G) break;
        __builtin_amdgcn_s_sleep(1);
        if ((++sp & 255u) == 0u) { if (xb_ld(&bar[XB_TMO])) break; if (sp > XB_SPIN_CAP) { atomicAdd(&bar[XB_TMO], 1u); break; } }
    }
    nloc = mine > 0u ? mine : 1u; nx = cnt > 0u ? cnt : 1u;
}

__device__ __forceinline__ void xcd_barrier(const XcdBarrier& b) {
    asm volatile("s_waitcnt vmcnt(0)" ::: "memory");
    __syncthreads();
    if (threadIdx.x == 0) {
        unsigned* bar = b.bar;
        __builtin_amdgcn_s_waitcnt(0);
        unsigned nloc = b.st[0], nx = b.st[1];
        if (nloc == 0u) { xcd_barrier_complete(bar, b.x, nloc, nx); b.st[0] = nloc; b.st[1] = nx; }
        const unsigned old = xb_add(&bar[XB_XSUB(b.x)], 1u);
        const unsigned gen = old / nloc;
        if (old + 1u == (gen + 1u) * nloc) {
            __builtin_amdgcn_fence(__ATOMIC_RELEASE, "agent");
            asm volatile("s_waitcnt vmcnt(0)" ::: "memory");
            const unsigned og = xb_add(&bar[XB_TOP], 1u);
            const unsigned tg = og / nx;
            if (og + 1u == (tg + 1u) * nx) xb_add(&bar[XB_TOPGEN], 1u);
            else XB_SPIN(xb_ld(&bar[XB_TOPGEN]) == tg, bar);
            __builtin_amdgcn_fence(__ATOMIC_ACQUIRE, "agent");
            xb_add(&bar[XB_XGEN(b.x)], 1u);
            asm volatile("s_waitcnt vmcnt(0)" ::: "memory");
        } else {
            XB_SPIN(xb_ld(&bar[XB_XGEN(b.x)]) == gen, bar);
            __builtin_amdgcn_fence(__ATOMIC_ACQUIRE, "agent");
            asm volatile("s_waitcnt vmcnt(0)" ::: "memory");
        }
    }
    __syncthreads();
}


template <bool PRE> __device__ __forceinline__ void gemm_inproj(CP P, const bf16_t* A, const float* xss, PG8_LAS unsigned char* lds) {
    pg8::Gemm g; g.A = A; g.Bt = P->Wi; g.M = M_TOK; g.N = LDP; g.K = DM;
    pg8::StaticOrder S; S.init(g.M, g.N, (int)gridDim.x, (int)blockIdx.x);
    EpiProj<PRE> E; E.O = P->proj; E.xss = xss;
    pg8::gemm_phase<EpiProj<PRE>, pg8::StaticOrder, false>(lds, g, S, E, nullptr);
}
__device__ __forceinline__ void gemm_outproj(CP P, const bf16_t* Wo, const float* xin, bf16_t* xb, float* xss, PG8_LAS unsigned char* lds) {
    pg8::Gemm g; g.A = P->actA; g.Bt = Wo; g.M = M_TOK; g.N = DM; g.K = DM;
    pg8::StaticOrder S; S.init(g.M, g.N, (int)gridDim.x, (int)blockIdx.x);
    EpiOut E; E.xin = xin; E.xout = P->out; E.xb = xb; E.xss = xss;
    pg8::gemm_phase<EpiOut, pg8::StaticOrder, false>(lds, g, S, E, nullptr);
}

#ifndef PROBE_DUP
#define PROBE_DUP 0
#endif
#ifndef PH_MASK
#define PH_MASK 0xFFF
#endif
#define RUN_PHASE(k, body) do { if ((PH_MASK >> (k)) & 1) { if (ph_lo <= (k) && (k) < ph_hi) { CP P = Pc; asm volatile("" : "+s"(P)); body; if ((PROBE_DUP >> (k)) & 1) { __syncthreads(); body; } if (coop && (k) + 1 < ph_hi) { if (coop == 2) grid.sync(); else xcd_barrier(xb); } } } } while (0)
__global__ void __launch_bounds__(512, 2) mega(Params Pk, int ph_lo, int ph_hi, int coop) {
    extern __shared__ __attribute__((aligned(16))) unsigned char shm[];
    PG8_LAS unsigned char* ldsb = (PG8_LAS unsigned char*)shm; ldsf lds = (ldsf)shm;
    cg::grid_group grid = cg::this_grid();
    const CP Pc = (CP)__builtin_amdgcn_kernarg_segment_ptr();
    volatile LAS unsigned* stw = (volatile LAS unsigned*)(shm + LDS_BYTES - 16);
    if (threadIdx.x < 4) stw[threadIdx.x] = 0u;
    __syncthreads();
    XcdBarrier xb = xcd_barrier_post(Pc->bar, stw);
    RUN_PHASE(0, { transpose_convert(P->in[2], DM, 7840, LDP, P->Wi, P->in[1], lds); x_convert(P); lora_convert(P); });
#ifdef PROBE_PRE
    { CP P = Pc; asm volatile("" : "+s"(P)); gemm_inproj<true>(P, P->actA, P->xss0, ldsb); grid.sync(); rwkv_prep(P, 0, lds); grid.sync(); scan_phase<PROBE_PRE>(P, 0, lds); grid.sync(); }
#endif
    RUN_PHASE(1, { gemm_inproj<true>(P, P->actA, P->xss0, ldsb);
                   const int nfull = (M_TOK / 256) * (LDP / 256) % (int)gridDim.x;
                   if (nfull > 0 && (int)blockIdx.x >= nfull) transpose_convert(P->in[3], DM, DM, DM, P->Wo0, nullptr, lds, (int)blockIdx.x - nfull, (int)gridDim.x - nfull);
                   else if (nfull == 0) transpose_convert(P->in[3], DM, DM, DM, P->Wo0, nullptr, lds); });
    RUN_PHASE(2, rwkv_prep(P, 0, lds));
    RUN_PHASE(3, scan_phase(P, 0, lds));
    RUN_PHASE(4, { finalize_phase(P, 0); transpose_convert(P->in[29], DM, 7872, LDP, P->Wi, P->in[28], lds); });
    RUN_PHASE(5, gemm_outproj(P, P->Wo0, P->in[0], P->xb1, P->xss1, ldsb));
    RUN_PHASE(6, { gemm_inproj<false>(P, P->xb1, P->xss1, ldsb);
                   const int nfull = (M_TOK / 256) * (LDP / 256) % (int)gridDim.x;
                   if (nfull > 0 && (int)blockIdx.x >= nfull) transpose_convert(P->in[30], DM, DM, DM, P->Wo1, nullptr, lds, (int)blockIdx.x - nfull, (int)gridDim.x - nfull);
                   else if (nfull == 0) transpose_convert(P->in[30], DM, DM, DM, P->Wo1, nullptr, lds); });
    RUN_PHASE(7, rwkv_prep(P, 1, lds));
    RUN_PHASE(8, scan_phase(P, 1, lds));
    RUN_PHASE(9, finalize_phase(P, 1));
    RUN_PHASE(10, gemm_outproj(P, P->Wo1, P->out, nullptr, P->xss2, ldsb));
    RUN_PHASE(11, final_norm(P));
}

#ifndef MK_COOP
#define MK_COOP 1
#endif
extern "C" void kernel_launch(void* const* d_in, const int* in_sizes, int n_in, void* d_out, int out_size, void* d_ws, size_t ws_size, hipStream_t stream) {
    Params p{};
    for (int i = 0; i < 58; ++i) p.in[i] = (const float*)d_in[i];
    p.out = (float*)d_out;
    char* w = (char*)d_ws; size_t off = 0;
    auto take = [&](size_t bytes) { char* r = w + off; off += (bytes + 255) & ~(size_t)255; return r; };
    p.Wi = (bf16_t*)take((size_t)LDP * DM * 2);
    p.Wo0 = (bf16_t*)take((size_t)DM * DM * 2);
    p.Wo1 = (bf16_t*)take((size_t)DM * DM * 2);
    p.actA = (bf16_t*)take((size_t)M_TOK * DM * 2);
    p.proj = (bf16_t*)take((size_t)M_TOK * LDP * 2);
    p.rwA = (float*)take((size_t)M_TOK * 512 * 4);
    p.rwB = (float*)take((size_t)M_TOK * 512 * 4);
    p.xb1 = (bf16_t*)p.rwA;
    p.rwV = (float*)take((size_t)M_TOK * 512 * 4);
    p.xss0 = (float*)take((size_t)M_TOK * XSSN * 4);
    p.xss1 = (float*)take((size_t)M_TOK * XSSN * 4);
    p.xss2 = (float*)take((size_t)M_TOK * XSSN * 4);
    p.bar = (unsigned*)take((size_t)XCD_BAR_WORDS * 4);
    p.lora = (bf16_t*)take((size_t)LORA_ELEMS * 2);
    p.bon = (float*)take((size_t)M_TOK * 8 * 4);
    if (off > ws_size) { fprintf(stderr, "workspace too small: need %zu have %zu\n", off, ws_size); return; }
    static int grid_blocks = 0;
    if (!grid_blocks) {
        hipFuncSetAttribute((const void*)mega, hipFuncAttributeMaxDynamicSharedMemorySize, LDS_BYTES);
        int dev = 0, cus = 0, per_cu = 0;
        hipGetDevice(&dev);
        hipDeviceGetAttribute(&cus, hipDeviceAttributeMultiprocessorCount, dev);
        hipOccupancyMaxActiveBlocksPerMultiprocessor(&per_cu, mega, 512, LDS_BYTES);
        if (per_cu > 1) per_cu = 1;
        grid_blocks = cus * per_cu;
        if (grid_blocks <= 0) grid_blocks = 256;
    }
#if MK_COOP
    hipMemsetAsync(p.bar, 0, (size_t)XCD_BAR_WORDS * 4, stream);
    int lo = 0, hi = N_PHASES, coop = 1;
    void* args[] = {&p, &lo, &hi, &coop};
    hipError_t e = hipLaunchCooperativeKernel((const void*)mega, dim3(grid_blocks), dim3(512), args, LDS_BYTES, stream);
    if (e != hipSuccess) fprintf(stderr, "cooperative launch failed: %s (grid %d)\n", hipGetErrorString(e), grid_blocks);
#else
    for (int ph = 0; ph < N_PHASES; ++ph) hipLaunchKernelGGL(mega, dim3(grid_blocks), dim3(512), LDS_BYTES, stream, p, ph, ph + 1, 0);
#endif
}
```

```cpp
#include <hip/hip_runtime.h>
#include <hip/hip_cooperative_groups.h>
#include <cstdio>
namespace cg = cooperative_groups;

namespace pg8 {
#define PG8_LAS __attribute__((address_space(3)))
typedef unsigned short bf16_t;
typedef short bf16x8 __attribute__((ext_vector_type(8)));
typedef float f32x4 __attribute__((ext_vector_type(4)));
typedef unsigned u32x4 __attribute__((ext_vector_type(4)));
constexpr int BM = 256, BK = 64, HALF = 128, HTB = HALF * BK * 2  , STAGE_BYTES = 8 * HTB, NXCD = 8, WGM = 8;

__host__ __device__ __forceinline__ int lds_byte(int r, int c) { const int st = (r >> 4) * 2 + (c >> 5), rr = r & 15, cc = c & 31, ob = rr * 64 + cc * 2; return st * 1024 + (ob ^ (((ob >> 9) & 1) << 5)); }
__host__ __device__ __forceinline__ void stage_rc(int b, int& R, int& C) { const int st = b / 1024, sb = b % 1024, swz = sb ^ (((sb >> 9) & 1) << 5); R = (st >> 1) * 16 + swz / 64; C = (st & 1) * 32 + (swz % 64) / 2; }
__host__ __device__ __forceinline__ int perm32(int rho) { const int n = rho >> 4, i = rho & 15; return 8 * (i >> 2) + 4 * n + (i & 3); }

struct Unit { int pm, pn; };
struct Gemm { const bf16_t* A; const bf16_t* Bt; int M, N, K; };

struct StaticOrder {
    int nM, nN, nwg, G, c;
    __host__ __device__ void init(int M, int N, int G_, int c_) { nM = M / BM; nN = N / BM; nwg = nM * nN; G = G_; c = c_; }
    __host__ __device__ bool next(int i, Unit& u) const {
        const long L = (long)i * G + c; if (L >= nwg) return false;
        int wgid = (int)L; { const int q = nwg / NXCD, r = nwg % NXCD, xcd = wgid % NXCD, off = wgid / NXCD; wgid = (xcd < r ? xcd * (q + 1) : r * (q + 1) + (xcd - r) * q) + off; }
        const int nig = WGM * nN, gid = wgid / nig, fm = gid * WGM, gsz = (nM - fm) < WGM ? (nM - fm) : WGM;
        u.pm = fm + ((wgid % nig) % gsz); u.pn = (wgid % nig) / gsz; return true;
    }
    __device__ __forceinline__ void a_ready(const Unit&) const {}
    __device__ __forceinline__ void done(const Unit&) const {}
};
__device__ __forceinline__ unsigned cvt_pk_bf16(float lo, float hi) { unsigned r; asm volatile("v_cvt_pk_bf16_f32 %0, %1, %2" : "=v"(r) : "v"(lo), "v"(hi)); return r; }
template <class Epi, class Sched, bool STAMP = false>
__device__ __forceinline__ void gemm_phase(PG8_LAS unsigned char* lds, const Gemm g, const Sched& S, const Epi& E, unsigned long long* stamps) {
    const int tid = threadIdx.x, wid = __builtin_amdgcn_readfirstlane(tid >> 6), lane = tid & 63, wr = wid >> 2, wc = wid & 3, fr = lane & 15, fq = lane >> 4;
    const int K = g.K, nt = K / BK;
    int ts_lo = 0, ts_hi = 0, nts = 0; const unsigned long long rt_entry = STAMP ? (unsigned long long)wall_clock64() : 0ull;
#define PG8_STAMP() do { if (STAMP && wid == 0 && nts < 64) { const unsigned long long _c = (unsigned long long)clock64(); \
        ts_lo = (lane == nts) ? (int)(unsigned)_c : ts_lo; ts_hi = (lane == nts) ? (int)(unsigned)(_c >> 32) : ts_hi; ++nts; } } while (0)
    PG8_STAMP();
    unsigned voffA[2], voffB[2];
#pragma unroll
    for (int i = 0; i < 2; ++i) { int R, C; stage_rc(tid * 16 + i * 8192, R, C); const int Rb = Epi::PERM ? ((R & ~31) + perm32(R & 31)) : R;
        voffA[i] = (unsigned)(R * K + C) * 2u; voffB[i] = (unsigned)(Rb * K + C) * 2u; }
    const size_t kstep = (size_t)(BK * 2);
    const size_t hstep = (size_t)HALF * K * 2;
    const size_t tstep = 2 * hstep;
    const unsigned ldsw = (unsigned)wid * 1024u;
    const int aoff = lds_byte(wr * 64 + fr, fq * 8), boff = lds_byte(wc * 32 + fr, fq * 8);
#define PG8_SA(b, h) (((b) * 2 + (h)) * HTB)
#define PG8_SB(b, h) ((4 + (b) * 2 + (h)) * HTB)
#define PG8_STAGE(bufoff, gbase, voff) do { _Pragma("unroll") for (int _i = 0; _i < 2; ++_i) \
        __builtin_amdgcn_global_load_lds((const unsigned*)((const char*)(gbase) + (voff)[_i]), (PG8_LAS unsigned*)(lds + (bufoff) + ldsw + _i * 8192), 16, 0, 0); } while (0)
#define PG8_LDA(dst, b, h) do { _Pragma("unroll") for (int m = 0; m < 4; ++m) _Pragma("unroll") for (int k = 0; k < 2; ++k) dst[m][k] = *(const PG8_LAS bf16x8*)(lds + PG8_SA(b, h) + aoff + m * 2048 + k * 1024); } while (0)
#define PG8_LDB(dst, b, h) do { _Pragma("unroll") for (int n = 0; n < 2; ++n) _Pragma("unroll") for (int k = 0; k < 2; ++k) dst[n][k] = *(const PG8_LAS bf16x8*)(lds + PG8_SB(b, h) + boff + n * 2048 + k * 1024); } while (0)
#define PG8_MMA(ai, bj, At, Bt) do { __builtin_amdgcn_s_setprio(1); _Pragma("unroll") for (int m = 0; m < 4; ++m) _Pragma("unroll") for (int n = 0; n < 2; ++n) _Pragma("unroll") for (int k = 0; k < 2; ++k) \
        acc[ai][bj][m][n] = __builtin_amdgcn_mfma_f32_16x16x32_bf16(Bt[n][k], At[m][k], acc[ai][bj][m][n], 0, 0, 0); __builtin_amdgcn_s_setprio(0); } while (0)
#define PG8_WAIT_V(n) asm volatile("s_waitcnt vmcnt(" #n ")" ::: "memory")
#define PG8_WAIT_L(n) asm volatile("s_waitcnt lgkmcnt(" #n ")" ::: "memory")
#define PG8_BAR __builtin_amdgcn_s_barrier()
#define PG8_SCHED __builtin_amdgcn_sched_barrier(0)
    Unit cur, nxt; int ui = 0;
    if (!S.next(0, cur)) return;
    f32x4 acc[2][2][4][2];
#pragma unroll
    for (int a = 0; a < 2; ++a)
#pragma unroll
        for (int b = 0; b < 2; ++b)
#pragma unroll
            for (int m = 0; m < 4; ++m)
#pragma unroll
                for (int n = 0; n < 2; ++n) acc[a][b][m][n] = (f32x4){0.f, 0.f, 0.f, 0.f};
    bf16x8 At[4][2], B0[2][2], B1[2][2];
    const char* cA = (const char*)g.A + (size_t)cur.pm * tstep; const char* cB = (const char*)g.Bt + (size_t)cur.pn * tstep;
    S.a_ready(cur);
    PG8_STAGE(PG8_SB(0, 0), cB, voffB); PG8_STAGE(PG8_SA(0, 0), cA, voffA); PG8_STAGE(PG8_SB(0, 1), cB + hstep, voffB); PG8_STAGE(PG8_SA(0, 1), cA + hstep, voffA);
    if (wr == 1) PG8_BAR;
    PG8_WAIT_V(4); PG8_BAR;
    PG8_STAGE(PG8_SB(1, 0), cB + kstep, voffB); PG8_STAGE(PG8_SA(1, 0), cA + kstep, voffA); PG8_STAGE(PG8_SB(1, 1), cB + hstep + kstep, voffB);
    PG8_WAIT_V(6); PG8_BAR;
    PG8_STAMP();
    for (;;) {
        const bool has_next = S.next(ui + 1, nxt);
        const char* nA = has_next ? (const char*)g.A + (size_t)nxt.pm * tstep : cA; const char* nB = has_next ? (const char*)g.Bt + (size_t)nxt.pn * tstep : cB;
        for (int t = 0; t < nt; t += 2) {
            const bool last = (t == nt - 2);
            const char* a1 = cA + (size_t)(t + 1) * kstep;
            const char* a2 = last ? nA : cA + (size_t)(t + 2) * kstep; const char* b2 = last ? nB : cB + (size_t)(t + 2) * kstep;
            const char* a3 = a2 + kstep; const char* b3 = b2 + kstep;
            if (last && has_next) S.a_ready(nxt);
            PG8_LDB(B0, 0, 0); PG8_SCHED; PG8_LDA(At, 0, 0); PG8_STAGE(PG8_SA(1, 1), a1 + hstep, voffA);
            PG8_WAIT_L(8); PG8_BAR; PG8_WAIT_L(0); PG8_MMA(0, 0, At, B0); PG8_BAR; PG8_SCHED;
            PG8_LDB(B1, 0, 1); PG8_STAGE(PG8_SB(0, 0), b2, voffB);
            PG8_BAR; PG8_WAIT_L(0); PG8_MMA(0, 1, At, B1); PG8_BAR;
            PG8_LDA(At, 0, 1); PG8_STAGE(PG8_SA(0, 0), a2, voffA);
            PG8_BAR; PG8_WAIT_L(0); PG8_MMA(1, 0, At, B0); PG8_BAR; PG8_SCHED;
            PG8_STAGE(PG8_SB(0, 1), b2 + hstep, voffB);
            PG8_WAIT_V(6); PG8_BAR; PG8_MMA(1, 1, At, B1); PG8_BAR;
            PG8_LDB(B0, 1, 0); PG8_SCHED; PG8_LDA(At, 1, 0); PG8_STAGE(PG8_SA(0, 1), a2 + hstep, voffA);
            PG8_WAIT_L(8); PG8_BAR; PG8_WAIT_L(0); PG8_MMA(0, 0, At, B0); PG8_BAR; PG8_SCHED;
            PG8_LDB(B1, 1, 1); PG8_STAGE(PG8_SB(1, 0), b3, voffB);
            PG8_BAR; PG8_WAIT_L(0); PG8_MMA(0, 1, At, B1); PG8_BAR;
            PG8_LDA(At, 1, 1); PG8_STAGE(PG8_SA(1, 0), a3, voffA);
            PG8_BAR; PG8_WAIT_L(0); PG8_MMA(1, 0, At, B0); PG8_BAR; PG8_SCHED;
            PG8_STAGE(PG8_SB(1, 1), b3 + hstep, voffB);
            PG8_WAIT_V(6); PG8_BAR; PG8_MMA(1, 1, At, B1); PG8_BAR;
        }
        PG8_STAMP();
        if constexpr (!Epi::AFTER_DRAIN) { E(acc, cur, wr, wc, fr, fq); S.done(cur); }
        PG8_STAMP();
        if (!has_next) break;
#pragma unroll
        for (int a = 0; a < 2; ++a)
#pragma unroll
            for (int b = 0; b < 2; ++b)
#pragma unroll
                for (int m = 0; m < 4; ++m)
#pragma unroll
                    for (int n = 0; n < 2; ++n) acc[a][b][m][n] = (f32x4){0.f, 0.f, 0.f, 0.f};
        cur = nxt; cA = nA; cB = nB; ++ui;
    }
    PG8_WAIT_V(0);
    if (wr == 0) PG8_BAR;
    PG8_BAR;
    if constexpr (Epi::AFTER_DRAIN) { E.fused(acc, cur, wr, wc, fr, fq, lds, wid, lane); S.done(cur); }
    PG8_STAMP();
    if (STAMP && wid == 0) { stamps[lane] = lane < nts ? (((unsigned long long)(unsigned)ts_hi << 32) | (unsigned)ts_lo) : 0ull;
        if (lane == 62) stamps[62] = rt_entry; if (lane == 63) stamps[63] = (unsigned long long)wall_clock64(); }
#undef PG8_STAMP
#undef PG8_SA
#undef PG8_SB
#undef PG8_STAGE
#undef PG8_LDA
#undef PG8_LDB
#undef PG8_MMA
#undef PG8_WAIT_V
#undef PG8_WAIT_L
#undef PG8_BAR
#undef PG8_SCHED
}
}

typedef unsigned short bf16_t;
typedef float f32x4 __attribute__((ext_vector_type(4)));
#define LAS __attribute__((address_space(3)))
typedef LAS float* ldsf;

constexpr int M_TOK = 8192, DM = 2048, SEQL = 2048, LDP = 7936, XSSN = 32;
constexpr int LDS_BYTES = 160 * 1024;
constexpr int N_PHASES = 12;
constexpr int LORA_L = 2 * 512 * 64 + 512 * 32, LORA_ELEMS = 2 * LORA_L;
constexpr int N_RW = 128, N_ITEMS = N_RW + 128;

enum { I_NORM_G = 0, I_W_IN, I_W_OUT, I_GK_W2, I_GK_B, I_GLA_NG, I_RW_MU, I_RW_W0, I_RW_W2, I_RW_A0, I_RW_A2, I_RW_KK, I_RW_KA, I_RW_RK, I_RW_LNG, I_RW_LNB,
       I_SSD_CW, I_SSD_CB, I_SSD_DTB, I_SSD_ALOG, I_SSD_D, I_SSD_NG, I_ML_CW, I_ML_CB, I_ML_IGB, I_ML_FGB, I_ML_NG };

struct Params {
    const float* in[58];
    float* out;
    bf16_t* Wi; bf16_t* Wo0; bf16_t* Wo1; bf16_t* actA; bf16_t* proj; bf16_t* xb1;
    float* rwA; float* rwB; float* rwV; float* xss0; float* xss1; float* xss2; unsigned* bar; bf16_t* lora; float* bon;
};
typedef const __attribute__((address_space(4))) Params* CP;
__device__ __forceinline__ const float* LP(CP P, int l, int idx) { return P->in[(l ? 28 : 1) + idx + ((l && idx >= I_RW_KK) ? 2 : 0)]; }

struct Cols { int rw, rwz, sx, sdt, sz, mqk, mv, mi, mf, mo, mz, nin; };
__device__ __forceinline__ Cols cols(int l) {
    const int RW = l ? 1696 : 1664; Cols c;
    c.rw = 1552; c.rwz = 1552 + RW; c.sx = c.rwz + 512; c.sdt = c.sx + 1024; c.sz = c.sdt + 8; c.mqk = c.sz + 512; c.mv = c.mqk + 1024;
    c.mi = c.mv + 512; c.mf = c.mi + 4; c.mo = c.mf + 4; c.mz = c.mo + 512; c.nin = c.mz + 512; return c;
}
constexpr int C_GQ = 0, C_GK = 256, C_GV = 512, C_GGK = 1024, C_GZ = 1040;

__device__ __forceinline__ float bf2f(bf16_t u) { return __uint_as_float(((unsigned)u) << 16); }
__device__ __forceinline__ bf16_t f2bf(float f) { unsigned u = __float_as_uint(f); u += 0x7FFFu + ((u >> 16) & 1u); return (bf16_t)(u >> 16); }
__device__ __forceinline__ unsigned pack2(float lo, float hi) { return (unsigned)f2bf(lo) | ((unsigned)f2bf(hi) << 16); }
__device__ __forceinline__ void unpack8(const uint4 u, float* f) {
    f[0] = __uint_as_float(u.x << 16); f[1] = __uint_as_float(u.x & 0xffff0000u); f[2] = __uint_as_float(u.y << 16); f[3] = __uint_as_float(u.y & 0xffff0000u);
    f[4] = __uint_as_float(u.z << 16); f[5] = __uint_as_float(u.z & 0xffff0000u); f[6] = __uint_as_float(u.w << 16); f[7] = __uint_as_float(u.w & 0xffff0000u);
}
__device__ __forceinline__ void load8(const bf16_t* p, float* f) { unpack8(*(const uint4*)p, f); }
__device__ __forceinline__ void store8(bf16_t* p, const float* f) { uint4 u; u.x = pack2(f[0], f[1]); u.y = pack2(f[2], f[3]); u.z = pack2(f[4], f[5]); u.w = pack2(f[6], f[7]); *(uint4*)p = u; }
__device__ __forceinline__ float softplusf(float x) { return fmaxf(x, 0.f) + log1pf(expf(-fabsf(x))); }
__device__ __forceinline__ float logsigmoidf(float x) { return fminf(x, 0.f) - log1pf(expf(-fabsf(x))); }
__device__ __forceinline__ float sigmoidf_(float x) { return __builtin_amdgcn_rcpf(1.f + __expf(-x)); }
__device__ __forceinline__ float siluf(float x) { return x * __builtin_amdgcn_rcpf(1.f + __expf(-x)); }
__device__ __forceinline__ float logsigmoid_fast(float x) { return fminf(x, 0.f) - __logf(1.f + __expf(-fabsf(x))); }
typedef float f32x2 __attribute__((ext_vector_type(2)));
__device__ __forceinline__ float wave_sum(float v) { for (int o = 32; o; o >>= 1) v += __shfl_xor(v, o); return v; }
__device__ __forceinline__ float wave_max(float v) { for (int o = 32; o; o >>= 1) v = fmaxf(v, __shfl_xor(v, o)); return v; }
template <int CTRL> __device__ __forceinline__ float dppf(float v) { return __int_as_float(__builtin_amdgcn_update_dpp(0, __float_as_int(v), CTRL, 0xF, 0xF, true)); }
__device__ __forceinline__ float reduce16(float v) { v += dppf<0xB1>(v); v += dppf<0x4E>(v); v += dppf<0x141>(v); v += dppf<0x140>(v); return v; }
__device__ __forceinline__ float reduce8(float v) { v += dppf<0xB1>(v); v += dppf<0x4E>(v); v += dppf<0x141>(v); return v; }

template <int CTRL> __device__ __forceinline__ float dpp_keep(float oldv, float v) { return __int_as_float(__builtin_amdgcn_update_dpp(__float_as_int(oldv), __float_as_int(v), CTRL, 0xF, 0xF, false)); }
__device__ __forceinline__ float rdlane(float v, int l) { return __int_as_float(__builtin_amdgcn_readlane(__float_as_int(v), l)); }
__device__ __forceinline__ float scan_add64(float v, int lane) {
    v += dppf<0x111>(v); v += dppf<0x112>(v); v += dppf<0x114>(v); v += dppf<0x118>(v);
    const float t0 = rdlane(v, 15), t1 = rdlane(v, 31), t2 = rdlane(v, 47); const int row = lane >> 4;
    return v + ((row >= 1) ? t0 : 0.f) + ((row >= 2) ? t1 : 0.f) + ((row >= 3) ? t2 : 0.f);
}
__device__ __forceinline__ float scan_max64(float v, int lane) {
    const float ninf = -__builtin_inff();
    v = fmaxf(v, dpp_keep<0x111>(ninf, v)); v = fmaxf(v, dpp_keep<0x112>(ninf, v)); v = fmaxf(v, dpp_keep<0x114>(ninf, v)); v = fmaxf(v, dpp_keep<0x118>(ninf, v));
    const float t0 = rdlane(v, 15), t1 = rdlane(v, 31), t2 = rdlane(v, 47); const int row = lane >> 4;
    return fmaxf(fmaxf(v, (row >= 1) ? t0 : ninf), fmaxf((row >= 2) ? t1 : ninf, (row >= 3) ? t2 : ninf));
}
__device__ __forceinline__ void lds_barrier() { asm volatile("s_waitcnt lgkmcnt(0)\n\ts_barrier" ::: "memory"); }
__device__ __forceinline__ int opaque_tid() { int t = threadIdx.x; asm volatile("" : "+v"(t)); return t; }
template <class FA, class FB> __device__ __forceinline__ f32x4 mm16(int K, FA fa, FB fb, f32x4 acc, int i, int kq) {
#pragma unroll 4
    for (int k0 = 0; k0 < K; k0 += 4) { const float a = fa(i, k0 + kq), b = fb(k0 + kq, i); acc = __builtin_amdgcn_mfma_f32_16x16x4f32(a, b, acc, 0, 0, 0); }
    return acc;
}
template <class FA, class FB1, class FB2> __device__ __forceinline__ void mm16_2(int K, FA fa, FB1 fb1, FB2 fb2, f32x4& acc1, f32x4& acc2, int i, int kq) {
#pragma unroll 4
    for (int k0 = 0; k0 < K; k0 += 4) { const float a = fa(i, k0 + kq), b1 = fb1(k0 + kq, i), b2 = fb2(k0 + kq, i);
        acc1 = __builtin_amdgcn_mfma_f32_16x16x4f32(a, b1, acc1, 0, 0, 0); acc2 = __builtin_amdgcn_mfma_f32_16x16x4f32(a, b2, acc2, 0, 0, 0); }
}
typedef short bf16x8 __attribute__((ext_vector_type(8)));
typedef LAS bf16_t* ldsh;
typedef unsigned u32x4 __attribute__((ext_vector_type(4)));
typedef unsigned u32x2 __attribute__((ext_vector_type(2)));
__device__ __forceinline__ void unpack8v(const u32x4 u, float* f) { unpack8(make_uint4(u.x, u.y, u.z, u.w), f); }
__device__ __forceinline__ unsigned pk2(float lo, float hi) { unsigned r; asm volatile("v_cvt_pk_bf16_f32 %0, %1, %2" : "=v"(r) : "v"(lo), "v"(hi)); return r; }
__device__ __forceinline__ f32x4 mmb(int K, const LAS bf16_t* pa, int lda, const LAS bf16_t* pb, int ldb, f32x4 acc, int li, int kq) {
    const LAS bf16_t* a = pa + li * lda + kq * 8; const LAS bf16_t* b = pb + li * ldb + kq * 8;
#pragma unroll 4
    for (int k0 = 0; k0 < K; k0 += 32) acc = __builtin_amdgcn_mfma_f32_16x16x32_bf16(*(const LAS bf16x8*)(a + k0), *(const LAS bf16x8*)(b + k0), acc, 0, 0, 0);
    return acc;
}
__device__ __forceinline__ void tri_tile(int idx, int& tl, int& ts) {
    tl = (idx >= 6) ? 3 : (idx >= 3) ? 2 : (idx >= 1) ? 1 : 0; ts = idx - (tl * (tl + 1)) / 2;
}

template <bool PRE> struct EpiProj {
    static constexpr bool PERM = true, AFTER_DRAIN = false;
    bf16_t* O; const float* xss;
    __device__ __forceinline__ void operator()(const f32x4 (&acc)[2][2][4][2], const pg8::Unit& u, int wr, int wc, int fr, int fq) const {
        const int row0 = u.pm * 256 + wr * 64 + fr, col0 = u.pn * 256 + wc * 32 + 8 * fq;
#pragma unroll
        for (int ai = 0; ai < 2; ++ai)
#pragma unroll
            for (int m = 0; m < 4; ++m) {
                const int row = row0 + ai * 128 + m * 16;
                float rstd;
                if (PRE) rstd = xss[row];
                else {
                    const float4* sp = (const float4*)(xss + (size_t)row * XSSN + fq * 8);
                    const float4 v0 = sp[0], v1 = sp[1];
                    float s = ((v0.x + v0.y) + (v0.z + v0.w)) + ((v1.x + v1.y) + (v1.z + v1.w));
                    s += __shfl_xor(s, 16); s += __shfl_xor(s, 32);
                    rstd = rsqrtf(s * (1.f / DM) + 1e-6f);
                }
                bf16_t* rowp = O + (size_t)row * LDP + col0;
#pragma unroll
                for (int bj = 0; bj < 2; ++bj) {
                    const f32x4 v0 = acc[ai][bj][m][0] * rstd, v1 = acc[ai][bj][m][1] * rstd;
                    uint4 o; o.x = pg8::cvt_pk_bf16(v0[0], v0[1]); o.y = pg8::cvt_pk_bf16(v0[2], v0[3]); o.z = pg8::cvt_pk_bf16(v1[0], v1[1]); o.w = pg8::cvt_pk_bf16(v1[2], v1[3]);
                    *(uint4*)(rowp + bj * 128) = o;
                }
            }
    }
};
struct EpiOut {
    static constexpr bool PERM = false, AFTER_DRAIN = false;
    const float* xin; float* xout; bf16_t* xb; float* xss;
    __device__ __forceinline__ void operator()(const f32x4 (&acc)[2][2][4][2], const pg8::Unit& u, int wr, int wc, int fr, int fq) const {
        const int row0 = u.pm * 256 + wr * 64 + fr, col0 = u.pn * 256 + wc * 32 + 4 * fq;
#pragma unroll
        for (int ai = 0; ai < 2; ++ai)
#pragma unroll
            for (int m = 0; m < 4; ++m) {
                const int row = row0 + ai * 128 + m * 16; float ss = 0.f;
#pragma unroll
                for (int bj = 0; bj < 2; ++bj)
#pragma unroll
                    for (int n = 0; n < 2; ++n) {
                        const size_t off = (size_t)row * DM + col0 + bj * 128 + n * 16;
                        const f32x4 v = acc[ai][bj][m][n] + *(const f32x4*)(xin + off);
                        *(f32x4*)(xout + off) = v; ss += v[0] * v[0] + v[1] * v[1] + v[2] * v[2] + v[3] * v[3];
                        if (xb) { uint2 o; o.x = pg8::cvt_pk_bf16(v[0], v[1]); o.y = pg8::cvt_pk_bf16(v[2], v[3]); *(uint2*)(xb + off) = o; }
                    }
                ss += __shfl_xor(ss, 16); ss += __shfl_xor(ss, 32);
                if (fq == 0) xss[(size_t)row * XSSN + u.pn * 4 + wc] = ss;
            }
    }
};

__device__ __forceinline__ void transpose_convert(const float* __restrict__ src, int K, int N, int Npad, bf16_t* __restrict__ dst, const float* __restrict__ rowscale, ldsf lds, int wg = -1, int nwg = 0) {
    if (wg < 0) { wg = blockIdx.x; nwg = gridDim.x; }
    const int tid = threadIdx.x, nkt = K / 64, ntiles = nkt * (Npad / 64);
    const int kk = tid >> 4, nn4 = (tid & 15) * 4;
    float4 c0 = make_float4(0.f, 0.f, 0.f, 0.f), c1 = c0;
    int tile = wg;
    if (tile < ntiles) {
        const int k0 = (tile % nkt) * 64, n0 = (tile / nkt) * 64;
        if (n0 + nn4 < N) { c0 = *(const float4*)(src + (size_t)(k0 + kk) * N + n0 + nn4); c1 = *(const float4*)(src + (size_t)(k0 + kk + 32) * N + n0 + nn4); }
    }
    for (; tile < ntiles; tile += nwg) {
        const int k0 = (tile % nkt) * 64, n0 = (tile / nkt) * 64;
        float4 a0 = c0, a1 = c1;
        const int nt = tile + nwg;
        c0 = make_float4(0.f, 0.f, 0.f, 0.f); c1 = c0;
        if (nt < ntiles) {
            const int k1 = (nt % nkt) * 64, n1 = (nt / nkt) * 64;
            if (n1 + nn4 < N) { c0 = *(const float4*)(src + (size_t)(k1 + kk) * N + n1 + nn4); c1 = *(const float4*)(src + (size_t)(k1 + kk + 32) * N + n1 + nn4); }
        }
        if (rowscale) { const float s0 = rowscale[k0 + kk], s1 = rowscale[k0 + kk + 32]; a0.x *= s0; a0.y *= s0; a0.z *= s0; a0.w *= s0; a1.x *= s1; a1.y *= s1; a1.z *= s1; a1.w *= s1; }
        lds[kk * 65 + nn4 + 0] = a0.x; lds[kk * 65 + nn4 + 1] = a0.y; lds[kk * 65 + nn4 + 2] = a0.z; lds[kk * 65 + nn4 + 3] = a0.w;
        lds[(kk + 32) * 65 + nn4 + 0] = a1.x; lds[(kk + 32) * 65 + nn4 + 1] = a1.y; lds[(kk + 32) * 65 + nn4 + 2] = a1.z; lds[(kk + 32) * 65 + nn4 + 3] = a1.w;
        __syncthreads();
        {
            const int nn = tid >> 3, k8 = (tid & 7) * 8;
            uint4 o;
            o.x = pack2(lds[(k8 + 0) * 65 + nn], lds[(k8 + 1) * 65 + nn]); o.y = pack2(lds[(k8 + 2) * 65 + nn], lds[(k8 + 3) * 65 + nn]);
            o.z = pack2(lds[(k8 + 4) * 65 + nn], lds[(k8 + 5) * 65 + nn]); o.w = pack2(lds[(k8 + 6) * 65 + nn], lds[(k8 + 7) * 65 + nn]);
            *(uint4*)(dst + (size_t)(n0 + nn) * K + k0 + k8) = o;
        }
        __syncthreads();
    }
}
__device__ __forceinline__ void x_convert(CP P) {
    const int wave = threadIdx.x >> 6, lane = threadIdx.x & 63;
    for (int row = blockIdx.x * 8 + wave; row < M_TOK; row += gridDim.x * 8) {
        const float4* xr = (const float4*)(P->in[0] + (size_t)row * DM); float ss = 0.f;
#pragma unroll
        for (int i = 0; i < 8; ++i) {
            const float4 v = xr[lane + i * 64]; ss += v.x * v.x + v.y * v.y + v.z * v.z + v.w * v.w;
            uint2 o; o.x = pack2(v.x, v.y); o.y = pack2(v.z, v.w); *(uint2*)(P->actA + (size_t)row * DM + (lane + i * 64) * 4) = o;
        }
        ss = wave_sum(ss);
        if (lane == 0) P->xss0[row] = rsqrtf(ss * (1.f / DM) + 1e-6f);
    }
}

__device__ __forceinline__ void lora_convert(CP P) {
    for (int l = 0; l < 2; ++l) {
        const float* w2 = LP(P, l, I_RW_W2); const float* a2 = LP(P, l, I_RW_A2); const float* v2 = P->in[40];
        bf16_t* W = P->lora + (size_t)l * LORA_L; bf16_t* A = W + 512 * 64; bf16_t* V = A + 512 * 64;
        for (int e = blockIdx.x * 512 + threadIdx.x; e < 512 * 64; e += gridDim.x * 512) { const int c = e >> 6, k = e & 63; W[e] = f2bf(w2[k * 512 + c]); A[e] = f2bf(a2[k * 512 + c]); }
        if (l) for (int e = blockIdx.x * 512 + threadIdx.x; e < 512 * 32; e += gridDim.x * 512) { const int c = e >> 5, k = e & 31; V[e] = f2bf(v2[k * 512 + c]); }
    }
}
__device__ __forceinline__ void rwkv_prep(CP P, int l, ldsf lds) {
    const Cols C = cols(l); const int tid = opaque_tid(), wave = tid >> 6, lane = tid & 63, li = lane & 15, kq = lane >> 4;
    const float* mu = LP(P, l, I_RW_MU); const float* w0 = LP(P, l, I_RW_W0); const float* a0 = LP(P, l, I_RW_A0); const float* v0 = P->in[39];
    const bf16_t* W2t = P->lora + (size_t)l * LORA_L; const bf16_t* A2t = W2t + 512 * 64; const bf16_t* V2t = A2t + 512 * 64;
    constexpr int AS = 72, VS = 40;
    const ldsh Wl = (ldsh)lds, Al = Wl + 32 * AS, Vl = Al + 32 * AS;
    for (int tile = blockIdx.x; tile < M_TOK / 32; tile += gridDim.x) {
        const int t0 = tile * 32;
        {
            const int tt = tid >> 4, g = tid & 15, t = t0 + tt;
            const bf16_t* pr = P->proj + (size_t)t * LDP + C.rw + 1536 + g * 8;
            const bool hasp = (t % SEQL) != 0;
            float cur[8], prev[8];
            load8(pr, cur);
            if (hasp) load8(pr - LDP, prev); else {
#pragma unroll
                for (int e = 0; e < 8; ++e) prev[e] = 0.f; }
            float f[8];
#pragma unroll
            for (int e = 0; e < 8; ++e) { f[e] = cur[e] + mu[1536 + g * 8 + e] * (prev[e] - cur[e]); if (g < 8) f[e] = tanhf(f[e]); }
            u32x4 o; o.x = pk2(f[0], f[1]); o.y = pk2(f[2], f[3]); o.z = pk2(f[4], f[5]); o.w = pk2(f[6], f[7]);
            *(LAS u32x4*)((g < 8 ? Wl : Al) + tt * AS + (g & 7) * 8) = o;
            if (l && g < 4) {
                load8(pr + 128, cur);
                if (hasp) load8(pr + 128 - LDP, prev);
#pragma unroll
                for (int e = 0; e < 8; ++e) f[e] = cur[e] + mu[1664 + g * 8 + e] * (prev[e] - cur[e]);
                o.x = pk2(f[0], f[1]); o.y = pk2(f[2], f[3]); o.z = pk2(f[4], f[5]); o.w = pk2(f[6], f[7]);
                *(LAS u32x4*)(Vl + tt * VS + g * 8) = o;
            }
        }
        __syncthreads();
        struct PrepIn { bf16x8 bw0, bw1, ba0, ba1, bv; float w0c, a0c, muc, v0c; bf16_t cur[4], prev[4]; float vf[4]; };
        auto ldp = [&](int tl) { PrepIn r;
            const int tt16 = tl & 1, c = (tl >> 1) * 16 + li;
            r.bw0 = *(const bf16x8*)(W2t + (size_t)c * 64 + kq * 8); r.bw1 = *(const bf16x8*)(W2t + (size_t)c * 64 + 32 + kq * 8);
            r.ba0 = *(const bf16x8*)(A2t + (size_t)c * 64 + kq * 8); r.ba1 = *(const bf16x8*)(A2t + (size_t)c * 64 + 32 + kq * 8);
            r.bv = r.bw0; if (l) r.bv = *(const bf16x8*)(V2t + (size_t)c * 32 + kq * 8);
            r.w0c = w0[c]; r.a0c = a0[c]; r.muc = mu[1024 + c]; r.v0c = l ? v0[c] : 0.f;
#pragma unroll
            for (int j = 0; j < 4; ++j) {
                const int t = t0 + tt16 * 16 + kq * 4 + j;
                r.cur[j] = P->proj[(size_t)t * LDP + C.rw + 1024 + c];
                r.prev[j] = (t % SEQL == 0) ? (bf16_t)0 : P->proj[(size_t)(t - 1) * LDP + C.rw + 1024 + c];
                r.vf[j] = l ? P->rwV[(size_t)t * 512 + c] : 0.f;
            }
            return r; };
        PrepIn cin = ldp(wave);
        for (int tl = wave; tl < 64; tl += 8) {
            const int tt16 = tl & 1, cc = (tl >> 1) * 16, c = cc + li;
            const PrepIn nin = ldp(tl + 8 < 64 ? tl + 8 : tl);
            f32x4 aW = {0.f, 0.f, 0.f, 0.f}, aA = aW, aV = aW;
            const LAS bf16_t* pw = Wl + (tt16 * 16 + li) * AS + kq * 8; const LAS bf16_t* pa = Al + (tt16 * 16 + li) * AS + kq * 8;
            aW = __builtin_amdgcn_mfma_f32_16x16x32_bf16(*(const LAS bf16x8*)(pw), cin.bw0, aW, 0, 0, 0);
            aW = __builtin_amdgcn_mfma_f32_16x16x32_bf16(*(const LAS bf16x8*)(pw + 32), cin.bw1, aW, 0, 0, 0);
            aA = __builtin_amdgcn_mfma_f32_16x16x32_bf16(*(const LAS bf16x8*)(pa), cin.ba0, aA, 0, 0, 0);
            aA = __builtin_amdgcn_mfma_f32_16x16x32_bf16(*(const LAS bf16x8*)(pa + 32), cin.ba1, aA, 0, 0, 0);
            if (l) aV = __builtin_amdgcn_mfma_f32_16x16x32_bf16(*(const LAS bf16x8*)(Vl + (tt16 * 16 + li) * VS + kq * 8), cin.bv, aV, 0, 0, 0);
#pragma unroll
            for (int j = 0; j < 4; ++j) {
                const int t = t0 + tt16 * 16 + kq * 4 + j; const size_t o = (size_t)t * 512 + c;
                const float wl = cin.w0c + aW[j];
                const float sp = fmaxf(-wl, 0.f) + __logf(1.f + __expf(-fabsf(wl)));
                P->rwA[o] = __expf(-__expf(-sp - 0.5f));
                P->rwB[o] = sigmoidf_(cin.a0c + aA[j]);
                const float cur = bf2f(cin.cur[j]), prev = bf2f(cin.prev[j]);
                float v = cur + cin.muc * (prev - cur);
                if (l) { const float g = sigmoidf_(cin.v0c + aV[j]); v = v + (cin.vf[j] - v) * g; }
                P->rwV[o] = v;
            }
            cin = nin;
        }
        __syncthreads();
    }
}

__device__ __forceinline__ void rwkv_scan_item(CP P, int l, int it, ldsf lds) {
    const Cols C = cols(l); const int tid = opaque_tid();
    const int b = it >> 5, h = (it >> 2) & 7, rq = it & 3;
    constexpr int BUF = 5 * 2048 + 512 + 8192;
    const float* mu = LP(P, l, I_RW_MU); const float* k_k = LP(P, l, I_RW_KK); const float* k_a = LP(P, l, I_RW_KA);
    const bool producer = tid >= 256; const int ptid = tid & 255;
    const int tt = ptid >> 3, cg8 = (ptid & 7) * 8, ch0 = h * 64 + cg8, c2 = (ptid & 7) * 2;
    const int ri = ptid >> 4, js = (ptid & 15) * 4;
    const float* r_k = LP(P, l, I_RW_RK);
    float mur[8], muk[8], kkc[8], kac[8], rkc[8];
#pragma unroll
    for (int e = 0; e < 8; ++e) { mur[e] = mu[ch0 + e]; muk[e] = mu[512 + ch0 + e]; kkc[e] = k_k[ch0 + e]; kac[e] = k_a[ch0 + e]; rkc[e] = r_k[ch0 + e]; }
    uint4 rcu, kcu, rpu, kpu; float4 ra0, ra1, rd0, rd1; float2 rv2;
    auto issue = [&](int c) {
        const int t = b * SEQL + c * 32 + tt;
        const bf16_t* pr = P->proj + (size_t)t * LDP + C.rw + ch0;
        rcu = *(const uint4*)pr; kcu = *(const uint4*)(pr + 512);
        rpu = make_uint4(0u, 0u, 0u, 0u); kpu = rpu;
        if (c > 0 || tt > 0) { rpu = *(const uint4*)(pr - LDP); kpu = *(const uint4*)(pr - LDP + 512); }
        const float* ap = P->rwB + (size_t)t * 512 + ch0; const float* dp = P->rwA + (size_t)t * 512 + ch0;
        ra0 = *(const float4*)ap; ra1 = *(const float4*)(ap + 4); rd0 = *(const float4*)dp; rd1 = *(const float4*)(dp + 4);
        rv2 = *(const float2*)(P->rwV + (size_t)t * 512 + h * 64 + rq * 16 + c2);
    };
    auto fill = [&](int c, ldsf buf) {
        ldsf sR = buf, sK = buf + 2048, sW = buf + 4096, sNK = buf + 6144, sB = buf + 8192, sV = buf + 10240;
        float rc[8], kc[8], rp[8], kp[8];
        alignas(16) float av[8]; alignas(16) float dv[8]; float kkr[8], kl[8];
        *(float4*)av = ra0; *(float4*)(av + 4) = ra1; *(float4*)dv = rd0; *(float4*)(dv + 4) = rd1;
        unpack8(rcu, rc); unpack8(kcu, kc); unpack8(rpu, rp); unpack8(kpu, kp);
        float ss = 0.f; alignas(16) float o1[8]; alignas(16) float o2[8]; alignas(16) float o3[8]; alignas(16) float o4[8];
#pragma unroll
        for (int e = 0; e < 8; ++e) {
            o1[e] = rc[e] + mur[e] * (rp[e] - rc[e]);
            kl[e] = kc[e] + muk[e] * (kp[e] - kc[e]);
            kkr[e] = kl[e] * kkc[e]; ss += kkr[e] * kkr[e];
        }
        *(LAS f32x4*)(sR + tt * 64 + cg8) = *(f32x4*)o1; *(LAS f32x4*)(sR + tt * 64 + cg8 + 4) = *(f32x4*)(o1 + 4);
        *(LAS f32x4*)(sW + tt * 64 + cg8) = *(f32x4*)dv; *(LAS f32x4*)(sW + tt * 64 + cg8 + 4) = *(f32x4*)(dv + 4);
        ss += dppf<0xB1>(ss); ss += dppf<0x4E>(ss); ss += dppf<0x141>(ss);
        const float inv = 1.f / fmaxf(sqrtf(ss), 1e-12f);
#pragma unroll
        for (int e = 0; e < 8; ++e) {
            const float kk = kkr[e] * inv;
            o2[e] = kl[e] * (1.f + (av[e] - 1.f) * kac[e]); o3[e] = -kk; o4[e] = kk * av[e];
        }
        if (rq == 0) {
            float bs = 0.f;
#pragma unroll
            for (int e = 0; e < 8; ++e) bs += o1[e] * o2[e] * rkc[e];
            bs += dppf<0xB1>(bs); bs += dppf<0x4E>(bs); bs += dppf<0x141>(bs);
            if ((ptid & 7) == 0) P->bon[(size_t)(b * SEQL + c * 32 + tt) * 8 + h] = bs;
        }
        *(LAS f32x4*)(sK + tt * 64 + cg8) = *(f32x4*)o2; *(LAS f32x4*)(sK + tt * 64 + cg8 + 4) = *(f32x4*)(o2 + 4);
        *(LAS f32x4*)(sNK + tt * 64 + cg8) = *(f32x4*)o3; *(LAS f32x4*)(sNK + tt * 64 + cg8 + 4) = *(f32x4*)(o3 + 4);
        *(LAS f32x4*)(sB + tt * 64 + cg8) = *(f32x4*)o4; *(LAS f32x4*)(sB + tt * 64 + cg8 + 4) = *(f32x4*)(o4 + 4);
        *(LAS f32x2*)(sV + tt * 16 + c2) = (f32x2){rv2.x, rv2.y};
    };
    auto flush = [&](int c, ldsf buf) {
        const LAS f32x4* yp = (const LAS f32x4*)(buf + 10752 + (tt * 16 + c2) * 16);
        const f32x4 s0 = (yp[0] + yp[1]) + (yp[2] + yp[3]), s1 = (yp[4] + yp[5]) + (yp[6] + yp[7]);
        *(unsigned*)(P->proj + (size_t)(b * SEQL + c * 32 + tt) * LDP + C.rw + 1024 + h * 64 + rq * 16 + c2) = pack2((s0.x + s0.y) + (s0.z + s0.w), (s1.x + s1.y) + (s1.z + s1.w));
    };
    f32x2 S[2] = {{0.f, 0.f}, {0.f, 0.f}};
    if (producer) { issue(0); fill(0, lds); issue(1); }
    lds_barrier();
    for (int c = 0; c < 64; ++c) {
        const ldsf cur = lds + (c & 1) * BUF, nxt = lds + ((c + 1) & 1) * BUF;
        if (producer) {
            if (c + 1 < 64) fill(c + 1, nxt);
            if (c > 0) flush(c - 1, nxt);
            if (c + 2 < 64) issue(c + 2);
        } else {
            const ldsf sR = cur, sK = cur + 2048, sW = cur + 4096, sNK = cur + 6144, sB = cur + 8192, sV = cur + 10240, sYp = cur + 10752 + ri * 16 + (tid & 15);
            struct Vecs { f32x4 nk, w, b, k, r; float vi; };
            auto ldv = [&](int t) { Vecs v;
                v.nk = *(const LAS f32x4*)(sNK + t * 64 + js); v.w = *(const LAS f32x4*)(sW + t * 64 + js); v.b = *(const LAS f32x4*)(sB + t * 64 + js);
                v.k = *(const LAS f32x4*)(sK + t * 64 + js); v.r = *(const LAS f32x4*)(sR + t * 64 + js); v.vi = sV[t * 16 + ri]; return v; };
            Vecs cur_v = ldv(0), nx1 = ldv(1);
            for (int t16 = 0; t16 < 2; ++t16) {
#pragma unroll
                for (int u = 0; u < 16; ++u) {
                    const int t = t16 * 16 + u;
                    const Vecs nxt = ldv((t + 2) & 31);
                    f32x2 s2 = S[0] * cur_v.nk.xy; s2 = S[1] * cur_v.nk.zw + s2;
                    const float sa = reduce16(s2.x + s2.y);
                    const f32x2 sav = {sa, sa}, viv = {cur_v.vi, cur_v.vi};
                    f32x2 t0 = viv * cur_v.k.xy; t0 = sav * cur_v.b.xy + t0; S[0] = S[0] * cur_v.w.xy + t0;
                    f32x2 t1 = viv * cur_v.k.zw; t1 = sav * cur_v.b.zw + t1; S[1] = S[1] * cur_v.w.zw + t1;
                    f32x2 y2 = S[0] * cur_v.r.xy; y2 = S[1] * cur_v.r.zw + y2;
                    sYp[t * 256] = y2.x + y2.y;
                    cur_v = nx1; nx1 = nxt;
                }
            }
        }
        lds_barrier();
    }
    if (producer) flush(63, lds + BUF);
    __syncthreads();
}

__device__ __forceinline__ void mlstm_item(CP P, int l, int it, ldsf lds) {
    const Cols C = cols(l); const int tid = opaque_tid(), wave = tid >> 6, lane = tid & 63, li = lane & 15, kq = lane >> 4;
    const int b = it >> 4, h = (it >> 2) & 3, es = it & 3;
    constexpr int QS = 136, SS = 72;
    const ldsh Qb = (ldsh)lds, Kb = Qb + 64 * QS, Ktb = Kb + 64 * QS, Vtb = Ktb + 128 * SS, Vwtb = Vtb + 32 * SS, Attb = Vwtb + 32 * SS, Ctb = Attb + 64 * SS, nbb = Ctb + 2 * 32 * QS, wendb = nbb + 2 * 128;
    const ldsf sCum = (ldsf)(wendb + 64), sLi = sCum + 64, sWend = sLi + 64, sMl = sWend + 64, sWint = sMl + 64, sScal = sWint + 64;
    const float* cw = LP(P, l, I_ML_CW); const float* cb = LP(P, l, I_ML_CB);
    const float igb = LP(P, l, I_ML_IGB)[h], fgb = LP(P, l, I_ML_FGB)[h];
    for (int e = tid; e < 64 * SS / 2; e += 512) ((LAS unsigned*)Attb)[e] = 0u;
    for (int e = tid; e < (2 * 32 * QS + 2 * 128) / 2; e += 512) ((LAS unsigned*)Ctb)[e] = 0u;
    float m_prev = 0.f;
    f32x4 Cm[2], nm[2];
#pragma unroll
    for (int q = 0; q < 2; ++q) { Cm[q] = (f32x4){0.f, 0.f, 0.f, 0.f}; nm[q] = Cm[q]; }
    const int cgp = tid & 31, rseg = tid >> 5, isk = cgp >> 4, d0 = (cgp & 15) * 8, col0 = isk * 512 + h * 128 + d0;
    const ldsh cdst = isk ? Kb : Qb; const float cscale = isk ? 0.08838834764831845f : 1.f;
    const bf16x8 ones8 = {(short)0x3F80, (short)0x3F80, (short)0x3F80, (short)0x3F80, (short)0x3F80, (short)0x3F80, (short)0x3F80, (short)0x3F80};
    uint4 raw[7]; uint4 vraw = make_uint4(0u, 0u, 0u, 0u); bf16_t gi_bits = 0, gf_bits = 0;
    auto issue_loads = [&](int nn) {
#pragma unroll
        for (int i = 0; i < 7; ++i) {
            const int ts = nn * 64 + rseg * 4 - 3 + i;
            raw[i] = (ts >= 0) ? *(const uint4*)(P->proj + (size_t)(b * SEQL + ts) * LDP + C.mqk + col0) : make_uint4(0u, 0u, 0u, 0u);
        }
        if (tid < 256) vraw = *(const uint4*)(P->proj + (size_t)(b * SEQL + nn * 64 + (tid >> 2)) * LDP + C.mv + h * 128 + es * 32 + (tid & 3) * 8);
        if (wave == 0) { const bf16_t* gp = P->proj + (size_t)(b * SEQL + nn * 64 + lane) * LDP; gi_bits = gp[C.mi + h]; gf_bits = gp[C.mf + h]; }
    };
    bf16_t pend[4] = {0, 0, 0, 0};
    auto store_pend = [&](int nprev) {
        const int tl = wave >> 1, te = wave & 1;
#pragma unroll
        for (int j = 0; j < 4; ++j) P->proj[(size_t)(b * SEQL + nprev * 64 + tl * 16 + kq * 4 + j) * LDP + C.mv + h * 128 + es * 32 + te * 16 + li] = pend[j];
    };
    issue_loads(0);
    alignas(16) float wreg[4][8]; alignas(16) float breg[8];
    *(float4*)breg = *(const float4*)(cb + col0); *(float4*)(breg + 4) = *(const float4*)(cb + col0 + 4);
#pragma unroll
    for (int j = 0; j < 4; ++j) { *(float4*)wreg[j] = *(const float4*)(cw + j * 1024 + col0); *(float4*)(wreg[j] + 4) = *(const float4*)(cw + j * 1024 + col0 + 4); }
    __syncthreads();
    for (int n = 0; n < 32; ++n) {
        const int t0 = b * SEQL + n * 64, pb = n & 1;
        {
            float acc[4][8];
#pragma unroll
            for (int r = 0; r < 4; ++r)
#pragma unroll
                for (int e = 0; e < 8; ++e) acc[r][e] = breg[e];
#pragma unroll
            for (int i = 0; i < 7; ++i) {
                float f[8]; unpack8(raw[i], f);
#pragma unroll
                for (int r = 0; r < 4; ++r) { const int j = i - r; if (j >= 0 && j < 4) {
#pragma unroll
                    for (int e = 0; e < 8; ++e) acc[r][e] += wreg[j][e] * f[e]; } }
            }
#pragma unroll
            for (int r = 0; r < 4; ++r) {
#pragma unroll
                for (int e = 0; e < 8; ++e) acc[r][e] = siluf(acc[r][e]) * cscale;
                u32x4 o; o.x = pk2(acc[r][0], acc[r][1]); o.y = pk2(acc[r][2], acc[r][3]); o.z = pk2(acc[r][4], acc[r][5]); o.w = pk2(acc[r][6], acc[r][7]);
                *(LAS u32x4*)(cdst + (rseg * 4 + r) * QS + d0) = o;
            }
            if (isk) {
#pragma unroll
                for (int e = 0; e < 8; ++e) { u32x2 o; o.x = pk2(acc[0][e], acc[1][e]); o.y = pk2(acc[2][e], acc[3][e]); *(LAS u32x2*)(Ktb + (d0 + e) * SS + rseg * 4) = o; }
            }
            if (tid < 256) {
                const LAS bf16_t* vs = (const LAS bf16_t*)0; (void)vs;
                const unsigned w4[4] = {vraw.x, vraw.y, vraw.z, vraw.w};
#pragma unroll
                for (int e = 0; e < 8; ++e) Vtb[((tid & 3) * 8 + e) * SS + (tid >> 2)] = (bf16_t)((e & 1) ? (w4[e >> 1] >> 16) : (w4[e >> 1] & 0xffffu));
            }
        }
        if (wave == 0) {
            const int s = lane;
            const float lgi = bf2f(gi_bits) + igb;
            const float lf = logsigmoidf(bf2f(gf_bits) + fgb);
            const float cum = scan_add64(lf, lane);
            const float last = rdlane(cum, 63);
            const float g = last - cum + lgi; const float gmax = rdlane(scan_max64(g, lane), 63);
            const float pm = scan_max64(lgi - cum, lane);
            const float minter = cum + m_prev; const float ml = fmaxf(minter, cum + pm);
            const float we = __expf(g - gmax);
            sCum[s] = cum; sLi[s] = lgi; sWend[s] = we; wendb[s] = f2bf(we); sMl[s] = ml; sWint[s] = __expf(minter - ml);
            if (lane == 0) { sScal[0] = last; sScal[1] = gmax; }
        }
        if (n > 0) store_pend(n - 1);
        if (n + 1 < 32) issue_loads(n + 1);
        lds_barrier();
        if (tid < 256) {
            const int e = tid >> 3, sg = (tid & 7) * 8;
            float f[8]; unpack8v(*(const LAS u32x4*)(Vtb + e * SS + sg), f);
            u32x4 o; o.x = pk2(f[0] * sWend[sg], f[1] * sWend[sg + 1]); o.y = pk2(f[2] * sWend[sg + 2], f[3] * sWend[sg + 3]);
            o.z = pk2(f[4] * sWend[sg + 4], f[5] * sWend[sg + 5]); o.w = pk2(f[6] * sWend[sg + 6], f[7] * sWend[sg + 7]);
            *(LAS u32x4*)(Vwtb + e * SS + sg) = o;
        }
        for (int idx = wave; idx < 10; idx += 8) {
            int tl, ts; tri_tile(idx, tl, ts);
            const f32x4 a = mmb(128, Qb + tl * 16 * QS, QS, Kb + ts * 16 * QS, QS, (f32x4){0.f, 0.f, 0.f, 0.f}, li, kq);
#pragma unroll
            for (int j = 0; j < 4; ++j) {
                const int lr = tl * 16 + kq * 4 + j, sc = ts * 16 + li;
                Attb[lr * SS + sc] = f2bf((sc <= lr) ? a[j] * __expf(sCum[lr] - sCum[sc] + sLi[sc] - sMl[lr]) : 0.f);
            }
        }
        lds_barrier();
        {
            const int tl = wave >> 1, te = wave & 1;
            f32x4 a1 = {0.f, 0.f, 0.f, 0.f}, ad = a1, a2 = a1, aq = a1;
            {
                const LAS bf16_t* pa = Attb + (tl * 16 + li) * SS + kq * 8; const LAS bf16_t* pv = Vtb + (te * 16 + li) * SS + kq * 8;
#pragma unroll
                for (int k0 = 0; k0 < 64; k0 += 32) { const bf16x8 av = *(const LAS bf16x8*)(pa + k0);
                    a1 = __builtin_amdgcn_mfma_f32_16x16x32_bf16(av, *(const LAS bf16x8*)(pv + k0), a1, 0, 0, 0); ad = __builtin_amdgcn_mfma_f32_16x16x32_bf16(av, ones8, ad, 0, 0, 0); }
                const LAS bf16_t* pq = Qb + (tl * 16 + li) * QS + kq * 8; const LAS bf16_t* pc = Ctb + pb * 32 * QS + (te * 16 + li) * QS + kq * 8; const LAS bf16_t* pn = nbb + pb * 128 + kq * 8;
#pragma unroll
                for (int k0 = 0; k0 < 128; k0 += 32) { const bf16x8 av = *(const LAS bf16x8*)(pq + k0);
                    a2 = __builtin_amdgcn_mfma_f32_16x16x32_bf16(av, *(const LAS bf16x8*)(pc + k0), a2, 0, 0, 0); aq = __builtin_amdgcn_mfma_f32_16x16x32_bf16(av, *(const LAS bf16x8*)(pn + k0), aq, 0, 0, 0); }
            }
#pragma unroll
            for (int j = 0; j < 4; ++j) {
                const int lr = tl * 16 + kq * 4 + j, e = te * 16 + li;
                const float wi = sWint[lr];
                const float den = fmaxf(fabsf(ad[j] + wi * aq[j]), __expf(-sMl[lr]));
                const float hv = (a1[j] + wi * a2[j]) / den;
                pend[j] = f2bf(hv);
            }
            const float last = sScal[0], gmax = sScal[1];
            const float m_new = fmaxf(last + m_prev, gmax), a_old = __expf(last + m_prev - m_new), a_new = __expf(gmax - m_new);
#pragma unroll
            for (int q = 0; q < 2; ++q) {
                const int tile = wave + q * 8, td = tile >> 1, te2 = tile & 1;
                const LAS bf16_t* pk = Ktb + (td * 16 + li) * SS + kq * 8; const LAS bf16_t* pv = Vwtb + (te2 * 16 + li) * SS + kq * 8; const LAS bf16_t* pw = wendb + kq * 8;
                f32x4 a = {0.f, 0.f, 0.f, 0.f}, an = a;
#pragma unroll
                for (int k0 = 0; k0 < 64; k0 += 32) { const bf16x8 av = *(const LAS bf16x8*)(pk + k0);
                    a = __builtin_amdgcn_mfma_f32_16x16x32_bf16(av, *(const LAS bf16x8*)(pv + k0), a, 0, 0, 0);
                    if (te2 == 0) an = __builtin_amdgcn_mfma_f32_16x16x32_bf16(av, *(const LAS bf16x8*)(pw + k0), an, 0, 0, 0); }
                Cm[q] = Cm[q] * a_old + a * a_new;
                u32x2 o; o.x = pk2(Cm[q][0], Cm[q][1]); o.y = pk2(Cm[q][2], Cm[q][3]);
                *(LAS u32x2*)(Ctb + (pb ^ 1) * 32 * QS + (te2 * 16 + li) * QS + td * 16 + kq * 4) = o;
                if (te2 == 0) {
                    nm[q] = nm[q] * a_old + an * a_new;
                    if (li == 0) { u32x2 o2; o2.x = pk2(nm[q][0], nm[q][1]); o2.y = pk2(nm[q][2], nm[q][3]); *(LAS u32x2*)(nbb + (pb ^ 1) * 128 + td * 16 + kq * 4) = o2; }
                }
            }
            m_prev = m_new;
        }
        lds_barrier();
    }
    store_pend(31);
}

__device__ __forceinline__ void ssd_item(CP P, int l, int it, ldsf lds) {
    const Cols C = cols(l); const int tid = opaque_tid(), wave = tid >> 6, lane = tid & 63, li = lane & 15, kq = lane >> 4;
    const int b = it >> 3, hh = it & 7, g = hh >> 2;
    constexpr int QS = 136, SS = 72;
    const ldsh Cmb = (ldsh)lds, Bmb = Cmb + 64 * QS, Bmtb = Bmb + 64 * QS, Lcb = Bmtb + 128 * SS, Xdtt = Lcb + 64 * SS, Xett = Xdtt + 64 * SS, Sb = Xett + 64 * SS;
    const ldsf sXr = (ldsf)(Sb + 2 * 64 * QS), sX = sXr + 67 * 64, sCum = sX + 64 * 65, sDt = sCum + 64, sE = sDt + 64, sEc = sE + 64, sScal = sEc + 64;
    const float* cw = LP(P, l, I_SSD_CW); const float* cb = LP(P, l, I_SSD_CB);
    const float Aneg = -expf(LP(P, l, I_SSD_ALOG)[hh]), dtb = LP(P, l, I_SSD_DTB)[hh], dsk = LP(P, l, I_SSD_D)[hh];
    for (int e = tid; e < 64 * SS / 2; e += 512) ((LAS unsigned*)Lcb)[e] = 0u;
    for (int e = tid; e < 2 * 64 * QS / 2; e += 512) ((LAS unsigned*)Sb)[e] = 0u;
    float hv = 0.f;
    f32x4 Sm[4];
#pragma unroll
    for (int q = 0; q < 4; ++q) Sm[q] = (f32x4){0.f, 0.f, 0.f, 0.f};
    const int cgp = tid & 31, rseg = tid >> 5, isc = cgp >> 4, n0 = (cgp & 15) * 8, col0 = 512 + isc * 256 + g * 128 + n0;
    const ldsh cdst = isc ? Cmb : Bmb;
    const int xcol = hh * 64 + (tid & 63);
    const float cb0 = cb[xcol], w0 = cw[xcol], w1 = cw[1024 + xcol], w2 = cw[2048 + xcol], w3 = cw[3072 + xcol];
    uint4 raw[7]; uint4 xraw = make_uint4(0u, 0u, 0u, 0u); bf16_t dt_bits = 0;
    auto issue_loads = [&](int nn) {
#pragma unroll
        for (int i = 0; i < 7; ++i) {
            const int ts = nn * 64 + rseg * 4 - 3 + i;
            raw[i] = (ts >= 0) ? *(const uint4*)(P->proj + (size_t)(b * SEQL + ts) * LDP + C.sx + col0) : make_uint4(0u, 0u, 0u, 0u);
        }
        xraw = *(const uint4*)(P->proj + (size_t)(b * SEQL + nn * 64 + (tid >> 3)) * LDP + C.sx + hh * 64 + (tid & 7) * 8);
        if (wave == 0) dt_bits = P->proj[(size_t)(b * SEQL + nn * 64 + lane) * LDP + C.sdt + hh];
    };
    bf16_t pend[2][4] = {{0, 0, 0, 0}, {0, 0, 0, 0}};
    auto store_pend = [&](int nprev) {
#pragma unroll
        for (int q = 0; q < 2; ++q) { const int tile = wave + q * 8, tl = tile >> 2, tp = tile & 3;
#pragma unroll
            for (int j = 0; j < 4; ++j) P->proj[(size_t)(b * SEQL + nprev * 64 + tl * 16 + kq * 4 + j) * LDP + C.sx + hh * 64 + tp * 16 + li] = pend[q][j]; }
    };
    issue_loads(0);
    alignas(16) float wreg[4][8]; alignas(16) float breg[8];
    *(float4*)breg = *(const float4*)(cb + col0); *(float4*)(breg + 4) = *(const float4*)(cb + col0 + 4);
#pragma unroll
    for (int j = 0; j < 4; ++j) { *(float4*)wreg[j] = *(const float4*)(cw + j * 1024 + col0); *(float4*)(wreg[j] + 4) = *(const float4*)(cw + j * 1024 + col0 + 4); }
    __syncthreads();
    for (int n = 0; n < 32; ++n) {
        const int t0 = b * SEQL + n * 64, pb = n & 1;
        if (tid < 192) sXr[tid] = hv;
        {
            float acc[4][8];
#pragma unroll
            for (int r = 0; r < 4; ++r)
#pragma unroll
                for (int e = 0; e < 8; ++e) acc[r][e] = breg[e];
#pragma unroll
            for (int i = 0; i < 7; ++i) {
                float f[8]; unpack8(raw[i], f);
#pragma unroll
                for (int r = 0; r < 4; ++r) { const int j = i - r; if (j >= 0 && j < 4) {
#pragma unroll
                    for (int e = 0; e < 8; ++e) acc[r][e] += wreg[j][e] * f[e]; } }
            }
#pragma unroll
            for (int r = 0; r < 4; ++r) {
#pragma unroll
                for (int e = 0; e < 8; ++e) acc[r][e] = siluf(acc[r][e]);
                u32x4 o; o.x = pk2(acc[r][0], acc[r][1]); o.y = pk2(acc[r][2], acc[r][3]); o.z = pk2(acc[r][4], acc[r][5]); o.w = pk2(acc[r][6], acc[r][7]);
                *(LAS u32x4*)(cdst + (rseg * 4 + r) * QS + n0) = o;
            }
            if (!isc) {
#pragma unroll
                for (int e = 0; e < 8; ++e) { u32x2 o; o.x = pk2(acc[0][e], acc[1][e]); o.y = pk2(acc[2][e], acc[3][e]); *(LAS u32x2*)(Bmtb + (n0 + e) * SS + rseg * 4) = o; }
            }
            { float f[8]; unpack8(xraw, f);
#pragma unroll
                for (int e = 0; e < 8; ++e) sXr[((tid >> 3) + 3) * 64 + (tid & 7) * 8 + e] = f[e]; }
        }
        if (wave == 0) {
            const float dt = softplusf(bf2f(dt_bits) + dtb);
            const float cum = scan_add64(dt * Aneg, lane);
            const float last = rdlane(cum, 63);
            sDt[lane] = dt; sCum[lane] = cum; sE[lane] = __expf(last - cum); sEc[lane] = __expf(cum);
            if (lane == 0) sScal[0] = __expf(last);
        }
        if (n > 0) store_pend(n - 1);
        if (n + 1 < 32) issue_loads(n + 1);
        lds_barrier();
        {
            const int p = tid & 63, mseg = tid >> 6;
            float xr[11];
#pragma unroll
            for (int i = 0; i < 11; ++i) xr[i] = sXr[(mseg * 8 + i) * 64 + p];
            float xd[8], xe[8];
#pragma unroll
            for (int r = 0; r < 8; ++r) {
                const int mm = mseg * 8 + r;
                const float x = siluf(cb0 + w0 * xr[r] + w1 * xr[r + 1] + w2 * xr[r + 2] + w3 * xr[r + 3]);
                sX[mm * 65 + p] = x; xd[r] = x * sDt[mm]; xe[r] = xd[r] * sE[mm];
            }
            u32x4 o; o.x = pk2(xd[0], xd[1]); o.y = pk2(xd[2], xd[3]); o.z = pk2(xd[4], xd[5]); o.w = pk2(xd[6], xd[7]); *(LAS u32x4*)(Xdtt + p * SS + mseg * 8) = o;
            o.x = pk2(xe[0], xe[1]); o.y = pk2(xe[2], xe[3]); o.z = pk2(xe[4], xe[5]); o.w = pk2(xe[6], xe[7]); *(LAS u32x4*)(Xett + p * SS + mseg * 8) = o;
        }
        for (int idx = wave; idx < 10; idx += 8) {
            int tl, ts; tri_tile(idx, tl, ts);
            const f32x4 a = mmb(128, Cmb + tl * 16 * QS, QS, Bmb + ts * 16 * QS, QS, (f32x4){0.f, 0.f, 0.f, 0.f}, li, kq);
#pragma unroll
            for (int j = 0; j < 4; ++j) {
                const int lr = tl * 16 + kq * 4 + j, sc = ts * 16 + li;
                Lcb[lr * SS + sc] = f2bf((sc <= lr) ? a[j] * __expf(sCum[lr] - sCum[sc]) : 0.f);
            }
        }
        lds_barrier();
        {
            const f32x4 z4 = {0.f, 0.f, 0.f, 0.f};
#pragma unroll
            for (int q = 0; q < 2; ++q) {
                const int tile = wave + q * 8, tl = tile >> 2, tp = tile & 3;
                const f32x4 a1 = mmb(64, Lcb + tl * 16 * SS, SS, Xdtt + tp * 16 * SS, SS, z4, li, kq);
                const f32x4 a2 = mmb(128, Cmb + tl * 16 * QS, QS, Sb + pb * 64 * QS + tp * 16 * QS, QS, z4, li, kq);
#pragma unroll
                for (int j = 0; j < 4; ++j) {
                    const int lr = tl * 16 + kq * 4 + j, p = tp * 16 + li;
                    const float y = a1[j] + sEc[lr] * a2[j] + dsk * sX[lr * 65 + p];
                    pend[q][j] = f2bf(y);
                }
            }
            const float elast = sScal[0];
#pragma unroll
            for (int q = 0; q < 4; ++q) {
                const int tile = wave + q * 8, tp2 = tile & 3, tn = tile >> 2;
                const f32x4 a = mmb(64, Xett + tp2 * 16 * SS, SS, Bmtb + tn * 16 * SS, SS, z4, li, kq);
                Sm[q] = Sm[q] * elast + a;
#pragma unroll
                for (int j = 0; j < 4; ++j) Sb[(pb ^ 1) * 64 * QS + (tp2 * 16 + kq * 4 + j) * QS + tn * 16 + li] = f2bf(Sm[q][j]);
            }
            if (tid < 192) hv = sXr[64 * 64 + tid];
        }
        lds_barrier();
    }
    store_pend(31);
}

__device__ __forceinline__ void gla_item(CP P, int l, int it, ldsf lds) {
    const int tid = opaque_tid(), wave = tid >> 6, lane = tid & 63, li = lane & 15, kq = lane >> 4;
    const int b = it >> 3, h = (it >> 1) & 3, vs = it & 1;
    constexpr int SS = 72;
    const ldsh Qgb = (ldsh)lds, Kgb = Qgb + 64 * SS, Kgtb = Kgb + 64 * SS, Vtb = Kgtb + 64 * SS, Attb = Vtb + 64 * SS, Stb = Attb + 64 * SS;
    const ldsf sQ = (ldsf)(Stb + 2 * 64 * SS), sK = sQ + 64 * 65, sCum = sK + 64 * 65, sGl = sCum + 64 * 65, sW2 = sGl + 64 * 17, sGb = sW2 + 16 * 64, sSeg = sGb + 64, sDec = sSeg + 8 * 64;
    const float* gw2 = LP(P, l, I_GK_W2); const float* gb = LP(P, l, I_GK_B);
    for (int e = tid; e < 16 * 64; e += 512) sW2[e] = gw2[(e >> 6) * 256 + h * 64 + (e & 63)];
    if (tid < 64) sGb[tid] = gb[h * 64 + tid];
    for (int e = tid; e < 64 * SS / 2; e += 512) ((LAS unsigned*)Attb)[e] = 0u;
    for (int e = tid; e < 2 * 64 * SS / 2; e += 512) ((LAS unsigned*)Stb)[e] = 0u;
    f32x4 Sm[2] = {{0.f, 0.f, 0.f, 0.f}, {0.f, 0.f, 0.f, 0.f}};
    uint4 qraw, kraw, xr, gr = make_uint4(0u, 0u, 0u, 0u);
    auto issue_loads = [&](int nn) {
        const int row = tid >> 3, cg = (tid & 7) * 8; const bf16_t* pr = P->proj + (size_t)(b * SEQL + nn * 64 + row) * LDP + h * 64 + cg;
        qraw = *(const uint4*)(pr + C_GQ); kraw = *(const uint4*)(pr + C_GK);
        xr = *(const uint4*)(P->proj + (size_t)(b * SEQL + nn * 64 + row) * LDP + C_GV + h * 128 + vs * 64 + cg);
        if (tid < 128) gr = *(const uint4*)(P->proj + (size_t)(b * SEQL + nn * 64 + (tid >> 1)) * LDP + C_GGK + (tid & 1) * 8);
    };
    bf16_t pend[2][4] = {{0, 0, 0, 0}, {0, 0, 0, 0}};
    auto store_pend = [&](int nprev) {
#pragma unroll
        for (int q = 0; q < 2; ++q) { const int tile = wave + q * 8, tl = tile >> 2, tv = tile & 3;
#pragma unroll
            for (int j = 0; j < 4; ++j) P->proj[(size_t)(b * SEQL + nprev * 64 + tl * 16 + kq * 4 + j) * LDP + C_GV + h * 128 + vs * 64 + tv * 16 + li] = pend[q][j]; }
    };
    issue_loads(0);
    __syncthreads();
    for (int n = 0; n < 32; ++n) {
        const int t0 = b * SEQL + n * 64, pb = n & 1;
        {
            const int row = tid >> 3, cg = (tid & 7) * 8;
            float f[8]; unpack8(qraw, f);
#pragma unroll
            for (int e = 0; e < 8; ++e) sQ[row * 65 + cg + e] = f[e] * 0.125f;
            unpack8(kraw, f);
#pragma unroll
            for (int e = 0; e < 8; ++e) sK[row * 65 + cg + e] = f[e];
            {
                const unsigned w4[4] = {xr.x, xr.y, xr.z, xr.w};
#pragma unroll
                for (int e = 0; e < 8; ++e) Vtb[(cg + e) * SS + row] = (bf16_t)((e & 1) ? (w4[e >> 1] >> 16) : (w4[e >> 1] & 0xffffu));
            }
            if (tid < 128) {
                unpack8(gr, f);
#pragma unroll
                for (int e = 0; e < 8; ++e) sGl[(tid >> 1) * 17 + (tid & 1) * 8 + e] = f[e];
            }
        }
        if (n > 0) store_pend(n - 1);
        if (n + 1 < 32) issue_loads(n + 1);
        lds_barrier();
        for (int e = tid; e < 4096; e += 512) {
            const int s = e >> 6, d = e & 63; float gk = sGb[d];
#pragma unroll
            for (int r = 0; r < 16; ++r) gk += sGl[s * 17 + r] * sW2[r * 64 + d];
            sCum[s * 65 + d] = logsigmoid_fast(gk) * 0.0625f;
        }
        lds_barrier();
        const int d = tid & 63, seg = tid >> 6;
        {
            float run = 0.f;
#pragma unroll
            for (int r = 0; r < 8; ++r) { run += sCum[(seg * 8 + r) * 65 + d]; sCum[(seg * 8 + r) * 65 + d] = run; }
            sSeg[seg * 64 + d] = run;
        }
        lds_barrier();
        {
            float off = 0.f;
            for (int s2 = 0; s2 < seg; ++s2) off += sSeg[s2 * 64 + d];
            float kg[8];
#pragma unroll
            for (int r = 0; r < 8; ++r) {
                const int s = seg * 8 + r; const float c = sCum[s * 65 + d] + off;
                const float ec = __expf(c);
                Qgb[s * SS + d] = f2bf(sQ[s * 65 + d] * ec);
                kg[r] = sK[s * 65 + d] * __expf(-c);
                Kgb[s * SS + d] = f2bf(kg[r]);
                if (s == 63) sDec[d] = ec;
            }
            u32x4 o; o.x = pk2(kg[0], kg[1]); o.y = pk2(kg[2], kg[3]); o.z = pk2(kg[4], kg[5]); o.w = pk2(kg[6], kg[7]);
            *(LAS u32x4*)(Kgtb + d * SS + seg * 8) = o;
        }
        lds_barrier();
        for (int idx = wave; idx < 10; idx += 8) {
            int tl, ts; tri_tile(idx, tl, ts);
            const f32x4 a = mmb(64, Qgb + tl * 16 * SS, SS, Kgb + ts * 16 * SS, SS, (f32x4){0.f, 0.f, 0.f, 0.f}, li, kq);
#pragma unroll
            for (int j = 0; j < 4; ++j) { const int lr = tl * 16 + kq * 4 + j, sc = ts * 16 + li; Attb[lr * SS + sc] = f2bf((sc <= lr) ? a[j] : 0.f); }
        }
        lds_barrier();
        {
            const f32x4 z4 = {0.f, 0.f, 0.f, 0.f};
#pragma unroll
            for (int q = 0; q < 2; ++q) {
                const int tile = wave + q * 8, tl = tile >> 2, tv = tile & 3;
                f32x4 a = mmb(64, Attb + tl * 16 * SS, SS, Vtb + tv * 16 * SS, SS, z4, li, kq);
                a = mmb(64, Qgb + tl * 16 * SS, SS, Stb + pb * 64 * SS + tv * 16 * SS, SS, a, li, kq);
#pragma unroll
                for (int j = 0; j < 4; ++j) pend[q][j] = f2bf(a[j]);
            }
#pragma unroll
            for (int q = 0; q < 2; ++q) {
                const int tile = wave + q * 8, td = tile >> 2, tv = tile & 3;
                const f32x4 u = mmb(64, Kgtb + td * 16 * SS, SS, Vtb + tv * 16 * SS, SS, z4, li, kq);
#pragma unroll
                for (int j = 0; j < 4; ++j) Sm[q][j] = sDec[td * 16 + kq * 4 + j] * (Sm[q][j] + u[j]);
                u32x2 o; o.x = pk2(Sm[q][0], Sm[q][1]); o.y = pk2(Sm[q][2], Sm[q][3]);
                *(LAS u32x2*)(Stb + (pb ^ 1) * 64 * SS + (tv * 16 + li) * SS + td * 16 + kq * 4) = o;
            }
        }
        lds_barrier();
    }
    store_pend(31);
}

#ifndef ITEM_MASK
#define ITEM_MASK 15
#endif
template <int IM = ITEM_MASK> __device__ __forceinline__ void scan_phase(CP P, int l, ldsf lds) {
    for (int it = blockIdx.x; it < N_ITEMS; it += gridDim.x) {
        if (it < N_RW) { if (IM & 1) rwkv_scan_item(P, l, it, lds); }
        else if (it < N_RW + 64) { if (IM & 2) mlstm_item(P, l, it - N_RW, lds); }
        else if (it < N_RW + 96) { if (IM & 4) ssd_item(P, l, it - N_RW - 64, lds); }
        else { if (IM & 8) gla_item(P, l, it - N_RW - 96, lds); }
        __syncthreads();
    }
}

__device__ __forceinline__ void finalize_phase(CP P, int l) {
    const Cols C = cols(l); const int wave = threadIdx.x >> 6, lane = threadIdx.x & 63, c8 = lane * 8;
    const float* gla_g = LP(P, l, I_GLA_NG); const float* mu = LP(P, l, I_RW_MU); const float* k_a = LP(P, l, I_RW_KA); const float* r_k = LP(P, l, I_RW_RK);
    const float* ln_g = LP(P, l, I_RW_LNG); const float* ln_b = LP(P, l, I_RW_LNB); const float* ssd_g = LP(P, l, I_SSD_NG); const float* ml_g = LP(P, l, I_ML_NG);
    for (int t = blockIdx.x * 8 + wave; t < M_TOK; t += gridDim.x * 8) {
        const bf16_t* pr = P->proj + (size_t)t * LDP; bf16_t* yo = P->actA + (size_t)t * DM;
        float a[8], z[8], y[8];
        {
            load8(pr + C_GV + c8, a); load8(pr + C_GZ + c8, z);
            float ss = 0.f;
#pragma unroll
            for (int e = 0; e < 8; ++e) ss += a[e] * a[e];
            ss += __shfl_xor(ss, 1); ss += __shfl_xor(ss, 2); ss += __shfl_xor(ss, 4); ss += __shfl_xor(ss, 8);
            const float rstd = rsqrtf(ss * (1.f / 128.f) + 1e-6f);
#pragma unroll
            for (int e = 0; e < 8; ++e) y[e] = a[e] * rstd * gla_g[c8 + e] * siluf(z[e]);
            store8(yo + c8, y);
        }
        {
            load8(pr + C.rw + 1024 + c8, a); load8(pr + C.rwz + c8, z);
            float s = 0.f;
#pragma unroll
            for (int e = 0; e < 8; ++e) s += a[e];
            s += __shfl_xor(s, 1); s += __shfl_xor(s, 2); s += __shfl_xor(s, 4);
            const float mean = s * (1.f / 64.f); float vs = 0.f;
#pragma unroll
            for (int e = 0; e < 8; ++e) { a[e] -= mean; vs += a[e] * a[e]; }
            vs += __shfl_xor(vs, 1); vs += __shfl_xor(vs, 2); vs += __shfl_xor(vs, 4);
            const float rstd = rsqrtf(vs * (1.f / 64.f) + 64e-5f);
            alignas(16) float vv[8];
            *(float4*)vv = *(const float4*)(P->rwV + (size_t)t * 512 + c8); *(float4*)(vv + 4) = *(const float4*)(P->rwV + (size_t)t * 512 + c8 + 4);
            const float bs = P->bon[(size_t)t * 8 + (lane >> 3)];
#pragma unroll
            for (int e = 0; e < 8; ++e) y[e] = (a[e] * rstd * ln_g[c8 + e] + ln_b[c8 + e] + bs * vv[e]) * siluf(z[e]);
            store8(yo + 512 + c8, y);
        }
        {
            load8(pr + C.sx + c8, a); load8(pr + C.sz + c8, z);
            float ss = 0.f;
#pragma unroll
            for (int e = 0; e < 8; ++e) { a[e] *= siluf(z[e]); ss += a[e] * a[e]; }
            ss = wave_sum(ss);
            const float rstd = rsqrtf(ss * (1.f / 512.f) + 1e-6f);
#pragma unroll
            for (int e = 0; e < 8; ++e) y[e] = a[e] * rstd * ssd_g[c8 + e];
            store8(yo + 1024 + c8, y);
        }
        {
            float o[8];
            load8(pr + C.mv + c8, a); load8(pr + C.mo + c8, o); load8(pr + C.mz + c8, z);
            float s = 0.f;
#pragma unroll
            for (int e = 0; e < 8; ++e) { a[e] *= sigmoidf_(o[e]); s += a[e]; }
            s += __shfl_xor(s, 1); s += __shfl_xor(s, 2); s += __shfl_xor(s, 4); s += __shfl_xor(s, 8);
            const float mean = s * (1.f / 128.f); float vs = 0.f;
#pragma unroll
            for (int e = 0; e < 8; ++e) { a[e] -= mean; vs += a[e] * a[e]; }
            vs += __shfl_xor(vs, 1); vs += __shfl_xor(vs, 2); vs += __shfl_xor(vs, 4); vs += __shfl_xor(vs, 8);
            const float rstd = rsqrtf(vs * (1.f / 128.f) + 1e-6f);
#pragma unroll
            for (int e = 0; e < 8; ++e) y[e] = a[e] * rstd * ml_g[c8 + e] * siluf(z[e]);
            store8(yo + 1536 + c8, y);
        }
    }
}

__device__ __forceinline__ void final_norm(CP P) {
    const int wave = threadIdx.x >> 6, lane = threadIdx.x & 63; const float* g = P->in[57];
    for (int row = blockIdx.x * 8 + wave; row < M_TOK; row += gridDim.x * 8) {
        float s = (lane < XSSN) ? P->xss2[(size_t)row * XSSN + lane] : 0.f; s = wave_sum(s);
        const float rstd = rsqrtf(s * (1.f / DM) + 1e-6f);
        float4* xr = (float4*)(P->out + (size_t)row * DM); const float4* gr = (const float4*)g;
#pragma unroll
        for (int i = 0; i < 8; ++i) { float4 v = xr[lane + i * 64]; const float4 gg = gr[lane + i * 64]; v.x *= rstd * gg.x; v.y *= rstd * gg.y; v.z *= rstd * gg.z; v.w *= rstd * gg.w; xr[lane + i * 64] = v; }
    }
}

#define XB_TMO      128
#define XB_XCNT(j)  (256  + 64 * (j))
#define XB_XSUB(j)  (1280 + 64 * (j))
#define XB_XGEN(j)  (2304 + 64 * (j))
#define XB_TOP      3328
#define XB_TOPGEN   3392
#define XCD_BAR_WORDS 3456
#define XB_SPIN_CAP (1u << 18)

__device__ __forceinline__ unsigned xb_ld(unsigned* p)              { return __hip_atomic_load(p, __ATOMIC_RELAXED, __HIP_MEMORY_SCOPE_AGENT); }
__device__ __forceinline__ unsigned xb_add(unsigned* p, unsigned v) { return __hip_atomic_fetch_add(p, v, __ATOMIC_RELAXED, __HIP_MEMORY_SCOPE_AGENT); }
__device__ __forceinline__ unsigned xb_xcc_id() { return (unsigned)__builtin_amdgcn_s_getreg((3 << 11) | 20) & 0xFu; }
#define XB_SPIN(cond, bar) do { unsigned _sp = 0; while (cond) { __builtin_amdgcn_s_sleep(1); \
    if ((++_sp & 255u) == 0u) { if (xb_ld(&(bar)[XB_TMO])) break; if (_sp > XB_SPIN_CAP) { atomicAdd(&(bar)[XB_TMO], 1u); break; } } } } while (0)

struct XcdBarrier {
    unsigned* bar; unsigned x;
    volatile LAS unsigned* st;
};

__device__ __forceinline__ XcdBarrier xcd_barrier_post(unsigned* bar, volatile LAS unsigned* st) {
    XcdBarrier b; b.bar = bar; b.x = xb_xcc_id(); b.st = st;
    if (threadIdx.x == 0) (void)xb_add(&bar[XB_XCNT(b.x)], 1u);
    return b;
}
__device__ __forceinline__ void xcd_barrier_complete(unsigned* bar, unsigned x, unsigned& nloc, unsigned& nx) {
    const unsigned G = gridDim.x * gridDim.y * gridDim.z;
    unsigned sum, cnt, mine, sp = 0u;
    for (;;) {
        sum = 0u; cnt = 0u; mine = 0u;
#pragma unroll
        for (unsigned j = 0; j < 16; ++j) { const unsigned c = xb_ld(&bar[XB_XCNT(j)]); sum += c; cnt += (c > 0u) ? 1u : 0u; mine = (j == x) ? c : mine; }
        if (sum == G) break;
        __builtin_amdgcn_s_sleep(1);
        if ((++sp & 255u) == 0u) { if (xb_ld(&bar[XB_TMO])) break; if (sp > XB_SPIN_CAP) { atomicAdd(&bar[XB_TMO], 1u); break; } }
    }
    nloc = mine > 0u ? mine : 1u; nx = cnt > 0u ? cnt : 1u;
}

__device__ __forceinline__ void xcd_barrier(const XcdBarrier& b) {
    asm volatile("s_waitcnt vmcnt(0)" ::: "memory");
    __syncthreads();
    if (threadIdx.x == 0) {
        unsigned* bar = b.bar;
        __builtin_amdgcn_s_waitcnt(0);
        unsigned nloc = b.st[0], nx = b.st[1];
        if (nloc == 0u) { xcd_barrier_complete(bar, b.x, nloc, nx); b.st[0] = nloc; b.st[1] = nx; }
        const unsigned old = xb_add(&bar[XB_XSUB(b.x)], 1u);
        const unsigned gen = old / nloc;
        if (old + 1u == (gen + 1u) * nloc) {
            __builtin_amdgcn_fence(__ATOMIC_RELEASE, "agent");
            asm volatile("s_waitcnt vmcnt(0)" ::: "memory");
            const unsigned og = xb_add(&bar[XB_TOP], 1u);
            const unsigned tg = og / nx;
            if (og + 1u == (tg + 1u) * nx) xb_add(&bar[XB_TOPGEN], 1u);
            else XB_SPIN(xb_ld(&bar[XB_TOPGEN]) == tg, bar);
            __builtin_amdgcn_fence(__ATOMIC_ACQUIRE, "agent");
            xb_add(&bar[XB_XGEN(b.x)], 1u);
            asm volatile("s_waitcnt vmcnt(0)" ::: "memory");
        } else {
            XB_SPIN(xb_ld(&bar[XB_XGEN(b.x)]) == gen, bar);
            __builtin_amdgcn_fence(__ATOMIC_ACQUIRE, "agent");
            asm volatile("s_waitcnt vmcnt(0)" ::: "memory");
        }
    }
    __syncthreads();
}


template <bool PRE> __device__ __forceinline__ void gemm_inproj(CP P, const bf16_t* A, const float* xss, PG8_LAS unsigned char* lds) {
    pg8::Gemm g; g.A = A; g.Bt = P->Wi; g.M = M_TOK; g.N = LDP; g.K = DM;
    pg8::StaticOrder S; S.init(g.M, g.N, (int)gridDim.x, (int)blockIdx.x);
    EpiProj<PRE> E; E.O = P->proj; E.xss = xss;
    pg8::gemm_phase<EpiProj<PRE>, pg8::StaticOrder, false>(lds, g, S, E, nullptr);
}
__device__ __forceinline__ void gemm_outproj(CP P, const bf16_t* Wo, const float* xin, bf16_t* xb, float* xss, PG8_LAS unsigned char* lds) {
    pg8::Gemm g; g.A = P->actA; g.Bt = Wo; g.M = M_TOK; g.N = DM; g.K = DM;
    pg8::StaticOrder S; S.init(g.M, g.N, (int)gridDim.x, (int)blockIdx.x);
    EpiOut E; E.xin = xin; E.xout = P->out; E.xb = xb; E.xss = xss;
    pg8::gemm_phase<EpiOut, pg8::StaticOrder, false>(lds, g, S, E, nullptr);
}

#ifndef PROBE_DUP
#define PROBE_DUP 0
#endif
#ifndef PH_MASK
#define PH_MASK 0xFFF
#endif
#define RUN_PHASE(k, body) do { if ((PH_MASK >> (k)) & 1) { if (ph_lo <= (k) && (k) < ph_hi) { CP P = Pc; asm volatile("" : "+s"(P)); body; if ((PROBE_DUP >> (k)) & 1) { __syncthreads(); body; } if (coop && (k) + 1 < ph_hi) { if (coop == 2) grid.sync(); else xcd_barrier(xb); } } } } while (0)
__global__ void __launch_bounds__(512, 2) mega(Params Pk, int ph_lo, int ph_hi, int coop) {
    extern __shared__ __attribute__((aligned(16))) unsigned char shm[];
    PG8_LAS unsigned char* ldsb = (PG8_LAS unsigned char*)shm; ldsf lds = (ldsf)shm;
    cg::grid_group grid = cg::this_grid();
    const CP Pc = (CP)__builtin_amdgcn_kernarg_segment_ptr();
    volatile LAS unsigned* stw = (volatile LAS unsigned*)(shm + LDS_BYTES - 16);
    if (threadIdx.x < 4) stw[threadIdx.x] = 0u;
    __syncthreads();
    XcdBarrier xb = xcd_barrier_post(Pc->bar, stw);
    RUN_PHASE(0, { transpose_convert(P->in[2], DM, 7840, LDP, P->Wi, P->in[1], lds); x_convert(P); lora_convert(P); });
#ifdef PROBE_PRE
    { CP P = Pc; asm volatile("" : "+s"(P)); gemm_inproj<true>(P, P->actA, P->xss0, ldsb); grid.sync(); rwkv_prep(P, 0, lds); grid.sync(); scan_phase<PROBE_PRE>(P, 0, lds); grid.sync(); }
#endif
    RUN_PHASE(1, { gemm_inproj<true>(P, P->actA, P->xss0, ldsb);
                   const int nfull = (M_TOK / 256) * (LDP / 256) % (int)gridDim.x;
                   if (nfull > 0 && (int)blockIdx.x >= nfull) transpose_convert(P->in[3], DM, DM, DM, P->Wo0, nullptr, lds, (int)blockIdx.x - nfull, (int)gridDim.x - nfull);
                   else if (nfull == 0) transpose_convert(P->in[3], DM, DM, DM, P->Wo0, nullptr, lds); });
    RUN_PHASE(2, rwkv_prep(P, 0, lds));
    RUN_PHASE(3, scan_phase(P, 0, lds));
    RUN_PHASE(4, { finalize_phase(P, 0); transpose_convert(P->in[29], DM, 7872, LDP, P->Wi, P->in[28], lds); });
    RUN_PHASE(5, gemm_outproj(P, P->Wo0, P->in[0], P->xb1, P->xss1, ldsb));
    RUN_PHASE(6, { gemm_inproj<false>(P, P->xb1, P->xss1, ldsb);
                   const int nfull = (M_TOK / 256) * (LDP / 256) % (int)gridDim.x;
                   if (nfull > 0 && (int)blockIdx.x >= nfull) transpose_convert(P->in[30], DM, DM, DM, P->Wo1, nullptr, lds, (int)blockIdx.x - nfull, (int)gridDim.x - nfull);
                   else if (nfull == 0) transpose_convert(P->in[30], DM, DM, DM, P->Wo1, nullptr, lds); });
    RUN_PHASE(7, rwkv_prep(P, 1, lds));
    RUN_PHASE(8, scan_phase(P, 1, lds));
    RUN_PHASE(9, finalize_phase(P, 1));
    RUN_PHASE(10, gemm_outproj(P, P->Wo1, P->out, nullptr, P->xss2, ldsb));
    RUN_PHASE(11, final_norm(P));
}

#ifndef MK_COOP
#define MK_COOP 1
#endif
extern "C" void kernel_launch(void* const* d_in, const int* in_sizes, int n_in, void* d_out, int out_size, void* d_ws, size_t ws_size, hipStream_t stream) {
    Params p{};
    for (int i = 0; i < 58; ++i) p.in[i] = (const float*)d_in[i];
    p.out = (float*)d_out;
    char* w = (char*)d_ws; size_t off = 0;
    auto take = [&](size_t bytes) { char* r = w + off; off += (bytes + 255) & ~(size_t)255; return r; };
    p.Wi = (bf16_t*)take((size_t)LDP * DM * 2);
    p.Wo0 = (bf16_t*)take((size_t)DM * DM * 2);
    p.Wo1 = (bf16_t*)take((size_t)DM * DM * 2);
    p.actA = (bf16_t*)take((size_t)M_TOK * DM * 2);
    p.proj = (bf16_t*)take((size_t)M_TOK * LDP * 2);
    p.rwA = (float*)take((size_t)M_TOK * 512 * 4);
    p.rwB = (float*)take((size_t)M_TOK * 512 * 4);
    p.xb1 = (bf16_t*)p.rwA;
    p.rwV = (float*)take((size_t)M_TOK * 512 * 4);
    p.xss0 = (float*)take((size_t)M_TOK * XSSN * 4);
    p.xss1 = (float*)take((size_t)M_TOK * XSSN * 4);
    p.xss2 = (float*)take((size_t)M_TOK * XSSN * 4);
    p.bar = (unsigned*)take((size_t)XCD_BAR_WORDS * 4);
    p.lora = (bf16_t*)take((size_t)LORA_ELEMS * 2);
    p.bon = (float*)take((size_t)M_TOK * 8 * 4);
    if (off > ws_size) { fprintf(stderr, "workspace too small: need %zu have %zu\n", off, ws_size); return; }
    static int grid_blocks = 0;
    if (!grid_blocks) {
        hipFuncSetAttribute((const void*)mega, hipFuncAttributeMaxDynamicSharedMemorySize, LDS_BYTES);
        int dev = 0, cus = 0, per_cu = 0;
        hipGetDevice(&dev);
        hipDeviceGetAttribute(&cus, hipDeviceAttributeMultiprocessorCount, dev);
        hipOccupancyMaxActiveBlocksPerMultiprocessor(&per_cu, mega, 512, LDS_BYTES);
        if (per_cu > 1) per_cu = 1;
        grid_blocks = cus * per_cu;
        if (grid_blocks <= 0) grid_blocks = 256;
    }
#if MK_COOP
    hipMemsetAsync(p.bar, 0, (size_t)XCD_BAR_WORDS * 4, stream);
    int lo = 0, hi = N_PHASES, coop = 1;
    void* args[] = {&p, &lo, &hi, &coop};
    hipError_t e = hipLaunchCooperativeKernel((const void*)mega, dim3(grid_blocks), dim3(512), args, LDS_BYTES, stream);
    if (e != hipSuccess) fprintf(stderr, "cooperative launch failed: %s (grid %d)\n", hipGetErrorString(e), grid_blocks);
#else
    for (int ph = 0; ph < N_PHASES; ++ph) hipLaunchKernelGGL(mega, dim3(grid_blocks), dim3(512), LDS_BYTES, stream, p, ph, ph + 1, 0);
#endif
}
```

```cpp
#include <hip/hip_runtime.h>
#include <hip/hip_cooperative_groups.h>
#include <cstdio>
namespace cg = cooperative_groups;

namespace pg8 {
#define PG8_LAS __attribute__((address_space(3)))
typedef unsigned short bf16_t;
typedef short bf16x8 __attribute__((ext_vector_type(8)));
typedef float f32x4 __attribute__((ext_vector_type(4)));
typedef unsigned u32x4 __attribute__((ext_vector_type(4)));
constexpr int BM = 256, BK = 64, HALF = 128, HTB = HALF * BK * 2  , STAGE_BYTES = 8 * HTB, NXCD = 8, WGM = 8;

__host__ __device__ __forceinline__ int lds_byte(int r, int c) { const int st = (r >> 4) * 2 + (c >> 5), rr = r & 15, cc = c & 31, ob = rr * 64 + cc * 2; return st * 1024 + (ob ^ (((ob >> 9) & 1) << 5)); }
__host__ __device__ __forceinline__ void stage_rc(int b, int& R, int& C) { const int st = b / 1024, sb = b % 1024, swz = sb ^ (((sb >> 9) & 1) << 5); R = (st >> 1) * 16 + swz / 64; C = (st & 1) * 32 + (swz % 64) / 2; }
__host__ __device__ __forceinline__ int perm32(int rho) { const int n = rho >> 4, i = rho & 15; return 8 * (i >> 2) + 4 * n + (i & 3); }

struct Unit { int pm, pn; };
struct Gemm { const bf16_t* A; const bf16_t* Bt; int M, N, K; };

struct StaticOrder {
    int nM, nN, nwg, G, c;
    __host__ __device__ void init(int M, int N, int G_, int c_) { nM = M / BM; nN = N / BM; nwg = nM * nN; G = G_; c = c_; }
    __host__ __device__ bool next(int i, Unit& u) const {
        const long L = (long)i * G + c; if (L >= nwg) return false;
        int wgid = (int)L; { const int q = nwg / NXCD, r = nwg % NXCD, xcd = wgid % NXCD, off = wgid / NXCD; wgid = (xcd < r ? xcd * (q + 1) : r * (q + 1) + (xcd - r) * q) + off; }
        const int nig = WGM * nN, gid = wgid / nig, fm = gid * WGM, gsz = (nM - fm) < WGM ? (nM - fm) : WGM;
        u.pm = fm + ((wgid % nig) % gsz); u.pn = (wgid % nig) / gsz; return true;
    }
    __device__ __forceinline__ void a_ready(const Unit&) const {}
    __device__ __forceinline__ void done(const Unit&) const {}
};
__device__ __forceinline__ unsigned cvt_pk_bf16(float lo, float hi) { unsigned r; asm volatile("v_cvt_pk_bf16_f32 %0, %1, %2" : "=v"(r) : "v"(lo), "v"(hi)); return r; }
template <class Epi, class Sched, bool STAMP = false>
__device__ __forceinline__ void gemm_phase(PG8_LAS unsigned char* lds, const Gemm g, const Sched& S, const Epi& E, unsigned long long* stamps) {
    const int tid = threadIdx.x, wid = __builtin_amdgcn_readfirstlane(tid >> 6), lane = tid & 63, wr = wid >> 2, wc = wid & 3, fr = lane & 15, fq = lane >> 4;
    const int K = g.K, nt = K / BK;
    int ts_lo = 0, ts_hi = 0, nts = 0; const unsigned long long rt_entry = STAMP ? (unsigned long long)wall_clock64() : 0ull;
#define PG8_STAMP() do { if (STAMP && wid == 0 && nts < 64) { const unsigned long long _c = (unsigned long long)clock64(); \
        ts_lo = (lane == nts) ? (int)(unsigned)_c : ts_lo; ts_hi = (lane == nts) ? (int)(unsigned)(_c >> 32) : ts_hi; ++nts; } } while (0)
    PG8_STAMP();
    unsigned voffA[2], voffB[2];
#pragma unroll
    for (int i = 0; i < 2; ++i) { int R, C; stage_rc(tid * 16 + i * 8192, R, C); const int Rb = Epi::PERM ? ((R & ~31) + perm32(R & 31)) : R;
        voffA[i] = (unsigned)(R * K + C) * 2u; voffB[i] = (unsigned)(Rb * K + C) * 2u; }
    const size_t kstep = (size_t)(BK * 2);
    const size_t hstep = (size_t)HALF * K * 2;
    const size_t tstep = 2 * hstep;
    const unsigned ldsw = (unsigned)wid * 1024u;
    const int aoff = lds_byte(wr * 64 + fr, fq * 8), boff = lds_byte(wc * 32 + fr, fq * 8);
#define PG8_SA(b, h) (((b) * 2 + (h)) * HTB)
#define PG8_SB(b, h) ((4 + (b) * 2 + (h)) * HTB)
#define PG8_STAGE(bufoff, gbase, voff) do { _Pragma("unroll") for (int _i = 0; _i < 2; ++_i) \
        __builtin_amdgcn_global_load_lds((const unsigned*)((const char*)(gbase) + (voff)[_i]), (PG8_LAS unsigned*)(lds + (bufoff) + ldsw + _i * 8192), 16, 0, 0); } while (0)
#define PG8_LDA(dst, b, h) do { _Pragma("unroll") for (int m = 0; m < 4; ++m) _Pragma("unroll") for (int k = 0; k < 2; ++k) dst[m][k] = *(const PG8_LAS bf16x8*)(lds + PG8_SA(b, h) + aoff + m * 2048 + k * 1024); } while (0)
#define PG8_LDB(dst, b, h) do { _Pragma("unroll") for (int n = 0; n < 2; ++n) _Pragma("unroll") for (int k = 0; k < 2; ++k) dst[n][k] = *(const PG8_LAS bf16x8*)(lds + PG8_SB(b, h) + boff + n * 2048 + k * 1024); } while (0)
#define PG8_MMA(ai, bj, At, Bt) do { __builtin_amdgcn_s_setprio(1); _Pragma("unroll") for (int m = 0; m < 4; ++m) _Pragma("unroll") for (int n = 0; n < 2; ++n) _Pragma("unroll") for (int k = 0; k < 2; ++k) \
        acc[ai][bj][m][n] = __builtin_amdgcn_mfma_f32_16x16x32_bf16(Bt[n][k], At[m][k], acc[ai][bj][m][n], 0, 0, 0); __builtin_amdgcn_s_setprio(0); } while (0)
#define PG8_WAIT_V(n) asm volatile("s_waitcnt vmcnt(" #n ")" ::: "memory")
#define PG8_WAIT_L(n) asm volatile("s_waitcnt lgkmcnt(" #n ")" ::: "memory")
#define PG8_BAR __builtin_amdgcn_s_barrier()
#define PG8_SCHED __builtin_amdgcn_sched_barrier(0)
    Unit cur, nxt; int ui = 0;
    if (!S.next(0, cur)) return;
    f32x4 acc[2][2][4][2];
#pragma unroll
    for (int a = 0; a < 2; ++a)
#pragma unroll
        for (int b = 0; b < 2; ++b)
#pragma unroll
            for (int m = 0; m < 4; ++m)
#pragma unroll
                for (int n = 0; n < 2; ++n) acc[a][b][m][n] = (f32x4){0.f, 0.f, 0.f, 0.f};
    bf16x8 At[4][2], B0[2][2], B1[2][2];
    const char* cA = (const char*)g.A + (size_t)cur.pm * tstep; const char* cB = (const char*)g.Bt + (size_t)cur.pn * tstep;
    S.a_ready(cur);
    PG8_STAGE(PG8_SB(0, 0), cB, voffB); PG8_STAGE(PG8_SA(0, 0), cA, voffA); PG8_STAGE(PG8_SB(0, 1), cB + hstep, voffB); PG8_STAGE(PG8_SA(0, 1), cA + hstep, voffA);
    if (wr == 1) PG8_BAR;
    PG8_WAIT_V(4); PG8_BAR;
    PG8_STAGE(PG8_SB(1, 0), cB + kstep, voffB); PG8_STAGE(PG8_SA(1, 0), cA + kstep, voffA); PG8_STAGE(PG8_SB(1, 1), cB + hstep + kstep, voffB);
    PG8_WAIT_V(6); PG8_BAR;
    PG8_STAMP();
    for (;;) {
        const bool has_next = S.next(ui + 1, nxt);
        const char* nA = has_next ? (const char*)g.A + (size_t)nxt.pm * tstep : cA; const char* nB = has_next ? (const char*)g.Bt + (size_t)nxt.pn * tstep : cB;
        for (int t = 0; t < nt; t += 2) {
            const bool last = (t == nt - 2);
            const char* a1 = cA + (size_t)(t + 1) * kstep;
            const char* a2 = last ? nA : cA + (size_t)(t + 2) * kstep; const char* b2 = last ? nB : cB + (size_t)(t + 2) * kstep;
            const char* a3 = a2 + kstep; const char* b3 = b2 + kstep;
            if (last && has_next) S.a_ready(nxt);
            PG8_LDB(B0, 0, 0); PG8_SCHED; PG8_LDA(At, 0, 0); PG8_STAGE(PG8_SA(1, 1), a1 + hstep, voffA);
            PG8_WAIT_L(8); PG8_BAR; PG8_WAIT_L(0); PG8_MMA(0, 0, At, B0); PG8_BAR; PG8_SCHED;
            PG8_LDB(B1, 0, 1); PG8_STAGE(PG8_SB(0, 0), b2, voffB);
            PG8_BAR; PG8_WAIT_L(0); PG8_MMA(0, 1, At, B1); PG8_BAR;
            PG8_LDA(At, 0, 1); PG8_STAGE(PG8_SA(0, 0), a2, voffA);
            PG8_BAR; PG8_WAIT_L(0); PG8_MMA(1, 0, At, B0); PG8_BAR; PG8_SCHED;
            PG8_STAGE(PG8_SB(0, 1), b2 + hstep, voffB);
            PG8_WAIT_V(6); PG8_BAR; PG8_MMA(1, 1, At, B1); PG8_BAR;
            PG8_LDB(B0, 1, 0); PG8_SCHED; PG8_LDA(At, 1, 0); PG8_STAGE(PG8_SA(0, 1), a2 + hstep, voffA);
            PG8_WAIT_L(8); PG8_BAR; PG8_WAIT_L(0); PG8_MMA(0, 0, At, B0); PG8_BAR; PG8_SCHED;
            PG8_LDB(B1, 1, 1); PG8_STAGE(PG8_SB(1, 0), b3, voffB);
            PG8_BAR; PG8_WAIT_L(0); PG8_MMA(0, 1, At, B1); PG8_BAR;
            PG8_LDA(At, 1, 1); PG8_STAGE(PG8_SA(1, 0), a3, voffA);
            PG8_BAR; PG8_WAIT_L(0); PG8_MMA(1, 0, At, B0); PG8_BAR; PG8_SCHED;
            PG8_STAGE(PG8_SB(1, 1), b3 + hstep, voffB);
            PG8_WAIT_V(6); PG8_BAR; PG8_MMA(1, 1, At, B1); PG8_BAR;
        }
        PG8_STAMP();
        if constexpr (!Epi::AFTER_DRAIN) { E(acc, cur, wr, wc, fr, fq); S.done(cur); }
        PG8_STAMP();
        if (!has_next) break;
#pragma unroll
        for (int a = 0; a < 2; ++a)
#pragma unroll
            for (int b = 0; b < 2; ++b)
#pragma unroll
                for (int m = 0; m < 4; ++m)
#pragma unroll
                    for (int n = 0; n < 2; ++n) acc[a][b][m][n] = (f32x4){0.f, 0.f, 0.f, 0.f};
        cur = nxt; cA = nA; cB = nB; ++ui;
    }
    PG8_WAIT_V(0);
    if (wr == 0) PG8_BAR;
    PG8_BAR;
    if constexpr (Epi::AFTER_DRAIN) { E.fused(acc, cur, wr, wc, fr, fq, lds, wid, lane); S.done(cur); }
    PG8_STAMP();
    if (STAMP && wid == 0) { stamps[lane] = lane < nts ? (((unsigned long long)(unsigned)ts_hi << 32) | (unsigned)ts_lo) : 0ull;
        if (lane == 62) stamps[62] = rt_entry; if (lane == 63) stamps[63] = (unsigned long long)wall_clock64(); }
#undef PG8_STAMP
#undef PG8_SA
#undef PG8_SB
#undef PG8_STAGE
#undef PG8_LDA
#undef PG8_LDB
#undef PG8_MMA
#undef PG8_WAIT_V
#undef PG8_WAIT_L
#undef PG8_BAR
#undef PG8_SCHED
}
}

typedef unsigned short bf16_t;
typedef float f32x4 __attribute__((ext_vector_type(4)));
#define LAS __attribute__((address_space(3)))
typedef LAS float* ldsf;

constexpr int M_TOK = 8192, DM = 2048, SEQL = 2048, LDP = 7936, XSSN = 32;
constexpr int LDS_BYTES = 160 * 1024;
constexpr int N_PHASES = 12;
constexpr int LORA_L = 2 * 512 * 64 + 512 * 32, LORA_ELEMS = 2 * LORA_L;
constexpr int N_RW = 128, N_ITEMS = N_RW + 128;

enum { I_NORM_G = 0, I_W_IN, I_W_OUT, I_GK_W2, I_GK_B, I_GLA_NG, I_RW_MU, I_RW_W0, I_RW_W2, I_RW_A0, I_RW_A2, I_RW_KK, I_RW_KA, I_RW_RK, I_RW_LNG, I_RW_LNB,
       I_SSD_CW, I_SSD_CB, I_SSD_DTB, I_SSD_ALOG, I_SSD_D, I_SSD_NG, I_ML_CW, I_ML_CB, I_ML_IGB, I_ML_FGB, I_ML_NG };

struct Params {
    const float* in[58];
    float* out;
    bf16_t* Wi; bf16_t* Wo0; bf16_t* Wo1; bf16_t* actA; bf16_t* proj; bf16_t* xb1;
    float* rwA; float* rwB; float* rwV; float* xss0; float* xss1; float* xss2; unsigned* bar; bf16_t* lora; float* bon;
};
typedef const __attribute__((address_space(4))) Params* CP;
__device__ __forceinline__ const float* LP(CP P, int l, int idx) { return P->in[(l ? 28 : 1) + idx + ((l && idx >= I_RW_KK) ? 2 : 0)]; }

struct Cols { int rw, rwz, sx, sdt, sz, mqk, mv, mi, mf, mo, mz, nin; };
__device__ __forceinline__ Cols cols(int l) {
    const int RW = l ? 1696 : 1664; Cols c;
    c.rw = 1552; c.rwz = 1552 + RW; c.sx = c.rwz + 512; c.sdt = c.sx + 1024; c.sz = c.sdt + 8; c.mqk = c.sz + 512; c.mv = c.mqk + 1024;
    c.mi = c.mv + 512; c.mf = c.mi + 4; c.mo = c.mf + 4; c.mz = c.mo + 512; c.nin = c.mz + 512; return c;
}
constexpr int C_GQ = 0, C_GK = 256, C_GV = 512, C_GGK = 1024, C_GZ = 1040;

__device__ __forceinline__ float bf2f(bf16_t u) { return __uint_as_float(((unsigned)u) << 16); }
__device__ __forceinline__ bf16_t f2bf(float f) { unsigned u = __float_as_uint(f); u += 0x7FFFu + ((u >> 16) & 1u); return (bf16_t)(u >> 16); }
__device__ __forceinline__ unsigned pack2(float lo, float hi) { return (unsigned)f2bf(lo) | ((unsigned)f2bf(hi) << 16); }
__device__ __forceinline__ void unpack8(const uint4 u, float* f) {
    f[0] = __uint_as_float(u.x << 16); f[1] = __uint_as_float(u.x & 0xffff0000u); f[2] = __uint_as_float(u.y << 16); f[3] = __uint_as_float(u.y & 0xffff0000u);
    f[4] = __uint_as_float(u.z << 16); f[5] = __uint_as_float(u.z & 0xffff0000u); f[6] = __uint_as_float(u.w << 16); f[7] = __uint_as_float(u.w & 0xffff0000u);
}
__device__ __forceinline__ void load8(const bf16_t* p, float* f) { unpack8(*(const uint4*)p, f); }
__device__ __forceinline__ void store8(bf16_t* p, const float* f) { uint4 u; u.x = pack2(f[0], f[1]); u.y = pack2(f[2], f[3]); u.z = pack2(f[4], f[5]); u.w = pack2(f[6], f[7]); *(uint4*)p = u; }
__device__ __forceinline__ float softplusf(float x) { return fmaxf(x, 0.f) + log1pf(expf(-fabsf(x))); }
__device__ __forceinline__ float logsigmoidf(float x) { return fminf(x, 0.f) - log1pf(expf(-fabsf(x))); }
__device__ __forceinline__ float sigmoidf_(float x) { return __builtin_amdgcn_rcpf(1.f + __expf(-x)); }
__device__ __forceinline__ float siluf(float x) { return x * __builtin_amdgcn_rcpf(1.f + __expf(-x)); }
__device__ __forceinline__ float logsigmoid_fast(float x) { return fminf(x, 0.f) - __logf(1.f + __expf(-fabsf(x))); }
typedef float f32x2 __attribute__((ext_vector_type(2)));
__device__ __forceinline__ float wave_sum(float v) { for (int o = 32; o; o >>= 1) v += __shfl_xor(v, o); return v; }
__device__ __forceinline__ float wave_max(float v) { for (int o = 32; o; o >>= 1) v = fmaxf(v, __shfl_xor(v, o)); return v; }
template <int CTRL> __device__ __forceinline__ float dppf(float v) { return __int_as_float(__builtin_amdgcn_update_dpp(0, __float_as_int(v), CTRL, 0xF, 0xF, true)); }
__device__ __forceinline__ float reduce16(float v) { v += dppf<0xB1>(v); v += dppf<0x4E>(v); v += dppf<0x141>(v); v += dppf<0x140>(v); return v; }
__device__ __forceinline__ float reduce8(float v) { v += dppf<0xB1>(v); v += dppf<0x4E>(v); v += dppf<0x141>(v); return v; }

template <int CTRL> __device__ __forceinline__ float dpp_keep(float oldv, float v) { return __int_as_float(__builtin_amdgcn_update_dpp(__float_as_int(oldv), __float_as_int(v), CTRL, 0xF, 0xF, false)); }
__device__ __forceinline__ float rdlane(float v, int l) { return __int_as_float(__builtin_amdgcn_readlane(__float_as_int(v), l)); }
__device__ __forceinline__ float scan_add64(float v, int lane) {
    v += dppf<0x111>(v); v += dppf<0x112>(v); v += dppf<0x114>(v); v += dppf<0x118>(v);
    const float t0 = rdlane(v, 15), t1 = rdlane(v, 31), t2 = rdlane(v, 47); const int row = lane >> 4;
    return v + ((row >= 1) ? t0 : 0.f) + ((row >= 2) ? t1 : 0.f) + ((row >= 3) ? t2 : 0.f);
}
__device__ __forceinline__ float scan_max64(float v, int lane) {
    const float ninf = -__builtin_inff();
    v = fmaxf(v, dpp_keep<0x111>(ninf, v)); v = fmaxf(v, dpp_keep<0x112>(ninf, v)); v = fmaxf(v, dpp_keep<0x114>(ninf, v)); v = fmaxf(v, dpp_keep<0x118>(ninf, v));
    const float t0 = rdlane(v, 15), t1 = rdlane(v, 31), t2 = rdlane(v, 47); const int row = lane >> 4;
    return fmaxf(fmaxf(v, (row >= 1) ? t0 : ninf), fmaxf((row >= 2) ? t1 : ninf, (row >= 3) ? t2 : ninf));
}
__device__ __forceinline__ void lds_barrier() { asm volatile("s_waitcnt lgkmcnt(0)\n\ts_barrier" ::: "memory"); }
__device__ __forceinline__ int opaque_tid() { int t = threadIdx.x; asm volatile("" : "+v"(t)); return t; }
template <class FA, class FB> __device__ __forceinline__ f32x4 mm16(int K, FA fa, FB fb, f32x4 acc, int i, int kq) {
#pragma unroll 4
    for (int k0 = 0; k0 < K; k0 += 4) { const float a = fa(i, k0 + kq), b = fb(k0 + kq, i); acc = __builtin_amdgcn_mfma_f32_16x16x4f32(a, b, acc, 0, 0, 0); }
    return acc;
}
template <class FA, class FB1, class FB2> __device__ __forceinline__ void mm16_2(int K, FA fa, FB1 fb1, FB2 fb2, f32x4& acc1, f32x4& acc2, int i, int kq) {
#pragma unroll 4
    for (int k0 = 0; k0 < K; k0 += 4) { const float a = fa(i, k0 + kq), b1 = fb1(k0 + kq, i), b2 = fb2(k0 + kq, i);
        acc1 = __builtin_amdgcn_mfma_f32_16x16x4f32(a, b1, acc1, 0, 0, 0); acc2 = __builtin_amdgcn_mfma_f32_16x16x4f32(a, b2, acc2, 0, 0, 0); }
}
typedef short bf16x8 __attribute__((ext_vector_type(8)));
typedef LAS bf16_t* ldsh;
typedef unsigned u32x4 __attribute__((ext_vector_type(4)));
typedef unsigned u32x2 __attribute__((ext_vector_type(2)));
__device__ __forceinline__ void unpack8v(const u32x4 u, float* f) { unpack8(make_uint4(u.x, u.y, u.z, u.w), f); }
__device__ __forceinline__ unsigned pk2(float lo, float hi) { unsigned r; asm volatile("v_cvt_pk_bf16_f32 %0, %1, %2" : "=v"(r) : "v"(lo), "v"(hi)); return r; }
__device__ __forceinline__ f32x4 mmb(int K, const LAS bf16_t* pa, int lda, const LAS bf16_t* pb, int ldb, f32x4 acc, int li, int kq) {
    const LAS bf16_t* a = pa + li * lda + kq * 8; const LAS bf16_t* b = pb + li * ldb + kq * 8;
#pragma unroll 4
    for (int k0 = 0; k0 < K; k0 += 32) acc = __builtin_amdgcn_mfma_f32_16x16x32_bf16(*(const LAS bf16x8*)(a + k0), *(const LAS bf16x8*)(b + k0), acc, 0, 0, 0);
    return acc;
}
__device__ __forceinline__ void tri_tile(int idx, int& tl, int& ts) {
    tl = (idx >= 6) ? 3 : (idx >= 3) ? 2 : (idx >= 1) ? 1 : 0; ts = idx - (tl * (tl + 1)) / 2;
}

template <bool PRE> struct EpiProj {
    static constexpr bool PERM = true, AFTER_DRAIN = false;
    bf16_t* O; const float* xss;
    __device__ __forceinline__ void operator()(const f32x4 (&acc)[2][2][4][2], const pg8::Unit& u, int wr, int wc, int fr, int fq) const {
        const int row0 = u.pm * 256 + wr * 64 + fr, col0 = u.pn * 256 + wc * 32 + 8 * fq;
#pragma unroll
        for (int ai = 0; ai < 2; ++ai)
#pragma unroll
            for (int m = 0; m < 4; ++m) {
                const int row = row0 + ai * 128 + m * 16;
                float rstd;
                if (PRE) rstd = xss[row];
                else {
                    const float4* sp = (const float4*)(xss + (size_t)row * XSSN + fq * 8);
                    const float4 v0 = sp[0], v1 = sp[1];
                    float s = ((v0.x + v0.y) + (v0.z + v0.w)) + ((v1.x + v1.y) + (v1.z + v1.w));
                    s += __shfl_xor(s, 16); s += __shfl_xor(s, 32);
                    rstd = rsqrtf(s * (1.f / DM) + 1e-6f);
                }
                bf16_t* rowp = O + (size_t)row * LDP + col0;
#pragma unroll
                for (int bj = 0; bj < 2; ++bj) {
                    const f32x4 v0 = acc[ai][bj][m][0] * rstd, v1 = acc[ai][bj][m][1] * rstd;
                    uint4 o; o.x = pg8::cvt_pk_bf16(v0[0], v0[1]); o.y = pg8::cvt_pk_bf16(v0[2], v0[3]); o.z = pg8::cvt_pk_bf16(v1[0], v1[1]); o.w = pg8::cvt_pk_bf16(v1[2], v1[3]);
                    *(uint4*)(rowp + bj * 128) = o;
                }
            }
    }
};
struct EpiOut {
    static constexpr bool PERM = false, AFTER_DRAIN = false;
    const float* xin; float* xout; bf16_t* xb; float* xss;
    __device__ __forceinline__ void operator()(const f32x4 (&acc)[2][2][4][2], const pg8::Unit& u, int wr, int wc, int fr, int fq) const {
        const int row0 = u.pm * 256 + wr * 64 + fr, col0 = u.pn * 256 + wc * 32 + 4 * fq;
#pragma unroll
        for (int ai = 0; ai < 2; ++ai)
#pragma unroll
            for (int m = 0; m < 4; ++m) {
                const int row = row0 + ai * 128 + m * 16; float ss = 0.f;
#pragma unroll
                for (int bj = 0; bj < 2; ++bj)
#pragma unroll
                    for (int n = 0; n < 2; ++n) {
                        const size_t off = (size_t)row * DM + col0 + bj * 128 + n * 16;
                        const f32x4 v = acc[ai][bj][m][n] + *(const f32x4*)(xin + off);
                        *(f32x4*)(xout + off) = v; ss += v[0] * v[0] + v[1] * v[1] + v[2] * v[2] + v[3] * v[3];
                        if (xb) { uint2 o; o.x = pg8::cvt_pk_bf16(v[0], v[1]); o.y = pg8::cvt_pk_bf16(v[2], v[3]); *(uint2*)(xb + off) = o; }
                    }
                ss += __shfl_xor(ss, 16); ss += __shfl_xor(ss, 32);
                if (fq == 0) xss[(size_t)row * XSSN + u.pn * 4 + wc] = ss;
            }
    }
};

__device__ __forceinline__ void transpose_convert(const float* __restrict__ src, int K, int N, int Npad, bf16_t* __restrict__ dst, const float* __restrict__ rowscale, ldsf lds, int wg = -1, int nwg = 0) {
    if (wg < 0) { wg = blockIdx.x; nwg = gridDim.x; }
    const int tid = threadIdx.x, nkt = K / 64, ntiles = nkt * (Npad / 64);
    const int kk = tid >> 4, nn4 = (tid & 15) * 4;
    float4 c0 = make_float4(0.f, 0.f, 0.f, 0.f), c1 = c0;
    int tile = wg;
    if (tile < ntiles) {
        const int k0 = (tile % nkt) * 64, n0 = (tile / nkt) * 64;
        if (n0 + nn4 < N) { c0 = *(const float4*)(src + (size_t)(k0 + kk) * N + n0 + nn4); c1 = *(const float4*)(src + (size_t)(k0 + kk + 32) * N + n0 + nn4); }
    }
    for (; tile < ntiles; tile += nwg) {
        const int k0 = (tile % nkt) * 64, n0 = (tile / nkt) * 64;
        float4 a0 = c0, a1 = c1;
        const int nt = tile + nwg;
        c0 = make_float4(0.f, 0.f, 0.f, 0.f); c1 = c0;
        if (nt < ntiles) {
            const int k1 = (nt % nkt) * 64, n1 = (nt / nkt) * 64;
            if (n1 + nn4 < N) { c0 = *(const float4*)(src + (size_t)(k1 + kk) * N + n1 + nn4); c1 = *(const float4*)(src + (size_t)(k1 + kk + 32) * N + n1 + nn4); }
        }
        if (rowscale) { const float s0 = rowscale[k0 + kk], s1 = rowscale[k0 + kk + 32]; a0.x *= s0; a0.y *= s0; a0.z *= s0; a0.w *= s0; a1.x *= s1; a1.y *= s1; a1.z *= s1; a1.w *= s1; }
        lds[kk * 65 + nn4 + 0] = a0.x; lds[kk * 65 + nn4 + 1] = a0.y; lds[kk * 65 + nn4 + 2] = a0.z; lds[kk * 65 + nn4 + 3] = a0.w;
        lds[(kk + 32) * 65 + nn4 + 0] = a1.x; lds[(kk + 32) * 65 + nn4 + 1] = a1.y; lds[(kk + 32) * 65 + nn4 + 2] = a1.z; lds[(kk + 32) * 65 + nn4 + 3] = a1.w;
        __syncthreads();
        {
            const int nn = tid >> 3, k8 = (tid & 7) * 8;
            uint4 o;
            o.x = pack2(lds[(k8 + 0) * 65 + nn], lds[(k8 + 1) * 65 + nn]); o.y = pack2(lds[(k8 + 2) * 65 + nn], lds[(k8 + 3) * 65 + nn]);
            o.z = pack2(lds[(k8 + 4) * 65 + nn], lds[(k8 + 5) * 65 + nn]); o.w = pack2(lds[(k8 + 6) * 65 + nn], lds[(k8 + 7) * 65 + nn]);
            *(uint4*)(dst + (size_t)(n0 + nn) * K + k0 + k8) = o;
        }
        __syncthreads();
    }
}
__device__ __forceinline__ void x_convert(CP P) {
    const int wave = threadIdx.x >> 6, lane = threadIdx.x & 63, rstep = gridDim.x * 8;
    int row = blockIdx.x * 8 + wave;
    float4 cur[8], nxt[8];
    if (row < M_TOK) {
#pragma unroll
        for (int i = 0; i < 8; ++i) cur[i] = ((const float4*)(P->in[0] + (size_t)row * DM))[lane + i * 64];
    }
    for (; row < M_TOK; row += rstep) {
        const int rn = row + rstep < M_TOK ? row + rstep : row;
#pragma unroll
        for (int i = 0; i < 8; ++i) nxt[i] = ((const float4*)(P->in[0] + (size_t)rn * DM))[lane + i * 64];
        float ss = 0.f;
#pragma unroll
        for (int i = 0; i < 8; ++i) {
            const float4 v = cur[i]; ss += v.x * v.x + v.y * v.y + v.z * v.z + v.w * v.w;
            uint2 o; o.x = pack2(v.x, v.y); o.y = pack2(v.z, v.w); *(uint2*)(P->actA + (size_t)row * DM + (lane + i * 64) * 4) = o;
        }
        ss = wave_sum(ss);
        if (lane == 0) P->xss0[row] = rsqrtf(ss * (1.f / DM) + 1e-6f);
#pragma unroll
        for (int i = 0; i < 8; ++i) cur[i] = nxt[i];
    }
}

__device__ __forceinline__ void lora_convert(CP P) {
    for (int l = 0; l < 2; ++l) {
        const float* w2 = LP(P, l, I_RW_W2); const float* a2 = LP(P, l, I_RW_A2); const float* v2 = P->in[40];
        bf16_t* W = P->lora + (size_t)l * LORA_L; bf16_t* A = W + 512 * 64; bf16_t* V = A + 512 * 64;
        for (int e = blockIdx.x * 512 + threadIdx.x; e < 512 * 64; e += gridDim.x * 512) { const int c = e >> 6, k = e & 63; W[e] = f2bf(w2[k * 512 + c]); A[e] = f2bf(a2[k * 512 + c]); }
        if (l) for (int e = blockIdx.x * 512 + threadIdx.x; e < 512 * 32; e += gridDim.x * 512) { const int c = e >> 5, k = e & 31; V[e] = f2bf(v2[k * 512 + c]); }
    }
}
__device__ __forceinline__ void rwkv_prep(CP P, int l, ldsf lds) {
    const Cols C = cols(l); const int tid = opaque_tid(), wave = tid >> 6, lane = tid & 63, li = lane & 15, kq = lane >> 4;
    const float* mu = LP(P, l, I_RW_MU); const float* w0 = LP(P, l, I_RW_W0); const float* a0 = LP(P, l, I_RW_A0); const float* v0 = P->in[39];
    const bf16_t* W2t = P->lora + (size_t)l * LORA_L; const bf16_t* A2t = W2t + 512 * 64; const bf16_t* V2t = A2t + 512 * 64;
    constexpr int AS = 72, VS = 40;
    const ldsh Wl = (ldsh)lds, Al = Wl + 32 * AS, Vl = Al + 32 * AS;
    for (int tile = blockIdx.x; tile < M_TOK / 32; tile += gridDim.x) {
        const int t0 = tile * 32;
        {
            const int tt = tid >> 4, g = tid & 15, t = t0 + tt;
            const bf16_t* pr = P->proj + (size_t)t * LDP + C.rw + 1536 + g * 8;
            const bool hasp = (t % SEQL) != 0;
            float cur[8], prev[8];
            load8(pr, cur);
            if (hasp) load8(pr - LDP, prev); else {
#pragma unroll
                for (int e = 0; e < 8; ++e) prev[e] = 0.f; }
            float f[8];
#pragma unroll
            for (int e = 0; e < 8; ++e) { f[e] = cur[e] + mu[1536 + g * 8 + e] * (prev[e] - cur[e]); if (g < 8) f[e] = tanhf(f[e]); }
            u32x4 o; o.x = pk2(f[0], f[1]); o.y = pk2(f[2], f[3]); o.z = pk2(f[4], f[5]); o.w = pk2(f[6], f[7]);
            *(LAS u32x4*)((g < 8 ? Wl : Al) + tt * AS + (g & 7) * 8) = o;
            if (l && g < 4) {
                load8(pr + 128, cur);
                if (hasp) load8(pr + 128 - LDP, prev);
#pragma unroll
                for (int e = 0; e < 8; ++e) f[e] = cur[e] + mu[1664 + g * 8 + e] * (prev[e] - cur[e]);
                o.x = pk2(f[0], f[1]); o.y = pk2(f[2], f[3]); o.z = pk2(f[4], f[5]); o.w = pk2(f[6], f[7]);
                *(LAS u32x4*)(Vl + tt * VS + g * 8) = o;
            }
        }
        __syncthreads();
        struct PrepIn { bf16x8 bw0, bw1, ba0, ba1, bv; float w0c, a0c, muc, v0c; bf16_t cur[4], prev[4]; float vf[4]; };
        auto ldp = [&](int tl) { PrepIn r;
            const int tt16 = tl & 1, c = (tl >> 1) * 16 + li;
            r.bw0 = *(const bf16x8*)(W2t + (size_t)c * 64 + kq * 8); r.bw1 = *(const bf16x8*)(W2t + (size_t)c * 64 + 32 + kq * 8);
            r.ba0 = *(const bf16x8*)(A2t + (size_t)c * 64 + kq * 8); r.ba1 = *(const bf16x8*)(A2t + (size_t)c * 64 + 32 + kq * 8);
            r.bv = r.bw0; if (l) r.bv = *(const bf16x8*)(V2t + (size_t)c * 32 + kq * 8);
            r.w0c = w0[c]; r.a0c = a0[c]; r.muc = mu[1024 + c]; r.v0c = l ? v0[c] : 0.f;
#pragma unroll
            for (int j = 0; j < 4; ++j) {
                const int t = t0 + tt16 * 16 + kq * 4 + j;
                r.cur[j] = P->proj[(size_t)t * LDP + C.rw + 1024 + c];
                r.prev[j] = (t % SEQL == 0) ? (bf16_t)0 : P->proj[(size_t)(t - 1) * LDP + C.rw + 1024 + c];
                r.vf[j] = l ? P->rwV[(size_t)t * 512 + c] : 0.f;
            }
            return r; };
        PrepIn cin = ldp(wave);
        for (int tl = wave; tl < 64; tl += 8) {
            const int tt16 = tl & 1, cc = (tl >> 1) * 16, c = cc + li;
            const PrepIn nin = ldp(tl + 8 < 64 ? tl + 8 : tl);
            f32x4 aW = {0.f, 0.f, 0.f, 0.f}, aA = aW, aV = aW;
            const LAS bf16_t* pw = Wl + (tt16 * 16 + li) * AS + kq * 8; const LAS bf16_t* pa = Al + (tt16 * 16 + li) * AS + kq * 8;
            aW = __builtin_amdgcn_mfma_f32_16x16x32_bf16(*(const LAS bf16x8*)(pw), cin.bw0, aW, 0, 0, 0);
            aW = __builtin_amdgcn_mfma_f32_16x16x32_bf16(*(const LAS bf16x8*)(pw + 32), cin.bw1, aW, 0, 0, 0);
            aA = __builtin_amdgcn_mfma_f32_16x16x32_bf16(*(const LAS bf16x8*)(pa), cin.ba0, aA, 0, 0, 0);
            aA = __builtin_amdgcn_mfma_f32_16x16x32_bf16(*(const LAS bf16x8*)(pa + 32), cin.ba1, aA, 0, 0, 0);
            if (l) aV = __builtin_amdgcn_mfma_f32_16x16x32_bf16(*(const LAS bf16x8*)(Vl + (tt16 * 16 + li) * VS + kq * 8), cin.bv, aV, 0, 0, 0);
#pragma unroll
            for (int j = 0; j < 4; ++j) {
                const int t = t0 + tt16 * 16 + kq * 4 + j; const size_t o = (size_t)t * 512 + c;
                const float wl = cin.w0c + aW[j];
                const float sp = fmaxf(-wl, 0.f) + __logf(1.f + __expf(-fabsf(wl)));
                P->rwA[o] = __expf(-__expf(-sp - 0.5f));
                P->rwB[o] = sigmoidf_(cin.a0c + aA[j]);
                const float cur = bf2f(cin.cur[j]), prev = bf2f(cin.prev[j]);
                float v = cur + cin.muc * (prev - cur);
                if (l) { const float g = sigmoidf_(cin.v0c + aV[j]); v = v + (cin.vf[j] - v) * g; }
                P->rwV[o] = v;
            }
            cin = nin;
        }
        __syncthreads();
    }
}

__device__ __forceinline__ void rwkv_scan_item(CP P, int l, int it, ldsf lds) {
    const Cols C = cols(l); const int tid = opaque_tid();
    const int b = it >> 5, h = (it >> 2) & 7, rq = it & 3;
    constexpr int BUF = 5 * 2048 + 512 + 8192;
    const float* mu = LP(P, l, I_RW_MU); const float* k_k = LP(P, l, I_RW_KK); const float* k_a = LP(P, l, I_RW_KA);
    const bool producer = tid >= 256; const int ptid = tid & 255;
    const int tt = ptid >> 3, cg8 = (ptid & 7) * 8, ch0 = h * 64 + cg8, c2 = (ptid & 7) * 2;
    const int ri = ptid >> 4, js = (ptid & 15) * 4;
    const float* r_k = LP(P, l, I_RW_RK);
    float mur[8], muk[8], kkc[8], kac[8], rkc[8];
#pragma unroll
    for (int e = 0; e < 8; ++e) { mur[e] = mu[ch0 + e]; muk[e] = mu[512 + ch0 + e]; kkc[e] = k_k[ch0 + e]; kac[e] = k_a[ch0 + e]; rkc[e] = r_k[ch0 + e]; }
    uint4 rcu, kcu, rpu, kpu; float4 ra0, ra1, rd0, rd1; float2 rv2;
    auto issue = [&](int c) {
        const int t = b * SEQL + c * 32 + tt;
        const bf16_t* pr = P->proj + (size_t)t * LDP + C.rw + ch0;
        rcu = *(const uint4*)pr; kcu = *(const uint4*)(pr + 512);
        rpu = make_uint4(0u, 0u, 0u, 0u); kpu = rpu;
        if (c > 0 || tt > 0) { rpu = *(const uint4*)(pr - LDP); kpu = *(const uint4*)(pr - LDP + 512); }
        const float* ap = P->rwB + (size_t)t * 512 + ch0; const float* dp = P->rwA + (size_t)t * 512 + ch0;
        ra0 = *(const float4*)ap; ra1 = *(const float4*)(ap + 4); rd0 = *(const float4*)dp; rd1 = *(const float4*)(dp + 4);
        rv2 = *(const float2*)(P->rwV + (size_t)t * 512 + h * 64 + rq * 16 + c2);
    };
    auto fill = [&](int c, ldsf buf) {
        ldsf sR = buf, sK = buf + 2048, sW = buf + 4096, sNK = buf + 6144, sB = buf + 8192, sV = buf + 10240;
        float rc[8], kc[8], rp[8], kp[8];
        alignas(16) float av[8]; alignas(16) float dv[8]; float kkr[8], kl[8];
        *(float4*)av = ra0; *(float4*)(av + 4) = ra1; *(float4*)dv = rd0; *(float4*)(dv + 4) = rd1;
        unpack8(rcu, rc); unpack8(kcu, kc); unpack8(rpu, rp); unpack8(kpu, kp);
        float ss = 0.f; alignas(16) float o1[8]; alignas(16) float o2[8]; alignas(16) float o3[8]; alignas(16) float o4[8];
#pragma unroll
        for (int e = 0; e < 8; ++e) {
            o1[e] = rc[e] + mur[e] * (rp[e] - rc[e]);
            kl[e] = kc[e] + muk[e] * (kp[e] - kc[e]);
            kkr[e] = kl[e] * kkc[e]; ss += kkr[e] * kkr[e];
        }
        *(LAS f32x4*)(sR + tt * 64 + cg8) = *(f32x4*)o1; *(LAS f32x4*)(sR + tt * 64 + cg8 + 4) = *(f32x4*)(o1 + 4);
        *(LAS f32x4*)(sW + tt * 64 + cg8) = *(f32x4*)dv; *(LAS f32x4*)(sW + tt * 64 + cg8 + 4) = *(f32x4*)(dv + 4);
        ss += dppf<0xB1>(ss); ss += dppf<0x4E>(ss); ss += dppf<0x141>(ss);
        const float inv = 1.f / fmaxf(sqrtf(ss), 1e-12f);
#pragma unroll
        for (int e = 0; e < 8; ++e) {
            const float kk = kkr[e] * inv;
            o2[e] = kl[e] * (1.f + (av[e] - 1.f) * kac[e]); o3[e] = -kk; o4[e] = kk * av[e];
        }
        if (rq == 0) {
            float bs = 0.f;
#pragma unroll
            for (int e = 0; e < 8; ++e) bs += o1[e] * o2[e] * rkc[e];
            bs += dppf<0xB1>(bs); bs += dppf<0x4E>(bs); bs += dppf<0x141>(bs);
            if ((ptid & 7) == 0) P->bon[(size_t)(b * SEQL + c * 32 + tt) * 8 + h] = bs;
        }
        *(LAS f32x4*)(sK + tt * 64 + cg8) = *(f32x4*)o2; *(LAS f32x4*)(sK + tt * 64 + cg8 + 4) = *(f32x4*)(o2 + 4);
        *(LAS f32x4*)(sNK + tt * 64 + cg8) = *(f32x4*)o3; *(LAS f32x4*)(sNK + tt * 64 + cg8 + 4) = *(f32x4*)(o3 + 4);
        *(LAS f32x4*)(sB + tt * 64 + cg8) = *(f32x4*)o4; *(LAS f32x4*)(sB + tt * 64 + cg8 + 4) = *(f32x4*)(o4 + 4);
        *(LAS f32x2*)(sV + tt * 16 + c2) = (f32x2){rv2.x, rv2.y};
    };
    auto flush = [&](int c, ldsf buf) {
        const LAS f32x4* yp = (const LAS f32x4*)(buf + 10752 + (tt * 16 + c2) * 16);
        const f32x4 s0 = (yp[0] + yp[1]) + (yp[2] + yp[3]), s1 = (yp[4] + yp[5]) + (yp[6] + yp[7]);
        *(unsigned*)(P->proj + (size_t)(b * SEQL + c * 32 + tt) * LDP + C.rw + 1024 + h * 64 + rq * 16 + c2) = pack2((s0.x + s0.y) + (s0.z + s0.w), (s1.x + s1.y) + (s1.z + s1.w));
    };
    f32x2 S[2] = {{0.f, 0.f}, {0.f, 0.f}};
    if (producer) { issue(0); fill(0, lds); issue(1); }
    lds_barrier();
    for (int c = 0; c < 64; ++c) {
        const ldsf cur = lds + (c & 1) * BUF, nxt = lds + ((c + 1) & 1) * BUF;
        if (producer) {
            if (c + 1 < 64) fill(c + 1, nxt);
            if (c > 0) flush(c - 1, nxt);
            if (c + 2 < 64) issue(c + 2);
        } else {
            const ldsf sR = cur, sK = cur + 2048, sW = cur + 4096, sNK = cur + 6144, sB = cur + 8192, sV = cur + 10240, sYp = cur + 10752 + ri * 16 + (tid & 15);
            struct Vecs { f32x4 nk, w, b, k, r; float vi; };
            auto ldv = [&](int t) { Vecs v;
                v.nk = *(const LAS f32x4*)(sNK + t * 64 + js); v.w = *(const LAS f32x4*)(sW + t * 64 + js); v.b = *(const LAS f32x4*)(sB + t * 64 + js);
                v.k = *(const LAS f32x4*)(sK + t * 64 + js); v.r = *(const LAS f32x4*)(sR + t * 64 + js); v.vi = sV[t * 16 + ri]; return v; };
            Vecs cur_v = ldv(0), nx1 = ldv(1);
            for (int t16 = 0; t16 < 2; ++t16) {
#pragma unroll
                for (int u = 0; u < 16; ++u) {
                    const int t = t16 * 16 + u;
                    const Vecs nxt = ldv((t + 2) & 31);
                    f32x2 s2 = S[0] * cur_v.nk.xy; s2 = S[1] * cur_v.nk.zw + s2;
                    const float sa = reduce16(s2.x + s2.y);
                    const f32x2 sav = {sa, sa}, viv = {cur_v.vi, cur_v.vi};
                    f32x2 t0 = viv * cur_v.k.xy; t0 = sav * cur_v.b.xy + t0; S[0] = S[0] * cur_v.w.xy + t0;
                    f32x2 t1 = viv * cur_v.k.zw; t1 = sav * cur_v.b.zw + t1; S[1] = S[1] * cur_v.w.zw + t1;
                    f32x2 y2 = S[0] * cur_v.r.xy; y2 = S[1] * cur_v.r.zw + y2;
                    sYp[t * 256] = y2.x + y2.y;
                    cur_v = nx1; nx1 = nxt;
                }
            }
        }
        lds_barrier();
    }
    if (producer) flush(63, lds + BUF);
    __syncthreads();
}

__device__ __forceinline__ void mlstm_item(CP P, int l, int it, ldsf lds) {
    const Cols C = cols(l); const int tid = opaque_tid(), wave = tid >> 6, lane = tid & 63, li = lane & 15, kq = lane >> 4;
    const int b = it >> 4, h = (it >> 2) & 3, es = it & 3;
    constexpr int QS = 136, SS = 72;
    const ldsh Qb = (ldsh)lds, Kb = Qb + 64 * QS, Ktb = Kb + 64 * QS, Vtb = Ktb + 128 * SS, Vwtb = Vtb + 32 * SS, Attb = Vwtb + 32 * SS, Ctb = Attb + 64 * SS, nbb = Ctb + 2 * 32 * QS, wendb = nbb + 2 * 128;
    const ldsf sCum = (ldsf)(wendb + 64), sLi = sCum + 64, sWend = sLi + 64, sMl = sWend + 64, sWint = sMl + 64, sScal = sWint + 64;
    const float* cw = LP(P, l, I_ML_CW); const float* cb = LP(P, l, I_ML_CB);
    const float igb = LP(P, l, I_ML_IGB)[h], fgb = LP(P, l, I_ML_FGB)[h];
    for (int e = tid; e < 64 * SS / 2; e += 512) ((LAS unsigned*)Attb)[e] = 0u;
    for (int e = tid; e < (2 * 32 * QS + 2 * 128) / 2; e += 512) ((LAS unsigned*)Ctb)[e] = 0u;
    float m_prev = 0.f;
    f32x4 Cm[2], nm[2];
#pragma unroll
    for (int q = 0; q < 2; ++q) { Cm[q] = (f32x4){0.f, 0.f, 0.f, 0.f}; nm[q] = Cm[q]; }
    const int cgp = tid & 31, rseg = tid >> 5, isk = cgp >> 4, d0 = (cgp & 15) * 8, col0 = isk * 512 + h * 128 + d0;
    const ldsh cdst = isk ? Kb : Qb; const float cscale = isk ? 0.08838834764831845f : 1.f;
    const bf16x8 ones8 = {(short)0x3F80, (short)0x3F80, (short)0x3F80, (short)0x3F80, (short)0x3F80, (short)0x3F80, (short)0x3F80, (short)0x3F80};
    uint4 raw[7]; uint4 vraw = make_uint4(0u, 0u, 0u, 0u); bf16_t gi_bits = 0, gf_bits = 0;
    auto issue_loads = [&](int nn) {
#pragma unroll
        for (int i = 0; i < 7; ++i) {
            const int ts = nn * 64 + rseg * 4 - 3 + i;
            raw[i] = (ts >= 0) ? *(const uint4*)(P->proj + (size_t)(b * SEQL + ts) * LDP + C.mqk + col0) : make_uint4(0u, 0u, 0u, 0u);
        }
        if (tid < 256) vraw = *(const uint4*)(P->proj + (size_t)(b * SEQL + nn * 64 + (tid >> 2)) * LDP + C.mv + h * 128 + es * 32 + (tid & 3) * 8);
        if (wave == 0) { const bf16_t* gp = P->proj + (size_t)(b * SEQL + nn * 64 + lane) * LDP; gi_bits = gp[C.mi + h]; gf_bits = gp[C.mf + h]; }
    };
    bf16_t pend[4] = {0, 0, 0, 0};
    auto store_pend = [&](int nprev) {
        const int tl = wave >> 1, te = wave & 1;
#pragma unroll
        for (int j = 0; j < 4; ++j) P->proj[(size_t)(b * SEQL + nprev * 64 + tl * 16 + kq * 4 + j) * LDP + C.mv + h * 128 + es * 32 + te * 16 + li] = pend[j];
    };
    issue_loads(0);
    alignas(16) float wreg[4][8]; alignas(16) float breg[8];
    *(float4*)breg = *(const float4*)(cb + col0); *(float4*)(breg + 4) = *(const float4*)(cb + col0 + 4);
#pragma unroll
    for (int j = 0; j < 4; ++j) { *(float4*)wreg[j] = *(const float4*)(cw + j * 1024 + col0); *(float4*)(wreg[j] + 4) = *(const float4*)(cw + j * 1024 + col0 + 4); }
    __syncthreads();
    for (int n = 0; n < 32; ++n) {
        const int t0 = b * SEQL + n * 64, pb = n & 1;
        {
            float acc[4][8];
#pragma unroll
            for (int r = 0; r < 4; ++r)
#pragma unroll
                for (int e = 0; e < 8; ++e) acc[r][e] = breg[e];
#pragma unroll
            for (int i = 0; i < 7; ++i) {
                float f[8]; unpack8(raw[i], f);
#pragma unroll
                for (int r = 0; r < 4; ++r) { const int j = i - r; if (j >= 0 && j < 4) {
#pragma unroll
                    for (int e = 0; e < 8; ++e) acc[r][e] += wreg[j][e] * f[e]; } }
            }
#pragma unroll
            for (int r = 0; r < 4; ++r) {
#pragma unroll
                for (int e = 0; e < 8; ++e) acc[r][e] = siluf(acc[r][e]) * cscale;
                u32x4 o; o.x = pk2(acc[r][0], acc[r][1]); o.y = pk2(acc[r][2], acc[r][3]); o.z = pk2(acc[r][4], acc[r][5]); o.w = pk2(acc[r][6], acc[r][7]);
                *(LAS u32x4*)(cdst + (rseg * 4 + r) * QS + d0) = o;
            }
            if (isk) {
#pragma unroll
                for (int e = 0; e < 8; ++e) { u32x2 o; o.x = pk2(acc[0][e], acc[1][e]); o.y = pk2(acc[2][e], acc[3][e]); *(LAS u32x2*)(Ktb + (d0 + e) * SS + rseg * 4) = o; }
            }
            if (tid < 256) {
                const LAS bf16_t* vs = (const LAS bf16_t*)0; (void)vs;
                const unsigned w4[4] = {vraw.x, vraw.y, vraw.z, vraw.w};
#pragma unroll
                for (int e = 0; e < 8; ++e) Vtb[((tid & 3) * 8 + e) * SS + (tid >> 2)] = (bf16_t)((e & 1) ? (w4[e >> 1] >> 16) : (w4[e >> 1] & 0xffffu));
            }
        }
        if (wave == 0) {
            const int s = lane;
            const float lgi = bf2f(gi_bits) + igb;
            const float lf = logsigmoidf(bf2f(gf_bits) + fgb);
            const float cum = scan_add64(lf, lane);
            const float last = rdlane(cum, 63);
            const float g = last - cum + lgi; const float gmax = rdlane(scan_max64(g, lane), 63);
            const float pm = scan_max64(lgi - cum, lane);
            const float minter = cum + m_prev; const float ml = fmaxf(minter, cum + pm);
            const float we = __expf(g - gmax);
            sCum[s] = cum; sLi[s] = lgi; sWend[s] = we; wendb[s] = f2bf(we); sMl[s] = ml; sWint[s] = __expf(minter - ml);
            if (lane == 0) { sScal[0] = last; sScal[1] = gmax; }
        }
        if (n > 0) store_pend(n - 1);
        if (n + 1 < 32) issue_loads(n + 1);
        lds_barrier();
        if (tid < 256) {
            const int e = tid >> 3, sg = (tid & 7) * 8;
            float f[8]; unpack8v(*(const LAS u32x4*)(Vtb + e * SS + sg), f);
            u32x4 o; o.x = pk2(f[0] * sWend[sg], f[1] * sWend[sg + 1]); o.y = pk2(f[2] * sWend[sg + 2], f[3] * sWend[sg + 3]);
            o.z = pk2(f[4] * sWend[sg + 4], f[5] * sWend[sg + 5]); o.w = pk2(f[6] * sWend[sg + 6], f[7] * sWend[sg + 7]);
            *(LAS u32x4*)(Vwtb + e * SS + sg) = o;
        }
        for (int idx = wave; idx < 10; idx += 8) {
            int tl, ts; tri_tile(idx, tl, ts);
            const f32x4 a = mmb(128, Qb + tl * 16 * QS, QS, Kb + ts * 16 * QS, QS, (f32x4){0.f, 0.f, 0.f, 0.f}, li, kq);
#pragma unroll
            for (int j = 0; j < 4; ++j) {
                const int lr = tl * 16 + kq * 4 + j, sc = ts * 16 + li;
                Attb[lr * SS + sc] = f2bf((sc <= lr) ? a[j] * __expf(sCum[lr] - sCum[sc] + sLi[sc] - sMl[lr]) : 0.f);
            }
        }
        lds_barrier();
        {
            const int tl = wave >> 1, te = wave & 1;
            f32x4 a1 = {0.f, 0.f, 0.f, 0.f}, ad = a1, a2 = a1, aq = a1;
            {
                const LAS bf16_t* pa = Attb + (tl * 16 + li) * SS + kq * 8; const LAS bf16_t* pv = Vtb + (te * 16 + li) * SS + kq * 8;
#pragma unroll
                for (int k0 = 0; k0 < 64; k0 += 32) { const bf16x8 av = *(const LAS bf16x8*)(pa + k0);
                    a1 = __builtin_amdgcn_mfma_f32_16x16x32_bf16(av, *(const LAS bf16x8*)(pv + k0), a1, 0, 0, 0); ad = __builtin_amdgcn_mfma_f32_16x16x32_bf16(av, ones8, ad, 0, 0, 0); }
                const LAS bf16_t* pq = Qb + (tl * 16 + li) * QS + kq * 8; const LAS bf16_t* pc = Ctb + pb * 32 * QS + (te * 16 + li) * QS + kq * 8; const LAS bf16_t* pn = nbb + pb * 128 + kq * 8;
#pragma unroll
                for (int k0 = 0; k0 < 128; k0 += 32) { const bf16x8 av = *(const LAS bf16x8*)(pq + k0);
                    a2 = __builtin_amdgcn_mfma_f32_16x16x32_bf16(av, *(const LAS bf16x8*)(pc + k0), a2, 0, 0, 0); aq = __builtin_amdgcn_mfma_f32_16x16x32_bf16(av, *(const LAS bf16x8*)(pn + k0), aq, 0, 0, 0); }
            }
#pragma unroll
            for (int j = 0; j < 4; ++j) {
                const int lr = tl * 16 + kq * 4 + j, e = te * 16 + li;
                const float wi = sWint[lr];
                const float den = fmaxf(fabsf(ad[j] + wi * aq[j]), __expf(-sMl[lr]));
                const float hv = (a1[j] + wi * a2[j]) / den;
                pend[j] = f2bf(hv);
            }
            const float last = sScal[0], gmax = sScal[1];
            const float m_new = fmaxf(last + m_prev, gmax), a_old = __expf(last + m_prev - m_new), a_new = __expf(gmax - m_new);
#pragma unroll
            for (int q = 0; q < 2; ++q) {
                const int tile = wave + q * 8, td = tile >> 1, te2 = tile & 1;
                const LAS bf16_t* pk = Ktb + (td * 16 + li) * SS + kq * 8; const LAS bf16_t* pv = Vwtb + (te2 * 16 + li) * SS + kq * 8; const LAS bf16_t* pw = wendb + kq * 8;
                f32x4 a = {0.f, 0.f, 0.f, 0.f}, an = a;
#pragma unroll
                for (int k0 = 0; k0 < 64; k0 += 32) { const bf16x8 av = *(const LAS bf16x8*)(pk + k0);
                    a = __builtin_amdgcn_mfma_f32_16x16x32_bf16(av, *(const LAS bf16x8*)(pv + k0), a, 0, 0, 0);
                    if (te2 == 0) an = __builtin_amdgcn_mfma_f32_16x16x32_bf16(av, *(const LAS bf16x8*)(pw + k0), an, 0, 0, 0); }
                Cm[q] = Cm[q] * a_old + a * a_new;
                u32x2 o; o.x = pk2(Cm[q][0], Cm[q][1]); o.y = pk2(Cm[q][2], Cm[q][3]);
                *(LAS u32x2*)(Ctb + (pb ^ 1) * 32 * QS + (te2 * 16 + li) * QS + td * 16 + kq * 4) = o;
                if (te2 == 0) {
                    nm[q] = nm[q] * a_old + an * a_new;
                    if (li == 0) { u32x2 o2; o2.x = pk2(nm[q][0], nm[q][1]); o2.y = pk2(nm[q][2], nm[q][3]); *(LAS u32x2*)(nbb + (pb ^ 1) * 128 + td * 16 + kq * 4) = o2; }
                }
            }
            m_prev = m_new;
        }
        lds_barrier();
    }
    store_pend(31);
}

__device__ __forceinline__ void ssd_item(CP P, int l, int it, ldsf lds) {
    const Cols C = cols(l); const int tid = opaque_tid(), wave = tid >> 6, lane = tid & 63, li = lane & 15, kq = lane >> 4;
    const int b = it >> 3, hh = it & 7, g = hh >> 2;
    constexpr int QS = 136, SS = 72;
    const ldsh Cmb = (ldsh)lds, Bmb = Cmb + 64 * QS, Bmtb = Bmb + 64 * QS, Lcb = Bmtb + 128 * SS, Xdtt = Lcb + 64 * SS, Xett = Xdtt + 64 * SS, Sb = Xett + 64 * SS;
    const ldsf sXr = (ldsf)(Sb + 2 * 64 * QS), sX = sXr + 67 * 64, sCum = sX + 64 * 65, sDt = sCum + 64, sE = sDt + 64, sEc = sE + 64, sScal = sEc + 64;
    const float* cw = LP(P, l, I_SSD_CW); const float* cb = LP(P, l, I_SSD_CB);
    const float Aneg = -expf(LP(P, l, I_SSD_ALOG)[hh]), dtb = LP(P, l, I_SSD_DTB)[hh], dsk = LP(P, l, I_SSD_D)[hh];
    for (int e = tid; e < 64 * SS / 2; e += 512) ((LAS unsigned*)Lcb)[e] = 0u;
    for (int e = tid; e < 2 * 64 * QS / 2; e += 512) ((LAS unsigned*)Sb)[e] = 0u;
    float hv = 0.f;
    f32x4 Sm[4];
#pragma unroll
    for (int q = 0; q < 4; ++q) Sm[q] = (f32x4){0.f, 0.f, 0.f, 0.f};
    const int cgp = tid & 31, rseg = tid >> 5, isc = cgp >> 4, n0 = (cgp & 15) * 8, col0 = 512 + isc * 256 + g * 128 + n0;
    const ldsh cdst = isc ? Cmb : Bmb;
    const int xcol = hh * 64 + (tid & 63);
    const float cb0 = cb[xcol], w0 = cw[xcol], w1 = cw[1024 + xcol], w2 = cw[2048 + xcol], w3 = cw[3072 + xcol];
    uint4 raw[7]; uint4 xraw = make_uint4(0u, 0u, 0u, 0u); bf16_t dt_bits = 0;
    auto issue_loads = [&](int nn) {
#pragma unroll
        for (int i = 0; i < 7; ++i) {
            const int ts = nn * 64 + rseg * 4 - 3 + i;
            raw[i] = (ts >= 0) ? *(const uint4*)(P->proj + (size_t)(b * SEQL + ts) * LDP + C.sx + col0) : make_uint4(0u, 0u, 0u, 0u);
        }
        xraw = *(const uint4*)(P->proj + (size_t)(b * SEQL + nn * 64 + (tid >> 3)) * LDP + C.sx + hh * 64 + (tid & 7) * 8);
        if (wave == 0) dt_bits = P->proj[(size_t)(b * SEQL + nn * 64 + lane) * LDP + C.sdt + hh];
    };
    bf16_t pend[2][4] = {{0, 0, 0, 0}, {0, 0, 0, 0}};
    auto store_pend = [&](int nprev) {
#pragma unroll
        for (int q = 0; q < 2; ++q) { const int tile = wave + q * 8, tl = tile >> 2, tp = tile & 3;
#pragma unroll
            for (int j = 0; j < 4; ++j) P->proj[(size_t)(b * SEQL + nprev * 64 + tl * 16 + kq * 4 + j) * LDP + C.sx + hh * 64 + tp * 16 + li] = pend[q][j]; }
    };
    issue_loads(0);
    alignas(16) float wreg[4][8]; alignas(16) float breg[8];
    *(float4*)breg = *(const float4*)(cb + col0); *(float4*)(breg + 4) = *(const float4*)(cb + col0 + 4);
#pragma unroll
    for (int j = 0; j < 4; ++j) { *(float4*)wreg[j] = *(const float4*)(cw + j * 1024 + col0); *(float4*)(wreg[j] + 4) = *(const float4*)(cw + j * 1024 + col0 + 4); }
    __syncthreads();
    for (int n = 0; n < 32; ++n) {
        const int t0 = b * SEQL + n * 64, pb = n & 1;
        if (tid < 192) sXr[tid] = hv;
        {
            float acc[4][8];
#pragma unroll
            for (int r = 0; r < 4; ++r)
#pragma unroll
                for (int e = 0; e < 8; ++e) acc[r][e] = breg[e];
#pragma unroll
            for (int i = 0; i < 7; ++i) {
                float f[8]; unpack8(raw[i], f);
#pragma unroll
                for (int r = 0; r < 4; ++r) { const int j = i - r; if (j >= 0 && j < 4) {
#pragma unroll
                    for (int e = 0; e < 8; ++e) acc[r][e] += wreg[j][e] * f[e]; } }
            }
#pragma unroll
            for (int r = 0; r < 4; ++r) {
#pragma unroll
                for (int e = 0; e < 8; ++e) acc[r][e] = siluf(acc[r][e]);
                u32x4 o; o.x = pk2(acc[r][0], acc[r][1]); o.y = pk2(acc[r][2], acc[r][3]); o.z = pk2(acc[r][4], acc[r][5]); o.w = pk2(acc[r][6], acc[r][7]);
                *(LAS u32x4*)(cdst + (rseg * 4 + r) * QS + n0) = o;
            }
            if (!isc) {
#pragma unroll
                for (int e = 0; e < 8; ++e) { u32x2 o; o.x = pk2(acc[0][e], acc[1][e]); o.y = pk2(acc[2][e], acc[3][e]); *(LAS u32x2*)(Bmtb + (n0 + e) * SS + rseg * 4) = o; }
            }
            { float f[8]; unpack8(xraw, f);
#pragma unroll
                for (int e = 0; e < 8; ++e) sXr[((tid >> 3) + 3) * 64 + (tid & 7) * 8 + e] = f[e]; }
        }
        if (wave == 0) {
            const float dt = softplusf(bf2f(dt_bits) + dtb);
            const float cum = scan_add64(dt * Aneg, lane);
            const float last = rdlane(cum, 63);
            sDt[lane] = dt; sCum[lane] = cum; sE[lane] = __expf(last - cum); sEc[lane] = __expf(cum);
            if (lane == 0) sScal[0] = __expf(last);
        }
        if (n > 0) store_pend(n - 1);
        if (n + 1 < 32) issue_loads(n + 1);
        lds_barrier();
        {
            const int p = tid & 63, mseg = tid >> 6;
            float xr[11];
#pragma unroll
            for (int i = 0; i < 11; ++i) xr[i] = sXr[(mseg * 8 + i) * 64 + p];
            float xd[8], xe[8];
#pragma unroll
            for (int r = 0; r < 8; ++r) {
                const int mm = mseg * 8 + r;
                const float x = siluf(cb0 + w0 * xr[r] + w1 * xr[r + 1] + w2 * xr[r + 2] + w3 * xr[r + 3]);
                sX[mm * 65 + p] = x; xd[r] = x * sDt[mm]; xe[r] = xd[r] * sE[mm];
            }
            u32x4 o; o.x = pk2(xd[0], xd[1]); o.y = pk2(xd[2], xd[3]); o.z = pk2(xd[4], xd[5]); o.w = pk2(xd[6], xd[7]); *(LAS u32x4*)(Xdtt + p * SS + mseg * 8) = o;
            o.x = pk2(xe[0], xe[1]); o.y = pk2(xe[2], xe[3]); o.z = pk2(xe[4], xe[5]); o.w = pk2(xe[6], xe[7]); *(LAS u32x4*)(Xett + p * SS + mseg * 8) = o;
        }
        for (int idx = wave; idx < 10; idx += 8) {
            int tl, ts; tri_tile(idx, tl, ts);
            const f32x4 a = mmb(128, Cmb + tl * 16 * QS, QS, Bmb + ts * 16 * QS, QS, (f32x4){0.f, 0.f, 0.f, 0.f}, li, kq);
#pragma unroll
            for (int j = 0; j < 4; ++j) {
                const int lr = tl * 16 + kq * 4 + j, sc = ts * 16 + li;
                Lcb[lr * SS + sc] = f2bf((sc <= lr) ? a[j] * __expf(sCum[lr] - sCum[sc]) : 0.f);
            }
        }
        lds_barrier();
        {
            const f32x4 z4 = {0.f, 0.f, 0.f, 0.f};
#pragma unroll
            for (int q = 0; q < 2; ++q) {
                const int tile = wave + q * 8, tl = tile >> 2, tp = tile & 3;
                const f32x4 a1 = mmb(64, Lcb + tl * 16 * SS, SS, Xdtt + tp * 16 * SS, SS, z4, li, kq);
                const f32x4 a2 = mmb(128, Cmb + tl * 16 * QS, QS, Sb + pb * 64 * QS + tp * 16 * QS, QS, z4, li, kq);
#pragma unroll
                for (int j = 0; j < 4; ++j) {
                    const int lr = tl * 16 + kq * 4 + j, p = tp * 16 + li;
                    const float y = a1[j] + sEc[lr] * a2[j] + dsk * sX[lr * 65 + p];
                    pend[q][j] = f2bf(y);
                }
            }
            const float elast = sScal[0];
#pragma unroll
            for (int q = 0; q < 4; ++q) {
                const int tile = wave + q * 8, tp2 = tile & 3, tn = tile >> 2;
                const f32x4 a = mmb(64, Xett + tp2 * 16 * SS, SS, Bmtb + tn * 16 * SS, SS, z4, li, kq);
                Sm[q] = Sm[q] * elast + a;
#pragma unroll
                for (int j = 0; j < 4; ++j) Sb[(pb ^ 1) * 64 * QS + (tp2 * 16 + kq * 4 + j) * QS + tn * 16 + li] = f2bf(Sm[q][j]);
            }
            if (tid < 192) hv = sXr[64 * 64 + tid];
        }
        lds_barrier();
    }
    store_pend(31);
}

__device__ __forceinline__ void gla_item(CP P, int l, int it, ldsf lds) {
    const int tid = opaque_tid(), wave = tid >> 6, lane = tid & 63, li = lane & 15, kq = lane >> 4;
    const int b = it >> 3, h = (it >> 1) & 3, vs = it & 1;
    constexpr int SS = 72;
    const ldsh Qgb = (ldsh)lds, Kgb = Qgb + 64 * SS, Kgtb = Kgb + 64 * SS, Vtb = Kgtb + 64 * SS, Attb = Vtb + 64 * SS, Stb = Attb + 64 * SS;
    const ldsf sQ = (ldsf)(Stb + 2 * 64 * SS), sK = sQ + 64 * 65, sCum = sK + 64 * 65, sGl = sCum + 64 * 65, sW2 = sGl + 64 * 17, sGb = sW2 + 16 * 64, sSeg = sGb + 64, sDec = sSeg + 8 * 64;
    const float* gw2 = LP(P, l, I_GK_W2); const float* gb = LP(P, l, I_GK_B);
    for (int e = tid; e < 16 * 64; e += 512) sW2[e] = gw2[(e >> 6) * 256 + h * 64 + (e & 63)];
    if (tid < 64) sGb[tid] = gb[h * 64 + tid];
    for (int e = tid; e < 64 * SS / 2; e += 512) ((LAS unsigned*)Attb)[e] = 0u;
    for (int e = tid; e < 2 * 64 * SS / 2; e += 512) ((LAS unsigned*)Stb)[e] = 0u;
    f32x4 Sm[2] = {{0.f, 0.f, 0.f, 0.f}, {0.f, 0.f, 0.f, 0.f}};
    uint4 qraw, kraw, xr, gr = make_uint4(0u, 0u, 0u, 0u);
    auto issue_loads = [&](int nn) {
        const int row = tid >> 3, cg = (tid & 7) * 8; const bf16_t* pr = P->proj + (size_t)(b * SEQL + nn * 64 + row) * LDP + h * 64 + cg;
        qraw = *(const uint4*)(pr + C_GQ); kraw = *(const uint4*)(pr + C_GK);
        xr = *(const uint4*)(P->proj + (size_t)(b * SEQL + nn * 64 + row) * LDP + C_GV + h * 128 + vs * 64 + cg);
        if (tid < 128) gr = *(const uint4*)(P->proj + (size_t)(b * SEQL + nn * 64 + (tid >> 1)) * LDP + C_GGK + (tid & 1) * 8);
    };
    bf16_t pend[2][4] = {{0, 0, 0, 0}, {0, 0, 0, 0}};
    auto store_pend = [&](int nprev) {
#pragma unroll
        for (int q = 0; q < 2; ++q) { const int tile = wave + q * 8, tl = tile >> 2, tv = tile & 3;
#pragma unroll
            for (int j = 0; j < 4; ++j) P->proj[(size_t)(b * SEQL + nprev * 64 + tl * 16 + kq * 4 + j) * LDP + C_GV + h * 128 + vs * 64 + tv * 16 + li] = pend[q][j]; }
    };
    issue_loads(0);
    __syncthreads();
    for (int n = 0; n < 32; ++n) {
        const int t0 = b * SEQL + n * 64, pb = n & 1;
        {
            const int row = tid >> 3, cg = (tid & 7) * 8;
            float f[8]; unpack8(qraw, f);
#pragma unroll
            for (int e = 0; e < 8; ++e) sQ[row * 65 + cg + e] = f[e] * 0.125f;
            unpack8(kraw, f);
#pragma unroll
            for (int e = 0; e < 8; ++e) sK[row * 65 + cg + e] = f[e];
            {
                const unsigned w4[4] = {xr.x, xr.y, xr.z, xr.w};
#pragma unroll
                for (int e = 0; e < 8; ++e) Vtb[(cg + e) * SS + row] = (bf16_t)((e & 1) ? (w4[e >> 1] >> 16) : (w4[e >> 1] & 0xffffu));
            }
            if (tid < 128) {
                unpack8(gr, f);
#pragma unroll
                for (int e = 0; e < 8; ++e) sGl[(tid >> 1) * 17 + (tid & 1) * 8 + e] = f[e];
            }
        }
        if (n > 0) store_pend(n - 1);
        if (n + 1 < 32) issue_loads(n + 1);
        lds_barrier();
        for (int e = tid; e < 4096; e += 512) {
            const int s = e >> 6, d = e & 63; float gk = sGb[d];
#pragma unroll
            for (int r = 0; r < 16; ++r) gk += sGl[s * 17 + r] * sW2[r * 64 + d];
            sCum[s * 65 + d] = logsigmoid_fast(gk) * 0.0625f;
        }
        lds_barrier();
        const int d = tid & 63, seg = tid >> 6;
        {
            float run = 0.f;
#pragma unroll
            for (int r = 0; r < 8; ++r) { run += sCum[(seg * 8 + r) * 65 + d]; sCum[(seg * 8 + r) * 65 + d] = run; }
            sSeg[seg * 64 + d] = run;
        }
        lds_barrier();
        {
            float off = 0.f;
            for (int s2 = 0; s2 < seg; ++s2) off += sSeg[s2 * 64 + d];
            float kg[8];
#pragma unroll
            for (int r = 0; r < 8; ++r) {
                const int s = seg * 8 + r; const float c = sCum[s * 65 + d] + off;
                const float ec = __expf(c);
                Qgb[s * SS + d] = f2bf(sQ[s * 65 + d] * ec);
                kg[r] = sK[s * 65 + d] * __expf(-c);
                Kgb[s * SS + d] = f2bf(kg[r]);
                if (s == 63) sDec[d] = ec;
            }
            u32x4 o; o.x = pk2(kg[0], kg[1]); o.y = pk2(kg[2], kg[3]); o.z = pk2(kg[4], kg[5]); o.w = pk2(kg[6], kg[7]);
            *(LAS u32x4*)(Kgtb + d * SS + seg * 8) = o;
        }
        lds_barrier();
        for (int idx = wave; idx < 10; idx += 8) {
            int tl, ts; tri_tile(idx, tl, ts);
            const f32x4 a = mmb(64, Qgb + tl * 16 * SS, SS, Kgb + ts * 16 * SS, SS, (f32x4){0.f, 0.f, 0.f, 0.f}, li, kq);
#pragma unroll
            for (int j = 0; j < 4; ++j) { const int lr = tl * 16 + kq * 4 + j, sc = ts * 16 + li; Attb[lr * SS + sc] = f2bf((sc <= lr) ? a[j] : 0.f); }
        }
        lds_barrier();
        {
            const f32x4 z4 = {0.f, 0.f, 0.f, 0.f};
#pragma unroll
            for (int q = 0; q < 2; ++q) {
                const int tile = wave + q * 8, tl = tile >> 2, tv = tile & 3;
                f32x4 a = mmb(64, Attb + tl * 16 * SS, SS, Vtb + tv * 16 * SS, SS, z4, li, kq);
                a = mmb(64, Qgb + tl * 16 * SS, SS, Stb + pb * 64 * SS + tv * 16 * SS, SS, a, li, kq);
#pragma unroll
                for (int j = 0; j < 4; ++j) pend[q][j] = f2bf(a[j]);
            }
#pragma unroll
            for (int q = 0; q < 2; ++q) {
                const int tile = wave + q * 8, td = tile >> 2, tv = tile & 3;
                const f32x4 u = mmb(64, Kgtb + td * 16 * SS, SS, Vtb + tv * 16 * SS, SS, z4, li, kq);
#pragma unroll
                for (int j = 0; j < 4; ++j) Sm[q][j] = sDec[td * 16 + kq * 4 + j] * (Sm[q][j] + u[j]);
                u32x2 o; o.x = pk2(Sm[q][0], Sm[q][1]); o.y = pk2(Sm[q][2], Sm[q][3]);
                *(LAS u32x2*)(Stb + (pb ^ 1) * 64 * SS + (tv * 16 + li) * SS + td * 16 + kq * 4) = o;
            }
        }
        lds_barrier();
    }
    store_pend(31);
}

#ifndef ITEM_MASK
#define ITEM_MASK 15
#endif
template <int IM = ITEM_MASK> __device__ __forceinline__ void scan_phase(CP P, int l, ldsf lds) {
    for (int it = blockIdx.x; it < N_ITEMS; it += gridDim.x) {
        if (it < N_RW) { if (IM & 1) rwkv_scan_item(P, l, it, lds); }
        else if (it < N_RW + 64) { if (IM & 2) mlstm_item(P, l, it - N_RW, lds); }
        else if (it < N_RW + 96) { if (IM & 4) ssd_item(P, l, it - N_RW - 64, lds); }
        else { if (IM & 8) gla_item(P, l, it - N_RW - 96, lds); }
        __syncthreads();
    }
}

__device__ __forceinline__ void finalize_phase(CP P, int l) {
    const Cols C = cols(l); const int wave = threadIdx.x >> 6, lane = threadIdx.x & 63, c8 = lane * 8;
    const float* gla_g = LP(P, l, I_GLA_NG); const float* mu = LP(P, l, I_RW_MU); const float* k_a = LP(P, l, I_RW_KA); const float* r_k = LP(P, l, I_RW_RK);
    const float* ln_g = LP(P, l, I_RW_LNG); const float* ln_b = LP(P, l, I_RW_LNB); const float* ssd_g = LP(P, l, I_SSD_NG); const float* ml_g = LP(P, l, I_ML_NG);
    for (int t = blockIdx.x * 8 + wave; t < M_TOK; t += gridDim.x * 8) {
        const bf16_t* pr = P->proj + (size_t)t * LDP; bf16_t* yo = P->actA + (size_t)t * DM;
        float a[8], z[8], y[8];
        {
            load8(pr + C_GV + c8, a); load8(pr + C_GZ + c8, z);
            float ss = 0.f;
#pragma unroll
            for (int e = 0; e < 8; ++e) ss += a[e] * a[e];
            ss += __shfl_xor(ss, 1); ss += __shfl_xor(ss, 2); ss += __shfl_xor(ss, 4); ss += __shfl_xor(ss, 8);
            const float rstd = rsqrtf(ss * (1.f / 128.f) + 1e-6f);
#pragma unroll
            for (int e = 0; e < 8; ++e) y[e] = a[e] * rstd * gla_g[c8 + e] * siluf(z[e]);
            store8(yo + c8, y);
        }
        {
            load8(pr + C.rw + 1024 + c8, a); load8(pr + C.rwz + c8, z);
            float s = 0.f;
#pragma unroll
            for (int e = 0; e < 8; ++e) s += a[e];
            s += __shfl_xor(s, 1); s += __shfl_xor(s, 2); s += __shfl_xor(s, 4);
            const float mean = s * (1.f / 64.f); float vs = 0.f;
#pragma unroll
            for (int e = 0; e < 8; ++e) { a[e] -= mean; vs += a[e] * a[e]; }
            vs += __shfl_xor(vs, 1); vs += __shfl_xor(vs, 2); vs += __shfl_xor(vs, 4);
            const float rstd = rsqrtf(vs * (1.f / 64.f) + 64e-5f);
            alignas(16) float vv[8];
            *(float4*)vv = *(const float4*)(P->rwV + (size_t)t * 512 + c8); *(float4*)(vv + 4) = *(const float4*)(P->rwV + (size_t)t * 512 + c8 + 4);
            const float bs = P->bon[(size_t)t * 8 + (lane >> 3)];
#pragma unroll
            for (int e = 0; e < 8; ++e) y[e] = (a[e] * rstd * ln_g[c8 + e] + ln_b[c8 + e] + bs * vv[e]) * siluf(z[e]);
            store8(yo + 512 + c8, y);
        }
        {
            load8(pr + C.sx + c8, a); load8(pr + C.sz + c8, z);
            float ss = 0.f;
#pragma unroll
            for (int e = 0; e < 8; ++e) { a[e] *= siluf(z[e]); ss += a[e] * a[e]; }
            ss = wave_sum(ss);
            const float rstd = rsqrtf(ss * (1.f / 512.f) + 1e-6f);
#pragma unroll
            for (int e = 0; e < 8; ++e) y[e] = a[e] * rstd * ssd_g[c8 + e];
            store8(yo + 1024 + c8, y);
        }
        {
            float o[8];
            load8(pr + C.mv + c8, a); load8(pr + C.mo + c8, o); load8(pr + C.mz + c8, z);
            float s = 0.f;
#pragma unroll
            for (int e = 0; e < 8; ++e) { a[e] *= sigmoidf_(o[e]); s += a[e]; }
            s += __shfl_xor(s, 1); s += __shfl_xor(s, 2); s += __shfl_xor(s, 4); s += __shfl_xor(s, 8);
            const float mean = s * (1.f / 128.f); float vs = 0.f;
#pragma unroll
            for (int e = 0; e < 8; ++e) { a[e] -= mean; vs += a[e] * a[e]; }
            vs += __shfl_xor(vs, 1); vs += __shfl_xor(vs, 2); vs += __shfl_xor(vs, 4); vs += __shfl_xor(vs, 8);
            const float rstd = rsqrtf(vs * (1.f / 128.f) + 1e-6f);
#pragma unroll
            for (int e = 0; e < 8; ++e) y[e] = a[e] * rstd * ml_g[c8 + e] * siluf(z[e]);
            store8(yo + 1536 + c8, y);
        }
    }
}

__device__ __forceinline__ void final_norm(CP P) {
    const int wave = threadIdx.x >> 6, lane = threadIdx.x & 63, rstep = gridDim.x * 8; const float4* gr = (const float4*)P->in[57];
    float4 gg[8];
#pragma unroll
    for (int i = 0; i < 8; ++i) gg[i] = gr[lane + i * 64];
    int row = blockIdx.x * 8 + wave;
    float4 cur[8], nxt[8]; float sc = 0.f, sn = 0.f;
    if (row < M_TOK) {
#pragma unroll
        for (int i = 0; i < 8; ++i) cur[i] = ((const float4*)(P->out + (size_t)row * DM))[lane + i * 64];
        sc = (lane < XSSN) ? P->xss2[(size_t)row * XSSN + lane] : 0.f;
    }
    for (; row < M_TOK; row += rstep) {
        const int rn = row + rstep < M_TOK ? row + rstep : row;
#pragma unroll
        for (int i = 0; i < 8; ++i) nxt[i] = ((const float4*)(P->out + (size_t)rn * DM))[lane + i * 64];
        sn = (lane < XSSN) ? P->xss2[(size_t)rn * XSSN + lane] : 0.f;
        const float rstd = rsqrtf(wave_sum(sc) * (1.f / DM) + 1e-6f);
        float4* xr = (float4*)(P->out + (size_t)row * DM);
#pragma unroll
        for (int i = 0; i < 8; ++i) { float4 v = cur[i]; v.x *= rstd * gg[i].x; v.y *= rstd * gg[i].y; v.z *= rstd * gg[i].z; v.w *= rstd * gg[i].w; xr[lane + i * 64] = v; }
#pragma unroll
        for (int i = 0; i < 8; ++i) cur[i] = nxt[i];
        sc = sn;
    }
}

#define XB_TMO      128
#define XB_XCNT(j)  (256  + 64 * (j))
#define XB_XSUB(j)  (1280 + 64 * (j))
#define XB_XGEN(j)  (2304 + 64 * (j))
#define XB_TOP      3328
#define XB_TOPGEN   3392
#define XCD_BAR_WORDS 3456
#define XB_SPIN_CAP (1u << 18)

__device__ __forceinline__ unsigned xb_ld(unsigned* p)              { return __hip_atomic_load(p, __ATOMIC_RELAXED, __HIP_MEMORY_SCOPE_AGENT); }
__device__ __forceinline__ unsigned xb_add(unsigned* p, unsigned v) { return __hip_atomic_fetch_add(p, v, __ATOMIC_RELAXED, __HIP_MEMORY_SCOPE_AGENT); }
__device__ __forceinline__ unsigned xb_xcc_id() { return (unsigned)__builtin_amdgcn_s_getreg((3 << 11) | 20) & 0xFu; }
#define XB_SPIN(cond, bar) do { unsigned _sp = 0; while (cond) { __builtin_amdgcn_s_sleep(1); \
    if ((++_sp & 255u) == 0u) { if (xb_ld(&(bar)[XB_TMO])) break; if (_sp > XB_SPIN_CAP) { atomicAdd(&(bar)[XB_TMO], 1u); break; } } } } while (0)

struct XcdBarrier {
    unsigned* bar; unsigned x;
    volatile LAS unsigned* st;
};

__device__ __forceinline__ XcdBarrier xcd_barrier_post(unsigned* bar, volatile LAS unsigned* st) {
    XcdBarrier b; b.bar = bar; b.x = xb_xcc_id(); b.st = st;
    if (threadIdx.x == 0) (void)xb_add(&bar[XB_XCNT(b.x)], 1u);
    return b;
}
__device__ __forceinline__ void xcd_barrier_complete(unsigned* bar, unsigned x, unsigned& nloc, unsigned& nx) {
    const unsigned G = gridDim.x * gridDim.y * gridDim.z;
    unsigned sum, cnt, mine, sp = 0u;
    for (;;) {
        sum = 0u; cnt = 0u; mine = 0u;
#pragma unroll
        for (unsigned j = 0; j < 16; ++j) { const unsigned c = xb_ld(&bar[XB_XCNT(j)]); sum += c; cnt += (c > 0u) ? 1u : 0u; mine = (j == x) ? c : mine; }
        if (sum == G) break;
        __builtin_amdgcn_s_sleep(1);
        if ((++sp & 255u) == 0u) { if (xb_ld(&bar[XB_TMO])) break; if (sp > XB_SPIN_CAP) { atomicAdd(&bar[XB_TMO], 1u); break; } }
    }
    nloc = mine > 0u ? mine : 1u; nx = cnt > 0u ? cnt : 1u;
}

__device__ __forceinline__ void xcd_barrier(const XcdBarrier& b) {
    asm volatile("s_waitcnt vmcnt(0)" ::: "memory");
    __syncthreads();
    if (threadIdx.x == 0) {
        unsigned* bar = b.bar;
        __builtin_amdgcn_s_waitcnt(0);
        unsigned nloc = b.st[0], nx = b.st[1];
        if (nloc == 0u) { xcd_barrier_complete(bar, b.x, nloc, nx); b.st[0] = nloc; b.st[1] = nx; }
        const unsigned old = xb_add(&bar[XB_XSUB(b.x)], 1u);
        const unsigned gen = old / nloc;
        if (old + 1u == (gen + 1u) * nloc) {
            __builtin_amdgcn_fence(__ATOMIC_RELEASE, "agent");
            asm volatile("s_waitcnt vmcnt(0)" ::: "memory");
            const unsigned og = xb_add(&bar[XB_TOP], 1u);
            const unsigned tg = og / nx;
            if (og + 1u == (tg + 1u) * nx) xb_add(&bar[XB_TOPGEN], 1u);
            else XB_SPIN(xb_ld(&bar[XB_TOPGEN]) == tg, bar);
            __builtin_amdgcn_fence(__ATOMIC_ACQUIRE, "agent");
            xb_add(&bar[XB_XGEN(b.x)], 1u);
            asm volatile("s_waitcnt vmcnt(0)" ::: "memory");
        } else {
            XB_SPIN(xb_ld(&bar[XB_XGEN(b.x)]) == gen, bar);
            __builtin_amdgcn_fence(__ATOMIC_ACQUIRE, "agent");
            asm volatile("s_waitcnt vmcnt(0)" ::: "memory");
        }
    }
    __syncthreads();
}


template <bool PRE> __device__ __forceinline__ void gemm_inproj(CP P, const bf16_t* A, const float* xss, PG8_LAS unsigned char* lds) {
    pg8::Gemm g; g.A = A; g.Bt = P->Wi; g.M = M_TOK; g.N = LDP; g.K = DM;
    pg8::StaticOrder S; S.init(g.M, g.N, (int)gridDim.x, (int)blockIdx.x);
    EpiProj<PRE> E; E.O = P->proj; E.xss = xss;
    pg8::gemm_phase<EpiProj<PRE>, pg8::StaticOrder, false>(lds, g, S, E, nullptr);
}
__device__ __forceinline__ void gemm_outproj(CP P, const bf16_t* Wo, const float* xin, bf16_t* xb, float* xss, PG8_LAS unsigned char* lds) {
    pg8::Gemm g; g.A = P->actA; g.Bt = Wo; g.M = M_TOK; g.N = DM; g.K = DM;
    pg8::StaticOrder S; S.init(g.M, g.N, (int)gridDim.x, (int)blockIdx.x);
    EpiOut E; E.xin = xin; E.xout = P->out; E.xb = xb; E.xss = xss;
    pg8::gemm_phase<EpiOut, pg8::StaticOrder, false>(lds, g, S, E, nullptr);
}

#ifndef PROBE_DUP
#define PROBE_DUP 0
#endif
#ifndef PH_MASK
#define PH_MASK 0xFFF
#endif
#define RUN_PHASE(k, body) do { if ((PH_MASK >> (k)) & 1) { if (ph_lo <= (k) && (k) < ph_hi) { CP P = Pc; asm volatile("" : "+s"(P)); body; if ((PROBE_DUP >> (k)) & 1) { __syncthreads(); body; } if (coop && (k) + 1 < ph_hi) { if (coop == 2) grid.sync(); else xcd_barrier(xb); } } } } while (0)
__global__ void __launch_bounds__(512, 2) mega(Params Pk, int ph_lo, int ph_hi, int coop) {
    extern __shared__ __attribute__((aligned(16))) unsigned char shm[];
    PG8_LAS unsigned char* ldsb = (PG8_LAS unsigned char*)shm; ldsf lds = (ldsf)shm;
    cg::grid_group grid = cg::this_grid();
    const CP Pc = (CP)__builtin_amdgcn_kernarg_segment_ptr();
    volatile LAS unsigned* stw = (volatile LAS unsigned*)(shm + LDS_BYTES - 16);
    if (threadIdx.x < 4) stw[threadIdx.x] = 0u;
    __syncthreads();
    XcdBarrier xb = xcd_barrier_post(Pc->bar, stw);
    RUN_PHASE(0, { transpose_convert(P->in[2], DM, 7840, LDP, P->Wi, P->in[1], lds); x_convert(P); lora_convert(P); });
#ifdef PROBE_PRE
    { CP P = Pc; asm volatile("" : "+s"(P)); gemm_inproj<true>(P, P->actA, P->xss0, ldsb); grid.sync(); rwkv_prep(P, 0, lds); grid.sync(); scan_phase<PROBE_PRE>(P, 0, lds); grid.sync(); }
#endif
    RUN_PHASE(1, { gemm_inproj<true>(P, P->actA, P->xss0, ldsb);
                   const int nfull = (M_TOK / 256) * (LDP / 256) % (int)gridDim.x;
                   if (nfull > 0 && (int)blockIdx.x >= nfull) transpose_convert(P->in[3], DM, DM, DM, P->Wo0, nullptr, lds, (int)blockIdx.x - nfull, (int)gridDim.x - nfull);
                   else if (nfull == 0) transpose_convert(P->in[3], DM, DM, DM, P->Wo0, nullptr, lds); });
    RUN_PHASE(2, rwkv_prep(P, 0, lds));
    RUN_PHASE(3, scan_phase(P, 0, lds));
    RUN_PHASE(4, { finalize_phase(P, 0); transpose_convert(P->in[29], DM, 7872, LDP, P->Wi, P->in[28], lds); });
    RUN_PHASE(5, gemm_outproj(P, P->Wo0, P->in[0], P->xb1, P->xss1, ldsb));
    RUN_PHASE(6, { gemm_inproj<false>(P, P->xb1, P->xss1, ldsb);
                   const int nfull = (M_TOK / 256) * (LDP / 256) % (int)gridDim.x;
                   if (nfull > 0 && (int)blockIdx.x >= nfull) transpose_convert(P->in[30], DM, DM, DM, P->Wo1, nullptr, lds, (int)blockIdx.x - nfull, (int)gridDim.x - nfull);
                   else if (nfull == 0) transpose_convert(P->in[30], DM, DM, DM, P->Wo1, nullptr, lds); });
    RUN_PHASE(7, rwkv_prep(P, 1, lds));
    RUN_PHASE(8, scan_phase(P, 1, lds));
    RUN_PHASE(9, finalize_phase(P, 1));
    RUN_PHASE(10, gemm_outproj(P, P->Wo1, P->out, nullptr, P->xss2, ldsb));
    RUN_PHASE(11, final_norm(P));
}

#ifndef MK_COOP
#define MK_COOP 1
#endif
extern "C" void kernel_launch(void* const* d_in, const int* in_sizes, int n_in, void* d_out, int out_size, void* d_ws, size_t ws_size, hipStream_t stream) {
    Params p{};
    for (int i = 0; i < 58; ++i) p.in[i] = (const float*)d_in[i];
    p.out = (float*)d_out;
    char* w = (char*)d_ws; size_t off = 0;
    auto take = [&](size_t bytes) { char* r = w + off; off += (bytes + 255) & ~(size_t)255; return r; };
    p.Wi = (bf16_t*)take((size_t)LDP * DM * 2);
    p.Wo0 = (bf16_t*)take((size_t)DM * DM * 2);
    p.Wo1 = (bf16_t*)take((size_t)DM * DM * 2);
    p.actA = (bf16_t*)take((size_t)M_TOK * DM * 2);
    p.proj = (bf16_t*)take((size_t)M_TOK * LDP * 2);
    p.rwA = (float*)take((size_t)M_TOK * 512 * 4);
    p.rwB = (float*)take((size_t)M_TOK * 512 * 4);
    p.xb1 = (bf16_t*)p.rwA;
    p.rwV = (float*)take((size_t)M_TOK * 512 * 4);
    p.xss0 = (float*)take((size_t)M_TOK * XSSN * 4);
    p.xss1 = (float*)take((size_t)M_TOK * XSSN * 4);
    p.xss2 = (float*)take((size_t)M_TOK * XSSN * 4);
    p.bar = (unsigned*)take((size_t)XCD_BAR_WORDS * 4);
    p.lora = (bf16_t*)take((size_t)LORA_ELEMS * 2);
    p.bon = (float*)take((size_t)M_TOK * 8 * 4);
    if (off > ws_size) { fprintf(stderr, "workspace too small: need %zu have %zu\n", off, ws_size); return; }
    static int grid_blocks = 0;
    if (!grid_blocks) {
        hipFuncSetAttribute((const void*)mega, hipFuncAttributeMaxDynamicSharedMemorySize, LDS_BYTES);
        int dev = 0, cus = 0, per_cu = 0;
        hipGetDevice(&dev);
        hipDeviceGetAttribute(&cus, hipDeviceAttributeMultiprocessorCount, dev);
        hipOccupancyMaxActiveBlocksPerMultiprocessor(&per_cu, mega, 512, LDS_BYTES);
        if (per_cu > 1) per_cu = 1;
        grid_blocks = cus * per_cu;
        if (grid_blocks <= 0) grid_blocks = 256;
    }
#if MK_COOP
    hipMemsetAsync(p.bar, 0, (size_t)XCD_BAR_WORDS * 4, stream);
    int lo = 0, hi = N_PHASES, coop = 1;
    void* args[] = {&p, &lo, &hi, &coop};
    hipError_t e = hipLaunchCooperativeKernel((const void*)mega, dim3(grid_blocks), dim3(512), args, LDS_BYTES, stream);
    if (e != hipSuccess) fprintf(stderr, "cooperative launch failed: %s (grid %d)\n", hipGetErrorString(e), grid_blocks);
#else
    for (int ph = 0; ph < N_PHASES; ++ph) hipLaunchKernelGGL(mega, dim3(grid_blocks), dim3(512), LDS_BYTES, stream, p, ph, ph + 1, 0);
#endif
}
```

```cpp
#include <hip/hip_runtime.h>
#include <hip/hip_cooperative_groups.h>
#include <cstdio>
namespace cg = cooperative_groups;

namespace pg8 {
#define PG8_LAS __attribute__((address_space(3)))
typedef unsigned short bf16_t;
typedef short bf16x8 __attribute__((ext_vector_type(8)));
typedef float f32x4 __attribute__((ext_vector_type(4)));
typedef unsigned u32x4 __attribute__((ext_vector_type(4)));
constexpr int BM = 256, BK = 64, HALF = 128, HTB = HALF * BK * 2  , STAGE_BYTES = 8 * HTB, NXCD = 8, WGM = 8;

__host__ __device__ __forceinline__ int lds_byte(int r, int c) { const int st = (r >> 4) * 2 + (c >> 5), rr = r & 15, cc = c & 31, ob = rr * 64 + cc * 2; return st * 1024 + (ob ^ (((ob >> 9) & 1) << 5)); }
__host__ __device__ __forceinline__ void stage_rc(int b, int& R, int& C) { const int st = b / 1024, sb = b % 1024, swz = sb ^ (((sb >> 9) & 1) << 5); R = (st >> 1) * 16 + swz / 64; C = (st & 1) * 32 + (swz % 64) / 2; }
__host__ __device__ __forceinline__ int perm32(int rho) { const int n = rho >> 4, i = rho & 15; return 8 * (i >> 2) + 4 * n + (i & 3); }

struct Unit { int pm, pn; };
struct Gemm { const bf16_t* A; const bf16_t* Bt; int M, N, K; };

struct StaticOrder {
    int nM, nN, nwg, G, c;
    __host__ __device__ void init(int M, int N, int G_, int c_) { nM = M / BM; nN = N / BM; nwg = nM * nN; G = G_; c = c_; }
    __host__ __device__ bool next(int i, Unit& u) const {
        const long L = (long)i * G + c; if (L >= nwg) return false;
        int wgid = (int)L; { const int q = nwg / NXCD, r = nwg % NXCD, xcd = wgid % NXCD, off = wgid / NXCD; wgid = (xcd < r ? xcd * (q + 1) : r * (q + 1) + (xcd - r) * q) + off; }
        const int nig = WGM * nN, gid = wgid / nig, fm = gid * WGM, gsz = (nM - fm) < WGM ? (nM - fm) : WGM;
        u.pm = fm + ((wgid % nig) % gsz); u.pn = (wgid % nig) / gsz; return true;
    }
    __device__ __forceinline__ void a_ready(const Unit&) const {}
    __device__ __forceinline__ void done(const Unit&) const {}
};
__device__ __forceinline__ unsigned cvt_pk_bf16(float lo, float hi) { unsigned r; asm volatile("v_cvt_pk_bf16_f32 %0, %1, %2" : "=v"(r) : "v"(lo), "v"(hi)); return r; }
template <class Epi, class Sched, bool STAMP = false>
__device__ __forceinline__ void gemm_phase(PG8_LAS unsigned char* lds, const Gemm g, const Sched& S, const Epi& E, unsigned long long* stamps) {
    const int tid = threadIdx.x, wid = __builtin_amdgcn_readfirstlane(tid >> 6), lane = tid & 63, wr = wid >> 2, wc = wid & 3, fr = lane & 15, fq = lane >> 4;
    const int K = g.K, nt = K / BK;
    int ts_lo = 0, ts_hi = 0, nts = 0; const unsigned long long rt_entry = STAMP ? (unsigned long long)wall_clock64() : 0ull;
#define PG8_STAMP() do { if (STAMP && wid == 0 && nts < 64) { const unsigned long long _c = (unsigned long long)clock64(); \
        ts_lo = (lane == nts) ? (int)(unsigned)_c : ts_lo; ts_hi = (lane == nts) ? (int)(unsigned)(_c >> 32) : ts_hi; ++nts; } } while (0)
    PG8_STAMP();
    unsigned voffA[2], voffB[2];
#pragma unroll
    for (int i = 0; i < 2; ++i) { int R, C; stage_rc(tid * 16 + i * 8192, R, C); const int Rb = Epi::PERM ? ((R & ~31) + perm32(R & 31)) : R;
        voffA[i] = (unsigned)(R * K + C) * 2u; voffB[i] = (unsigned)(Rb * K + C) * 2u; }
    const size_t kstep = (size_t)(BK * 2);
    const size_t hstep = (size_t)HALF * K * 2;
    const size_t tstep = 2 * hstep;
    const unsigned ldsw = (unsigned)wid * 1024u;
    const int aoff = lds_byte(wr * 64 + fr, fq * 8), boff = lds_byte(wc * 32 + fr, fq * 8);
#define PG8_SA(b, h) (((b) * 2 + (h)) * HTB)
#define PG8_SB(b, h) ((4 + (b) * 2 + (h)) * HTB)
#define PG8_STAGE(bufoff, gbase, voff) do { _Pragma("unroll") for (int _i = 0; _i < 2; ++_i) \
        __builtin_amdgcn_global_load_lds((const unsigned*)((const char*)(gbase) + (voff)[_i]), (PG8_LAS unsigned*)(lds + (bufoff) + ldsw + _i * 8192), 16, 0, 0); } while (0)
#define PG8_LDA(dst, b, h) do { _Pragma("unroll") for (int m = 0; m < 4; ++m) _Pragma("unroll") for (int k = 0; k < 2; ++k) dst[m][k] = *(const PG8_LAS bf16x8*)(lds + PG8_SA(b, h) + aoff + m * 2048 + k * 1024); } while (0)
#define PG8_LDB(dst, b, h) do { _Pragma("unroll") for (int n = 0; n < 2; ++n) _Pragma("unroll") for (int k = 0; k < 2; ++k) dst[n][k] = *(const PG8_LAS bf16x8*)(lds + PG8_SB(b, h) + boff + n * 2048 + k * 1024); } while (0)
#define PG8_MMA(ai, bj, At, Bt) do { __builtin_amdgcn_s_setprio(1); _Pragma("unroll") for (int m = 0; m < 4; ++m) _Pragma("unroll") for (int n = 0; n < 2; ++n) _Pragma("unroll") for (int k = 0; k < 2; ++k) \
        acc[ai][bj][m][n] = __builtin_amdgcn_mfma_f32_16x16x32_bf16(Bt[n][k], At[m][k], acc[ai][bj][m][n], 0, 0, 0); __builtin_amdgcn_s_setprio(0); } while (0)
#define PG8_WAIT_V(n) asm volatile("s_waitcnt vmcnt(" #n ")" ::: "memory")
#define PG8_WAIT_L(n) asm volatile("s_waitcnt lgkmcnt(" #n ")" ::: "memory")
#define PG8_BAR __builtin_amdgcn_s_barrier()
#define PG8_SCHED __builtin_amdgcn_sched_barrier(0)
    Unit cur, nxt; int ui = 0;
    if (!S.next(0, cur)) return;
    f32x4 acc[2][2][4][2];
#pragma unroll
    for (int a = 0; a < 2; ++a)
#pragma unroll
        for (int b = 0; b < 2; ++b)
#pragma unroll
            for (int m = 0; m < 4; ++m)
#pragma unroll
                for (int n = 0; n < 2; ++n) acc[a][b][m][n] = (f32x4){0.f, 0.f, 0.f, 0.f};
    bf16x8 At[4][2], B0[2][2], B1[2][2];
    const char* cA = (const char*)g.A + (size_t)cur.pm * tstep; const char* cB = (const char*)g.Bt + (size_t)cur.pn * tstep;
    S.a_ready(cur);
    PG8_STAGE(PG8_SB(0, 0), cB, voffB); PG8_STAGE(PG8_SA(0, 0), cA, voffA); PG8_STAGE(PG8_SB(0, 1), cB + hstep, voffB); PG8_STAGE(PG8_SA(0, 1), cA + hstep, voffA);
    if (wr == 1) PG8_BAR;
    PG8_WAIT_V(4); PG8_BAR;
    PG8_STAGE(PG8_SB(1, 0), cB + kstep, voffB); PG8_STAGE(PG8_SA(1, 0), cA + kstep, voffA); PG8_STAGE(PG8_SB(1, 1), cB + hstep + kstep, voffB);
    PG8_WAIT_V(6); PG8_BAR;
    PG8_STAMP();
    for (;;) {
        const bool has_next = S.next(ui + 1, nxt);
        const char* nA = has_next ? (const char*)g.A + (size_t)nxt.pm * tstep : cA; const char* nB = has_next ? (const char*)g.Bt + (size_t)nxt.pn * tstep : cB;
        for (int t = 0; t < nt; t += 2) {
            const bool last = (t == nt - 2);
            const char* a1 = cA + (size_t)(t + 1) * kstep;
            const char* a2 = last ? nA : cA + (size_t)(t + 2) * kstep; const char* b2 = last ? nB : cB + (size_t)(t + 2) * kstep;
            const char* a3 = a2 + kstep; const char* b3 = b2 + kstep;
            if (last && has_next) S.a_ready(nxt);
            PG8_LDB(B0, 0, 0); PG8_SCHED; PG8_LDA(At, 0, 0); PG8_STAGE(PG8_SA(1, 1), a1 + hstep, voffA);
            PG8_WAIT_L(8); PG8_BAR; PG8_WAIT_L(0); PG8_MMA(0, 0, At, B0); PG8_BAR; PG8_SCHED;
            PG8_LDB(B1, 0, 1); PG8_STAGE(PG8_SB(0, 0), b2, voffB);
            PG8_BAR; PG8_WAIT_L(0); PG8_MMA(0, 1, At, B1); PG8_BAR;
            PG8_LDA(At, 0, 1); PG8_STAGE(PG8_SA(0, 0), a2, voffA);
            PG8_BAR; PG8_WAIT_L(0); PG8_MMA(1, 0, At, B0); PG8_BAR; PG8_SCHED;
            PG8_STAGE(PG8_SB(0, 1), b2 + hstep, voffB);
            PG8_WAIT_V(6); PG8_BAR; PG8_MMA(1, 1, At, B1); PG8_BAR;
            PG8_LDB(B0, 1, 0); PG8_SCHED; PG8_LDA(At, 1, 0); PG8_STAGE(PG8_SA(0, 1), a2 + hstep, voffA);
            PG8_WAIT_L(8); PG8_BAR; PG8_WAIT_L(0); PG8_MMA(0, 0, At, B0); PG8_BAR; PG8_SCHED;
            PG8_LDB(B1, 1, 1); PG8_STAGE(PG8_SB(1, 0), b3, voffB);
            PG8_BAR; PG8_WAIT_L(0); PG8_MMA(0, 1, At, B1); PG8_BAR;
            PG8_LDA(At, 1, 1); PG8_STAGE(PG8_SA(1, 0), a3, voffA);
            PG8_BAR; PG8_WAIT_L(0); PG8_MMA(1, 0, At, B0); PG8_BAR; PG8_SCHED;
            PG8_STAGE(PG8_SB(1, 1), b3 + hstep, voffB);
            PG8_WAIT_V(6); PG8_BAR; PG8_MMA(1, 1, At, B1); PG8_BAR;
        }
        PG8_STAMP();
        if constexpr (!Epi::AFTER_DRAIN) { E(acc, cur, wr, wc, fr, fq); S.done(cur); }
        PG8_STAMP();
        if (!has_next) break;
#pragma unroll
        for (int a = 0; a < 2; ++a)
#pragma unroll
            for (int b = 0; b < 2; ++b)
#pragma unroll
                for (int m = 0; m < 4; ++m)
#pragma unroll
                    for (int n = 0; n < 2; ++n) acc[a][b][m][n] = (f32x4){0.f, 0.f, 0.f, 0.f};
        cur = nxt; cA = nA; cB = nB; ++ui;
    }
    PG8_WAIT_V(0);
    if (wr == 0) PG8_BAR;
    PG8_BAR;
    if constexpr (Epi::AFTER_DRAIN) { E.fused(acc, cur, wr, wc, fr, fq, lds, wid, lane); S.done(cur); }
    PG8_STAMP();
    if (STAMP && wid == 0) { stamps[lane] = lane < nts ? (((unsigned long long)(unsigned)ts_hi << 32) | (unsigned)ts_lo) : 0ull;
        if (lane == 62) stamps[62] = rt_entry; if (lane == 63) stamps[63] = (unsigned long long)wall_clock64(); }
#undef PG8_STAMP
#undef PG8_SA
#undef PG8_SB
#undef PG8_STAGE
#undef PG8_LDA
#undef PG8_LDB
#undef PG8_MMA
#undef PG8_WAIT_V
#undef PG8_WAIT_L
#undef PG8_BAR
#undef PG8_SCHED
}
}

typedef unsigned short bf16_t;
typedef float f32x4 __attribute__((ext_vector_type(4)));
#define LAS __attribute__((address_space(3)))
typedef LAS float* ldsf;

constexpr int M_TOK = 8192, DM = 2048, SEQL = 2048, LDP = 7936, XSSN = 32;
constexpr int LDS_BYTES = 160 * 1024;
constexpr int N_PHASES = 12;
constexpr int LORA_L = 2 * 512 * 64 + 512 * 32, LORA_ELEMS = 2 * LORA_L;
constexpr int N_RW = 128, N_ITEMS = N_RW + 128;

enum { I_NORM_G = 0, I_W_IN, I_W_OUT, I_GK_W2, I_GK_B, I_GLA_NG, I_RW_MU, I_RW_W0, I_RW_W2, I_RW_A0, I_RW_A2, I_RW_KK, I_RW_KA, I_RW_RK, I_RW_LNG, I_RW_LNB,
       I_SSD_CW, I_SSD_CB, I_SSD_DTB, I_SSD_ALOG, I_SSD_D, I_SSD_NG, I_ML_CW, I_ML_CB, I_ML_IGB, I_ML_FGB, I_ML_NG };

struct Params {
    const float* in[58];
    float* out;
    bf16_t* Wi; bf16_t* Wo0; bf16_t* Wo1; bf16_t* actA; bf16_t* proj; bf16_t* xb1;
    float* rwA; float* rwB; float* rwV; float* xss0; float* xss1; float* xss2; unsigned* bar; bf16_t* lora; float* bon;
};
typedef const __attribute__((address_space(4))) Params* CP;
__device__ __forceinline__ const float* LP(CP P, int l, int idx) { return P->in[(l ? 28 : 1) + idx + ((l && idx >= I_RW_KK) ? 2 : 0)]; }

struct Cols { int rw, rwz, sx, sdt, sz, mqk, mv, mi, mf, mo, mz, nin; };
__device__ __forceinline__ Cols cols(int l) {
    const int RW = l ? 1696 : 1664; Cols c;
    c.rw = 1552; c.rwz = 1552 + RW; c.sx = c.rwz + 512; c.sdt = c.sx + 1024; c.sz = c.sdt + 8; c.mqk = c.sz + 512; c.mv = c.mqk + 1024;
    c.mi = c.mv + 512; c.mf = c.mi + 4; c.mo = c.mf + 4; c.mz = c.mo + 512; c.nin = c.mz + 512; return c;
}
constexpr int C_GQ = 0, C_GK = 256, C_GV = 512, C_GGK = 1024, C_GZ = 1040;

__device__ __forceinline__ float bf2f(bf16_t u) { return __uint_as_float(((unsigned)u) << 16); }
__device__ __forceinline__ bf16_t f2bf(float f) { unsigned u = __float_as_uint(f); u += 0x7FFFu + ((u >> 16) & 1u); return (bf16_t)(u >> 16); }
__device__ __forceinline__ unsigned pack2(float lo, float hi) { return (unsigned)f2bf(lo) | ((unsigned)f2bf(hi) << 16); }
__device__ __forceinline__ void unpack8(const uint4 u, float* f) {
    f[0] = __uint_as_float(u.x << 16); f[1] = __uint_as_float(u.x & 0xffff0000u); f[2] = __uint_as_float(u.y << 16); f[3] = __uint_as_float(u.y & 0xffff0000u);
    f[4] = __uint_as_float(u.z << 16); f[5] = __uint_as_float(u.z & 0xffff0000u); f[6] = __uint_as_float(u.w << 16); f[7] = __uint_as_float(u.w & 0xffff0000u);
}
__device__ __forceinline__ void load8(const bf16_t* p, float* f) { unpack8(*(const uint4*)p, f); }
__device__ __forceinline__ void store8(bf16_t* p, const float* f) { uint4 u; u.x = pack2(f[0], f[1]); u.y = pack2(f[2], f[3]); u.z = pack2(f[4], f[5]); u.w = pack2(f[6], f[7]); *(uint4*)p = u; }
__device__ __forceinline__ float softplusf(float x) { return fmaxf(x, 0.f) + log1pf(expf(-fabsf(x))); }
__device__ __forceinline__ float logsigmoidf(float x) { return fminf(x, 0.f) - log1pf(expf(-fabsf(x))); }
__device__ __forceinline__ float sigmoidf_(float x) { return __builtin_amdgcn_rcpf(1.f + __expf(-x)); }
__device__ __forceinline__ float siluf(float x) { return x * __builtin_amdgcn_rcpf(1.f + __expf(-x)); }
__device__ __forceinline__ float logsigmoid_fast(float x) { return fminf(x, 0.f) - __logf(1.f + __expf(-fabsf(x))); }
typedef float f32x2 __attribute__((ext_vector_type(2)));
__device__ __forceinline__ float wave_sum(float v) { for (int o = 32; o; o >>= 1) v += __shfl_xor(v, o); return v; }
__device__ __forceinline__ float wave_max(float v) { for (int o = 32; o; o >>= 1) v = fmaxf(v, __shfl_xor(v, o)); return v; }
template <int CTRL> __device__ __forceinline__ float dppf(float v) { return __int_as_float(__builtin_amdgcn_update_dpp(0, __float_as_int(v), CTRL, 0xF, 0xF, true)); }
__device__ __forceinline__ float reduce16(float v) { v += dppf<0xB1>(v); v += dppf<0x4E>(v); v += dppf<0x141>(v); v += dppf<0x140>(v); return v; }
__device__ __forceinline__ float reduce8(float v) { v += dppf<0xB1>(v); v += dppf<0x4E>(v); v += dppf<0x141>(v); return v; }

template <int CTRL> __device__ __forceinline__ float dpp_keep(float oldv, float v) { return __int_as_float(__builtin_amdgcn_update_dpp(__float_as_int(oldv), __float_as_int(v), CTRL, 0xF, 0xF, false)); }
__device__ __forceinline__ float rdlane(float v, int l) { return __int_as_float(__builtin_amdgcn_readlane(__float_as_int(v), l)); }
__device__ __forceinline__ float scan_add64(float v, int lane) {
    v += dppf<0x111>(v); v += dppf<0x112>(v); v += dppf<0x114>(v); v += dppf<0x118>(v);
    const float t0 = rdlane(v, 15), t1 = rdlane(v, 31), t2 = rdlane(v, 47); const int row = lane >> 4;
    return v + ((row >= 1) ? t0 : 0.f) + ((row >= 2) ? t1 : 0.f) + ((row >= 3) ? t2 : 0.f);
}
__device__ __forceinline__ float scan_max64(float v, int lane) {
    const float ninf = -__builtin_inff();
    v = fmaxf(v, dpp_keep<0x111>(ninf, v)); v = fmaxf(v, dpp_keep<0x112>(ninf, v)); v = fmaxf(v, dpp_keep<0x114>(ninf, v)); v = fmaxf(v, dpp_keep<0x118>(ninf, v));
    const float t0 = rdlane(v, 15), t1 = rdlane(v, 31), t2 = rdlane(v, 47); const int row = lane >> 4;
    return fmaxf(fmaxf(v, (row >= 1) ? t0 : ninf), fmaxf((row >= 2) ? t1 : ninf, (row >= 3) ? t2 : ninf));
}
__device__ __forceinline__ void lds_barrier() { asm volatile("s_waitcnt lgkmcnt(0)\n\ts_barrier" ::: "memory"); }
__device__ __forceinline__ int opaque_tid() { int t = threadIdx.x; asm volatile("" : "+v"(t)); return t; }
template <class FA, class FB> __device__ __forceinline__ f32x4 mm16(int K, FA fa, FB fb, f32x4 acc, int i, int kq) {
#pragma unroll 4
    for (int k0 = 0; k0 < K; k0 += 4) { const float a = fa(i, k0 + kq), b = fb(k0 + kq, i); acc = __builtin_amdgcn_mfma_f32_16x16x4f32(a, b, acc, 0, 0, 0); }
    return acc;
}
template <class FA, class FB1, class FB2> __device__ __forceinline__ void mm16_2(int K, FA fa, FB1 fb1, FB2 fb2, f32x4& acc1, f32x4& acc2, int i, int kq) {
#pragma unroll 4
    for (int k0 = 0; k0 < K; k0 += 4) { const float a = fa(i, k0 + kq), b1 = fb1(k0 + kq, i), b2 = fb2(k0 + kq, i);
        acc1 = __builtin_amdgcn_mfma_f32_16x16x4f32(a, b1, acc1, 0, 0, 0); acc2 = __builtin_amdgcn_mfma_f32_16x16x4f32(a, b2, acc2, 0, 0, 0); }
}
typedef short bf16x8 __attribute__((ext_vector_type(8)));
typedef LAS bf16_t* ldsh;
typedef unsigned u32x4 __attribute__((ext_vector_type(4)));
typedef unsigned u32x2 __attribute__((ext_vector_type(2)));
__device__ __forceinline__ void unpack8v(const u32x4 u, float* f) { unpack8(make_uint4(u.x, u.y, u.z, u.w), f); }
__device__ __forceinline__ unsigned pk2(float lo, float hi) { unsigned r; asm volatile("v_cvt_pk_bf16_f32 %0, %1, %2" : "=v"(r) : "v"(lo), "v"(hi)); return r; }
__device__ __forceinline__ f32x4 mmb(int K, const LAS bf16_t* pa, int lda, const LAS bf16_t* pb, int ldb, f32x4 acc, int li, int kq) {
    const LAS bf16_t* a = pa + li * lda + kq * 8; const LAS bf16_t* b = pb + li * ldb + kq * 8;
#pragma unroll 4
    for (int k0 = 0; k0 < K; k0 += 32) acc = __builtin_amdgcn_mfma_f32_16x16x32_bf16(*(const LAS bf16x8*)(a + k0), *(const LAS bf16x8*)(b + k0), acc, 0, 0, 0);
    return acc;
}
__device__ __forceinline__ void tri_tile(int idx, int& tl, int& ts) {
    tl = (idx >= 6) ? 3 : (idx >= 3) ? 2 : (idx >= 1) ? 1 : 0; ts = idx - (tl * (tl + 1)) / 2;
}

template <bool PRE> struct EpiProj {
    static constexpr bool PERM = true, AFTER_DRAIN = false;
    bf16_t* O; const float* xss;
    __device__ __forceinline__ void operator()(const f32x4 (&acc)[2][2][4][2], const pg8::Unit& u, int wr, int wc, int fr, int fq) const {
        const int row0 = u.pm * 256 + wr * 64 + fr, col0 = u.pn * 256 + wc * 32 + 8 * fq;
#pragma unroll
        for (int ai = 0; ai < 2; ++ai)
#pragma unroll
            for (int m = 0; m < 4; ++m) {
                const int row = row0 + ai * 128 + m * 16;
                float rstd;
                if (PRE) rstd = xss[row];
                else {
                    const float4* sp = (const float4*)(xss + (size_t)row * XSSN + fq * 8);
                    const float4 v0 = sp[0], v1 = sp[1];
                    float s = ((v0.x + v0.y) + (v0.z + v0.w)) + ((v1.x + v1.y) + (v1.z + v1.w));
                    s += __shfl_xor(s, 16); s += __shfl_xor(s, 32);
                    rstd = rsqrtf(s * (1.f / DM) + 1e-6f);
                }
                bf16_t* rowp = O + (size_t)row * LDP + col0;
#pragma unroll
                for (int bj = 0; bj < 2; ++bj) {
                    const f32x4 v0 = acc[ai][bj][m][0] * rstd, v1 = acc[ai][bj][m][1] * rstd;
                    uint4 o; o.x = pg8::cvt_pk_bf16(v0[0], v0[1]); o.y = pg8::cvt_pk_bf16(v0[2], v0[3]); o.z = pg8::cvt_pk_bf16(v1[0], v1[1]); o.w = pg8::cvt_pk_bf16(v1[2], v1[3]);
                    *(uint4*)(rowp + bj * 128) = o;
                }
            }
    }
};
struct EpiOut {
    static constexpr bool PERM = false, AFTER_DRAIN = false;
    const float* xin; float* xout; bf16_t* xb; float* xss;
    __device__ __forceinline__ void operator()(const f32x4 (&acc)[2][2][4][2], const pg8::Unit& u, int wr, int wc, int fr, int fq) const {
        const int row0 = u.pm * 256 + wr * 64 + fr, col0 = u.pn * 256 + wc * 32 + 4 * fq;
#pragma unroll
        for (int ai = 0; ai < 2; ++ai)
#pragma unroll
            for (int m = 0; m < 4; ++m) {
                const int row = row0 + ai * 128 + m * 16; float ss = 0.f;
#pragma unroll
                for (int bj = 0; bj < 2; ++bj)
#pragma unroll
                    for (int n = 0; n < 2; ++n) {
                        const size_t off = (size_t)row * DM + col0 + bj * 128 + n * 16;
                        const f32x4 v = acc[ai][bj][m][n] + *(const f32x4*)(xin + off);
                        *(f32x4*)(xout + off) = v; ss += v[0] * v[0] + v[1] * v[1] + v[2] * v[2] + v[3] * v[3];
                        if (xb) { uint2 o; o.x = pg8::cvt_pk_bf16(v[0], v[1]); o.y = pg8::cvt_pk_bf16(v[2], v[3]); *(uint2*)(xb + off) = o; }
                    }
                ss += __shfl_xor(ss, 16); ss += __shfl_xor(ss, 32);
                if (fq == 0) xss[(size_t)row * XSSN + u.pn * 4 + wc] = ss;
            }
    }
};

__device__ __forceinline__ void transpose_convert(const float* __restrict__ src, int K, int N, int Npad, bf16_t* __restrict__ dst, const float* __restrict__ rowscale, ldsf lds, int wg = -1, int nwg = 0) {
    if (wg < 0) { wg = blockIdx.x; nwg = gridDim.x; }
    const int tid = threadIdx.x, nkt = K / 64, ntiles = nkt * (Npad / 64);
    const int kk = tid >> 4, nn4 = (tid & 15) * 4;
    float4 c0 = make_float4(0.f, 0.f, 0.f, 0.f), c1 = c0;
    int tile = wg;
    if (tile < ntiles) {
        const int k0 = (tile % nkt) * 64, n0 = (tile / nkt) * 64;
        if (n0 + nn4 < N) { c0 = *(const float4*)(src + (size_t)(k0 + kk) * N + n0 + nn4); c1 = *(const float4*)(src + (size_t)(k0 + kk + 32) * N + n0 + nn4); }
    }
    for (; tile < ntiles; tile += nwg) {
        const int k0 = (tile % nkt) * 64, n0 = (tile / nkt) * 64;
        float4 a0 = c0, a1 = c1;
        const int nt = tile + nwg;
        c0 = make_float4(0.f, 0.f, 0.f, 0.f); c1 = c0;
        if (nt < ntiles) {
            const int k1 = (nt % nkt) * 64, n1 = (nt / nkt) * 64;
            if (n1 + nn4 < N) { c0 = *(const float4*)(src + (size_t)(k1 + kk) * N + n1 + nn4); c1 = *(const float4*)(src + (size_t)(k1 + kk + 32) * N + n1 + nn4); }
        }
        if (rowscale) { const float s0 = rowscale[k0 + kk], s1 = rowscale[k0 + kk + 32]; a0.x *= s0; a0.y *= s0; a0.z *= s0; a0.w *= s0; a1.x *= s1; a1.y *= s1; a1.z *= s1; a1.w *= s1; }
        lds[kk * 65 + nn4 + 0] = a0.x; lds[kk * 65 + nn4 + 1] = a0.y; lds[kk * 65 + nn4 + 2] = a0.z; lds[kk * 65 + nn4 + 3] = a0.w;
        lds[(kk + 32) * 65 + nn4 + 0] = a1.x; lds[(kk + 32) * 65 + nn4 + 1] = a1.y; lds[(kk + 32) * 65 + nn4 + 2] = a1.z; lds[(kk + 32) * 65 + nn4 + 3] = a1.w;
        __syncthreads();
        {
            const int nn = tid >> 3, k8 = (tid & 7) * 8;
            uint4 o;
            o.x = pack2(lds[(k8 + 0) * 65 + nn], lds[(k8 + 1) * 65 + nn]); o.y = pack2(lds[(k8 + 2) * 65 + nn], lds[(k8 + 3) * 65 + nn]);
            o.z = pack2(lds[(k8 + 4) * 65 + nn], lds[(k8 + 5) * 65 + nn]); o.w = pack2(lds[(k8 + 6) * 65 + nn], lds[(k8 + 7) * 65 + nn]);
            *(uint4*)(dst + (size_t)(n0 + nn) * K + k0 + k8) = o;
        }
        __syncthreads();
    }
}
__device__ __forceinline__ void x_convert(CP P) {
    const int wave = threadIdx.x >> 6, lane = threadIdx.x & 63, rstep = gridDim.x * 8;
    int row = blockIdx.x * 8 + wave;
    float4 cur[8], nxt[8];
    if (row < M_TOK) {
#pragma unroll
        for (int i = 0; i < 8; ++i) cur[i] = ((const float4*)(P->in[0] + (size_t)row * DM))[lane + i * 64];
    }
    for (; row < M_TOK; row += rstep) {
        const int rn = row + rstep < M_TOK ? row + rstep : row;
#pragma unroll
        for (int i = 0; i < 8; ++i) nxt[i] = ((const float4*)(P->in[0] + (size_t)rn * DM))[lane + i * 64];
        float ss = 0.f;
#pragma unroll
        for (int i = 0; i < 8; ++i) {
            const float4 v = cur[i]; ss += v.x * v.x + v.y * v.y + v.z * v.z + v.w * v.w;
            uint2 o; o.x = pack2(v.x, v.y); o.y = pack2(v.z, v.w); *(uint2*)(P->actA + (size_t)row * DM + (lane + i * 64) * 4) = o;
        }
        ss = wave_sum(ss);
        if (lane == 0) P->xss0[row] = rsqrtf(ss * (1.f / DM) + 1e-6f);
#pragma unroll
        for (int i = 0; i < 8; ++i) cur[i] = nxt[i];
    }
}

__device__ __forceinline__ void lora_convert(CP P) {
    for (int l = 0; l < 2; ++l) {
        const float* w2 = LP(P, l, I_RW_W2); const float* a2 = LP(P, l, I_RW_A2); const float* v2 = P->in[40];
        bf16_t* W = P->lora + (size_t)l * LORA_L; bf16_t* A = W + 512 * 64; bf16_t* V = A + 512 * 64;
        for (int e = blockIdx.x * 512 + threadIdx.x; e < 512 * 64; e += gridDim.x * 512) { const int c = e >> 6, k = e & 63; W[e] = f2bf(w2[k * 512 + c]); A[e] = f2bf(a2[k * 512 + c]); }
        if (l) for (int e = blockIdx.x * 512 + threadIdx.x; e < 512 * 32; e += gridDim.x * 512) { const int c = e >> 5, k = e & 31; V[e] = f2bf(v2[k * 512 + c]); }
    }
}
__device__ __forceinline__ void rwkv_prep(CP P, int l, ldsf lds) {
    const Cols C = cols(l); const int tid = opaque_tid(), wave = tid >> 6, lane = tid & 63, li = lane & 15, kq = lane >> 4;
    const float* mu = LP(P, l, I_RW_MU); const float* w0 = LP(P, l, I_RW_W0); const float* a0 = LP(P, l, I_RW_A0); const float* v0 = P->in[39];
    const bf16_t* W2t = P->lora + (size_t)l * LORA_L; const bf16_t* A2t = W2t + 512 * 64; const bf16_t* V2t = A2t + 512 * 64;
    constexpr int AS = 72, VS = 40;
    const ldsh Wl = (ldsh)lds, Al = Wl + 32 * AS, Vl = Al + 32 * AS;
    for (int tile = blockIdx.x; tile < M_TOK / 32; tile += gridDim.x) {
        const int t0 = tile * 32;
        {
            const int tt = tid >> 4, g = tid & 15, t = t0 + tt;
            const bf16_t* pr = P->proj + (size_t)t * LDP + C.rw + 1536 + g * 8;
            const bool hasp = (t % SEQL) != 0;
            float cur[8], prev[8];
            load8(pr, cur);
            if (hasp) load8(pr - LDP, prev); else {
#pragma unroll
                for (int e = 0; e < 8; ++e) prev[e] = 0.f; }
            float f[8];
#pragma unroll
            for (int e = 0; e < 8; ++e) { f[e] = cur[e] + mu[1536 + g * 8 + e] * (prev[e] - cur[e]); if (g < 8) f[e] = tanhf(f[e]); }
            u32x4 o; o.x = pk2(f[0], f[1]); o.y = pk2(f[2], f[3]); o.z = pk2(f[4], f[5]); o.w = pk2(f[6], f[7]);
            *(LAS u32x4*)((g < 8 ? Wl : Al) + tt * AS + (g & 7) * 8) = o;
            if (l && g < 4) {
                load8(pr + 128, cur);
                if (hasp) load8(pr + 128 - LDP, prev);
#pragma unroll
                for (int e = 0; e < 8; ++e) f[e] = cur[e] + mu[1664 + g * 8 + e] * (prev[e] - cur[e]);
                o.x = pk2(f[0], f[1]); o.y = pk2(f[2], f[3]); o.z = pk2(f[4], f[5]); o.w = pk2(f[6], f[7]);
                *(LAS u32x4*)(Vl + tt * VS + g * 8) = o;
            }
        }
        __syncthreads();
        struct PrepIn { bf16x8 bw0, bw1, ba0, ba1, bv; float w0c, a0c, muc, v0c; bf16_t cur[4], prev[4]; float vf[4]; };
        auto ldp = [&](int tl) { PrepIn r;
            const int tt16 = tl & 1, c = (tl >> 1) * 16 + li;
            r.bw0 = *(const bf16x8*)(W2t + (size_t)c * 64 + kq * 8); r.bw1 = *(const bf16x8*)(W2t + (size_t)c * 64 + 32 + kq * 8);
            r.ba0 = *(const bf16x8*)(A2t + (size_t)c * 64 + kq * 8); r.ba1 = *(const bf16x8*)(A2t + (size_t)c * 64 + 32 + kq * 8);
            r.bv = r.bw0; if (l) r.bv = *(const bf16x8*)(V2t + (size_t)c * 32 + kq * 8);
            r.w0c = w0[c]; r.a0c = a0[c]; r.muc = mu[1024 + c]; r.v0c = l ? v0[c] : 0.f;
#pragma unroll
            for (int j = 0; j < 4; ++j) {
                const int t = t0 + tt16 * 16 + kq * 4 + j;
                r.cur[j] = P->proj[(size_t)t * LDP + C.rw + 1024 + c];
                r.prev[j] = (t % SEQL == 0) ? (bf16_t)0 : P->proj[(size_t)(t - 1) * LDP + C.rw + 1024 + c];
                r.vf[j] = l ? P->rwV[(size_t)t * 512 + c] : 0.f;
            }
            return r; };
        PrepIn cin = ldp(wave);
        for (int tl = wave; tl < 64; tl += 8) {
            const int tt16 = tl & 1, cc = (tl >> 1) * 16, c = cc + li;
            const PrepIn nin = ldp(tl + 8 < 64 ? tl + 8 : tl);
            f32x4 aW = {0.f, 0.f, 0.f, 0.f}, aA = aW, aV = aW;
            const LAS bf16_t* pw = Wl + (tt16 * 16 + li) * AS + kq * 8; const LAS bf16_t* pa = Al + (tt16 * 16 + li) * AS + kq * 8;
            aW = __builtin_amdgcn_mfma_f32_16x16x32_bf16(*(const LAS bf16x8*)(pw), cin.bw0, aW, 0, 0, 0);
            aW = __builtin_amdgcn_mfma_f32_16x16x32_bf16(*(const LAS bf16x8*)(pw + 32), cin.bw1, aW, 0, 0, 0);
            aA = __builtin_amdgcn_mfma_f32_16x16x32_bf16(*(const LAS bf16x8*)(pa), cin.ba0, aA, 0, 0, 0);
            aA = __builtin_amdgcn_mfma_f32_16x16x32_bf16(*(const LAS bf16x8*)(pa + 32), cin.ba1, aA, 0, 0, 0);
            if (l) aV = __builtin_amdgcn_mfma_f32_16x16x32_bf16(*(const LAS bf16x8*)(Vl + (tt16 * 16 + li) * VS + kq * 8), cin.bv, aV, 0, 0, 0);
#pragma unroll
            for (int j = 0; j < 4; ++j) {
                const int t = t0 + tt16 * 16 + kq * 4 + j; const size_t o = (size_t)t * 512 + c;
                const float wl = cin.w0c + aW[j];
                const float sp = fmaxf(-wl, 0.f) + __logf(1.f + __expf(-fabsf(wl)));
                P->rwA[o] = __expf(-__expf(-sp - 0.5f));
                P->rwB[o] = sigmoidf_(cin.a0c + aA[j]);
                const float cur = bf2f(cin.cur[j]), prev = bf2f(cin.prev[j]);
                float v = cur + cin.muc * (prev - cur);
                if (l) { const float g = sigmoidf_(cin.v0c + aV[j]); v = v + (cin.vf[j] - v) * g; }
                P->rwV[o] = v;
            }
            cin = nin;
        }
        __syncthreads();
    }
}

__device__ __forceinline__ void rwkv_scan_item(CP P, int l, int it, ldsf lds) {
    const Cols C = cols(l); const int tid = opaque_tid();
    const int b = it >> 5, h = (it >> 2) & 7, rq = it & 3;
    constexpr int BUF = 5 * 2048 + 512 + 8192;
    const float* mu = LP(P, l, I_RW_MU); const float* k_k = LP(P, l, I_RW_KK); const float* k_a = LP(P, l, I_RW_KA);
    const bool producer = tid >= 256; const int ptid = tid & 255;
    const int tt = ptid >> 3, cg8 = (ptid & 7) * 8, ch0 = h * 64 + cg8, c2 = (ptid & 7) * 2;
    const int ri = ptid >> 4, js = (ptid & 15) * 4;
    const float* r_k = LP(P, l, I_RW_RK);
    float mur[8], muk[8], kkc[8], kac[8], rkc[8];
#pragma unroll
    for (int e = 0; e < 8; ++e) { mur[e] = mu[ch0 + e]; muk[e] = mu[512 + ch0 + e]; kkc[e] = k_k[ch0 + e]; kac[e] = k_a[ch0 + e]; rkc[e] = r_k[ch0 + e]; }
    uint4 rcu, kcu, rpu, kpu; float4 ra0, ra1, rd0, rd1; float2 rv2;
    auto issue = [&](int c) {
        const int t = b * SEQL + c * 32 + tt;
        const bf16_t* pr = P->proj + (size_t)t * LDP + C.rw + ch0;
        rcu = *(const uint4*)pr; kcu = *(const uint4*)(pr + 512);
        rpu = make_uint4(0u, 0u, 0u, 0u); kpu = rpu;
        if (c > 0 || tt > 0) { rpu = *(const uint4*)(pr - LDP); kpu = *(const uint4*)(pr - LDP + 512); }
        const float* ap = P->rwB + (size_t)t * 512 + ch0; const float* dp = P->rwA + (size_t)t * 512 + ch0;
        ra0 = *(const float4*)ap; ra1 = *(const float4*)(ap + 4); rd0 = *(const float4*)dp; rd1 = *(const float4*)(dp + 4);
        rv2 = *(const float2*)(P->rwV + (size_t)t * 512 + h * 64 + rq * 16 + c2);
    };
    auto fill = [&](int c, ldsf buf) {
        ldsf sR = buf, sK = buf + 2048, sW = buf + 4096, sNK = buf + 6144, sB = buf + 8192, sV = buf + 10240;
        float rc[8], kc[8], rp[8], kp[8];
        alignas(16) float av[8]; alignas(16) float dv[8]; float kkr[8], kl[8];
        *(float4*)av = ra0; *(float4*)(av + 4) = ra1; *(float4*)dv = rd0; *(float4*)(dv + 4) = rd1;
        unpack8(rcu, rc); unpack8(kcu, kc); unpack8(rpu, rp); unpack8(kpu, kp);
        float ss = 0.f; alignas(16) float o1[8]; alignas(16) float o2[8]; alignas(16) float o3[8]; alignas(16) float o4[8];
#pragma unroll
        for (int e = 0; e < 8; ++e) {
            o1[e] = rc[e] + mur[e] * (rp[e] - rc[e]);
            kl[e] = kc[e] + muk[e] * (kp[e] - kc[e]);
            kkr[e] = kl[e] * kkc[e]; ss += kkr[e] * kkr[e];
        }
        *(LAS f32x4*)(sR + tt * 64 + cg8) = *(f32x4*)o1; *(LAS f32x4*)(sR + tt * 64 + cg8 + 4) = *(f32x4*)(o1 + 4);
        *(LAS f32x4*)(sW + tt * 64 + cg8) = *(f32x4*)dv; *(LAS f32x4*)(sW + tt * 64 + cg8 + 4) = *(f32x4*)(dv + 4);
        ss += dppf<0xB1>(ss); ss += dppf<0x4E>(ss); ss += dppf<0x141>(ss);
        const float inv = 1.f / fmaxf(sqrtf(ss), 1e-12f);
#pragma unroll
        for (int e = 0; e < 8; ++e) {
            const float kk = kkr[e] * inv;
            o2[e] = kl[e] * (1.f + (av[e] - 1.f) * kac[e]); o3[e] = -kk; o4[e] = kk * av[e];
        }
        if (rq == 0) {
            float bs = 0.f;
#pragma unroll
            for (int e = 0; e < 8; ++e) bs += o1[e] * o2[e] * rkc[e];
            bs += dppf<0xB1>(bs); bs += dppf<0x4E>(bs); bs += dppf<0x141>(bs);
            if ((ptid & 7) == 0) P->bon[(size_t)(b * SEQL + c * 32 + tt) * 8 + h] = bs;
        }
        *(LAS f32x4*)(sK + tt * 64 + cg8) = *(f32x4*)o2; *(LAS f32x4*)(sK + tt * 64 + cg8 + 4) = *(f32x4*)(o2 + 4);
        *(LAS f32x4*)(sNK + tt * 64 + cg8) = *(f32x4*)o3; *(LAS f32x4*)(sNK + tt * 64 + cg8 + 4) = *(f32x4*)(o3 + 4);
        *(LAS f32x4*)(sB + tt * 64 + cg8) = *(f32x4*)o4; *(LAS f32x4*)(sB + tt * 64 + cg8 + 4) = *(f32x4*)(o4 + 4);
        *(LAS f32x2*)(sV + tt * 16 + c2) = (f32x2){rv2.x, rv2.y};
    };
    auto flush = [&](int c, ldsf buf) {
        const LAS f32x4* yp = (const LAS f32x4*)(buf + 10752 + (tt * 16 + c2) * 16);
        const f32x4 s0 = (yp[0] + yp[1]) + (yp[2] + yp[3]), s1 = (yp[4] + yp[5]) + (yp[6] + yp[7]);
        *(unsigned*)(P->proj + (size_t)(b * SEQL + c * 32 + tt) * LDP + C.rw + 1024 + h * 64 + rq * 16 + c2) = pack2((s0.x + s0.y) + (s0.z + s0.w), (s1.x + s1.y) + (s1.z + s1.w));
    };
    f32x2 S[2] = {{0.f, 0.f}, {0.f, 0.f}};
    if (producer) { issue(0); fill(0, lds); issue(1); }
    lds_barrier();
    for (int c = 0; c < 64; ++c) {
        const ldsf cur = lds + (c & 1) * BUF, nxt = lds + ((c + 1) & 1) * BUF;
        if (producer) {
            if (c + 1 < 64) fill(c + 1, nxt);
            if (c > 0) flush(c - 1, nxt);
            if (c + 2 < 64) issue(c + 2);
        } else {
            const ldsf sR = cur, sK = cur + 2048, sW = cur + 4096, sNK = cur + 6144, sB = cur + 8192, sV = cur + 10240, sYp = cur + 10752 + ri * 16 + (tid & 15);
            struct Vecs { f32x4 nk, w, b, k, r; float vi; };
            auto ldv = [&](int t) { Vecs v;
                v.nk = *(const LAS f32x4*)(sNK + t * 64 + js); v.w = *(const LAS f32x4*)(sW + t * 64 + js); v.b = *(const LAS f32x4*)(sB + t * 64 + js);
                v.k = *(const LAS f32x4*)(sK + t * 64 + js); v.r = *(const LAS f32x4*)(sR + t * 64 + js); v.vi = sV[t * 16 + ri]; return v; };
            Vecs cur_v = ldv(0), nx1 = ldv(1);
            for (int t16 = 0; t16 < 2; ++t16) {
#pragma unroll
                for (int u = 0; u < 16; ++u) {
                    const int t = t16 * 16 + u;
                    const Vecs nxt = ldv((t + 2) & 31);
                    f32x2 s2 = S[0] * cur_v.nk.xy; s2 = S[1] * cur_v.nk.zw + s2;
                    const float sa = reduce16(s2.x + s2.y);
                    const f32x2 sav = {sa, sa}, viv = {cur_v.vi, cur_v.vi};
                    f32x2 t0 = viv * cur_v.k.xy; t0 = sav * cur_v.b.xy + t0; S[0] = S[0] * cur_v.w.xy + t0;
                    f32x2 t1 = viv * cur_v.k.zw; t1 = sav * cur_v.b.zw + t1; S[1] = S[1] * cur_v.w.zw + t1;
                    f32x2 y2 = S[0] * cur_v.r.xy; y2 = S[1] * cur_v.r.zw + y2;
                    sYp[t * 256] = y2.x + y2.y;
                    cur_v = nx1; nx1 = nxt;
                }
            }
        }
        lds_barrier();
    }
    if (producer) flush(63, lds + BUF);
    __syncthreads();
}

__device__ __forceinline__ void mlstm_item(CP P, int l, int it, ldsf lds) {
    const Cols C = cols(l); const int tid = opaque_tid(), wave = tid >> 6, lane = tid & 63, li = lane & 15, kq = lane >> 4;
    const int b = it >> 4, h = (it >> 2) & 3, es = it & 3;
    constexpr int QS = 136, SS = 72;
    const ldsh Qb = (ldsh)lds, Kb = Qb + 64 * QS, Ktb = Kb + 64 * QS, Vtb = Ktb + 128 * SS, Vwtb = Vtb + 32 * SS, Attb = Vwtb + 32 * SS, Ctb = Attb + 64 * SS, nbb = Ctb + 2 * 32 * QS, wendb = nbb + 2 * 128;
    const ldsf sCum = (ldsf)(wendb + 64), sLi = sCum + 64, sWend = sLi + 64, sMl = sWend + 64, sWint = sMl + 64, sScal = sWint + 64;
    const float* cw = LP(P, l, I_ML_CW); const float* cb = LP(P, l, I_ML_CB);
    const float igb = LP(P, l, I_ML_IGB)[h], fgb = LP(P, l, I_ML_FGB)[h];
    for (int e = tid; e < 64 * SS / 2; e += 512) ((LAS unsigned*)Attb)[e] = 0u;
    for (int e = tid; e < (2 * 32 * QS + 2 * 128) / 2; e += 512) ((LAS unsigned*)Ctb)[e] = 0u;
    float m_prev = 0.f;
    f32x4 Cm[2], nm[2];
#pragma unroll
    for (int q = 0; q < 2; ++q) { Cm[q] = (f32x4){0.f, 0.f, 0.f, 0.f}; nm[q] = Cm[q]; }
    const int cgp = tid & 31, rseg = tid >> 5, isk = cgp >> 4, d0 = (cgp & 15) * 8, col0 = isk * 512 + h * 128 + d0;
    const ldsh cdst = isk ? Kb : Qb; const float cscale = isk ? 0.08838834764831845f : 1.f;
    const bf16x8 ones8 = {(short)0x3F80, (short)0x3F80, (short)0x3F80, (short)0x3F80, (short)0x3F80, (short)0x3F80, (short)0x3F80, (short)0x3F80};
    uint4 raw[7]; uint4 vraw = make_uint4(0u, 0u, 0u, 0u); bf16_t gi_bits = 0, gf_bits = 0;
    auto issue_loads = [&](int nn) {
#pragma unroll
        for (int i = 0; i < 7; ++i) {
            const int ts = nn * 64 + rseg * 4 - 3 + i;
            raw[i] = (ts >= 0) ? *(const uint4*)(P->proj + (size_t)(b * SEQL + ts) * LDP + C.mqk + col0) : make_uint4(0u, 0u, 0u, 0u);
        }
        if (tid < 256) vraw = *(const uint4*)(P->proj + (size_t)(b * SEQL + nn * 64 + (tid >> 2)) * LDP + C.mv + h * 128 + es * 32 + (tid & 3) * 8);
        if (wave == 0) { const bf16_t* gp = P->proj + (size_t)(b * SEQL + nn * 64 + lane) * LDP; gi_bits = gp[C.mi + h]; gf_bits = gp[C.mf + h]; }
    };
    bf16_t pend[4] = {0, 0, 0, 0};
    auto store_pend = [&](int nprev) {
        const int tl = wave >> 1, te = wave & 1;
#pragma unroll
        for (int j = 0; j < 4; ++j) P->proj[(size_t)(b * SEQL + nprev * 64 + tl * 16 + kq * 4 + j) * LDP + C.mv + h * 128 + es * 32 + te * 16 + li] = pend[j];
    };
    issue_loads(0);
    alignas(16) float wreg[4][8]; alignas(16) float breg[8];
    *(float4*)breg = *(const float4*)(cb + col0); *(float4*)(breg + 4) = *(const float4*)(cb + col0 + 4);
#pragma unroll
    for (int j = 0; j < 4; ++j) { *(float4*)wreg[j] = *(const float4*)(cw + j * 1024 + col0); *(float4*)(wreg[j] + 4) = *(const float4*)(cw + j * 1024 + col0 + 4); }
    __syncthreads();
    for (int n = 0; n < 32; ++n) {
        const int t0 = b * SEQL + n * 64, pb = n & 1;
        {
            float acc[4][8];
#pragma unroll
            for (int r = 0; r < 4; ++r)
#pragma unroll
                for (int e = 0; e < 8; ++e) acc[r][e] = breg[e];
#pragma unroll
            for (int i = 0; i < 7; ++i) {
                float f[8]; unpack8(raw[i], f);
#pragma unroll
                for (int r = 0; r < 4; ++r) { const int j = i - r; if (j >= 0 && j < 4) {
#pragma unroll
                    for (int e = 0; e < 8; ++e) acc[r][e] += wreg[j][e] * f[e]; } }
            }
#pragma unroll
            for (int r = 0; r < 4; ++r) {
#pragma unroll
                for (int e = 0; e < 8; ++e) acc[r][e] = siluf(acc[r][e]) * cscale;
                u32x4 o; o.x = pk2(acc[r][0], acc[r][1]); o.y = pk2(acc[r][2], acc[r][3]); o.z = pk2(acc[r][4], acc[r][5]); o.w = pk2(acc[r][6], acc[r][7]);
                *(LAS u32x4*)(cdst + (rseg * 4 + r) * QS + d0) = o;
            }
            if (isk) {
#pragma unroll
                for (int e = 0; e < 8; ++e) { u32x2 o; o.x = pk2(acc[0][e], acc[1][e]); o.y = pk2(acc[2][e], acc[3][e]); *(LAS u32x2*)(Ktb + (d0 + e) * SS + rseg * 4) = o; }
            }
            if (tid < 256) {
                const LAS bf16_t* vs = (const LAS bf16_t*)0; (void)vs;
                const unsigned w4[4] = {vraw.x, vraw.y, vraw.z, vraw.w};
#pragma unroll
                for (int e = 0; e < 8; ++e) Vtb[((tid & 3) * 8 + e) * SS + (tid >> 2)] = (bf16_t)((e & 1) ? (w4[e >> 1] >> 16) : (w4[e >> 1] & 0xffffu));
            }
        }
        if (wave == 0) {
            const int s = lane;
            const float lgi = bf2f(gi_bits) + igb;
            const float lf = logsigmoidf(bf2f(gf_bits) + fgb);
            const float cum = scan_add64(lf, lane);
            const float last = rdlane(cum, 63);
            const float g = last - cum + lgi; const float gmax = rdlane(scan_max64(g, lane), 63);
            const float pm = scan_max64(lgi - cum, lane);
            const float minter = cum + m_prev; const float ml = fmaxf(minter, cum + pm);
            const float we = __expf(g - gmax);
            sCum[s] = cum; sLi[s] = lgi; sWend[s] = we; wendb[s] = f2bf(we); sMl[s] = ml; sWint[s] = __expf(minter - ml);
            if (lane == 0) { sScal[0] = last; sScal[1] = gmax; }
        }
        if (n > 0) store_pend(n - 1);
        if (n + 1 < 32) issue_loads(n + 1);
        lds_barrier();
        if (tid < 256) {
            const int e = tid >> 3, sg = (tid & 7) * 8;
            float f[8]; unpack8v(*(const LAS u32x4*)(Vtb + e * SS + sg), f);
            u32x4 o; o.x = pk2(f[0] * sWend[sg], f[1] * sWend[sg + 1]); o.y = pk2(f[2] * sWend[sg + 2], f[3] * sWend[sg + 3]);
            o.z = pk2(f[4] * sWend[sg + 4], f[5] * sWend[sg + 5]); o.w = pk2(f[6] * sWend[sg + 6], f[7] * sWend[sg + 7]);
            *(LAS u32x4*)(Vwtb + e * SS + sg) = o;
        }
        for (int q = 0; q < 2; ++q) {
            const int idx = (q == 0) ? wave : (wave >= 6 ? wave + 2 : 99);
            if (idx >= 10) break;
            int tl, ts; tri_tile(idx, tl, ts);
            const f32x4 a = mmb(128, Qb + tl * 16 * QS, QS, Kb + ts * 16 * QS, QS, (f32x4){0.f, 0.f, 0.f, 0.f}, li, kq);
#pragma unroll
            for (int j = 0; j < 4; ++j) {
                const int lr = tl * 16 + kq * 4 + j, sc = ts * 16 + li;
                Attb[lr * SS + sc] = f2bf((sc <= lr) ? a[j] * __expf(sCum[lr] - sCum[sc] + sLi[sc] - sMl[lr]) : 0.f);
            }
        }
        lds_barrier();
        {
            const int tl = wave >> 1, te = wave & 1;
            f32x4 a1 = {0.f, 0.f, 0.f, 0.f}, ad = a1, a2 = a1, aq = a1;
            {
                const LAS bf16_t* pa = Attb + (tl * 16 + li) * SS + kq * 8; const LAS bf16_t* pv = Vtb + (te * 16 + li) * SS + kq * 8;
#pragma unroll
                for (int k0 = 0; k0 < 64; k0 += 32) { const bf16x8 av = *(const LAS bf16x8*)(pa + k0);
                    a1 = __builtin_amdgcn_mfma_f32_16x16x32_bf16(av, *(const LAS bf16x8*)(pv + k0), a1, 0, 0, 0); ad = __builtin_amdgcn_mfma_f32_16x16x32_bf16(av, ones8, ad, 0, 0, 0); }
                const LAS bf16_t* pq = Qb + (tl * 16 + li) * QS + kq * 8; const LAS bf16_t* pc = Ctb + pb * 32 * QS + (te * 16 + li) * QS + kq * 8; const LAS bf16_t* pn = nbb + pb * 128 + kq * 8;
#pragma unroll
                for (int k0 = 0; k0 < 128; k0 += 32) { const bf16x8 av = *(const LAS bf16x8*)(pq + k0);
                    a2 = __builtin_amdgcn_mfma_f32_16x16x32_bf16(av, *(const LAS bf16x8*)(pc + k0), a2, 0, 0, 0); aq = __builtin_amdgcn_mfma_f32_16x16x32_bf16(av, *(const LAS bf16x8*)(pn + k0), aq, 0, 0, 0); }
            }
#pragma unroll
            for (int j = 0; j < 4; ++j) {
                const int lr = tl * 16 + kq * 4 + j, e = te * 16 + li;
                const float wi = sWint[lr];
                const float den = fmaxf(fabsf(ad[j] + wi * aq[j]), __expf(-sMl[lr]));
                const float hv = (a1[j] + wi * a2[j]) / den;
                pend[j] = f2bf(hv);
            }
            const float last = sScal[0], gmax = sScal[1];
            const float m_new = fmaxf(last + m_prev, gmax), a_old = __expf(last + m_prev - m_new), a_new = __expf(gmax - m_new);
#pragma unroll
            for (int q = 0; q < 2; ++q) {
                const int tile = wave + q * 8, td = tile >> 1, te2 = tile & 1;
                const LAS bf16_t* pk = Ktb + (td * 16 + li) * SS + kq * 8; const LAS bf16_t* pv = Vwtb + (te2 * 16 + li) * SS + kq * 8; const LAS bf16_t* pw = wendb + kq * 8;
                f32x4 a = {0.f, 0.f, 0.f, 0.f}, an = a;
#pragma unroll
                for (int k0 = 0; k0 < 64; k0 += 32) { const bf16x8 av = *(const LAS bf16x8*)(pk + k0);
                    a = __builtin_amdgcn_mfma_f32_16x16x32_bf16(av, *(const LAS bf16x8*)(pv + k0), a, 0, 0, 0);
                    if (te2 == 0) an = __builtin_amdgcn_mfma_f32_16x16x32_bf16(av, *(const LAS bf16x8*)(pw + k0), an, 0, 0, 0); }
                Cm[q] = Cm[q] * a_old + a * a_new;
                u32x2 o; o.x = pk2(Cm[q][0], Cm[q][1]); o.y = pk2(Cm[q][2], Cm[q][3]);
                *(LAS u32x2*)(Ctb + (pb ^ 1) * 32 * QS + (te2 * 16 + li) * QS + td * 16 + kq * 4) = o;
                if (te2 == 0) {
                    nm[q] = nm[q] * a_old + an * a_new;
                    if (li == 0) { u32x2 o2; o2.x = pk2(nm[q][0], nm[q][1]); o2.y = pk2(nm[q][2], nm[q][3]); *(LAS u32x2*)(nbb + (pb ^ 1) * 128 + td * 16 + kq * 4) = o2; }
                }
            }
            m_prev = m_new;
        }
        lds_barrier();
    }
    store_pend(31);
}

__device__ __forceinline__ void ssd_item(CP P, int l, int it, ldsf lds) {
    const Cols C = cols(l); const int tid = opaque_tid(), wave = tid >> 6, lane = tid & 63, li = lane & 15, kq = lane >> 4;
    const int b = it >> 3, hh = it & 7, g = hh >> 2;
    constexpr int QS = 136, SS = 72;
    const ldsh Cmb = (ldsh)lds, Bmb = Cmb + 64 * QS, Bmtb = Bmb + 64 * QS, Lcb = Bmtb + 128 * SS, Xdtt = Lcb + 64 * SS, Xett = Xdtt + 64 * SS, Sb = Xett + 64 * SS;
    const ldsf sXr = (ldsf)(Sb + 2 * 64 * QS), sX = sXr + 67 * 64, sCum = sX + 64 * 65, sDt = sCum + 64, sE = sDt + 64, sEc = sE + 64, sScal = sEc + 64;
    const float* cw = LP(P, l, I_SSD_CW); const float* cb = LP(P, l, I_SSD_CB);
    const float Aneg = -expf(LP(P, l, I_SSD_ALOG)[hh]), dtb = LP(P, l, I_SSD_DTB)[hh], dsk = LP(P, l, I_SSD_D)[hh];
    for (int e = tid; e < 64 * SS / 2; e += 512) ((LAS unsigned*)Lcb)[e] = 0u;
    for (int e = tid; e < 2 * 64 * QS / 2; e += 512) ((LAS unsigned*)Sb)[e] = 0u;
    float hv = 0.f;
    f32x4 Sm[4];
#pragma unroll
    for (int q = 0; q < 4; ++q) Sm[q] = (f32x4){0.f, 0.f, 0.f, 0.f};
    const int cgp = tid & 31, rseg = tid >> 5, isc = cgp >> 4, n0 = (cgp & 15) * 8, col0 = 512 + isc * 256 + g * 128 + n0;
    const ldsh cdst = isc ? Cmb : Bmb;
    const int xcol = hh * 64 + (tid & 63);
    const float cb0 = cb[xcol], w0 = cw[xcol], w1 = cw[1024 + xcol], w2 = cw[2048 + xcol], w3 = cw[3072 + xcol];
    uint4 raw[7]; uint4 xraw = make_uint4(0u, 0u, 0u, 0u); bf16_t dt_bits = 0;
    auto issue_loads = [&](int nn) {
#pragma unroll
        for (int i = 0; i < 7; ++i) {
            const int ts = nn * 64 + rseg * 4 - 3 + i;
            raw[i] = (ts >= 0) ? *(const uint4*)(P->proj + (size_t)(b * SEQL + ts) * LDP + C.sx + col0) : make_uint4(0u, 0u, 0u, 0u);
        }
        xraw = *(const uint4*)(P->proj + (size_t)(b * SEQL + nn * 64 + (tid >> 3)) * LDP + C.sx + hh * 64 + (tid & 7) * 8);
        if (wave == 0) dt_bits = P->proj[(size_t)(b * SEQL + nn * 64 + lane) * LDP + C.sdt + hh];
    };
    bf16_t pend[2][4] = {{0, 0, 0, 0}, {0, 0, 0, 0}};
    auto store_pend = [&](int nprev) {
#pragma unroll
        for (int q = 0; q < 2; ++q) { const int tile = wave + q * 8, tl = tile >> 2, tp = tile & 3;
#pragma unroll
            for (int j = 0; j < 4; ++j) P->proj[(size_t)(b * SEQL + nprev * 64 + tl * 16 + kq * 4 + j) * LDP + C.sx + hh * 64 + tp * 16 + li] = pend[q][j]; }
    };
    issue_loads(0);
    alignas(16) float wreg[4][8]; alignas(16) float breg[8];
    *(float4*)breg = *(const float4*)(cb + col0); *(float4*)(breg + 4) = *(const float4*)(cb + col0 + 4);
#pragma unroll
    for (int j = 0; j < 4; ++j) { *(float4*)wreg[j] = *(const float4*)(cw + j * 1024 + col0); *(float4*)(wreg[j] + 4) = *(const float4*)(cw + j * 1024 + col0 + 4); }
    __syncthreads();
    for (int n = 0; n < 32; ++n) {
        const int t0 = b * SEQL + n * 64, pb = n & 1;
        if (tid < 192) sXr[tid] = hv;
        {
            float acc[4][8];
#pragma unroll
            for (int r = 0; r < 4; ++r)
#pragma unroll
                for (int e = 0; e < 8; ++e) acc[r][e] = breg[e];
#pragma unroll
            for (int i = 0; i < 7; ++i) {
                float f[8]; unpack8(raw[i], f);
#pragma unroll
                for (int r = 0; r < 4; ++r) { const int j = i - r; if (j >= 0 && j < 4) {
#pragma unroll
                    for (int e = 0; e < 8; ++e) acc[r][e] += wreg[j][e] * f[e]; } }
            }
#pragma unroll
            for (int r = 0; r < 4; ++r) {
#pragma unroll
                for (int e = 0; e < 8; ++e) acc[r][e] = siluf(acc[r][e]);
                u32x4 o; o.x = pk2(acc[r][0], acc[r][1]); o.y = pk2(acc[r][2], acc[r][3]); o.z = pk2(acc[r][4], acc[r][5]); o.w = pk2(acc[r][6], acc[r][7]);
                *(LAS u32x4*)(cdst + (rseg * 4 + r) * QS + n0) = o;
            }
            if (!isc) {
#pragma unroll
                for (int e = 0; e < 8; ++e) { u32x2 o; o.x = pk2(acc[0][e], acc[1][e]); o.y = pk2(acc[2][e], acc[3][e]); *(LAS u32x2*)(Bmtb + (n0 + e) * SS + rseg * 4) = o; }
            }
            { float f[8]; unpack8(xraw, f);
#pragma unroll
                for (int e = 0; e < 8; ++e) sXr[((tid >> 3) + 3) * 64 + (tid & 7) * 8 + e] = f[e]; }
        }
        if (wave == 0) {
            const float dt = softplusf(bf2f(dt_bits) + dtb);
            const float cum = scan_add64(dt * Aneg, lane);
            const float last = rdlane(cum, 63);
            sDt[lane] = dt; sCum[lane] = cum; sE[lane] = __expf(last - cum); sEc[lane] = __expf(cum);
            if (lane == 0) sScal[0] = __expf(last);
        }
        if (n > 0) store_pend(n - 1);
        if (n + 1 < 32) issue_loads(n + 1);
        lds_barrier();
        {
            const int p = tid & 63, mseg = tid >> 6;
            float xr[11];
#pragma unroll
            for (int i = 0; i < 11; ++i) xr[i] = sXr[(mseg * 8 + i) * 64 + p];
            float xd[8], xe[8];
#pragma unroll
            for (int r = 0; r < 8; ++r) {
                const int mm = mseg * 8 + r;
                const float x = siluf(cb0 + w0 * xr[r] + w1 * xr[r + 1] + w2 * xr[r + 2] + w3 * xr[r + 3]);
                sX[mm * 65 + p] = x; xd[r] = x * sDt[mm]; xe[r] = xd[r] * sE[mm];
            }
            u32x4 o; o.x = pk2(xd[0], xd[1]); o.y = pk2(xd[2], xd[3]); o.z = pk2(xd[4], xd[5]); o.w = pk2(xd[6], xd[7]); *(LAS u32x4*)(Xdtt + p * SS + mseg * 8) = o;
            o.x = pk2(xe[0], xe[1]); o.y = pk2(xe[2], xe[3]); o.z = pk2(xe[4], xe[5]); o.w = pk2(xe[6], xe[7]); *(LAS u32x4*)(Xett + p * SS + mseg * 8) = o;
        }
        for (int idx = wave; idx < 10; idx += 8) {
            int tl, ts; tri_tile(idx, tl, ts);
            const f32x4 a = mmb(128, Cmb + tl * 16 * QS, QS, Bmb + ts * 16 * QS, QS, (f32x4){0.f, 0.f, 0.f, 0.f}, li, kq);
#pragma unroll
            for (int j = 0; j < 4; ++j) {
                const int lr = tl * 16 + kq * 4 + j, sc = ts * 16 + li;
                Lcb[lr * SS + sc] = f2bf((sc <= lr) ? a[j] * __expf(sCum[lr] - sCum[sc]) : 0.f);
            }
        }
        lds_barrier();
        {
            const f32x4 z4 = {0.f, 0.f, 0.f, 0.f};
#pragma unroll
            for (int q = 0; q < 2; ++q) {
                const int tile = wave + q * 8, tl = tile >> 2, tp = tile & 3;
                const f32x4 a1 = mmb(64, Lcb + tl * 16 * SS, SS, Xdtt + tp * 16 * SS, SS, z4, li, kq);
                const f32x4 a2 = mmb(128, Cmb + tl * 16 * QS, QS, Sb + pb * 64 * QS + tp * 16 * QS, QS, z4, li, kq);
#pragma unroll
                for (int j = 0; j < 4; ++j) {
                    const int lr = tl * 16 + kq * 4 + j, p = tp * 16 + li;
                    const float y = a1[j] + sEc[lr] * a2[j] + dsk * sX[lr * 65 + p];
                    pend[q][j] = f2bf(y);
                }
            }
            const float elast = sScal[0];
#pragma unroll
            for (int q = 0; q < 4; ++q) {
                const int tile = wave + q * 8, tp2 = tile & 3, tn = tile >> 2;
                const f32x4 a = mmb(64, Xett + tp2 * 16 * SS, SS, Bmtb + tn * 16 * SS, SS, z4, li, kq);
                Sm[q] = Sm[q] * elast + a;
#pragma unroll
                for (int j = 0; j < 4; ++j) Sb[(pb ^ 1) * 64 * QS + (tp2 * 16 + kq * 4 + j) * QS + tn * 16 + li] = f2bf(Sm[q][j]);
            }
            if (tid < 192) hv = sXr[64 * 64 + tid];
        }
        lds_barrier();
    }
    store_pend(31);
}

__device__ __forceinline__ void gla_item(CP P, int l, int it, ldsf lds) {
    const int tid = opaque_tid(), wave = tid >> 6, lane = tid & 63, li = lane & 15, kq = lane >> 4;
    const int b = it >> 3, h = (it >> 1) & 3, vs = it & 1;
    constexpr int SS = 72;
    const ldsh Qgb = (ldsh)lds, Kgb = Qgb + 64 * SS, Kgtb = Kgb + 64 * SS, Vtb = Kgtb + 64 * SS, Attb = Vtb + 64 * SS, Stb = Attb + 64 * SS;
    const ldsf sQ = (ldsf)(Stb + 2 * 64 * SS), sK = sQ + 64 * 65, sCum = sK + 64 * 65, sGl = sCum + 64 * 65, sW2 = sGl + 64 * 17, sGb = sW2 + 16 * 64, sSeg = sGb + 64, sDec = sSeg + 8 * 64;
    const float* gw2 = LP(P, l, I_GK_W2); const float* gb = LP(P, l, I_GK_B);
    for (int e = tid; e < 16 * 64; e += 512) sW2[e] = gw2[(e >> 6) * 256 + h * 64 + (e & 63)];
    if (tid < 64) sGb[tid] = gb[h * 64 + tid];
    for (int e = tid; e < 64 * SS / 2; e += 512) ((LAS unsigned*)Attb)[e] = 0u;
    for (int e = tid; e < 2 * 64 * SS / 2; e += 512) ((LAS unsigned*)Stb)[e] = 0u;
    f32x4 Sm[2] = {{0.f, 0.f, 0.f, 0.f}, {0.f, 0.f, 0.f, 0.f}};
    uint4 qraw, kraw, xr, gr = make_uint4(0u, 0u, 0u, 0u);
    auto issue_loads = [&](int nn) {
        const int row = tid >> 3, cg = (tid & 7) * 8; const bf16_t* pr = P->proj + (size_t)(b * SEQL + nn * 64 + row) * LDP + h * 64 + cg;
        qraw = *(const uint4*)(pr + C_GQ); kraw = *(const uint4*)(pr + C_GK);
        xr = *(const uint4*)(P->proj + (size_t)(b * SEQL + nn * 64 + row) * LDP + C_GV + h * 128 + vs * 64 + cg);
        if (tid < 128) gr = *(const uint4*)(P->proj + (size_t)(b * SEQL + nn * 64 + (tid >> 1)) * LDP + C_GGK + (tid & 1) * 8);
    };
    bf16_t pend[2][4] = {{0, 0, 0, 0}, {0, 0, 0, 0}};
    auto store_pend = [&](int nprev) {
#pragma unroll
        for (int q = 0; q < 2; ++q) { const int tile = wave + q * 8, tl = tile >> 2, tv = tile & 3;
#pragma unroll
            for (int j = 0; j < 4; ++j) P->proj[(size_t)(b * SEQL + nprev * 64 + tl * 16 + kq * 4 + j) * LDP + C_GV + h * 128 + vs * 64 + tv * 16 + li] = pend[q][j]; }
    };
    issue_loads(0);
    __syncthreads();
    for (int n = 0; n < 32; ++n) {
        const int t0 = b * SEQL + n * 64, pb = n & 1;
        {
            const int row = tid >> 3, cg = (tid & 7) * 8;
            float f[8]; unpack8(qraw, f);
#pragma unroll
            for (int e = 0; e < 8; ++e) sQ[row * 65 + cg + e] = f[e] * 0.125f;
            unpack8(kraw, f);
#pragma unroll
            for (int e = 0; e < 8; ++e) sK[row * 65 + cg + e] = f[e];
            {
                const unsigned w4[4] = {xr.x, xr.y, xr.z, xr.w};
#pragma unroll
                for (int e = 0; e < 8; ++e) Vtb[(cg + e) * SS + row] = (bf16_t)((e & 1) ? (w4[e >> 1] >> 16) : (w4[e >> 1] & 0xffffu));
            }
            if (tid < 128) {
                unpack8(gr, f);
#pragma unroll
                for (int e = 0; e < 8; ++e) sGl[(tid >> 1) * 17 + (tid & 1) * 8 + e] = f[e];
            }
        }
        if (n > 0) store_pend(n - 1);
        if (n + 1 < 32) issue_loads(n + 1);
        lds_barrier();
        for (int e = tid; e < 4096; e += 512) {
            const int s = e >> 6, d = e & 63; float gk = sGb[d];
#pragma unroll
            for (int r = 0; r < 16; ++r) gk += sGl[s * 17 + r] * sW2[r * 64 + d];
            sCum[s * 65 + d] = logsigmoid_fast(gk) * 0.0625f;
        }
        lds_barrier();
        const int d = tid & 63, seg = tid >> 6;
        {
            float run = 0.f;
#pragma unroll
            for (int r = 0; r < 8; ++r) { run += sCum[(seg * 8 + r) * 65 + d]; sCum[(seg * 8 + r) * 65 + d] = run; }
            sSeg[seg * 64 + d] = run;
        }
        lds_barrier();
        {
            float off = 0.f;
            for (int s2 = 0; s2 < seg; ++s2) off += sSeg[s2 * 64 + d];
            float kg[8];
#pragma unroll
            for (int r = 0; r < 8; ++r) {
                const int s = seg * 8 + r; const float c = sCum[s * 65 + d] + off;
                const float ec = __expf(c);
                Qgb[s * SS + d] = f2bf(sQ[s * 65 + d] * ec);
                kg[r] = sK[s * 65 + d] * __expf(-c);
                Kgb[s * SS + d] = f2bf(kg[r]);
                if (s == 63) sDec[d] = ec;
            }
            u32x4 o; o.x = pk2(kg[0], kg[1]); o.y = pk2(kg[2], kg[3]); o.z = pk2(kg[4], kg[5]); o.w = pk2(kg[6], kg[7]);
            *(LAS u32x4*)(Kgtb + d * SS + seg * 8) = o;
        }
        lds_barrier();
        for (int idx = wave; idx < 10; idx += 8) {
            int tl, ts; tri_tile(idx, tl, ts);
            const f32x4 a = mmb(64, Qgb + tl * 16 * SS, SS, Kgb + ts * 16 * SS, SS, (f32x4){0.f, 0.f, 0.f, 0.f}, li, kq);
#pragma unroll
            for (int j = 0; j < 4; ++j) { const int lr = tl * 16 + kq * 4 + j, sc = ts * 16 + li; Attb[lr * SS + sc] = f2bf((sc <= lr) ? a[j] : 0.f); }
        }
        lds_barrier();
        {
            const f32x4 z4 = {0.f, 0.f, 0.f, 0.f};
#pragma unroll
            for (int q = 0; q < 2; ++q) {
                const int tile = wave + q * 8, tl = tile >> 2, tv = tile & 3;
                f32x4 a = mmb(64, Attb + tl * 16 * SS, SS, Vtb + tv * 16 * SS, SS, z4, li, kq);
                a = mmb(64, Qgb + tl * 16 * SS, SS, Stb + pb * 64 * SS + tv * 16 * SS, SS, a, li, kq);
#pragma unroll
                for (int j = 0; j < 4; ++j) pend[q][j] = f2bf(a[j]);
            }
#pragma unroll
            for (int q = 0; q < 2; ++q) {
                const int tile = wave + q * 8, td = tile >> 2, tv = tile & 3;
                const f32x4 u = mmb(64, Kgtb + td * 16 * SS, SS, Vtb + tv * 16 * SS, SS, z4, li, kq);
#pragma unroll
                for (int j = 0; j < 4; ++j) Sm[q][j] = sDec[td * 16 + kq * 4 + j] * (Sm[q][j] + u[j]);
                u32x2 o; o.x = pk2(Sm[q][0], Sm[q][1]); o.y = pk2(Sm[q][2], Sm[q][3]);
                *(LAS u32x2*)(Stb + (pb ^ 1) * 64 * SS + (tv * 16 + li) * SS + td * 16 + kq * 4) = o;
            }
        }
        lds_barrier();
    }
    store_pend(31);
}

#ifndef ITEM_MASK
#define ITEM_MASK 15
#endif
template <int IM = ITEM_MASK> __device__ __forceinline__ void scan_phase(CP P, int l, ldsf lds) {
    for (int it = blockIdx.x; it < N_ITEMS; it += gridDim.x) {
        if (it < N_RW) { if (IM & 1) rwkv_scan_item(P, l, it, lds); }
        else if (it < N_RW + 64) { if (IM & 2) mlstm_item(P, l, it - N_RW, lds); }
        else if (it < N_RW + 96) { if (IM & 4) ssd_item(P, l, it - N_RW - 64, lds); }
        else { if (IM & 8) gla_item(P, l, it - N_RW - 96, lds); }
        __syncthreads();
    }
}

__device__ __forceinline__ void finalize_phase(CP P, int l) {
    const Cols C = cols(l); const int wave = threadIdx.x >> 6, lane = threadIdx.x & 63, c8 = lane * 8;
    const float* gla_g = LP(P, l, I_GLA_NG); const float* mu = LP(P, l, I_RW_MU); const float* k_a = LP(P, l, I_RW_KA); const float* r_k = LP(P, l, I_RW_RK);
    const float* ln_g = LP(P, l, I_RW_LNG); const float* ln_b = LP(P, l, I_RW_LNB); const float* ssd_g = LP(P, l, I_SSD_NG); const float* ml_g = LP(P, l, I_ML_NG);
    for (int t = blockIdx.x * 8 + wave; t < M_TOK; t += gridDim.x * 8) {
        const bf16_t* pr = P->proj + (size_t)t * LDP; bf16_t* yo = P->actA + (size_t)t * DM;
        float a[8], z[8], y[8];
        {
            load8(pr + C_GV + c8, a); load8(pr + C_GZ + c8, z);
            float ss = 0.f;
#pragma unroll
            for (int e = 0; e < 8; ++e) ss += a[e] * a[e];
            ss += __shfl_xor(ss, 1); ss += __shfl_xor(ss, 2); ss += __shfl_xor(ss, 4); ss += __shfl_xor(ss, 8);
            const float rstd = rsqrtf(ss * (1.f / 128.f) + 1e-6f);
#pragma unroll
            for (int e = 0; e < 8; ++e) y[e] = a[e] * rstd * gla_g[c8 + e] * siluf(z[e]);
            store8(yo + c8, y);
        }
        {
            load8(pr + C.rw + 1024 + c8, a); load8(pr + C.rwz + c8, z);
            float s = 0.f;
#pragma unroll
            for (int e = 0; e < 8; ++e) s += a[e];
            s += __shfl_xor(s, 1); s += __shfl_xor(s, 2); s += __shfl_xor(s, 4);
            const float mean = s * (1.f / 64.f); float vs = 0.f;
#pragma unroll
            for (int e = 0; e < 8; ++e) { a[e] -= mean; vs += a[e] * a[e]; }
            vs += __shfl_xor(vs, 1); vs += __shfl_xor(vs, 2); vs += __shfl_xor(vs, 4);
            const float rstd = rsqrtf(vs * (1.f / 64.f) + 64e-5f);
            alignas(16) float vv[8];
            *(float4*)vv = *(const float4*)(P->rwV + (size_t)t * 512 + c8); *(float4*)(vv + 4) = *(const float4*)(P->rwV + (size_t)t * 512 + c8 + 4);
            const float bs = P->bon[(size_t)t * 8 + (lane >> 3)];
#pragma unroll
            for (int e = 0; e < 8; ++e) y[e] = (a[e] * rstd * ln_g[c8 + e] + ln_b[c8 + e] + bs * vv[e]) * siluf(z[e]);
            store8(yo + 512 + c8, y);
        }
        {
            load8(pr + C.sx + c8, a); load8(pr + C.sz + c8, z);
            float ss = 0.f;
#pragma unroll
            for (int e = 0; e < 8; ++e) { a[e] *= siluf(z[e]); ss += a[e] * a[e]; }
            ss = wave_sum(ss);
            const float rstd = rsqrtf(ss * (1.f / 512.f) + 1e-6f);
#pragma unroll
            for (int e = 0; e < 8; ++e) y[e] = a[e] * rstd * ssd_g[c8 + e];
            store8(yo + 1024 + c8, y);
        }
        {
            float o[8];
            load8(pr + C.mv + c8, a); load8(pr + C.mo + c8, o); load8(pr + C.mz + c8, z);
            float s = 0.f;
#pragma unroll
            for (int e = 0; e < 8; ++e) { a[e] *= sigmoidf_(o[e]); s += a[e]; }
            s += __shfl_xor(s, 1); s += __shfl_xor(s, 2); s += __shfl_xor(s, 4); s += __shfl_xor(s, 8);
            const float mean = s * (1.f / 128.f); float vs = 0.f;
#pragma unroll
            for (int e = 0; e < 8; ++e) { a[e] -= mean; vs += a[e] * a[e]; }
            vs += __shfl_xor(vs, 1); vs += __shfl_xor(vs, 2); vs += __shfl_xor(vs, 4); vs += __shfl_xor(vs, 8);
            const float rstd = rsqrtf(vs * (1.f / 128.f) + 1e-6f);
#pragma unroll
            for (int e = 0; e < 8; ++e) y[e] = a[e] * rstd * ml_g[c8 + e] * siluf(z[e]);
            store8(yo + 1536 + c8, y);
        }
    }
}

__device__ __forceinline__ void final_norm(CP P) {
    const int wave = threadIdx.x >> 6, lane = threadIdx.x & 63, rstep = gridDim.x * 8; const float4* gr = (const float4*)P->in[57];
    float4 gg[8];
#pragma unroll
    for (int i = 0; i < 8; ++i) gg[i] = gr[lane + i * 64];
    int row = blockIdx.x * 8 + wave;
    float4 cur[8], nxt[8]; float sc = 0.f, sn = 0.f;
    if (row < M_TOK) {
#pragma unroll
        for (int i = 0; i < 8; ++i) cur[i] = ((const float4*)(P->out + (size_t)row * DM))[lane + i * 64];
        sc = (lane < XSSN) ? P->xss2[(size_t)row * XSSN + lane] : 0.f;
    }
    for (; row < M_TOK; row += rstep) {
        const int rn = row + rstep < M_TOK ? row + rstep : row;
#pragma unroll
        for (int i = 0; i < 8; ++i) nxt[i] = ((const float4*)(P->out + (size_t)rn * DM))[lane + i * 64];
        sn = (lane < XSSN) ? P->xss2[(size_t)rn * XSSN + lane] : 0.f;
        const float rstd = rsqrtf(wave_sum(sc) * (1.f / DM) + 1e-6f);
        float4* xr = (float4*)(P->out + (size_t)row * DM);
#pragma unroll
        for (int i = 0; i < 8; ++i) { float4 v = cur[i]; v.x *= rstd * gg[i].x; v.y *= rstd * gg[i].y; v.z *= rstd * gg[i].z; v.w *= rstd * gg[i].w; xr[lane + i * 64] = v; }
#pragma unroll
        for (int i = 0; i < 8; ++i) cur[i] = nxt[i];
        sc = sn;
    }
}

#define XB_TMO      128
#define XB_XCNT(j)  (256  + 64 * (j))
#define XB_XSUB(j)  (1280 + 64 * (j))
#define XB_XGEN(j)  (2304 + 64 * (j))
#define XB_TOP      3328
#define XB_TOPGEN   3392
#define XCD_BAR_WORDS 3456
#define XB_SPIN_CAP (1u << 18)

__device__ __forceinline__ unsigned xb_ld(unsigned* p)              { return __hip_atomic_load(p, __ATOMIC_RELAXED, __HIP_MEMORY_SCOPE_AGENT); }
__device__ __forceinline__ unsigned xb_add(unsigned* p, unsigned v) { return __hip_atomic_fetch_add(p, v, __ATOMIC_RELAXED, __HIP_MEMORY_SCOPE_AGENT); }
__device__ __forceinline__ unsigned xb_xcc_id() { return (unsigned)__builtin_amdgcn_s_getreg((3 << 11) | 20) & 0xFu; }
#define XB_SPIN(cond, bar) do { unsigned _sp = 0; while (cond) { __builtin_amdgcn_s_sleep(1); \
    if ((++_sp & 255u) == 0u) { if (xb_ld(&(bar)[XB_TMO])) break; if (_sp > XB_SPIN_CAP) { atomicAdd(&(bar)[XB_TMO], 1u); break; } } } } while (0)

struct XcdBarrier {
    unsigned* bar; unsigned x;
    volatile LAS unsigned* st;
};

__device__ __forceinline__ XcdBarrier xcd_barrier_post(unsigned* bar, volatile LAS unsigned* st) {
    XcdBarrier b; b.bar = bar; b.x = xb_xcc_id(); b.st = st;
    if (threadIdx.x == 0) (void)xb_add(&bar[XB_XCNT(b.x)], 1u);
    return b;
}
__device__ __forceinline__ void xcd_barrier_complete(unsigned* bar, unsigned x, unsigned& nloc, unsigned& nx) {
    const unsigned G = gridDim.x * gridDim.y * gridDim.z;
    unsigned sum, cnt, mine, sp = 0u;
    for (;;) {
        sum = 0u; cnt = 0u; mine = 0u;
#pragma unroll
        for (unsigned j = 0; j < 16; ++j) { const unsigned c = xb_ld(&bar[XB_XCNT(j)]); sum += c; cnt += (c > 0u) ? 1u : 0u; mine = (j == x) ? c : mine; }
        if (sum == G) break;
        __builtin_amdgcn_s_sleep(1);
        if ((++sp & 255u) == 0u) { if (xb_ld(&bar[XB_TMO])) break; if (sp > XB_SPIN_CAP) { atomicAdd(&bar[XB_TMO], 1u); break; } }
    }
    nloc = mine > 0u ? mine : 1u; nx = cnt > 0u ? cnt : 1u;
}

__device__ __forceinline__ void xcd_barrier(const XcdBarrier& b) {
    asm volatile("s_waitcnt vmcnt(0)" ::: "memory");
    __syncthreads();
    if (threadIdx.x == 0) {
        unsigned* bar = b.bar;
        __builtin_amdgcn_s_waitcnt(0);
        unsigned nloc = b.st[0], nx = b.st[1];
        if (nloc == 0u) { xcd_barrier_complete(bar, b.x, nloc, nx); b.st[0] = nloc; b.st[1] = nx; }
        const unsigned old = xb_add(&bar[XB_XSUB(b.x)], 1u);
        const unsigned gen = old / nloc;
        if (old + 1u == (gen + 1u) * nloc) {
            __builtin_amdgcn_fence(__ATOMIC_RELEASE, "agent");
            asm volatile("s_waitcnt vmcnt(0)" ::: "memory");
            const unsigned og = xb_add(&bar[XB_TOP], 1u);
            const unsigned tg = og / nx;
            if (og + 1u == (tg + 1u) * nx) xb_add(&bar[XB_TOPGEN], 1u);
            else XB_SPIN(xb_ld(&bar[XB_TOPGEN]) == tg, bar);
            __builtin_amdgcn_fence(__ATOMIC_ACQUIRE, "agent");
            xb_add(&bar[XB_XGEN(b.x)], 1u);
            asm volatile("s_waitcnt vmcnt(0)" ::: "memory");
        } else {
            XB_SPIN(xb_ld(&bar[XB_XGEN(b.x)]) == gen, bar);
            __builtin_amdgcn_fence(__ATOMIC_ACQUIRE, "agent");
            asm volatile("s_waitcnt vmcnt(0)" ::: "memory");
        }
    }
    __syncthreads();
}


template <bool PRE> __device__ __forceinline__ void gemm_inproj(CP P, const bf16_t* A, const float* xss, PG8_LAS unsigned char* lds) {
    pg8::Gemm g; g.A = A; g.Bt = P->Wi; g.M = M_TOK; g.N = LDP; g.K = DM;
    pg8::StaticOrder S; S.init(g.M, g.N, (int)gridDim.x, (int)blockIdx.x);
    EpiProj<PRE> E; E.O = P->proj; E.xss = xss;
    pg8::gemm_phase<EpiProj<PRE>, pg8::StaticOrder, false>(lds, g, S, E, nullptr);
}
__device__ __forceinline__ void gemm_outproj(CP P, const bf16_t* Wo, const float* xin, bf16_t* xb, float* xss, PG8_LAS unsigned char* lds) {
    pg8::Gemm g; g.A = P->actA; g.Bt = Wo; g.M = M_TOK; g.N = DM; g.K = DM;
    pg8::StaticOrder S; S.init(g.M, g.N, (int)gridDim.x, (int)blockIdx.x);
    EpiOut E; E.xin = xin; E.xout = P->out; E.xb = xb; E.xss = xss;
    pg8::gemm_phase<EpiOut, pg8::StaticOrder, false>(lds, g, S, E, nullptr);
}

#ifndef PROBE_DUP
#define PROBE_DUP 0
#endif
#ifndef PH_MASK
#define PH_MASK 0xFFF
#endif
#define RUN_PHASE(k, body) do { if ((PH_MASK >> (k)) & 1) { if (ph_lo <= (k) && (k) < ph_hi) { CP P = Pc; asm volatile("" : "+s"(P)); body; if ((PROBE_DUP >> (k)) & 1) { __syncthreads(); body; } if (coop && (k) + 1 < ph_hi) { if (coop == 2) grid.sync(); else xcd_barrier(xb); } } } } while (0)
__global__ void __launch_bounds__(512, 2) mega(Params Pk, int ph_lo, int ph_hi, int coop) {
    extern __shared__ __attribute__((aligned(16))) unsigned char shm[];
    PG8_LAS unsigned char* ldsb = (PG8_LAS unsigned char*)shm; ldsf lds = (ldsf)shm;
    cg::grid_group grid = cg::this_grid();
    const CP Pc = (CP)__builtin_amdgcn_kernarg_segment_ptr();
    volatile LAS unsigned* stw = (volatile LAS unsigned*)(shm + LDS_BYTES - 16);
    if (threadIdx.x < 4) stw[threadIdx.x] = 0u;
    __syncthreads();
    XcdBarrier xb = xcd_barrier_post(Pc->bar, stw);
    RUN_PHASE(0, { transpose_convert(P->in[2], DM, 7840, LDP, P->Wi, P->in[1], lds); x_convert(P); lora_convert(P); });
#ifdef PROBE_PRE
    { CP P = Pc; asm volatile("" : "+s"(P)); gemm_inproj<true>(P, P->actA, P->xss0, ldsb); grid.sync(); rwkv_prep(P, 0, lds); grid.sync(); scan_phase<PROBE_PRE>(P, 0, lds); grid.sync(); }
#endif
    RUN_PHASE(1, { gemm_inproj<true>(P, P->actA, P->xss0, ldsb);
                   const int nfull = (M_TOK / 256) * (LDP / 256) % (int)gridDim.x;
                   if (nfull > 0 && (int)blockIdx.x >= nfull) transpose_convert(P->in[3], DM, DM, DM, P->Wo0, nullptr, lds, (int)blockIdx.x - nfull, (int)gridDim.x - nfull);
                   else if (nfull == 0) transpose_convert(P->in[3], DM, DM, DM, P->Wo0, nullptr, lds); });
    RUN_PHASE(2, rwkv_prep(P, 0, lds));
    RUN_PHASE(3, scan_phase(P, 0, lds));
    RUN_PHASE(4, { finalize_phase(P, 0); transpose_convert(P->in[29], DM, 7872, LDP, P->Wi, P->in[28], lds); });
    RUN_PHASE(5, gemm_outproj(P, P->Wo0, P->in[0], P->xb1, P->xss1, ldsb));
    RUN_PHASE(6, { gemm_inproj<false>(P, P->xb1, P->xss1, ldsb);
                   const int nfull = (M_TOK / 256) * (LDP / 256) % (int)gridDim.x;
                   if (nfull > 0 && (int)blockIdx.x >= nfull) transpose_convert(P->in[30], DM, DM, DM, P->Wo1, nullptr, lds, (int)blockIdx.x - nfull, (int)gridDim.x - nfull);
                   else if (nfull == 0) transpose_convert(P->in[30], DM, DM, DM, P->Wo1, nullptr, lds); });
    RUN_PHASE(7, rwkv_prep(P, 1, lds));
    RUN_PHASE(8, scan_phase(P, 1, lds));
    RUN_PHASE(9, finalize_phase(P, 1));
    RUN_PHASE(10, gemm_outproj(P, P->Wo1, P->out, nullptr, P->xss2, ldsb));
    RUN_PHASE(11, final_norm(P));
}

#ifndef MK_COOP
#define MK_COOP 1
#endif
extern "C" void kernel_launch(void* const* d_in, const int* in_sizes, int n_in, void* d_out, int out_size, void* d_ws, size_t ws_size, hipStream_t stream) {
    Params p{};
    for (int i = 0; i < 58; ++i) p.in[i] = (const float*)d_in[i];
    p.out = (float*)d_out;
    char* w = (char*)d_ws; size_t off = 0;
    auto take = [&](size_t bytes) { char* r = w + off; off += (bytes + 255) & ~(size_t)255; return r; };
    p.Wi = (bf16_t*)take((size_t)LDP * DM * 2);
    p.Wo0 = (bf16_t*)take((size_t)DM * DM * 2);
    p.Wo1 = (bf16_t*)take((size_t)DM * DM * 2);
    p.actA = (bf16_t*)take((size_t)M_TOK * DM * 2);
    p.proj = (bf16_t*)take((size_t)M_TOK * LDP * 2);
    p.rwA = (float*)take((size_t)M_TOK * 512 * 4);
    p.rwB = (float*)take((size_t)M_TOK * 512 * 4);
    p.xb1 = (bf16_t*)p.rwA;
    p.rwV = (float*)take((size_t)M_TOK * 512 * 4);
    p.xss0 = (float*)take((size_t)M_TOK * XSSN * 4);
    p.xss1 = (float*)take((size_t)M_TOK * XSSN * 4);
    p.xss2 = (float*)take((size_t)M_TOK * XSSN * 4);
    p.bar = (unsigned*)take((size_t)XCD_BAR_WORDS * 4);
    p.lora = (bf16_t*)take((size_t)LORA_ELEMS * 2);
    p.bon = (float*)take((size_t)M_TOK * 8 * 4);
    if (off > ws_size) { fprintf(stderr, "workspace too small: need %zu have %zu\n", off, ws_size); return; }
    static int grid_blocks = 0;
    if (!grid_blocks) {
        hipFuncSetAttribute((const void*)mega, hipFuncAttributeMaxDynamicSharedMemorySize, LDS_BYTES);
        int dev = 0, cus = 0, per_cu = 0;
        hipGetDevice(&dev);
        hipDeviceGetAttribute(&cus, hipDeviceAttributeMultiprocessorCount, dev);
        hipOccupancyMaxActiveBlocksPerMultiprocessor(&per_cu, mega, 512, LDS_BYTES);
        if (per_cu > 1) per_cu = 1;
        grid_blocks = cus * per_cu;
        if (grid_blocks <= 0) grid_blocks = 256;
    }
#if MK_COOP
    hipMemsetAsync(p.bar, 0, (size_t)XCD_BAR_WORDS * 4, stream);
    int lo = 0, hi = N_PHASES, coop = 1;
    void* args[] = {&p, &lo, &hi, &coop};
    hipError_t e = hipLaunchCooperativeKernel((const void*)mega, dim3(grid_blocks), dim3(512), args, LDS_BYTES, stream);
    if (e != hipSuccess) fprintf(stderr, "cooperative launch failed: %s (grid %d)\n", hipGetErrorString(e), grid_blocks);
#else
    for (int ph = 0; ph < N_PHASES; ++ph) hipLaunchKernelGGL(mega, dim3(grid_blocks), dim3(512), LDS_BYTES, stream, p, ph, ph + 1, 0);
#endif
}
```
